# Optimizing an MI355X kernel written in HIP

```python
import jax, jax.numpy as jnp
from jax import lax
import numpy as np

D_MODEL = 2048
BATCH = 2
SEQ = 4096
DEPTH = 1

GRID_W = 64
ROPE_THETA = 10000.0
RMS_EPS = 1e-6
Q_BLOCK = 128

N_HEADS_A = 8
N_KV_A = 2
HEAD_DIM_A = 128
GROUPS_A = N_HEADS_A // N_KV_A

N_HEADS_B = 8
Q_LORA = 512
KV_LORA = 512
NOPE_DIM_B = 128
ROPE_DIM_B = 64
V_DIM_B = 128
QK_DIM_B = NOPE_DIM_B + ROPE_DIM_B

D_FF = ((8 * D_MODEL // 3 + 255) // 256) * 256

PLE_DIM = 256

COL_SIZES = (
    N_HEADS_A * HEAD_DIM_A,
    N_KV_A * HEAD_DIM_A,
    N_KV_A * HEAD_DIM_A,
    Q_LORA,
    KV_LORA,
    ROPE_DIM_B,
    D_MODEL,
    D_MODEL,
)
IN_COLS = sum(COL_SIZES)
SPLITS = tuple(int(s) for s in np.cumsum(COL_SIZES)[:-1])

kernel_name = "hybrid_gqa_mla_gated_encoder_block"


def rmsnorm(x, g):
    x32 = x.astype(jnp.float32)
    y = x32 * lax.rsqrt(jnp.mean(x32 * x32, axis=-1, keepdims=True) + RMS_EPS)
    return (y * g.astype(jnp.float32)).astype(x.dtype)


def axial_angles(row, col, d):
    half = d // 2
    inv = 1.0 / (ROPE_THETA ** (jnp.arange(0, half, 2, dtype=jnp.float32) / half))
    return row[:, None] * inv[None, :], col[:, None] * inv[None, :]


def rotate(x, ang):
    n2 = x.shape[-1] // 2
    cos = jnp.cos(ang)[:, None, :].astype(x.dtype)
    sin = jnp.sin(ang)[:, None, :].astype(x.dtype)
    x1, x2 = x[..., :n2], x[..., n2:]
    return jnp.concatenate([x1 * cos - x2 * sin, x2 * cos + x1 * sin], axis=-1)


def axial_rope(x, ang_r, ang_c):
    half = x.shape[-1] // 2
    return jnp.concatenate([rotate(x[..., :half], ang_r), rotate(x[..., half:], ang_c)], axis=-1)


def block_attention(q, k, v, scale):
    b, s, hk, g, dk = q.shape
    nb = s // Q_BLOCK
    qb = q.reshape(b, nb, Q_BLOCK, hk, g, dk).transpose(1, 0, 2, 3, 4, 5)

    def one_block(qi):
        sc = jnp.einsum('bqhgd,bkhd->bhgqk', qi, k).astype(jnp.float32) * scale
        pr = jax.nn.softmax(sc, axis=-1).astype(v.dtype)
        return jnp.einsum('bhgqk,bkhd->bqhgd', pr, v)

    o = lax.map(one_block, qb)
    return o.transpose(1, 0, 2, 3, 4, 5).reshape(b, s, hk * g, v.shape[-1])


def setup_inputs(seed: int = 0) -> dict:
    key = jax.random.key(seed)
    ks = jax.random.split(key, 32)
    f32 = jnp.float32

    def w(k, shape, fan_in):
        return jax.random.normal(k, shape, f32) * (fan_in ** -0.5)

    def gain(k, n):
        return 1.0 + 0.02 * jax.random.normal(k, (DEPTH, n), f32)

    return {
        "x": jax.random.normal(ks[0], (BATCH, SEQ, D_MODEL), f32),
        "p": jax.random.normal(ks[1], (DEPTH, BATCH, SEQ, PLE_DIM), f32),
        "g_mix": gain(ks[2], D_MODEL),
        "w_in": w(ks[3], (DEPTH, D_MODEL, IN_COLS), D_MODEL),
        "q_norm_a": gain(ks[4], HEAD_DIM_A),
        "k_norm_a": gain(ks[5], HEAD_DIM_A),
        "q_a_norm": gain(ks[6], Q_LORA),
        "w_q_b": w(ks[7], (DEPTH, Q_LORA, N_HEADS_B * QK_DIM_B), Q_LORA),
        "kv_a_norm": gain(ks[8], KV_LORA),
        "w_kv_b": w(ks[9], (DEPTH, KV_LORA, N_HEADS_B * (NOPE_DIM_B + V_DIM_B)), KV_LORA),
        "w_a_out": w(ks[10], (DEPTH, N_HEADS_A * HEAD_DIM_A, D_MODEL), N_HEADS_A * HEAD_DIM_A),
        "w_b_out": w(ks[11], (DEPTH, N_HEADS_B * V_DIM_B, D_MODEL), N_HEADS_B * V_DIM_B),
        "w_o": w(ks[12], (DEPTH, D_MODEL, D_MODEL), D_MODEL),
        "g_ffn": gain(ks[13], D_MODEL),
        "w_gate_up": w(ks[14], (DEPTH, D_MODEL, 2 * D_FF), D_MODEL),
        "w_down": w(ks[15], (DEPTH, D_FF, D_MODEL), D_FF),
        "g_ple": gain(ks[16], D_MODEL),
        "w_ple_gate": w(ks[17], (DEPTH, D_MODEL, D_MODEL), D_MODEL),
        "w_ple_proj": w(ks[18], (DEPTH, PLE_DIM, D_MODEL), PLE_DIM),
        "g_ple_post": gain(ks[19], D_MODEL),
        "g_final": 1.0 + 0.02 * jax.random.normal(ks[20], (D_MODEL,), f32),
    }


def reference(x, p, g_mix, w_in, q_norm_a, k_norm_a, q_a_norm, w_q_b, kv_a_norm, w_kv_b,
              w_a_out, w_b_out, w_o, g_ffn, w_gate_up, w_down, g_ple, w_ple_gate,
              w_ple_proj, g_ple_post, g_final):
    b, s, _ = x.shape
    rows = s // GRID_W
    row = jnp.repeat(jnp.arange(rows, dtype=jnp.float32), GRID_W)
    col = jnp.tile(jnp.arange(GRID_W, dtype=jnp.float32), rows)
    ang_ra, ang_ca = axial_angles(row, col, HEAD_DIM_A)
    ang_rb, ang_cb = axial_angles(row, col, ROPE_DIM_B)

    h = x
    for i in range(DEPTH):
        u = rmsnorm(h, g_mix[i])
        z = u @ w_in[i]
        qa, ka, va, cq, ckv, kr, ga, gb = jnp.split(z, SPLITS, axis=-1)

        qa = rmsnorm(qa.reshape(b, s, N_HEADS_A, HEAD_DIM_A), q_norm_a[i])
        ka = rmsnorm(ka.reshape(b, s, N_KV_A, HEAD_DIM_A), k_norm_a[i])
        qa = axial_rope(qa, ang_ra, ang_ca)
        ka = axial_rope(ka, ang_ra, ang_ca)
        va = va.reshape(b, s, N_KV_A, HEAD_DIM_A)
        oa = block_attention(qa.reshape(b, s, N_KV_A, GROUPS_A, HEAD_DIM_A), ka, va,
                             HEAD_DIM_A ** -0.5)
        ya = oa.reshape(b, s, N_HEADS_A * HEAD_DIM_A) @ w_a_out[i]

        qb = (rmsnorm(cq, q_a_norm[i]) @ w_q_b[i]).reshape(b, s, N_HEADS_B, QK_DIM_B)
        q_nope, q_pe = qb[..., :NOPE_DIM_B], qb[..., NOPE_DIM_B:]
        q_pe = axial_rope(q_pe, ang_rb, ang_cb)
        kv = (rmsnorm(ckv, kv_a_norm[i]) @ w_kv_b[i]).reshape(b, s, N_HEADS_B, NOPE_DIM_B + V_DIM_B)
        k_nope, vb = kv[..., :NOPE_DIM_B], kv[..., NOPE_DIM_B:]
        k_pe = axial_rope(kr[:, :, None, :], ang_rb, ang_cb)
        k_pe = jnp.broadcast_to(k_pe, (b, s, N_HEADS_B, ROPE_DIM_B))
        q_full = jnp.concatenate([q_nope, q_pe], axis=-1)[:, :, :, None, :]
        k_full = jnp.concatenate([k_nope, k_pe], axis=-1)
        ob = block_attention(q_full, k_full, vb, QK_DIM_B ** -0.5)
        yb = ob.reshape(b, s, N_HEADS_B * V_DIM_B) @ w_b_out[i]

        merged = jax.nn.sigmoid(ga) * ya + jax.nn.sigmoid(gb) * yb
        h = h + merged @ w_o[i]

        gu = rmsnorm(h, g_ffn[i]) @ w_gate_up[i]
        g_, u_ = gu[..., :D_FF], gu[..., D_FF:]
        h = h + (jax.nn.silu(g_) * u_) @ w_down[i]

        e = rmsnorm(p[i] @ w_ple_proj[i], g_ple_post[i])
        gate = jax.nn.sigmoid(rmsnorm(h, g_ple[i]) @ w_ple_gate[i])
        h = h + gate * e

    return rmsnorm(h, g_final)
```

```cpp
#include <hip/hip_runtime.h>
#include <hip/hip_cooperative_groups.h>
#include <cstdio>
#include <cstdint>
namespace cg = cooperative_groups;

#ifndef ATT_SD_A
#define ATT_SD_A 1
#endif
#ifndef ATT_SD_B
#define ATT_SD_B 1
#endif
#ifndef MK_ONE_LAUNCH
#define MK_ONE_LAUNCH 1
#endif

#define LAS __attribute__((address_space(3)))
typedef unsigned short bf16_t;
typedef short bf16x8 __attribute__((ext_vector_type(8)));
typedef short s16x4 __attribute__((ext_vector_type(4)));
typedef float f32x4 __attribute__((ext_vector_type(4)));
typedef float f32x16 __attribute__((ext_vector_type(16)));
typedef unsigned u32x4 __attribute__((ext_vector_type(4)));
typedef unsigned u32x2 __attribute__((ext_vector_type(2)));

constexpr int DM = 2048, SEQ = 4096, M = 8192, DFF = 5632, PLE = 256, NIN = 6720, NINP = 6912;
constexpr float EPS = 1e-6f;
constexpr int NWAVES = 8, NTHREADS = 512;
constexpr int LDS_BYTES = 139264;

constexpr size_t MiB = 1u << 20;
constexpr size_t WS_WIN = 1 * MiB, WS_WQB = 28 * MiB, WS_WKVB = 30 * MiB, WS_WAB = 32 * MiB, WS_WO = 40 * MiB, WS_WGU = 48 * MiB, WS_WD = 92 * MiB,
                 WS_WPG = 114 * MiB, WS_WPP = 122 * MiB, WS_PB = 123 * MiB, WS_KR = 127 * MiB, WS_U = 128 * MiB, WS_ZS = 160 * MiB, WS_SG = 200 * MiB,
                 WS_QA = 264 * MiB, WS_QB = 280 * MiB, WS_KVB = 304 * MiB, WS_END = 344 * MiB;
constexpr size_t WS_CQN = 1 * MiB, WS_CKVN = 9 * MiB, WS_KA = 17 * MiB, WS_KPE = 21 * MiB;
constexpr size_t WS_T1 = 264 * MiB;
constexpr size_t WS_OAB = WS_U, WS_MERGED = WS_ZS, WS_ACT = 160 * MiB, WS_GATE = 160 * MiB, WS_ERAW = 280 * MiB;

typedef float f32x2_t __attribute__((ext_vector_type(2)));
typedef __bf16 bf16x2_t __attribute__((ext_vector_type(2)));
__device__ __forceinline__ unsigned cvt_pk_bf16(float lo, float hi) { f32x2_t v = {lo, hi}; bf16x2_t b = __builtin_convertvector(v, bf16x2_t); return __builtin_bit_cast(unsigned, b); }
__device__ __forceinline__ float bf_lo(unsigned w) { return __uint_as_float(w << 16); }
__device__ __forceinline__ float bf_hi(unsigned w) { return __uint_as_float(w & 0xffff0000u); }
__device__ __forceinline__ float bf1(bf16_t h) { return __uint_as_float(((unsigned)h) << 16); }
__device__ __forceinline__ bf16_t f2bf(float f) { unsigned u = __float_as_uint(f); return (bf16_t)((u + 0x7fffu + ((u >> 16) & 1u)) >> 16); }
__device__ __forceinline__ float sigmoidf_(float x) { return __builtin_amdgcn_rcpf(1.f + __expf(-x)); }
__device__ __forceinline__ float wave_sum(float v) {
#pragma unroll
    for (int o = 1; o < 64; o <<= 1) v += __shfl_xor(v, o);
    return v;
}

namespace pg8 {
constexpr int BM = 256, BK = 64, HALF = 128, HTB = HALF * BK * 2, STAGE_BYTES = 8 * HTB, NXCD = 8, WGM = 8;
__host__ __device__ __forceinline__ int lds_byte(int r, int c) { const int st = (r >> 4) * 2 + (c >> 5), rr = r & 15, cc = c & 31, ob = rr * 64 + cc * 2; return st * 1024 + (ob ^ (((ob >> 9) & 1) << 5)); }
__host__ __device__ __forceinline__ void stage_rc(int b, int& R, int& C) { const int st = b / 1024, sb = b % 1024, swz = sb ^ (((sb >> 9) & 1) << 5); R = (st >> 1) * 16 + swz / 64; C = (st & 1) * 32 + (swz % 64) / 2; }
__host__ __device__ __forceinline__ int perm32(int rho) { const int n = rho >> 4, i = rho & 15; return 8 * (i >> 2) + 4 * n + (i & 3); }
struct Unit { int pm, pn, kh; };
struct Gemm { const bf16_t* A; const bf16_t* Bt; int M, N, K, ld, koff; };
struct StaticOrder {
    int nM, nN, nwg, G, c;
    __host__ __device__ void init(int M_, int N_, int G_, int c_) { nM = M_ / BM; nN = N_ / BM; nwg = nM * nN; G = G_; c = c_; }
    __host__ __device__ bool next(int i, Unit& u) const {
        const long L = (long)i * G + c; if (L >= nwg) return false;
        int wgid = (int)L; { const int q = nwg / NXCD, r = nwg % NXCD, xcd = wgid % NXCD, off = wgid / NXCD; wgid = (xcd < r ? xcd * (q + 1) : r * (q + 1) + (xcd - r) * q) + off; }
        const int nig = WGM * nN, gid = wgid / nig, fm = gid * WGM, gsz = (nM - fm) < WGM ? (nM - fm) : WGM;
        u.pm = fm + ((wgid % nig) % gsz); u.pn = (wgid % nig) / gsz; u.kh = 0; return true;
    }
    __device__ __forceinline__ void a_ready(const Unit&) const {}
    __device__ __forceinline__ void done(const Unit&) const {}
};
struct DualOrder : StaticOrder {
    __host__ __device__ bool next(int i, Unit& u) const { if (!StaticOrder::next(i >> 1, u)) return false; u.kh = i & 1; return true; }
};
typedef f32x4 Acc[2][2][4][2];

__device__ __forceinline__ void store8(bf16_t* p, f32x4 v0, f32x4 v1) {
    u32x4 w; w.x = cvt_pk_bf16(v0[0], v0[1]); w.y = cvt_pk_bf16(v0[2], v0[3]); w.z = cvt_pk_bf16(v1[0], v1[1]); w.w = cvt_pk_bf16(v1[2], v1[3]);
    *(u32x4*)p = w;
}
struct EpiIn {
    static constexpr bool PERM = true, AFTER_DRAIN = false;
    bf16_t *ZS, *SG, *KR;
    __device__ __forceinline__ void operator()(const Acc& acc, const Unit& u, int wr, int wc, int fr, int fq) const {
        const int pn = u.pn; bf16_t* base; int ldc, colt; bool sig = false;
        if (pn < 10) { base = ZS; ldc = 2560; colt = pn * 256; }
        else if (pn < 26) { base = SG; ldc = 4096; colt = (pn - 10) * 256; sig = true; }
        else { base = KR; ldc = 64; colt = 0; }
        const int row0 = u.pm * BM + wr * 64 + fr, col0 = colt + wc * 32 + 8 * fq;
#pragma unroll
        for (int ai = 0; ai < 2; ++ai)
#pragma unroll
            for (int m = 0; m < 4; ++m) { bf16_t* rowp = base + (size_t)(row0 + ai * HALF + m * 16) * ldc + col0;
#pragma unroll
                for (int bj = 0; bj < 2; ++bj) {
                    if (pn == 26 && (bj == 1 || wc >= 2)) continue;
                    f32x4 v0 = acc[ai][bj][m][0], v1 = acc[ai][bj][m][1];
                    if (sig) {
#pragma unroll
                        for (int j = 0; j < 4; ++j) { v0[j] = sigmoidf_(v0[j]); v1[j] = sigmoidf_(v1[j]); } }
                    store8(rowp + bj * HALF, v0, v1); } }
    }
};
template <int ACT  > struct EpiBf16 {
    static constexpr bool PERM = true, AFTER_DRAIN = false;
    bf16_t* O; int ldc; const float* ssq;
    __device__ __forceinline__ void operator()(const Acc& acc, const Unit& u, int wr, int wc, int fr, int fq) const {
        const int row0 = u.pm * BM + wr * 64 + fr, col0 = u.pn * BM + wc * 32 + 8 * fq;
#pragma unroll
        for (int ai = 0; ai < 2; ++ai)
#pragma unroll
            for (int m = 0; m < 4; ++m) { bf16_t* rowp = O + (size_t)(row0 + ai * HALF + m * 16) * ldc + col0;
                const float r = ssq ? 1.0f / sqrtf(ssq[row0 + ai * HALF + m * 16] * (1.f / DM) + EPS) : 1.f;
#pragma unroll
                for (int bj = 0; bj < 2; ++bj) { f32x4 v0 = acc[ai][bj][m][0] * r, v1 = acc[ai][bj][m][1] * r;
                    if (ACT == 1) {
#pragma unroll
                        for (int j = 0; j < 4; ++j) { v0[j] = sigmoidf_(v0[j]); v1[j] = sigmoidf_(v1[j]); } }
                    store8(rowp + bj * HALF, v0, v1); } }
    }
};
struct EpiQB {
    static constexpr bool PERM = true, AFTER_DRAIN = false;
    bf16_t* O;
    __device__ __forceinline__ void operator()(const Acc& acc, const Unit& u, int wr, int wc, int fr, int fq) const {
        const int row0 = u.pm * BM + wr * 64 + fr, col0 = u.pn * BM + wc * 32 + 8 * fq;
        float inv[8];
#pragma unroll
        for (int t = 0; t < 8; ++t) inv[t] = __builtin_amdgcn_exp2f(-(float)(2 * ((fq & 1) * 8 + t)) * (13.287712379549449f / 32.f));
        const float sgn = (fq >= 2) ? 1.f : -1.f;
#pragma unroll
        for (int ai = 0; ai < 2; ++ai)
#pragma unroll
            for (int m = 0; m < 4; ++m) { const int row = row0 + ai * HALF + m * 16, sq = row & (SEQ - 1); const float prow = (float)(sq >> 6), pcol = (float)(sq & 63);
#pragma unroll
                for (int bj = 0; bj < 2; ++bj) { f32x4 v0 = acc[ai][bj][m][0], v1 = acc[ai][bj][m][1];
                    const int rel = (u.pn * BM + bj * HALF + wc * 32) % 192;
                    if (rel >= 128) { const float pos = (rel >= 160) ? pcol : prow;
#pragma unroll
                        for (int t = 0; t < 4; ++t) {
                            const float a0 = pos * inv[t], a1 = pos * inv[4 + t];
                            const float p0 = __shfl_xor(v0[t], 32), p1 = __shfl_xor(v1[t], 32);
                            v0[t] = v0[t] * __cosf(a0) + sgn * p0 * __sinf(a0); v1[t] = v1[t] * __cosf(a1) + sgn * p1 * __sinf(a1); } }
                    store8(O + (size_t)row * 1536 + col0 + bj * HALF, v0, v1); } }
    }
};
struct EpiGate {
    static constexpr bool PERM = true, AFTER_DRAIN = false;
    const bf16_t* SG; bf16_t* T1; bf16_t* O;
    __device__ __forceinline__ void operator()(const Acc& acc, const Unit& u, int wr, int wc, int fr, int fq) const {
        const int row0 = u.pm * BM + wr * 64 + fr, col0 = u.pn * BM + wc * 32 + 8 * fq; const bool second = (u.kh != 0);
#pragma unroll
        for (int ai = 0; ai < 2; ++ai)
#pragma unroll
            for (int m = 0; m < 4; ++m) { const size_t ro = (size_t)(row0 + ai * HALF + m * 16);
#pragma unroll
                for (int bj = 0; bj < 2; ++bj) {
                    const u32x4 b = *(const u32x4*)(SG + ro * 4096 + (second ? 2048 : 0) + col0 + bj * HALF);
                    f32x4 s0, s1;
                    s0[0] = bf_lo(b.x); s0[1] = bf_hi(b.x); s0[2] = bf_lo(b.y); s0[3] = bf_hi(b.y);
                    s1[0] = bf_lo(b.z); s1[1] = bf_hi(b.z); s1[2] = bf_lo(b.w); s1[3] = bf_hi(b.w);
                    bf16_t* tp = T1 + ro * 2048 + col0 + bj * HALF;
                    f32x4 v0 = acc[ai][bj][m][0] * s0, v1 = acc[ai][bj][m][1] * s1;
                    if (second) { const u32x4 tw = *(const u32x4*)tp;
                        v0[0] += bf_lo(tw.x); v0[1] += bf_hi(tw.x); v0[2] += bf_lo(tw.y); v0[3] += bf_hi(tw.y); v1[0] += bf_lo(tw.z); v1[1] += bf_hi(tw.z); v1[2] += bf_lo(tw.w); v1[3] += bf_hi(tw.w);
                        tp = O + ro * 2048 + col0 + bj * HALF; }
                    store8(tp, v0, v1); } }
    }
};
template <bool BASEBF> struct EpiResid {
    static constexpr bool PERM = false, AFTER_DRAIN = false;
    const float* basef; const bf16_t* baseb; bf16_t* HB; float* ssq;
    __device__ __forceinline__ void operator()(const Acc& acc, const Unit& u, int wr, int wc, int fr, int fq) const {
        const int row0 = u.pm * BM + wr * 64 + fr, col0 = u.pn * BM + wc * 32 + 4 * fq;
#pragma unroll
        for (int ai = 0; ai < 2; ++ai)
#pragma unroll
            for (int m = 0; m < 4; ++m) { const int row = row0 + ai * HALF + m * 16; const size_t ro = (size_t)row * DM + col0; float ss = 0.f;
#pragma unroll
                for (int bj = 0; bj < 2; ++bj)
#pragma unroll
                    for (int n = 0; n < 2; ++n) { const size_t o = ro + bj * HALF + n * 16;
                        f32x4 v = acc[ai][bj][m][n];
                        if constexpr (BASEBF) { const u32x2 bw = *(const u32x2*)(baseb + o); v = v + (f32x4){bf_lo(bw.x), bf_hi(bw.x), bf_lo(bw.y), bf_hi(bw.y)}; }
                        else v = v + *(const f32x4*)(basef + o);
                        u32x2 w; w.x = cvt_pk_bf16(v.x, v.y); w.y = cvt_pk_bf16(v.z, v.w);
                        *(u32x2*)(HB + o) = w; ss += (v.x * v.x + v.y * v.y) + (v.z * v.z + v.w * v.w); }
                ss += __shfl_xor(ss, 16); ss += __shfl_xor(ss, 32);
                if (fq == 0) (void)__hip_atomic_fetch_add((__attribute__((address_space(1))) float*)(ssq + row), ss, __ATOMIC_RELAXED, __HIP_MEMORY_SCOPE_AGENT); }
    }
};
struct EpiSwiglu {
    static constexpr bool PERM = true, AFTER_DRAIN = false;
    bf16_t* O; const float* ssq;
    __device__ __forceinline__ void operator()(const Acc& acc, const Unit& u, int wr, int wc, int fr, int fq) const {
        const int row0 = u.pm * BM + wr * 64 + fr, col0 = u.pn * HALF + wc * 32 + 8 * fq;
#pragma unroll
        for (int ai = 0; ai < 2; ++ai)
#pragma unroll
            for (int m = 0; m < 4; ++m) {
                f32x4 a0, a1; const float r = 1.0f / sqrtf(ssq[row0 + ai * HALF + m * 16] * (1.f / DM) + EPS);
#pragma unroll
                for (int j = 0; j < 4; ++j) { const float g0 = acc[ai][0][m][0][j] * r, g1 = acc[ai][0][m][1][j] * r;
                    a0[j] = g0 * sigmoidf_(g0) * (acc[ai][1][m][0][j] * r); a1[j] = g1 * sigmoidf_(g1) * (acc[ai][1][m][1][j] * r); }
                store8(O + (size_t)(row0 + ai * HALF + m * 16) * DFF + col0, a0, a1); }
    }
};

template <class Epi, class Sched, bool ALIGN_EPI, bool SP2, bool MID>
__device__ __forceinline__ void gemm_phase(LAS unsigned char* lds, const Gemm g, const Sched S, const Epi E) {
    const int tid = threadIdx.x, wid = __builtin_amdgcn_readfirstlane(tid >> 6), lane = tid & 63, wr = wid >> 2, wc = wid & 3, fr = lane & 15, fq = lane >> 4;
    const int K = g.ld, nt = g.K / BK;
    unsigned voffA[2], voffB[2];
#pragma unroll
    for (int i = 0; i < 2; ++i) { int R, C; stage_rc(tid * 16 + i * 8192, R, C); const int Rb = Epi::PERM ? ((R & ~31) + perm32(R & 31)) : R;
        voffA[i] = (unsigned)(R * K + C) * 2u; voffB[i] = (unsigned)(Rb * K + C) * 2u; }
    const size_t kstep = (size_t)(BK * 2);
    const size_t hstep = (size_t)HALF * K * 2;
    const size_t tstep = 2 * hstep;
    const unsigned ldsw = (unsigned)wid * 1024u;
    const int aoff = lds_byte(wr * 64 + fr, fq * 8), boff = lds_byte(wc * 32 + fr, fq * 8);
#define PG8_SA(b, h) (((b) * 2 + (h)) * HTB)
#define PG8_SB(b, h) ((4 + (b) * 2 + (h)) * HTB)
#define PG8_STAGE(bufoff, gbase, voff) do { _Pragma("unroll") for (int _i = 0; _i < 2; ++_i) \
        __builtin_amdgcn_global_load_lds((const unsigned*)((const char*)(gbase) + (voff)[_i]), (LAS unsigned*)(lds + (bufoff) + ldsw + _i * 8192), 16, 0, 0); } while (0)
#define PG8_LDA(dst, b, h) do { _Pragma("unroll") for (int m = 0; m < 4; ++m) _Pragma("unroll") for (int k = 0; k < 2; ++k) dst[m][k] = *(const LAS bf16x8*)(lds + PG8_SA(b, h) + aoff + m * 2048 + k * 1024); } while (0)
#define PG8_LDB(dst, b, h) do { _Pragma("unroll") for (int n = 0; n < 2; ++n) _Pragma("unroll") for (int k = 0; k < 2; ++k) dst[n][k] = *(const LAS bf16x8*)(lds + PG8_SB(b, h) + boff + n * 2048 + k * 1024); } while (0)
#define PG8_MMA(ai, bj, At, Bt) do { __builtin_amdgcn_s_setprio(1); _Pragma("unroll") for (int m = 0; m < 4; ++m) _Pragma("unroll") for (int n = 0; n < 2; ++n) _Pragma("unroll") for (int k = 0; k < 2; ++k) \
        acc[ai][bj][m][n] = __builtin_amdgcn_mfma_f32_16x16x32_bf16(Bt[n][k], At[m][k], acc[ai][bj][m][n], 0, 0, 0); __builtin_amdgcn_s_setprio(0); } while (0)
#define PG8_WAIT_V(n) asm volatile("s_waitcnt vmcnt(" #n ")" ::: "memory")
#define PG8_WAIT_L(n) asm volatile("s_waitcnt lgkmcnt(" #n ")" ::: "memory")
#define PG8_BAR __builtin_amdgcn_s_barrier()
#define PG8_SCHED __builtin_amdgcn_sched_barrier(0)
    Unit cur, nxt; int ui = 0;
    if (!S.next(0, cur)) return;
    Acc acc;
#pragma unroll
    for (int a = 0; a < 2; ++a)
#pragma unroll
        for (int b = 0; b < 2; ++b)
#pragma unroll
            for (int m = 0; m < 4; ++m)
#pragma unroll
                for (int n = 0; n < 2; ++n) acc[a][b][m][n] = (f32x4){0.f, 0.f, 0.f, 0.f};
    bf16x8 At[4][2], B0[2][2], B1[2][2];
    const char* cA = (const char*)g.A + (size_t)cur.pm * tstep + (size_t)cur.kh * g.koff; const char* cB = (const char*)g.Bt + (size_t)cur.pn * tstep + (size_t)cur.kh * g.koff;
    S.a_ready(cur);
    if constexpr (SP2) {
        PG8_STAGE(PG8_SB(0, 0), cB, voffB); PG8_STAGE(PG8_SB(0, 1), cB + hstep, voffB); PG8_STAGE(PG8_SA(0, 0), cA, voffA); PG8_STAGE(PG8_SA(0, 1), cA + hstep, voffA);
        if (wr == 1) PG8_BAR;
        PG8_WAIT_V(2); PG8_BAR;
        PG8_STAGE(PG8_SB(1, 0), cB + kstep, voffB); PG8_STAGE(PG8_SA(1, 0), cA + kstep, voffA); PG8_STAGE(PG8_SB(1, 1), cB + hstep + kstep, voffB);
        PG8_WAIT_V(6); PG8_BAR;
    } else {
        PG8_STAGE(PG8_SB(0, 0), cB, voffB); PG8_STAGE(PG8_SA(0, 0), cA, voffA); PG8_STAGE(PG8_SB(0, 1), cB + hstep, voffB); PG8_STAGE(PG8_SA(0, 1), cA + hstep, voffA);
        if (wr == 1) PG8_BAR;
        PG8_WAIT_V(4); PG8_BAR;
        PG8_STAGE(PG8_SB(1, 0), cB + kstep, voffB); PG8_STAGE(PG8_SA(1, 0), cA + kstep, voffA); PG8_STAGE(PG8_SB(1, 1), cB + hstep + kstep, voffB);
        PG8_WAIT_V(6); PG8_BAR;
    }
    for (;;) {
        const bool has_next = S.next(ui + 1, nxt);
        const char* nA = has_next ? (const char*)g.A + (size_t)nxt.pm * tstep + (size_t)nxt.kh * g.koff : cA; const char* nB = has_next ? (const char*)g.Bt + (size_t)nxt.pn * tstep + (size_t)nxt.kh * g.koff : cB;
        for (int t = 0; t < nt; t += 2) {
            const bool last = (t == nt - 2);
            const char* a1 = cA + (size_t)(t + 1) * kstep;
            const char* a2 = last ? nA : cA + (size_t)(t + 2) * kstep; const char* b2 = last ? nB : cB + (size_t)(t + 2) * kstep;
            const char* a3 = a2 + kstep; const char* b3 = b2 + kstep;
            if (last && has_next) S.a_ready(nxt);
            if constexpr (SP2) {
            PG8_LDB(B0, 0, 0); PG8_LDB(B1, 0, 1); PG8_SCHED; PG8_LDA(At, 0, 0); PG8_STAGE(PG8_SA(1, 1), a1 + hstep, voffA);
            PG8_WAIT_V(8); PG8_WAIT_L(0); PG8_BAR; PG8_MMA(0, 0, At, B0); PG8_MMA(0, 1, At, B1); PG8_BAR; PG8_SCHED;
            PG8_LDA(At, 0, 1); PG8_STAGE(PG8_SB(0, 0), b2, voffB); PG8_STAGE(PG8_SB(0, 1), b2 + hstep, voffB); PG8_STAGE(PG8_SA(0, 0), a2, voffA);
            PG8_WAIT_V(8); PG8_WAIT_L(0); PG8_BAR; PG8_MMA(1, 0, At, B0); PG8_MMA(1, 1, At, B1); PG8_BAR; PG8_SCHED;
            PG8_LDB(B0, 1, 0); PG8_LDB(B1, 1, 1); PG8_SCHED; PG8_LDA(At, 1, 0); PG8_STAGE(PG8_SA(0, 1), a2 + hstep, voffA);
            PG8_WAIT_V(8); PG8_WAIT_L(0); PG8_BAR; PG8_MMA(0, 0, At, B0); PG8_MMA(0, 1, At, B1); PG8_BAR; PG8_SCHED;
            PG8_LDA(At, 1, 1); PG8_STAGE(PG8_SB(1, 0), b3, voffB); PG8_STAGE(PG8_SB(1, 1), b3 + hstep, voffB); PG8_STAGE(PG8_SA(1, 0), a3, voffA);
            PG8_WAIT_V(8); PG8_WAIT_L(0); PG8_BAR; PG8_MMA(1, 0, At, B0); PG8_MMA(1, 1, At, B1); PG8_BAR; PG8_SCHED;
            } else {
            PG8_LDB(B0, 0, 0); PG8_SCHED; PG8_LDA(At, 0, 0); PG8_STAGE(PG8_SA(1, 1), a1 + hstep, voffA);
            PG8_WAIT_L(8); PG8_BAR; PG8_WAIT_L(0); PG8_MMA(0, 0, At, B0); PG8_BAR; PG8_SCHED;
            PG8_LDB(B1, 0, 1); PG8_STAGE(PG8_SB(0, 0), b2, voffB);
            PG8_BAR; PG8_WAIT_L(0); PG8_MMA(0, 1, At, B1); PG8_BAR;
            PG8_LDA(At, 0, 1); PG8_STAGE(PG8_SA(0, 0), a2, voffA);
            PG8_BAR; PG8_WAIT_L(0); PG8_MMA(1, 0, At, B0); PG8_BAR; PG8_SCHED;
            PG8_STAGE(PG8_SB(0, 1), b2 + hstep, voffB);
            PG8_WAIT_V(6); PG8_BAR; PG8_MMA(1, 1, At, B1); PG8_BAR;
            PG8_LDB(B0, 1, 0); PG8_SCHED; PG8_LDA(At, 1, 0); PG8_STAGE(PG8_SA(0, 1), a2 + hstep, voffA);
            PG8_WAIT_L(8); PG8_BAR; PG8_WAIT_L(0); PG8_MMA(0, 0, At, B0); PG8_BAR; PG8_SCHED;
            PG8_LDB(B1, 1, 1); PG8_STAGE(PG8_SB(1, 0), b3, voffB);
            PG8_BAR; PG8_WAIT_L(0); PG8_MMA(0, 1, At, B1); PG8_BAR;
            PG8_LDA(At, 1, 1); PG8_STAGE(PG8_SA(1, 0), a3, voffA);
            PG8_BAR; PG8_WAIT_L(0); PG8_MMA(1, 0, At, B0); PG8_BAR; PG8_SCHED;
            PG8_STAGE(PG8_SB(1, 1), b3 + hstep, voffB);
            PG8_WAIT_V(6); PG8_BAR; PG8_MMA(1, 1, At, B1); PG8_BAR;
            }
        }
        if constexpr (ALIGN_EPI) { if (wr == 0) PG8_BAR; }
        { E(acc, cur, wr, wc, fr, fq); S.done(cur);
#pragma unroll
        for (int a = 0; a < 2; ++a)
#pragma unroll
            for (int b = 0; b < 2; ++b)
#pragma unroll
                for (int m = 0; m < 4; ++m)
#pragma unroll
                    for (int n = 0; n < 2; ++n) acc[a][b][m][n] = (f32x4){0.f, 0.f, 0.f, 0.f};
        }
        if (!has_next) break;
        cur = nxt; cA = nA; cB = nB; ++ui;
        if constexpr (ALIGN_EPI) { if (wr == 1) PG8_BAR; }
    }
    PG8_WAIT_V(0);
    if constexpr (!ALIGN_EPI) { if (wr == 0) PG8_BAR; }
    PG8_BAR;
#undef PG8_SA
#undef PG8_SB
#undef PG8_STAGE
#undef PG8_LDA
#undef PG8_LDB
#undef PG8_MMA
#undef PG8_WAIT_V
#undef PG8_WAIT_L
#undef PG8_BAR
#undef PG8_SCHED
}
}

namespace att {
constexpr int NW = 8, QBLK = 32, KVBLK = 64;
constexpr int SHM_V = KVBLK * 128 * 2, SHM_K = KVBLK * 128 * 2, SHM_KR = KVBLK * 64 * 2;
constexpr int OFF_V = 0, OFF_K = 2 * SHM_V, OFF_WS = OFF_K + 2 * SHM_K, OFF_KR = OFF_WS + NW * 64 * 4, OFF_QR = OFF_KR + 2 * SHM_KR, QR_WAVE = 6144, ATT_LDS = OFF_QR + NW * QR_WAVE;
constexpr float THR = 8.f;
#define KSWZ(row, colB) ((row) * 256 + ((colB) ^ (((row) & 7) << 4)))
#define KRSWZ(row, colB) ((row) * 128 + ((colB) ^ ((((row) >> 1) & 7) << 4)))
#define SBAR() __builtin_amdgcn_sched_barrier(0)
__device__ __forceinline__ int crow(int r, int hi) { return (r & 3) + 8 * (r >> 2) + 4 * hi; }

__device__ __forceinline__ void partialSM(f32x16& p0, f32x16& p1, float& m_reg, float& mn, float& alpha, const float C, const float THRS) {
  float pmax = p0[0];
#pragma unroll
  for (int r = 1; r < 16; ++r) pmax = fmaxf(pmax, p0[r]);
#pragma unroll
  for (int r = 0; r < 16; ++r) pmax = fmaxf(pmax, p1[r]);
  { auto rr = __builtin_amdgcn_permlane32_swap(__float_as_uint(pmax), __float_as_uint(pmax), false, false);
    pmax = fmaxf(__uint_as_float(rr[0]), __uint_as_float(rr[1])); }
  if (__builtin_expect(__all(pmax - m_reg <= THRS), 1)) { mn = m_reg; alpha = 1.f; }
  else { mn = fmaxf(m_reg, pmax); alpha = __builtin_amdgcn_exp2f((m_reg - mn) * C); m_reg = mn; }
  float mnC = -mn * C;
#pragma unroll
  for (int r = 0; r < 16; ++r) p0[r] = fmaf(p0[r], C, mnC);
#pragma unroll
  for (int r = 0; r < 16; ++r) p1[r] = fmaf(p1[r], C, mnC);
#pragma unroll
  for (int r = 0; r < 16; ++r) p0[r] = __builtin_amdgcn_exp2f(p0[r]);
}
__device__ __forceinline__ void finishSM(f32x16& p0, f32x16& p1, float alpha, float& l_reg, bf16x8& pa0, bf16x8& pa1, bf16x8& pa2, bf16x8& pa3) {
#pragma unroll
  for (int r = 0; r < 16; ++r) p1[r] = __builtin_amdgcn_exp2f(p1[r]);
  float ps = 0;
#pragma unroll
  for (int r = 0; r < 16; ++r) ps += p0[r];
#pragma unroll
  for (int r = 0; r < 16; ++r) ps += p1[r];
  { auto rr = __builtin_amdgcn_permlane32_swap(__float_as_uint(ps), __float_as_uint(ps), false, false);
    ps = __uint_as_float(rr[0]) + __uint_as_float(rr[1]); }
  l_reg = l_reg * alpha + ps;
#define PK4(P, BASE, OUT) do { unsigned a0 = cvt_pk_bf16(P[BASE + 0], P[BASE + 1]), a1 = cvt_pk_bf16(P[BASE + 2], P[BASE + 3]);   \
    unsigned b0 = cvt_pk_bf16(P[BASE + 4], P[BASE + 5]), b1 = cvt_pk_bf16(P[BASE + 6], P[BASE + 7]);                              \
    auto r0 = __builtin_amdgcn_permlane32_swap(a0, b0, false, false); auto r1 = __builtin_amdgcn_permlane32_swap(a1, b1, false, false); \
    u32x4 w = {r0[0], r1[0], r0[1], r1[1]}; OUT = *reinterpret_cast<bf16x8*>(&w); } while (0)
  PK4(p0, 0, pa0); PK4(p0, 8, pa1); PK4(p1, 0, pa2); PK4(p1, 8, pa3);
#undef PK4
}
template <int DK, int NQR>
__device__ __forceinline__ void qkt(f32x16& p0, f32x16& p1, const char* Ks, const char* Krs, const bf16x8* qr, const char* qrl, int r32, int hi) {
  p0 = f32x16{}; p1 = f32x16{};
#pragma unroll
  for (int d0 = 0; d0 < 8; ++d0) { int cb = (d0 * 16 + hi * 8) * 2;
    bf16x8 b0 = *reinterpret_cast<const bf16x8*>(Ks + KSWZ(r32, cb));
    bf16x8 b1 = *reinterpret_cast<const bf16x8*>(Ks + KSWZ(32 + r32, cb));
    bf16x8 qv; if (d0 < NQR) qv = qr[d0 < NQR ? d0 : 0]; else qv = *reinterpret_cast<const bf16x8*>(qrl + (d0 - NQR) * 1024);
    p0 = __builtin_amdgcn_mfma_f32_32x32x16_bf16(b0, qv, p0, 0, 0, 0);
    p1 = __builtin_amdgcn_mfma_f32_32x32x16_bf16(b1, qv, p1, 0, 0, 0); }
  if constexpr (DK == 192) {
#pragma unroll
    for (int d0 = 0; d0 < 4; ++d0) { int cb = (d0 * 16 + hi * 8) * 2;
      bf16x8 b0 = *reinterpret_cast<const bf16x8*>(Krs + KRSWZ(r32, cb));
      bf16x8 b1 = *reinterpret_cast<const bf16x8*>(Krs + KRSWZ(32 + r32, cb));
      const bf16x8 qv = *reinterpret_cast<const bf16x8*>(qrl + (8 - NQR + d0) * 1024);
      p0 = __builtin_amdgcn_mfma_f32_32x32x16_bf16(b0, qv, p0, 0, 0, 0);
      p1 = __builtin_amdgcn_mfma_f32_32x32x16_bf16(b1, qv, p1, 0, 0, 0); }
  }
}
__device__ __forceinline__ int v_st(int k, int c) { const int kk = (k & ~0xC) | ((k & 4) << 1) | ((k & 8) >> 1); return ((kk >> 3) * 4 + (c >> 5)) * 512 + ((kk & 7) * 32 + (c & 31)) * 2; }
__device__ __forceinline__ int v_rd_base(int lane) { return ((lane & 3) << 3) | (((lane >> 2) & 3) << 6) | (((lane >> 4) & 1) << 5) | (((lane >> 5) & 1) << 8); }
constexpr int v_rd_off(int d0, int ks, int half) { return d0 * 512 + ks * 4096 + half * 2048; }
template <int OFF> __device__ __forceinline__ s16x4 tr_read(int vb) {
  s16x4 r; asm volatile("ds_read_b64_tr_b16 %0, %1 offset:%2" : "=&v"(r) : "v"(vb), "i"(OFF) : "memory"); return r;
}
template <int D0> __device__ __forceinline__ void pv_one(f32x16& od, int vb, bf16x8 pa0, bf16x8 pa1, bf16x8 pa2, bf16x8 pa3) {
  const s16x4 l0 = tr_read<v_rd_off(D0, 0, 0)>(vb), h0 = tr_read<v_rd_off(D0, 0, 1)>(vb), l1 = tr_read<v_rd_off(D0, 1, 0)>(vb), h1 = tr_read<v_rd_off(D0, 1, 1)>(vb);
  const s16x4 l2 = tr_read<v_rd_off(D0, 2, 0)>(vb), h2 = tr_read<v_rd_off(D0, 2, 1)>(vb), l3 = tr_read<v_rd_off(D0, 3, 0)>(vb), h3 = tr_read<v_rd_off(D0, 3, 1)>(vb);
  asm volatile("s_waitcnt lgkmcnt(0)" ::: "memory"); SBAR();
#define PK(L, H) (bf16x8){L[0], L[1], L[2], L[3], H[0], H[1], H[2], H[3]}
  od = __builtin_amdgcn_mfma_f32_32x32x16_bf16(pa0, PK(l0, h0), od, 0, 0, 0);
  od = __builtin_amdgcn_mfma_f32_32x32x16_bf16(pa1, PK(l1, h1), od, 0, 0, 0);
  od = __builtin_amdgcn_mfma_f32_32x32x16_bf16(pa2, PK(l2, h2), od, 0, 0, 0);
  od = __builtin_amdgcn_mfma_f32_32x32x16_bf16(pa3, PK(l3, h3), od, 0, 0, 0);
#undef PK
}
__device__ __forceinline__ void pv_d0(f32x16* o, int vb, bf16x8 pa0, bf16x8 pa1, bf16x8 pa2, bf16x8 pa3) {
  pv_one<0>(o[0], vb, pa0, pa1, pa2, pa3); pv_one<1>(o[1], vb, pa0, pa1, pa2, pa3); pv_one<2>(o[2], vb, pa0, pa1, pa2, pa3); pv_one<3>(o[3], vb, pa0, pa1, pa2, pa3);
}

template <int DK, int SDEPTH, int ldq, int ldk, int ldv, int ldo, int seq>
__device__ __forceinline__ void attn_unit(const bf16_t* __restrict__ Qb, const bf16_t* __restrict__ Kh, const bf16_t* __restrict__ Krp,
                                          const bf16_t* __restrict__ Vh, bf16_t* __restrict__ Ob, char* lds) {
  constexpr float SCALE = (DK == 128) ? 0.088388347648318440f : 0.072168783648703220f;
  constexpr float C = SCALE * 1.4426950408889634f, THRS = THR / SCALE;
  constexpr int ND = DK / 16, NQR = (DK == 128) ? 8 : 6;
  const int tid = threadIdx.x, wid = tid >> 6, lane = tid & 63, r32 = lane & 31, hi = lane >> 5;
  char* V_lds = lds + OFF_V; char* K_lds = lds + OFF_K; char* KR_lds = lds + OFF_KR;
  float* ws = (float*)(lds + OFF_WS) + wid * 64; float* li_l = ws; float* al_l = ws + 32;
  float m_reg = -1e30f, l_reg = 0; f32x16 o[4] = {}; bf16x8 qr[NQR];
  const bf16_t* Qw = Qb + (long)(wid * QBLK + r32) * ldq + hi * 8;
#pragma unroll
  for (int d0 = 0; d0 < NQR; ++d0) qr[d0] = *reinterpret_cast<const bf16x8*>(Qw + d0 * 16);
  char* qrl = lds + OFF_QR + wid * QR_WAVE + lane * 16;
#pragma unroll
  for (int d0 = NQR; d0 < ND; ++d0) *reinterpret_cast<bf16x8*>(qrl + (d0 - NQR) * 1024) = *reinterpret_cast<const bf16x8*>(Qw + d0 * 16);
  const int sr = tid >> 4, sc = (tid & 15) * 8, vst0 = v_st(sr, sc), vst1 = v_st(32 + sr, sc);
  const int krr = tid >> 3, krc = (tid & 7) * 8;
  const int vb0 = (int)(uintptr_t)V_lds + v_rd_base(lane);
  bf16x8 vs0[SDEPTH], vs1[SDEPTH], ks0[SDEPTH], ks1[SDEPTH], kr0[SDEPTH];
  const unsigned voffV = (unsigned)((sr * ldv + sc) * 2), voffK = (unsigned)((sr * ldk + sc) * 2), voffR = (unsigned)((krr * 64 + krc) * 2);
#define SLOAD(i, k0) do { const char* vb_ = (const char*)Vh + (size_t)(k0) * (ldv * 2); const char* kb_ = (const char*)Kh + (size_t)(k0) * (ldk * 2); \
    vs0[i] = *(const bf16x8*)(vb_ + voffV); vs1[i] = *(const bf16x8*)(vb_ + 32 * ldv * 2 + voffV); \
    ks0[i] = *(const bf16x8*)(kb_ + voffK); ks1[i] = *(const bf16x8*)(kb_ + 32 * ldk * 2 + voffK); \
    if constexpr (DK == 192) kr0[i] = *(const bf16x8*)((const char*)Krp + (size_t)(k0) * 128 + voffR); } while (0)
#define SWRITE(b, i) do { *(bf16x8*)(V_lds + (b) * SHM_V + vst0) = vs0[i];          \
    *(bf16x8*)(V_lds + (b) * SHM_V + vst1) = vs1[i]; int kc = sc * 2;               \
    *(bf16x8*)(K_lds + (b) * SHM_K + KSWZ(sr, kc)) = ks0[i];                       \
    *(bf16x8*)(K_lds + (b) * SHM_K + KSWZ(32 + sr, kc)) = ks1[i];                  \
    if constexpr (DK == 192) *(bf16x8*)(KR_lds + (b) * SHM_KR + KRSWZ(krr, krc * 2)) = kr0[i]; } while (0)
#define SWAIT() do { if constexpr (SDEPTH == 1) asm volatile("s_waitcnt vmcnt(0)" ::: "memory"); else if constexpr (DK == 192) asm volatile("s_waitcnt vmcnt(5)" ::: "memory"); else asm volatile("s_waitcnt vmcnt(4)" ::: "memory"); } while (0)
#define RESC(a) do { if (__any((a) < 1.f)) { if (hi == 0) al_l[r32] = (a); asm volatile("s_waitcnt lgkmcnt(0)" ::: "memory"); \
    _Pragma("unroll") for (int d = 0; d < 4; ++d) _Pragma("unroll") for (int r = 0; r < 16; ++r) o[d][r] *= al_l[crow(r, hi)]; } } while (0)
  f32x16 pA0, pA1, pB0, pB1; float mnA, mnB, alA, alB; bf16x8 pa0, pa1, pa2, pa3; const int NT = seq / KVBLK;
  constexpr int SE = 0, SO = SDEPTH - 1;
  SLOAD(SE, 0); asm volatile("s_waitcnt vmcnt(0)" ::: "memory"); SWRITE(0, SE); __syncthreads();
  qkt<DK, NQR>(pA0, pA1, K_lds, KR_lds, qr, qrl, r32, hi); partialSM(pA0, pA1, m_reg, mnA, alA, C, THRS);
  SLOAD(SO, KVBLK); if constexpr (SDEPTH == 2) { if (2 < NT) SLOAD(SE, 2 * KVBLK); }
  SWAIT(); SWRITE(1, SO); __syncthreads();
  for (int j = 1; j + 1 < NT; j += 2) {
    SBAR(); qkt<DK, NQR>(pB0, pB1, K_lds + SHM_K, KR_lds + SHM_KR, qr, qrl, r32, hi);
    finishSM(pA0, pA1, alA, l_reg, pa0, pa1, pa2, pa3); SBAR();
    SLOAD(SO, (j + SDEPTH) * KVBLK); SBAR();
    pv_d0(o, vb0, pa0, pa1, pa2, pa3); partialSM(pB0, pB1, m_reg, mnB, alB, C, THRS);
    __syncthreads(); SWAIT(); SWRITE(0, SE);
    RESC(alB); __syncthreads();
    SBAR(); qkt<DK, NQR>(pA0, pA1, K_lds, KR_lds, qr, qrl, r32, hi);
    finishSM(pB0, pB1, alB, l_reg, pa0, pa1, pa2, pa3); SBAR();
    if (SDEPTH == 1 || j + 3 < NT) SLOAD(SE, (j + 1 + SDEPTH) * KVBLK); SBAR();
    pv_d0(o, vb0 + SHM_V, pa0, pa1, pa2, pa3); partialSM(pA0, pA1, m_reg, mnA, alA, C, THRS);
    __syncthreads(); SWAIT(); SWRITE(1, SO);
    RESC(alA); __syncthreads();
  }
  SBAR(); qkt<DK, NQR>(pB0, pB1, K_lds + SHM_K, KR_lds + SHM_KR, qr, qrl, r32, hi);
  finishSM(pA0, pA1, alA, l_reg, pa0, pa1, pa2, pa3); SBAR();
  pv_d0(o, vb0, pa0, pa1, pa2, pa3); partialSM(pB0, pB1, m_reg, mnB, alB, C, THRS);
  __syncthreads(); RESC(alB);
  finishSM(pB0, pB1, alB, l_reg, pa0, pa1, pa2, pa3); SBAR();
  pv_d0(o, vb0 + SHM_V, pa0, pa1, pa2, pa3);
  if (hi == 0) li_l[r32] = l_reg; asm volatile("s_waitcnt lgkmcnt(0)" ::: "memory");
  float rli[16];
#pragma unroll
  for (int r = 0; r < 16; ++r) rli[r] = __builtin_amdgcn_rcpf(li_l[crow(r, hi)]);
  bf16_t* Ow = Ob + (long)(wid * QBLK) * ldo;
#pragma unroll
  for (int r = 0; r < 16; ++r) { int orow = crow(r, hi);
#pragma unroll
    for (int d0 = 0; d0 < 4; ++d0) Ow[(long)orow * ldo + d0 * 32 + r32] = f2bf(o[d0][r] * rli[r]); }
#undef SLOAD
#undef SWRITE
#undef SWAIT
#undef RESC
}
}

struct TrItem { const float* W; bf16_t* WT; int ldw, k0, n0, ldt, drow0, dk0; const float* gain; };
__device__ __forceinline__ void tr_load(f32x4 (&v)[16], const TrItem& t, int lane) {
    const int lr = lane >> 4, lc = (lane & 15) * 4;
#pragma unroll
    for (int i = 0; i < 16; ++i) v[i] = *(const f32x4*)(t.W + (size_t)(t.k0 + 4 * i + lr) * t.ldw + t.n0 + lc);
}
__device__ __forceinline__ void tr_store(const f32x4 (&v)[16], const TrItem& t, LAS float* scr, int lane) {
    const int lr = lane >> 4, lc = (lane & 15) * 4;
#pragma unroll
    for (int i = 0; i < 16; ++i) { LAS float* d = scr + (4 * i + lr) * 65 + lc; const float gk = t.gain ? t.gain[t.k0 + 4 * i + lr] : 1.f;
        d[0] = v[i].x * gk; d[1] = v[i].y * gk; d[2] = v[i].z * gk; d[3] = v[i].w * gk; }
    asm volatile("s_waitcnt lgkmcnt(0)" ::: "memory");
    const int c = lane & 7;
#pragma unroll
    for (int j = 0; j < 8; ++j) { const int n = (lane >> 3) + 8 * j; const LAS float* s = scr + (8 * c) * 65 + n;
        u32x4 o; o.x = cvt_pk_bf16(s[0], s[65]); o.y = cvt_pk_bf16(s[130], s[195]); o.z = cvt_pk_bf16(s[260], s[325]); o.w = cvt_pk_bf16(s[390], s[455]);
        *(u32x4*)(t.WT + (size_t)(t.drow0 + n) * t.ldt + t.dk0 + 8 * c) = o; }
    asm volatile("s_waitcnt lgkmcnt(0)" ::: "memory");
}
__device__ __forceinline__ void tr_item(const float* __restrict__ W, int ldw, int k0, int n0, bf16_t* __restrict__ WT, int ldt, int drow0, int dk0, LAS float* scr, int lane) {
    TrItem t{W, WT, ldw, k0, n0, ldt, drow0, dk0, nullptr}; f32x4 v[16]; tr_load(v, t, lane); tr_store(v, t, scr, lane);
}
__device__ __forceinline__ void rms_row_to_bf16(const float* __restrict__ xrow, const float* __restrict__ g, bf16_t* __restrict__ orow, int lane) {
    f32x4 v[8]; float s = 0.f;
#pragma unroll
    for (int j = 0; j < 8; ++j) { v[j] = *(const f32x4*)(xrow + 4 * lane + 256 * j); s += (v[j].x * v[j].x + v[j].y * v[j].y) + (v[j].z * v[j].z + v[j].w * v[j].w); }
    const float r = 1.0f / sqrtf(wave_sum(s) * (1.f / DM) + EPS);
#pragma unroll
    for (int j = 0; j < 8; ++j) { const f32x4 gg = *(const f32x4*)(g + 4 * lane + 256 * j);
        u32x2 o; o.x = cvt_pk_bf16(v[j].x * r * gg.x, v[j].y * r * gg.y); o.y = cvt_pk_bf16(v[j].z * r * gg.z, v[j].w * r * gg.w);
        *(u32x2*)(orow + 4 * lane + 256 * j) = o; }
}

#define XB_TMO      128
#define XB_XCNT(j)  (256  + 64 * (j))
#define XB_XSUB(j)  (1280 + 64 * (j))
#define XB_XGEN(j)  (2304 + 64 * (j))
#define XB_TOP      3328
#define XB_TOPGEN   3392
#define XCD_BAR_WORDS 3456
#define XB_SPIN_CAP (1u << 18)
__device__ __forceinline__ unsigned xb_ld(unsigned* p)              { return __hip_atomic_load(p, __ATOMIC_RELAXED, __HIP_MEMORY_SCOPE_AGENT); }
__device__ __forceinline__ unsigned xb_add(unsigned* p, unsigned v) { return __hip_atomic_fetch_add(p, v, __ATOMIC_RELAXED, __HIP_MEMORY_SCOPE_AGENT); }
__device__ __forceinline__ unsigned xb_xcc_id() { return (unsigned)__builtin_amdgcn_s_getreg((3 << 11) | 20) & 0xFu; }
#define XB_SPIN(cond, bar) do { unsigned _sp = 0; while (cond) { __builtin_amdgcn_s_sleep(1); \
    if ((++_sp & 255u) == 0u) { if (xb_ld(&(bar)[XB_TMO])) break; if (_sp > XB_SPIN_CAP) { atomicAdd(&(bar)[XB_TMO], 1u); break; } } } } while (0)
struct XcdBarrier { unsigned* bar; unsigned x; volatile LAS unsigned* st; };
__device__ __forceinline__ XcdBarrier xcd_barrier_post(unsigned* bar, volatile LAS unsigned* st) {
    XcdBarrier b; b.bar = bar; b.x = xb_xcc_id(); b.st = st;
    if (threadIdx.x == 0) (void)xb_add(&bar[XB_XCNT(b.x)], 1u);
    return b;
}
__device__ __forceinline__ void xcd_barrier_complete(unsigned* bar, unsigned x, unsigned& nloc, unsigned& nx) {
    const unsigned G = gridDim.x * gridDim.y * gridDim.z;
    unsigned sum, cnt, mine, sp = 0u;
    for (;;) {
        sum = 0u; cnt = 0u; mine = 0u;
#pragma unroll
        for (unsigned j = 0; j < 16; ++j) { const unsigned c = xb_ld(&bar[XB_XCNT(j)]); sum += c; cnt += (c > 0u) ? 1u : 0u; mine = (j == x) ? c : mine; }
        if (sum == G) break;
        __builtin_amdgcn_s_sleep(1);
        if ((++sp & 255u) == 0u) { if (xb_ld(&bar[XB_TMO])) break; if (sp > XB_SPIN_CAP) { atomicAdd(&bar[XB_TMO], 1u); break; } }
    }
    nloc = mine > 0u ? mine : 1u; nx = cnt > 0u ? cnt : 1u;
}
__device__ __forceinline__ void xcd_barrier(const XcdBarrier& b) {
    asm volatile("s_waitcnt vmcnt(0)" ::: "memory");
    __syncthreads();
    if (threadIdx.x == 0) {
        unsigned* bar = b.bar;
        __builtin_amdgcn_s_waitcnt(0);
        unsigned nloc = b.st[0], nx = b.st[1];
        if (nloc == 0u) { xcd_barrier_complete(bar, b.x, nloc, nx); b.st[0] = nloc; b.st[1] = nx; }
        const unsigned old = xb_add(&bar[XB_XSUB(b.x)], 1u);
        const unsigned gen = old / nloc;
        if (old + 1u == (gen + 1u) * nloc) {
            __builtin_amdgcn_fence(__ATOMIC_RELEASE, "agent");
            asm volatile("s_waitcnt vmcnt(0)" ::: "memory");
            const unsigned og = xb_add(&bar[XB_TOP], 1u);
            const unsigned tg = og / nx;
            if (og + 1u == (tg + 1u) * nx) xb_add(&bar[XB_TOPGEN], 1u);
            else XB_SPIN(xb_ld(&bar[XB_TOPGEN]) == tg, bar);
            __builtin_amdgcn_fence(__ATOMIC_ACQUIRE, "agent");
            xb_add(&bar[XB_XGEN(b.x)], 1u);
            asm volatile("s_waitcnt vmcnt(0)" ::: "memory");
        } else {
            XB_SPIN(xb_ld(&bar[XB_XGEN(b.x)]) == gen, bar);
            __builtin_amdgcn_fence(__ATOMIC_ACQUIRE, "agent");
            asm volatile("s_waitcnt vmcnt(0)" ::: "memory");
        }
    }
    __syncthreads();
}

struct Args {
    const float *x, *p, *g_mix, *w_in, *q_norm_a, *k_norm_a, *q_a_norm, *w_q_b, *kv_a_norm, *w_kv_b, *w_a_out, *w_b_out, *w_o, *g_ffn, *w_gate_up, *w_down, *g_ple,
                *w_ple_gate, *w_ple_proj, *g_ple_post, *g_final;
    float* out; unsigned char* ws; int ph_lo, ph_hi;
};

constexpr int NPHASE = 14;

__global__ void __launch_bounds__(NTHREADS, 2) mk_fwd(Args a) {
    extern __shared__ __attribute__((aligned(16))) unsigned char lds_raw[];
    LAS unsigned char* lds = (LAS unsigned char*)lds_raw;
    const int tid = threadIdx.x, lane = tid & 63, wave = __builtin_amdgcn_readfirstlane(tid >> 6);
    const int G = gridDim.x, bx = blockIdx.x;
    const int gw = bx * NWAVES + wave, NGW = G * NWAVES;
    unsigned char* ws = a.ws;
    bf16_t* WinT = (bf16_t*)(ws + WS_WIN); bf16_t* WqbT = (bf16_t*)(ws + WS_WQB); bf16_t* WkvbT = (bf16_t*)(ws + WS_WKVB); bf16_t* WabT = (bf16_t*)(ws + WS_WAB);
    bf16_t* WoT = (bf16_t*)(ws + WS_WO); bf16_t* WguT = (bf16_t*)(ws + WS_WGU); bf16_t* WdT = (bf16_t*)(ws + WS_WD); bf16_t* WpgT = (bf16_t*)(ws + WS_WPG);
    bf16_t* WppT = (bf16_t*)(ws + WS_WPP); bf16_t* PB = (bf16_t*)(ws + WS_PB); bf16_t* KR = (bf16_t*)(ws + WS_KR); bf16_t* U = (bf16_t*)(ws + WS_U);
    bf16_t* ZS = (bf16_t*)(ws + WS_ZS); bf16_t* SG = (bf16_t*)(ws + WS_SG); bf16_t* QA = (bf16_t*)(ws + WS_QA); bf16_t* QB = (bf16_t*)(ws + WS_QB);
    bf16_t* KVB = (bf16_t*)(ws + WS_KVB); bf16_t* CQN = (bf16_t*)(ws + WS_CQN); bf16_t* CKVN = (bf16_t*)(ws + WS_CKVN); bf16_t* KA = (bf16_t*)(ws + WS_KA);
    bf16_t* KPE = (bf16_t*)(ws + WS_KPE); bf16_t* OAB = (bf16_t*)(ws + WS_OAB); bf16_t* MERGED = (bf16_t*)(ws + WS_MERGED); bf16_t* ACT = (bf16_t*)(ws + WS_ACT);
    bf16_t* GATE = (bf16_t*)(ws + WS_GATE); bf16_t* ERAW = (bf16_t*)(ws + WS_ERAW); float* H = a.out;
    float* SSQ1 = (float*)(ws + 65536); float* SSQ2 = (float*)(ws + 131072);
    const int lo = a.ph_lo, hi = a.ph_hi;
#define IN(k) (lo <= (k) && (k) < hi)
#define SEAM(k) do { if (IN(k) && IN((k) + 1)) { xcd_barrier(xbar); } } while (0)
    volatile LAS unsigned* xst = (volatile LAS unsigned*)(lds + LDS_BYTES - 64);
    if (tid == 0) { xst[0] = 0u; xst[1] = 0u; }
    __syncthreads();
    XcdBarrier xbar = xcd_barrier_post((unsigned*)ws, xst);
    if (a.ph_lo < 0) cg::this_grid().sync();

    constexpr int I0 = 32 * 105, I1 = 8 * 24, I2 = 8 * 32, I3 = 16 * 32, I4 = 16 * 32, I5 = 32 * 32, I6 = 32 * 176, I7 = 88 * 32, I8 = 32 * 32, I9 = 4 * 32;
    constexpr int NREST = I1 + I2 + I3 + I4 + I5 + I6 + I7 + I8 + I9;
    if (IN(0)) {
        LAS float* scr = (LAS float*)(lds + wave * 16640);
        for (int it = gw; it < I0; it += NGW) {
            const int kb = it / 105, nb = it % 105, n0 = nb * 64; const int dr = n0 < 2560 ? n0 : (n0 < 2624 ? 6656 + (n0 - 2560) : n0 - 64);
            tr_item(a.w_in, NIN, kb * 64, n0, WinT, 2048, dr, kb * 64, scr, lane);
        }
        for (int m = gw; m < M; m += NGW) {
            rms_row_to_bf16(a.x + (size_t)m * DM, a.g_mix, U + (size_t)m * DM, lane);
            const f32x4 pv = *(const f32x4*)(a.p + (size_t)m * PLE + 4 * lane);
            u32x2 o; o.x = cvt_pk_bf16(pv.x, pv.y); o.y = cvt_pk_bf16(pv.z, pv.w);
            *(u32x2*)(PB + (size_t)m * PLE + 4 * lane) = o;
        }
        for (int i = bx * NTHREADS + tid; i < (NINP - NIN) * 2048 / 8; i += G * NTHREADS) *(u32x4*)(WinT + (size_t)NIN * 2048 + (size_t)i * 8) = (u32x4){0u, 0u, 0u, 0u};
        __syncthreads();
    }
    SEAM(0);
    if (IN(1)) {
        constexpr int NU = (M / 256) * (NINP / 256);
        const int GG = (G >= 256) ? 216 : G;
        if (bx < GG) {
            pg8::Gemm g{U, WinT, M, NINP, DM, DM, 0}; pg8::StaticOrder S; S.init(M, NINP, GG, bx);
            pg8::EpiIn E{ZS, SG, KR};
            pg8::gemm_phase<pg8::EpiIn, pg8::StaticOrder, true, true, false>(lds, g, S, E);
        }
        {
            int idx = bx - GG, cnt = G - GG; if (cnt <= 0) { idx = bx; cnt = G; }
            if (idx >= 0) {
                LAS float* scr = (LAS float*)(lds + wave * 16640);
                auto decode = [&](int r) -> TrItem {
                    if (r < I1) { const int kb = r / 24, nb = r % 24; return TrItem{a.w_q_b, WqbT, 1536, kb * 64, nb * 64, 512, nb * 64, kb * 64, nullptr}; } r -= I1;
                    if (r < I2) { const int kb = r / 32, nb = r % 32; return TrItem{a.w_kv_b, WkvbT, 2048, kb * 64, nb * 64, 512, nb * 64, kb * 64, nullptr}; } r -= I2;
                    if (r < I3) { const int kb = r / 32, nb = r % 32; return TrItem{a.w_a_out, WabT, 2048, kb * 64, nb * 64, 2048, nb * 64, kb * 64, nullptr}; } r -= I3;
                    if (r < I4) { const int kb = r / 32, nb = r % 32; return TrItem{a.w_b_out, WabT, 2048, kb * 64, nb * 64, 2048, nb * 64, 1024 + kb * 64, nullptr}; } r -= I4;
                    if (r < I5) { const int kb = r / 32, nb = r % 32; return TrItem{a.w_o, WoT, 2048, kb * 64, nb * 64, 2048, nb * 64, kb * 64, nullptr}; } r -= I5;
                    if (r < I6) { const int kb = r / 176, nb = r % 176, n0 = nb * 64; const int s_ = n0 >= DFF ? 1 : 0, j = n0 - s_ * DFF; const int dr = 256 * (j >> 7) + 128 * s_ + (j & 127);
                        return TrItem{a.w_gate_up, WguT, 2 * DFF, kb * 64, n0, 2048, dr, kb * 64, a.g_ffn}; } r -= I6;
                    if (r < I7) { const int kb = r / 32, nb = r % 32; return TrItem{a.w_down, WdT, 2048, kb * 64, nb * 64, DFF, nb * 64, kb * 64, nullptr}; } r -= I7;
                    if (r < I8) { const int kb = r / 32, nb = r % 32; return TrItem{a.w_ple_gate, WpgT, 2048, kb * 64, nb * 64, 2048, nb * 64, kb * 64, a.g_ple}; } r -= I8;
                    { const int kb = r / 32, nb = r % 32; return TrItem{a.w_ple_proj, WppT, 2048, kb * 64, nb * 64, 256, nb * 64, kb * 64, nullptr}; }
                };
                const int stride = cnt * NWAVES; int it = idx * NWAVES + wave;
                f32x4 va[16], vb[16]; TrItem ta{}, tb{};
                if (it < NREST) { ta = decode(it); tr_load(va, ta, lane); }
                while (it < NREST) {
                    int it2 = it + stride; if (it2 < NREST) { tb = decode(it2); tr_load(vb, tb, lane); }
                    tr_store(va, ta, scr, lane);
                    it = it2; if (it >= NREST) break;
                    it2 = it + stride; if (it2 < NREST) { ta = decode(it2); tr_load(va, ta, lane); }
                    tr_store(vb, tb, scr, lane);
                    it = it2;
                }
            }
            __syncthreads();
        }
        (void)NU;
    }
    SEAM(1);
    if (IN(2)) {
        const int l5 = lane & 31, hsel = lane >> 5, d0 = l5 * 4, isx2 = (l5 >> 3) & 1, halfc = (l5 >> 4) & 1;
        float invA4[4]; f32x4 gq, gk;
#pragma unroll
        for (int i = 0; i < 4; ++i) invA4[i] = powf(10000.f, -(float)(2 * ((d0 & 31) + i)) / 64.f);
        gq = *(const f32x4*)(a.q_norm_a + d0); gk = *(const f32x4*)(a.k_norm_a + d0);
        const int hfb = (lane >> 4) & 1, jb = lane & 15;
        const float invB = powf(10000.f, -(float)(2 * jb) / 32.f);
        for (int m = gw; m < M; m += NGW) {
            const int s = m & (SEQ - 1); const float prow = (float)(s >> 6), pcol = (float)(s & 63);
            const float posA = halfc ? pcol : prow; float cA[4], sA[4];
#pragma unroll
            for (int i = 0; i < 4; ++i) { const float ang = posA * invA4[i]; cA[i] = cosf(ang); sA[i] = sinf(ang); }
            const bf16_t* zr = ZS + (size_t)m * 2560;
#pragma unroll
            for (int it = 0; it < 5; ++it) {
                const int head = 2 * it + hsel;
                const u32x2 w = *(const u32x2*)(zr + head * 128 + d0);
                const float x[4] = {bf_lo(w.x), bf_hi(w.x), bf_lo(w.y), bf_hi(w.y)};
                float ss = (x[0] * x[0] + x[1] * x[1]) + (x[2] * x[2] + x[3] * x[3]);
#pragma unroll
                for (int o2 = 1; o2 < 32; o2 <<= 1) ss += __shfl_xor(ss, o2);
                const float r = 1.0f / sqrtf(ss * (1.f / 128.f) + EPS);
                const f32x4 g = (it < 4) ? gq : gk; float o[4];
#pragma unroll
                for (int i = 0; i < 4; ++i) { const float y = x[i] * r * g[i]; const float p = __shfl_xor(y, 8);
                    o[i] = isx2 ? (y * cA[i] + p * sA[i]) : (y * cA[i] - p * sA[i]); }
                u32x2 ow; ow.x = cvt_pk_bf16(o[0], o[1]); ow.y = cvt_pk_bf16(o[2], o[3]);
                bf16_t* dst = (it < 4) ? (QA + (size_t)m * 1024 + head * 128 + d0) : (KA + (size_t)m * 256 + (head - 8) * 128 + d0);
                *(u32x2*)dst = ow;
            }
#pragma unroll
            for (int t = 0; t < 2; ++t) {
                const u32x4 w = *(const u32x4*)(zr + 1536 + t * 512 + lane * 8);
                float v[8] = {bf_lo(w.x), bf_hi(w.x), bf_lo(w.y), bf_hi(w.y), bf_lo(w.z), bf_hi(w.z), bf_lo(w.w), bf_hi(w.w)};
                float ss = 0.f;
#pragma unroll
                for (int i = 0; i < 8; ++i) ss += v[i] * v[i];
                const float r = 1.0f / sqrtf(wave_sum(ss) * (1.f / 512.f) + EPS);
                const float* gg = (t == 0 ? a.q_a_norm : a.kv_a_norm) + lane * 8;
                const f32x4 g0 = *(const f32x4*)gg, g1 = *(const f32x4*)(gg + 4);
                u32x4 o; o.x = cvt_pk_bf16(v[0] * r * g0.x, v[1] * r * g0.y); o.y = cvt_pk_bf16(v[2] * r * g0.z, v[3] * r * g0.w);
                o.z = cvt_pk_bf16(v[4] * r * g1.x, v[5] * r * g1.y); o.w = cvt_pk_bf16(v[6] * r * g1.z, v[7] * r * g1.w);
                *(u32x4*)((t == 0 ? CQN : CKVN) + (size_t)m * 512 + lane * 8) = o;
            }
            if (lane < 32) {
                const float angB = (hfb ? pcol : prow) * invB; const float cB = cosf(angB), sB = sinf(angB);
                const bf16_t* kr = KR + (size_t)m * 64 + hfb * 32 + jb;
                const float x1 = bf1(kr[0]), x2 = bf1(kr[16]);
                bf16_t* dst = KPE + (size_t)m * 64 + hfb * 32 + jb;
                dst[0] = f2bf(x1 * cB - x2 * sB); dst[16] = f2bf(x2 * cB + x1 * sB);
            }
        }
    }
    SEAM(2);
    if (IN(3)) {
        { pg8::Gemm g{CQN, WqbT, M, 1536, 512, 512, 0}; pg8::StaticOrder S; S.init(M, 1536, G, bx); pg8::EpiQB E{QB};
          pg8::gemm_phase<pg8::EpiQB, pg8::StaticOrder, true, true, false>(lds, g, S, E); }
        { pg8::Gemm g{CKVN, WkvbT, M, 2048, 512, 512, 0}; pg8::StaticOrder S; S.init(M, 2048, G, bx); pg8::EpiBf16<0> E{KVB, 2048, nullptr};
          pg8::gemm_phase<pg8::EpiBf16<0>, pg8::StaticOrder, true, true, false>(lds, g, S, E); }
    }
    SEAM(3);
    if (IN(5)) {
        char* lds_g = (char*)lds_raw;
        const int x = bx & 7, i = bx >> 3;
        for (int c = bx; c < 256; c += G) {
            const int xx = c & 7, ii = c >> 3;
            {
                const int combo = xx >> 1, w = (xx & 1) * 32 + ii, b = combo >> 1, kvh = combo & 1, hq = kvh * 4 + (w >> 4), qb = w & 15;
                const size_t row0 = (size_t)b * SEQ;
                __syncthreads();
                att::attn_unit<128, ATT_SD_A, 1024, 256, 2560, 2048, SEQ>(QA + (row0 + qb * 256) * 1024 + hq * 128, KA + row0 * 256 + kvh * 128, nullptr,
                                    ZS + row0 * 2560 + 1280 + kvh * 128, OAB + (row0 + qb * 256) * 2048 + hq * 128, lds_g);
            }
            {
                const int unit = xx * 32 + ii, bh = unit >> 4, qb = unit & 15, b = bh >> 3, h = bh & 7;
                const size_t row0 = (size_t)b * SEQ;
                __syncthreads();
                att::attn_unit<192, ATT_SD_B, 1536, 2048, 2048, 2048, SEQ>(QB + (row0 + qb * 256) * 1536 + h * 192, KVB + row0 * 2048 + h * 256, KPE + row0 * 64,
                                    KVB + row0 * 2048 + h * 256 + 128, OAB + (row0 + qb * 256) * 2048 + 1024 + h * 128, lds_g);
            }
        }
        (void)x; (void)i;
        __syncthreads();
    }
    SEAM(5);
    if (IN(6)) {
        bf16_t* T1 = (bf16_t*)(ws + WS_T1);
        { pg8::Gemm g{OAB, WabT, M, 2048, 1024, 2048, 2048}; pg8::DualOrder S; S.init(M, 2048, G, bx); pg8::EpiGate E{SG, T1, MERGED};
          pg8::gemm_phase<pg8::EpiGate, pg8::DualOrder, true, true, false>(lds, g, S, E); }
    }
    SEAM(6);
    if (IN(7)) {
        pg8::Gemm g{MERGED, WoT, M, 2048, 2048, 2048, 0}; pg8::StaticOrder S; S.init(M, 2048, G, bx); pg8::EpiResid<false> E{a.x, nullptr, U, SSQ1};
        pg8::gemm_phase<pg8::EpiResid<false>, pg8::StaticOrder, true, true, false>(lds, g, S, E);
    }
    SEAM(7);
    if (IN(9)) {
        pg8::Gemm g{U, WguT, M, 2 * DFF, DM, DM, 0}; pg8::StaticOrder S; S.init(M, 2 * DFF, G, bx); pg8::EpiSwiglu E{ACT, SSQ1};
        pg8::gemm_phase<pg8::EpiSwiglu, pg8::StaticOrder, true, true, false>(lds, g, S, E);
        {
            constexpr int NU = (M / 256) * (2 * DFF / 256);
            const int nr = (NU + G - 1) / G, nbusy = NU - (nr - 1) * G; int idx = bx - nbusy, cnt = G - nbusy; if (cnt < 32) { idx = bx; cnt = G; }
            if (idx >= 0) { pg8::Gemm g2{PB, WppT, M, 2048, PLE, PLE, 0}; pg8::StaticOrder S2; S2.init(M, 2048, cnt, idx); pg8::EpiBf16<0> E2{ERAW, 2048, nullptr};
                pg8::gemm_phase<pg8::EpiBf16<0>, pg8::StaticOrder, true, true, false>(lds, g2, S2, E2); }
        }
    }
    SEAM(9);
    if (IN(10)) {
        pg8::Gemm g{ACT, WdT, M, 2048, DFF, DFF, 0}; pg8::StaticOrder S; S.init(M, 2048, G, bx); pg8::EpiResid<true> E{nullptr, U, U, SSQ2};
        pg8::gemm_phase<pg8::EpiResid<true>, pg8::StaticOrder, true, true, false>(lds, g, S, E);
    }
    SEAM(10);
    if (IN(12)) {
        { pg8::Gemm g{U, WpgT, M, 2048, DM, DM, 0}; pg8::StaticOrder S; S.init(M, 2048, G, bx); pg8::EpiBf16<1> E{GATE, 2048, SSQ2};
          pg8::gemm_phase<pg8::EpiBf16<1>, pg8::StaticOrder, true, true, false>(lds, g, S, E); }
    }
    SEAM(12);
    if (IN(13)) {
        for (int m = gw; m < M; m += NGW) {
            f32x4 h[8], e[8]; u32x2 gtw[8]; float se = 0.f;
#pragma unroll
            for (int j = 0; j < 8; ++j) gtw[j] = *(const u32x2*)(GATE + (size_t)m * DM + 4 * lane + 256 * j);
#pragma unroll
            for (int j = 0; j < 8; ++j) { { const u32x2 hw = *(const u32x2*)(U + (size_t)m * DM + 4 * lane + 256 * j); h[j] = (f32x4){bf_lo(hw.x), bf_hi(hw.x), bf_lo(hw.y), bf_hi(hw.y)}; } { const u32x2 ew = *(const u32x2*)(ERAW + (size_t)m * DM + 4 * lane + 256 * j); e[j] = (f32x4){bf_lo(ew.x), bf_hi(ew.x), bf_lo(ew.y), bf_hi(ew.y)}; }
                se += (e[j].x * e[j].x + e[j].y * e[j].y) + (e[j].z * e[j].z + e[j].w * e[j].w); }
            const float re = 1.0f / sqrtf(wave_sum(se) * (1.f / DM) + EPS);
            float sh = 0.f;
#pragma unroll
            for (int j = 0; j < 8; ++j) { const u32x2 gt = gtw[j];
                const f32x4 gp = *(const f32x4*)(a.g_ple_post + 4 * lane + 256 * j);
                h[j].x += bf_lo(gt.x) * (e[j].x * re * gp.x); h[j].y += bf_hi(gt.x) * (e[j].y * re * gp.y);
                h[j].z += bf_lo(gt.y) * (e[j].z * re * gp.z); h[j].w += bf_hi(gt.y) * (e[j].w * re * gp.w);
                sh += (h[j].x * h[j].x + h[j].y * h[j].y) + (h[j].z * h[j].z + h[j].w * h[j].w); }
            const float rh = 1.0f / sqrtf(wave_sum(sh) * (1.f / DM) + EPS);
#pragma unroll
            for (int j = 0; j < 8; ++j) { const f32x4 gf = *(const f32x4*)(a.g_final + 4 * lane + 256 * j);
                f32x4 o; o.x = h[j].x * rh * gf.x; o.y = h[j].y * rh * gf.y; o.z = h[j].z * rh * gf.z; o.w = h[j].w * rh * gf.w;
                *(f32x4*)(a.out + (size_t)m * DM + 4 * lane + 256 * j) = o;
            }
        }
    }
#undef IN
#undef SEAM
}

extern "C" void kernel_launch(void* const* d_in, const int* in_sizes, int n_in, void* d_out, int out_size, void* d_ws, size_t ws_size, hipStream_t stream) {
    static int grid = 0;
    if (grid == 0) {
        if (n_in != 21 || in_sizes[0] != M * DM || out_size != M * DM || ws_size < WS_END) {
            fprintf(stderr, "kernel_launch: unexpected shapes: n_in %d in0 %d out %d ws %zu (need %zu)\n", n_in, n_in > 0 ? in_sizes[0] : -1, out_size, ws_size, (size_t)WS_END); grid = -1; return; }
        int dev = 0, cus = 0, per_cu = 0;
        if (hipGetDevice(&dev) != hipSuccess || hipDeviceGetAttribute(&cus, hipDeviceAttributeMultiprocessorCount, dev) != hipSuccess) { grid = -1; return; }
        if (hipFuncSetAttribute((const void*)mk_fwd, hipFuncAttributeMaxDynamicSharedMemorySize, LDS_BYTES) != hipSuccess) { fprintf(stderr, "kernel_launch: hipFuncSetAttribute failed\n"); grid = -1; return; }
        if (hipOccupancyMaxActiveBlocksPerMultiprocessor(&per_cu, (const void*)mk_fwd, NTHREADS, LDS_BYTES) != hipSuccess || per_cu < 1) { fprintf(stderr, "kernel_launch: occupancy query says %d\n", per_cu); per_cu = 1; }
        (void)hipGetLastError();
        grid = cus * 1;
    }
    if (grid < 0) return;
    Args a{};
    const float** f = (const float**)&a;
    for (int i = 0; i < 21; ++i) f[i] = (const float*)d_in[i];
    a.out = (float*)d_out; a.ws = (unsigned char*)d_ws;
#if MK_ONE_LAUNCH
    if (hipMemsetAsync(d_ws, 0, 196608, stream) != hipSuccess) { fprintf(stderr, "kernel_launch: memset failed\n"); return; }
    a.ph_lo = 0; a.ph_hi = NPHASE;
    void* args[] = {&a};
    hipError_t e = hipLaunchCooperativeKernel((const void*)mk_fwd, dim3(grid), dim3(NTHREADS), args, LDS_BYTES, stream);
    if (e != hipSuccess) fprintf(stderr, "kernel_launch: cooperative launch failed: %s (grid %d)\n", hipGetErrorString(e), grid);
#else
    for (int ph = 0; ph < NPHASE; ++ph) {
        a.ph_lo = ph; a.ph_hi = ph + 1;
        hipLaunchKernelGGL(mk_fwd, dim3(grid), dim3(NTHREADS), LDS_BYTES, stream, a);
    }
#endif
}
```

```cpp
#include <hip/hip_runtime.h>
#include <hip/hip_cooperative_groups.h>
#include <cstdio>
#include <cstdint>
namespace cg = cooperative_groups;

#ifndef ATT_SD_A
#define ATT_SD_A 1
#endif
#ifndef ATT_SD_B
#define ATT_SD_B 1
#endif
#ifndef MK_ONE_LAUNCH
#define MK_ONE_LAUNCH 1
#endif

#define LAS __attribute__((address_space(3)))
typedef unsigned short bf16_t;
typedef short bf16x8 __attribute__((ext_vector_type(8)));
typedef short s16x4 __attribute__((ext_vector_type(4)));
typedef float f32x4 __attribute__((ext_vector_type(4)));
typedef float f32x16 __attribute__((ext_vector_type(16)));
typedef unsigned u32x4 __attribute__((ext_vector_type(4)));
typedef unsigned u32x2 __attribute__((ext_vector_type(2)));

constexpr int DM = 2048, SEQ = 4096, M = 8192, DFF = 5632, PLE = 256, NIN = 6720, NINP = 6912;
constexpr float EPS = 1e-6f;
constexpr int NWAVES = 8, NTHREADS = 512;
constexpr int LDS_BYTES = 139264;

constexpr size_t MiB = 1u << 20;
constexpr size_t WS_WIN = 1 * MiB, WS_WQB = 28 * MiB, WS_WKVB = 30 * MiB, WS_WAB = 32 * MiB, WS_WO = 40 * MiB, WS_WGU = 48 * MiB, WS_WD = 92 * MiB,
                 WS_WPG = 114 * MiB, WS_WPP = 122 * MiB, WS_PB = 123 * MiB, WS_KR = 127 * MiB, WS_U = 128 * MiB, WS_ZS = 160 * MiB, WS_SG = 200 * MiB,
                 WS_QA = 264 * MiB, WS_QB = 280 * MiB, WS_KVB = 304 * MiB, WS_END = 344 * MiB;
constexpr size_t WS_CQN = 1 * MiB, WS_CKVN = 9 * MiB, WS_KA = 17 * MiB, WS_KPE = 21 * MiB;
constexpr size_t WS_T1 = 264 * MiB;
constexpr size_t WS_OAB = WS_U, WS_MERGED = WS_ZS, WS_ACT = 160 * MiB, WS_GATE = 160 * MiB, WS_ERAW = 280 * MiB;

typedef float f32x2_t __attribute__((ext_vector_type(2)));
typedef __bf16 bf16x2_t __attribute__((ext_vector_type(2)));
__device__ __forceinline__ unsigned cvt_pk_bf16(float lo, float hi) { f32x2_t v = {lo, hi}; bf16x2_t b = __builtin_convertvector(v, bf16x2_t); return __builtin_bit_cast(unsigned, b); }
__device__ __forceinline__ float bf_lo(unsigned w) { return __uint_as_float(w << 16); }
__device__ __forceinline__ float bf_hi(unsigned w) { return __uint_as_float(w & 0xffff0000u); }
__device__ __forceinline__ float bf1(bf16_t h) { return __uint_as_float(((unsigned)h) << 16); }
__device__ __forceinline__ bf16_t f2bf(float f) { unsigned u = __float_as_uint(f); return (bf16_t)((u + 0x7fffu + ((u >> 16) & 1u)) >> 16); }
__device__ __forceinline__ float sigmoidf_(float x) { return __builtin_amdgcn_rcpf(1.f + __expf(-x)); }
__device__ __forceinline__ float wave_sum(float v) {
#pragma unroll
    for (int o = 1; o < 64; o <<= 1) v += __shfl_xor(v, o);
    return v;
}

namespace pg8 {
constexpr int BM = 256, BK = 64, HALF = 128, HTB = HALF * BK * 2, STAGE_BYTES = 8 * HTB, NXCD = 8, WGM = 8;
__host__ __device__ __forceinline__ int lds_byte(int r, int c) { const int st = (r >> 4) * 2 + (c >> 5), rr = r & 15, cc = c & 31, ob = rr * 64 + cc * 2; return st * 1024 + (ob ^ (((ob >> 9) & 1) << 5)); }
__host__ __device__ __forceinline__ void stage_rc(int b, int& R, int& C) { const int st = b / 1024, sb = b % 1024, swz = sb ^ (((sb >> 9) & 1) << 5); R = (st >> 1) * 16 + swz / 64; C = (st & 1) * 32 + (swz % 64) / 2; }
__host__ __device__ __forceinline__ int perm32(int rho) { const int n = rho >> 4, i = rho & 15; return 8 * (i >> 2) + 4 * n + (i & 3); }
struct Unit { int pm, pn, kh; };
struct Gemm { const bf16_t* A; const bf16_t* Bt; int M, N, K, ld, koff; };
struct StaticOrder {
    int nM, nN, nwg, G, c;
    __host__ __device__ void init(int M_, int N_, int G_, int c_) { nM = M_ / BM; nN = N_ / BM; nwg = nM * nN; G = G_; c = c_; }
    __host__ __device__ bool next(int i, Unit& u) const {
        const long L = (long)i * G + c; if (L >= nwg) return false;
        int wgid = (int)L; { const int q = nwg / NXCD, r = nwg % NXCD, xcd = wgid % NXCD, off = wgid / NXCD; wgid = (xcd < r ? xcd * (q + 1) : r * (q + 1) + (xcd - r) * q) + off; }
        const int nig = WGM * nN, gid = wgid / nig, fm = gid * WGM, gsz = (nM - fm) < WGM ? (nM - fm) : WGM;
        u.pm = fm + ((wgid % nig) % gsz); u.pn = (wgid % nig) / gsz; u.kh = 0; return true;
    }
    __device__ __forceinline__ void a_ready(const Unit&) const {}
    __device__ __forceinline__ void done(const Unit&) const {}
};
struct DualOrder : StaticOrder {
    __host__ __device__ bool next(int i, Unit& u) const { if (!StaticOrder::next(i >> 1, u)) return false; u.kh = i & 1; return true; }
};
typedef f32x4 Acc[2][2][4][2];

__device__ __forceinline__ void store8(bf16_t* p, f32x4 v0, f32x4 v1) {
    u32x4 w; w.x = cvt_pk_bf16(v0[0], v0[1]); w.y = cvt_pk_bf16(v0[2], v0[3]); w.z = cvt_pk_bf16(v1[0], v1[1]); w.w = cvt_pk_bf16(v1[2], v1[3]);
    *(u32x4*)p = w;
}
struct EpiIn {
    static constexpr bool PERM = true, AFTER_DRAIN = false;
    bf16_t *ZS, *SG, *KR;
    __device__ __forceinline__ void operator()(const Acc& acc, const Unit& u, int wr, int wc, int fr, int fq) const {
        const int pn = u.pn; bf16_t* base; int ldc, colt; bool sig = false;
        if (pn < 10) { base = ZS; ldc = 2560; colt = pn * 256; }
        else if (pn < 26) { base = SG; ldc = 4096; colt = (pn - 10) * 256; sig = true; }
        else { base = KR; ldc = 64; colt = 0; }
        const int row0 = u.pm * BM + wr * 64 + fr, col0 = colt + wc * 32 + 8 * fq;
#pragma unroll
        for (int ai = 0; ai < 2; ++ai)
#pragma unroll
            for (int m = 0; m < 4; ++m) { bf16_t* rowp = base + (size_t)(row0 + ai * HALF + m * 16) * ldc + col0;
#pragma unroll
                for (int bj = 0; bj < 2; ++bj) {
                    if (pn == 26 && (bj == 1 || wc >= 2)) continue;
                    f32x4 v0 = acc[ai][bj][m][0], v1 = acc[ai][bj][m][1];
                    if (sig) {
#pragma unroll
                        for (int j = 0; j < 4; ++j) { v0[j] = sigmoidf_(v0[j]); v1[j] = sigmoidf_(v1[j]); } }
                    store8(rowp + bj * HALF, v0, v1); } }
    }
};
template <int ACT  > struct EpiBf16 {
    static constexpr bool PERM = true, AFTER_DRAIN = false;
    bf16_t* O; int ldc; const float* ssq;
    __device__ __forceinline__ void operator()(const Acc& acc, const Unit& u, int wr, int wc, int fr, int fq) const {
        const int row0 = u.pm * BM + wr * 64 + fr, col0 = u.pn * BM + wc * 32 + 8 * fq;
#pragma unroll
        for (int ai = 0; ai < 2; ++ai)
#pragma unroll
            for (int m = 0; m < 4; ++m) { bf16_t* rowp = O + (size_t)(row0 + ai * HALF + m * 16) * ldc + col0;
                const float r = ssq ? 1.0f / sqrtf(ssq[row0 + ai * HALF + m * 16] * (1.f / DM) + EPS) : 1.f;
#pragma unroll
                for (int bj = 0; bj < 2; ++bj) { f32x4 v0 = acc[ai][bj][m][0] * r, v1 = acc[ai][bj][m][1] * r;
                    if (ACT == 1) {
#pragma unroll
                        for (int j = 0; j < 4; ++j) { v0[j] = sigmoidf_(v0[j]); v1[j] = sigmoidf_(v1[j]); } }
                    store8(rowp + bj * HALF, v0, v1); } }
    }
};
struct EpiQB {
    static constexpr bool PERM = true, AFTER_DRAIN = false;
    bf16_t* O;
    __device__ __forceinline__ void operator()(const Acc& acc, const Unit& u, int wr, int wc, int fr, int fq) const {
        const int row0 = u.pm * BM + wr * 64 + fr, col0 = u.pn * BM + wc * 32 + 8 * fq;
        float inv[8];
#pragma unroll
        for (int t = 0; t < 8; ++t) inv[t] = __builtin_amdgcn_exp2f(-(float)(2 * ((fq & 1) * 8 + t)) * (13.287712379549449f / 32.f));
        const float sgn = (fq >= 2) ? 1.f : -1.f;
#pragma unroll
        for (int ai = 0; ai < 2; ++ai)
#pragma unroll
            for (int m = 0; m < 4; ++m) { const int row = row0 + ai * HALF + m * 16, sq = row & (SEQ - 1); const float prow = (float)(sq >> 6), pcol = (float)(sq & 63);
#pragma unroll
                for (int bj = 0; bj < 2; ++bj) { f32x4 v0 = acc[ai][bj][m][0], v1 = acc[ai][bj][m][1];
                    const int rel = (u.pn * BM + bj * HALF + wc * 32) % 192;
                    if (rel >= 128) { const float pos = (rel >= 160) ? pcol : prow;
#pragma unroll
                        for (int t = 0; t < 4; ++t) {
                            const float a0 = pos * inv[t], a1 = pos * inv[4 + t];
                            const float p0 = __shfl_xor(v0[t], 32), p1 = __shfl_xor(v1[t], 32);
                            v0[t] = v0[t] * __cosf(a0) + sgn * p0 * __sinf(a0); v1[t] = v1[t] * __cosf(a1) + sgn * p1 * __sinf(a1); } }
                    store8(O + (size_t)row * 1536 + col0 + bj * HALF, v0, v1); } }
    }
};
template <bool SECOND> struct EpiGate {
    static constexpr bool PERM = true, AFTER_DRAIN = false;
    const bf16_t* SG; bf16_t* T1; bf16_t* O;
    __device__ __forceinline__ void operator()(const Acc& acc, const Unit& u, int wr, int wc, int fr, int fq) const {
        const int row0 = u.pm * BM + wr * 64 + fr, col0 = u.pn * BM + wc * 32 + 8 * fq;
#pragma unroll
        for (int ai = 0; ai < 2; ++ai)
#pragma unroll
            for (int m = 0; m < 4; ++m) { const size_t ro = (size_t)(row0 + ai * HALF + m * 16);
#pragma unroll
                for (int bj = 0; bj < 2; ++bj) {
                    const u32x4 b = *(const u32x4*)(SG + ro * 4096 + (SECOND ? 2048 : 0) + col0 + bj * HALF);
                    f32x4 s0, s1;
                    s0[0] = bf_lo(b.x); s0[1] = bf_hi(b.x); s0[2] = bf_lo(b.y); s0[3] = bf_hi(b.y);
                    s1[0] = bf_lo(b.z); s1[1] = bf_hi(b.z); s1[2] = bf_lo(b.w); s1[3] = bf_hi(b.w);
                    bf16_t* tp = T1 + ro * 2048 + col0 + bj * HALF;
                    if constexpr (!SECOND) { store8(tp, acc[ai][bj][m][0] * s0, acc[ai][bj][m][1] * s1); }
                    else { const u32x4 tw = *(const u32x4*)tp; f32x4 t0, t1;
                        t0[0] = bf_lo(tw.x); t0[1] = bf_hi(tw.x); t0[2] = bf_lo(tw.y); t0[3] = bf_hi(tw.y); t1[0] = bf_lo(tw.z); t1[1] = bf_hi(tw.z); t1[2] = bf_lo(tw.w); t1[3] = bf_hi(tw.w);
                        store8(O + ro * 2048 + col0 + bj * HALF, t0 + acc[ai][bj][m][0] * s0, t1 + acc[ai][bj][m][1] * s1); } } }
    }
};
template <bool BASEBF> struct EpiResid {
    static constexpr bool PERM = false, AFTER_DRAIN = false;
    const float* basef; const bf16_t* baseb; bf16_t* HB; float* ssq;
    __device__ __forceinline__ void operator()(const Acc& acc, const Unit& u, int wr, int wc, int fr, int fq) const {
        const int row0 = u.pm * BM + wr * 64 + fr, col0 = u.pn * BM + wc * 32 + 4 * fq;
#pragma unroll
        for (int ai = 0; ai < 2; ++ai)
#pragma unroll
            for (int m = 0; m < 4; ++m) { const int row = row0 + ai * HALF + m * 16; const size_t ro = (size_t)row * DM + col0; float ss = 0.f;
#pragma unroll
                for (int bj = 0; bj < 2; ++bj)
#pragma unroll
                    for (int n = 0; n < 2; ++n) { const size_t o = ro + bj * HALF + n * 16;
                        f32x4 v = acc[ai][bj][m][n];
                        if constexpr (BASEBF) { const u32x2 bw = *(const u32x2*)(baseb + o); v = v + (f32x4){bf_lo(bw.x), bf_hi(bw.x), bf_lo(bw.y), bf_hi(bw.y)}; }
                        else v = v + *(const f32x4*)(basef + o);
                        u32x2 w; w.x = cvt_pk_bf16(v.x, v.y); w.y = cvt_pk_bf16(v.z, v.w);
                        *(u32x2*)(HB + o) = w; ss += (v.x * v.x + v.y * v.y) + (v.z * v.z + v.w * v.w); }
                ss += __shfl_xor(ss, 16); ss += __shfl_xor(ss, 32);
                if (fq == 0) (void)__hip_atomic_fetch_add((__attribute__((address_space(1))) float*)(ssq + row), ss, __ATOMIC_RELAXED, __HIP_MEMORY_SCOPE_AGENT); }
    }
};
struct EpiSwiglu {
    static constexpr bool PERM = true, AFTER_DRAIN = false;
    bf16_t* O; const float* ssq;
    __device__ __forceinline__ void operator()(const Acc& acc, const Unit& u, int wr, int wc, int fr, int fq) const {
        const int row0 = u.pm * BM + wr * 64 + fr, col0 = u.pn * HALF + wc * 32 + 8 * fq;
#pragma unroll
        for (int ai = 0; ai < 2; ++ai)
#pragma unroll
            for (int m = 0; m < 4; ++m) {
                f32x4 a0, a1; const float r = 1.0f / sqrtf(ssq[row0 + ai * HALF + m * 16] * (1.f / DM) + EPS);
#pragma unroll
                for (int j = 0; j < 4; ++j) { const float g0 = acc[ai][0][m][0][j] * r, g1 = acc[ai][0][m][1][j] * r;
                    a0[j] = g0 * sigmoidf_(g0) * (acc[ai][1][m][0][j] * r); a1[j] = g1 * sigmoidf_(g1) * (acc[ai][1][m][1][j] * r); }
                store8(O + (size_t)(row0 + ai * HALF + m * 16) * DFF + col0, a0, a1); }
    }
};

template <class Epi, class Sched, bool ALIGN_EPI, bool SP2, bool MID>
__device__ __forceinline__ void gemm_phase(LAS unsigned char* lds, const Gemm g, const Sched S, const Epi E) {
    const int tid = threadIdx.x, wid = __builtin_amdgcn_readfirstlane(tid >> 6), lane = tid & 63, wr = wid >> 2, wc = wid & 3, fr = lane & 15, fq = lane >> 4;
    const int K = g.ld, nt = g.K / BK;
    unsigned voffA[2], voffB[2];
#pragma unroll
    for (int i = 0; i < 2; ++i) { int R, C; stage_rc(tid * 16 + i * 8192, R, C); const int Rb = Epi::PERM ? ((R & ~31) + perm32(R & 31)) : R;
        voffA[i] = (unsigned)(R * K + C) * 2u; voffB[i] = (unsigned)(Rb * K + C) * 2u; }
    const size_t kstep = (size_t)(BK * 2);
    const size_t hstep = (size_t)HALF * K * 2;
    const size_t tstep = 2 * hstep;
    const unsigned ldsw = (unsigned)wid * 1024u;
    const int aoff = lds_byte(wr * 64 + fr, fq * 8), boff = lds_byte(wc * 32 + fr, fq * 8);
#define PG8_SA(b, h) (((b) * 2 + (h)) * HTB)
#define PG8_SB(b, h) ((4 + (b) * 2 + (h)) * HTB)
#define PG8_STAGE(bufoff, gbase, voff) do { _Pragma("unroll") for (int _i = 0; _i < 2; ++_i) \
        __builtin_amdgcn_global_load_lds((const unsigned*)((const char*)(gbase) + (voff)[_i]), (LAS unsigned*)(lds + (bufoff) + ldsw + _i * 8192), 16, 0, 0); } while (0)
#define PG8_LDA(dst, b, h) do { _Pragma("unroll") for (int m = 0; m < 4; ++m) _Pragma("unroll") for (int k = 0; k < 2; ++k) dst[m][k] = *(const LAS bf16x8*)(lds + PG8_SA(b, h) + aoff + m * 2048 + k * 1024); } while (0)
#define PG8_LDB(dst, b, h) do { _Pragma("unroll") for (int n = 0; n < 2; ++n) _Pragma("unroll") for (int k = 0; k < 2; ++k) dst[n][k] = *(const LAS bf16x8*)(lds + PG8_SB(b, h) + boff + n * 2048 + k * 1024); } while (0)
#define PG8_MMA(ai, bj, At, Bt) do { __builtin_amdgcn_s_setprio(1); _Pragma("unroll") for (int m = 0; m < 4; ++m) _Pragma("unroll") for (int n = 0; n < 2; ++n) _Pragma("unroll") for (int k = 0; k < 2; ++k) \
        acc[ai][bj][m][n] = __builtin_amdgcn_mfma_f32_16x16x32_bf16(Bt[n][k], At[m][k], acc[ai][bj][m][n], 0, 0, 0); __builtin_amdgcn_s_setprio(0); } while (0)
#define PG8_WAIT_V(n) asm volatile("s_waitcnt vmcnt(" #n ")" ::: "memory")
#define PG8_WAIT_L(n) asm volatile("s_waitcnt lgkmcnt(" #n ")" ::: "memory")
#define PG8_BAR __builtin_amdgcn_s_barrier()
#define PG8_SCHED __builtin_amdgcn_sched_barrier(0)
    Unit cur, nxt; int ui = 0;
    if (!S.next(0, cur)) return;
    Acc acc;
#pragma unroll
    for (int a = 0; a < 2; ++a)
#pragma unroll
        for (int b = 0; b < 2; ++b)
#pragma unroll
            for (int m = 0; m < 4; ++m)
#pragma unroll
                for (int n = 0; n < 2; ++n) acc[a][b][m][n] = (f32x4){0.f, 0.f, 0.f, 0.f};
    bf16x8 At[4][2], B0[2][2], B1[2][2];
    const char* cA = (const char*)g.A + (size_t)cur.pm * tstep + (size_t)cur.kh * g.koff; const char* cB = (const char*)g.Bt + (size_t)cur.pn * tstep + (size_t)cur.kh * g.koff;
    S.a_ready(cur);
    if constexpr (SP2) {
        PG8_STAGE(PG8_SB(0, 0), cB, voffB); PG8_STAGE(PG8_SB(0, 1), cB + hstep, voffB); PG8_STAGE(PG8_SA(0, 0), cA, voffA); PG8_STAGE(PG8_SA(0, 1), cA + hstep, voffA);
        if (wr == 1) PG8_BAR;
        PG8_WAIT_V(2); PG8_BAR;
        PG8_STAGE(PG8_SB(1, 0), cB + kstep, voffB); PG8_STAGE(PG8_SA(1, 0), cA + kstep, voffA); PG8_STAGE(PG8_SB(1, 1), cB + hstep + kstep, voffB);
        PG8_WAIT_V(6); PG8_BAR;
    } else {
        PG8_STAGE(PG8_SB(0, 0), cB, voffB); PG8_STAGE(PG8_SA(0, 0), cA, voffA); PG8_STAGE(PG8_SB(0, 1), cB + hstep, voffB); PG8_STAGE(PG8_SA(0, 1), cA + hstep, voffA);
        if (wr == 1) PG8_BAR;
        PG8_WAIT_V(4); PG8_BAR;
        PG8_STAGE(PG8_SB(1, 0), cB + kstep, voffB); PG8_STAGE(PG8_SA(1, 0), cA + kstep, voffA); PG8_STAGE(PG8_SB(1, 1), cB + hstep + kstep, voffB);
        PG8_WAIT_V(6); PG8_BAR;
    }
    for (;;) {
        const bool has_next = S.next(ui + 1, nxt);
        const char* nA = has_next ? (const char*)g.A + (size_t)nxt.pm * tstep + (size_t)nxt.kh * g.koff : cA; const char* nB = has_next ? (const char*)g.Bt + (size_t)nxt.pn * tstep + (size_t)nxt.kh * g.koff : cB;
        for (int t = 0; t < nt; t += 2) {
            const bool last = (t == nt - 2);
            const char* a1 = cA + (size_t)(t + 1) * kstep;
            const char* a2 = last ? nA : cA + (size_t)(t + 2) * kstep; const char* b2 = last ? nB : cB + (size_t)(t + 2) * kstep;
            const char* a3 = a2 + kstep; const char* b3 = b2 + kstep;
            if (last && has_next) S.a_ready(nxt);
            if constexpr (SP2) {
            PG8_LDB(B0, 0, 0); PG8_LDB(B1, 0, 1); PG8_SCHED; PG8_LDA(At, 0, 0); PG8_STAGE(PG8_SA(1, 1), a1 + hstep, voffA);
            PG8_WAIT_V(8); PG8_WAIT_L(0); PG8_BAR; PG8_MMA(0, 0, At, B0); PG8_MMA(0, 1, At, B1); PG8_BAR; PG8_SCHED;
            PG8_LDA(At, 0, 1); PG8_STAGE(PG8_SB(0, 0), b2, voffB); PG8_STAGE(PG8_SB(0, 1), b2 + hstep, voffB); PG8_STAGE(PG8_SA(0, 0), a2, voffA);
            PG8_WAIT_V(8); PG8_WAIT_L(0); PG8_BAR; PG8_MMA(1, 0, At, B0); PG8_MMA(1, 1, At, B1); PG8_BAR; PG8_SCHED;
            PG8_LDB(B0, 1, 0); PG8_LDB(B1, 1, 1); PG8_SCHED; PG8_LDA(At, 1, 0); PG8_STAGE(PG8_SA(0, 1), a2 + hstep, voffA);
            PG8_WAIT_V(8); PG8_WAIT_L(0); PG8_BAR; PG8_MMA(0, 0, At, B0); PG8_MMA(0, 1, At, B1); PG8_BAR; PG8_SCHED;
            PG8_LDA(At, 1, 1); PG8_STAGE(PG8_SB(1, 0), b3, voffB); PG8_STAGE(PG8_SB(1, 1), b3 + hstep, voffB); PG8_STAGE(PG8_SA(1, 0), a3, voffA);
            PG8_WAIT_V(8); PG8_WAIT_L(0); PG8_BAR; PG8_MMA(1, 0, At, B0); PG8_MMA(1, 1, At, B1); PG8_BAR; PG8_SCHED;
            } else {
            PG8_LDB(B0, 0, 0); PG8_SCHED; PG8_LDA(At, 0, 0); PG8_STAGE(PG8_SA(1, 1), a1 + hstep, voffA);
            PG8_WAIT_L(8); PG8_BAR; PG8_WAIT_L(0); PG8_MMA(0, 0, At, B0); PG8_BAR; PG8_SCHED;
            PG8_LDB(B1, 0, 1); PG8_STAGE(PG8_SB(0, 0), b2, voffB);
            PG8_BAR; PG8_WAIT_L(0); PG8_MMA(0, 1, At, B1); PG8_BAR;
            PG8_LDA(At, 0, 1); PG8_STAGE(PG8_SA(0, 0), a2, voffA);
            PG8_BAR; PG8_WAIT_L(0); PG8_MMA(1, 0, At, B0); PG8_BAR; PG8_SCHED;
            PG8_STAGE(PG8_SB(0, 1), b2 + hstep, voffB);
            PG8_WAIT_V(6); PG8_BAR; PG8_MMA(1, 1, At, B1); PG8_BAR;
            PG8_LDB(B0, 1, 0); PG8_SCHED; PG8_LDA(At, 1, 0); PG8_STAGE(PG8_SA(0, 1), a2 + hstep, voffA);
            PG8_WAIT_L(8); PG8_BAR; PG8_WAIT_L(0); PG8_MMA(0, 0, At, B0); PG8_BAR; PG8_SCHED;
            PG8_LDB(B1, 1, 1); PG8_STAGE(PG8_SB(1, 0), b3, voffB);
            PG8_BAR; PG8_WAIT_L(0); PG8_MMA(0, 1, At, B1); PG8_BAR;
            PG8_LDA(At, 1, 1); PG8_STAGE(PG8_SA(1, 0), a3, voffA);
            PG8_BAR; PG8_WAIT_L(0); PG8_MMA(1, 0, At, B0); PG8_BAR; PG8_SCHED;
            PG8_STAGE(PG8_SB(1, 1), b3 + hstep, voffB);
            PG8_WAIT_V(6); PG8_BAR; PG8_MMA(1, 1, At, B1); PG8_BAR;
            }
        }
        if constexpr (ALIGN_EPI) { if (wr == 0) PG8_BAR; }
        { E(acc, cur, wr, wc, fr, fq); S.done(cur);
#pragma unroll
        for (int a = 0; a < 2; ++a)
#pragma unroll
            for (int b = 0; b < 2; ++b)
#pragma unroll
                for (int m = 0; m < 4; ++m)
#pragma unroll
                    for (int n = 0; n < 2; ++n) acc[a][b][m][n] = (f32x4){0.f, 0.f, 0.f, 0.f};
        }
        if (!has_next) break;
        cur = nxt; cA = nA; cB = nB; ++ui;
        if constexpr (ALIGN_EPI) { if (wr == 1) PG8_BAR; }
    }
    PG8_WAIT_V(0);
    if constexpr (!ALIGN_EPI) { if (wr == 0) PG8_BAR; }
    PG8_BAR;
#undef PG8_SA
#undef PG8_SB
#undef PG8_STAGE
#undef PG8_LDA
#undef PG8_LDB
#undef PG8_MMA
#undef PG8_WAIT_V
#undef PG8_WAIT_L
#undef PG8_BAR
#undef PG8_SCHED
}
}

namespace att {
constexpr int NW = 8, QBLK = 32, KVBLK = 64;
constexpr int SHM_V = KVBLK * 128 * 2, SHM_K = KVBLK * 128 * 2, SHM_KR = KVBLK * 64 * 2;
constexpr int OFF_V = 0, OFF_K = 2 * SHM_V, OFF_WS = OFF_K + 2 * SHM_K, OFF_KR = OFF_WS + NW * 64 * 4, OFF_QR = OFF_KR + 2 * SHM_KR, QR_WAVE = 6144, ATT_LDS = OFF_QR + NW * QR_WAVE;
constexpr float THR = 8.f;
#define KSWZ(row, colB) ((row) * 256 + ((colB) ^ (((row) & 7) << 4)))
#define KRSWZ(row, colB) ((row) * 128 + ((colB) ^ ((((row) >> 1) & 7) << 4)))
#define SBAR() __builtin_amdgcn_sched_barrier(0)
__device__ __forceinline__ int crow(int r, int hi) { return (r & 3) + 8 * (r >> 2) + 4 * hi; }

__device__ __forceinline__ void partialSM(f32x16& p0, f32x16& p1, float& m_reg, float& mn, float& alpha, const float C, const float THRS) {
  float pmax = p0[0];
#pragma unroll
  for (int r = 1; r < 16; ++r) pmax = fmaxf(pmax, p0[r]);
#pragma unroll
  for (int r = 0; r < 16; ++r) pmax = fmaxf(pmax, p1[r]);
  { auto rr = __builtin_amdgcn_permlane32_swap(__float_as_uint(pmax), __float_as_uint(pmax), false, false);
    pmax = fmaxf(__uint_as_float(rr[0]), __uint_as_float(rr[1])); }
  if (__builtin_expect(__all(pmax - m_reg <= THRS), 1)) { mn = m_reg; alpha = 1.f; }
  else { mn = fmaxf(m_reg, pmax); alpha = __builtin_amdgcn_exp2f((m_reg - mn) * C); m_reg = mn; }
  float mnC = -mn * C;
#pragma unroll
  for (int r = 0; r < 16; ++r) p0[r] = fmaf(p0[r], C, mnC);
#pragma unroll
  for (int r = 0; r < 16; ++r) p1[r] = fmaf(p1[r], C, mnC);
#pragma unroll
  for (int r = 0; r < 16; ++r) p0[r] = __builtin_amdgcn_exp2f(p0[r]);
}
__device__ __forceinline__ void finishSM(f32x16& p0, f32x16& p1, float alpha, float& l_reg, bf16x8& pa0, bf16x8& pa1, bf16x8& pa2, bf16x8& pa3) {
#pragma unroll
  for (int r = 0; r < 16; ++r) p1[r] = __builtin_amdgcn_exp2f(p1[r]);
  float ps = 0;
#pragma unroll
  for (int r = 0; r < 16; ++r) ps += p0[r];
#pragma unroll
  for (int r = 0; r < 16; ++r) ps += p1[r];
  { auto rr = __builtin_amdgcn_permlane32_swap(__float_as_uint(ps), __float_as_uint(ps), false, false);
    ps = __uint_as_float(rr[0]) + __uint_as_float(rr[1]); }
  l_reg = l_reg * alpha + ps;
#define PK4(P, BASE, OUT) do { unsigned a0 = cvt_pk_bf16(P[BASE + 0], P[BASE + 1]), a1 = cvt_pk_bf16(P[BASE + 2], P[BASE + 3]);   \
    unsigned b0 = cvt_pk_bf16(P[BASE + 4], P[BASE + 5]), b1 = cvt_pk_bf16(P[BASE + 6], P[BASE + 7]);                              \
    auto r0 = __builtin_amdgcn_permlane32_swap(a0, b0, false, false); auto r1 = __builtin_amdgcn_permlane32_swap(a1, b1, false, false); \
    u32x4 w = {r0[0], r1[0], r0[1], r1[1]}; OUT = *reinterpret_cast<bf16x8*>(&w); } while (0)
  PK4(p0, 0, pa0); PK4(p0, 8, pa1); PK4(p1, 0, pa2); PK4(p1, 8, pa3);
#undef PK4
}
template <int DK, int NQR>
__device__ __forceinline__ void qkt(f32x16& p0, f32x16& p1, const char* Ks, const char* Krs, const bf16x8* qr, const char* qrl, int r32, int hi) {
  p0 = f32x16{}; p1 = f32x16{};
#pragma unroll
  for (int d0 = 0; d0 < 8; ++d0) { int cb = (d0 * 16 + hi * 8) * 2;
    bf16x8 b0 = *reinterpret_cast<const bf16x8*>(Ks + KSWZ(r32, cb));
    bf16x8 b1 = *reinterpret_cast<const bf16x8*>(Ks + KSWZ(32 + r32, cb));
    bf16x8 qv; if (d0 < NQR) qv = qr[d0 < NQR ? d0 : 0]; else qv = *reinterpret_cast<const bf16x8*>(qrl + (d0 - NQR) * 1024);
    p0 = __builtin_amdgcn_mfma_f32_32x32x16_bf16(b0, qv, p0, 0, 0, 0);
    p1 = __builtin_amdgcn_mfma_f32_32x32x16_bf16(b1, qv, p1, 0, 0, 0); }
  if constexpr (DK == 192) {
#pragma unroll
    for (int d0 = 0; d0 < 4; ++d0) { int cb = (d0 * 16 + hi * 8) * 2;
      bf16x8 b0 = *reinterpret_cast<const bf16x8*>(Krs + KRSWZ(r32, cb));
      bf16x8 b1 = *reinterpret_cast<const bf16x8*>(Krs + KRSWZ(32 + r32, cb));
      const bf16x8 qv = *reinterpret_cast<const bf16x8*>(qrl + (8 - NQR + d0) * 1024);
      p0 = __builtin_amdgcn_mfma_f32_32x32x16_bf16(b0, qv, p0, 0, 0, 0);
      p1 = __builtin_amdgcn_mfma_f32_32x32x16_bf16(b1, qv, p1, 0, 0, 0); }
  }
}
__device__ __forceinline__ int v_st(int k, int c) { const int kk = (k & ~0xC) | ((k & 4) << 1) | ((k & 8) >> 1); return ((kk >> 3) * 4 + (c >> 5)) * 512 + ((kk & 7) * 32 + (c & 31)) * 2; }
__device__ __forceinline__ int v_rd_base(int lane) { return ((lane & 3) << 3) | (((lane >> 2) & 3) << 6) | (((lane >> 4) & 1) << 5) | (((lane >> 5) & 1) << 8); }
constexpr int v_rd_off(int d0, int ks, int half) { return d0 * 512 + ks * 4096 + half * 2048; }
template <int OFF> __device__ __forceinline__ s16x4 tr_read(int vb) {
  s16x4 r; asm volatile("ds_read_b64_tr_b16 %0, %1 offset:%2" : "=&v"(r) : "v"(vb), "i"(OFF) : "memory"); return r;
}
template <int D0> __device__ __forceinline__ void pv_one(f32x16& od, int vb, bf16x8 pa0, bf16x8 pa1, bf16x8 pa2, bf16x8 pa3) {
  const s16x4 l0 = tr_read<v_rd_off(D0, 0, 0)>(vb), h0 = tr_read<v_rd_off(D0, 0, 1)>(vb), l1 = tr_read<v_rd_off(D0, 1, 0)>(vb), h1 = tr_read<v_rd_off(D0, 1, 1)>(vb);
  const s16x4 l2 = tr_read<v_rd_off(D0, 2, 0)>(vb), h2 = tr_read<v_rd_off(D0, 2, 1)>(vb), l3 = tr_read<v_rd_off(D0, 3, 0)>(vb), h3 = tr_read<v_rd_off(D0, 3, 1)>(vb);
  asm volatile("s_waitcnt lgkmcnt(0)" ::: "memory"); SBAR();
#define PK(L, H) (bf16x8){L[0], L[1], L[2], L[3], H[0], H[1], H[2], H[3]}
  od = __builtin_amdgcn_mfma_f32_32x32x16_bf16(pa0, PK(l0, h0), od, 0, 0, 0);
  od = __builtin_amdgcn_mfma_f32_32x32x16_bf16(pa1, PK(l1, h1), od, 0, 0, 0);
  od = __builtin_amdgcn_mfma_f32_32x32x16_bf16(pa2, PK(l2, h2), od, 0, 0, 0);
  od = __builtin_amdgcn_mfma_f32_32x32x16_bf16(pa3, PK(l3, h3), od, 0, 0, 0);
#undef PK
}
__device__ __forceinline__ void pv_d0(f32x16* o, int vb, bf16x8 pa0, bf16x8 pa1, bf16x8 pa2, bf16x8 pa3) {
  pv_one<0>(o[0], vb, pa0, pa1, pa2, pa3); pv_one<1>(o[1], vb, pa0, pa1, pa2, pa3); pv_one<2>(o[2], vb, pa0, pa1, pa2, pa3); pv_one<3>(o[3], vb, pa0, pa1, pa2, pa3);
}

template <int DK, int SDEPTH, int ldq, int ldk, int ldv, int ldo, int seq>
__device__ __forceinline__ void attn_unit(const bf16_t* __restrict__ Qb, const bf16_t* __restrict__ Kh, const bf16_t* __restrict__ Krp,
                                          const bf16_t* __restrict__ Vh, bf16_t* __restrict__ Ob, char* lds) {
  constexpr float SCALE = (DK == 128) ? 0.088388347648318440f : 0.072168783648703220f;
  constexpr float C = SCALE * 1.4426950408889634f, THRS = THR / SCALE;
  constexpr int ND = DK / 16, NQR = (DK == 128) ? 8 : 6;
  const int tid = threadIdx.x, wid = tid >> 6, lane = tid & 63, r32 = lane & 31, hi = lane >> 5;
  char* V_lds = lds + OFF_V; char* K_lds = lds + OFF_K; char* KR_lds = lds + OFF_KR;
  float* ws = (float*)(lds + OFF_WS) + wid * 64; float* li_l = ws; float* al_l = ws + 32;
  float m_reg = -1e30f, l_reg = 0; f32x16 o[4] = {}; bf16x8 qr[NQR];
  const bf16_t* Qw = Qb + (long)(wid * QBLK + r32) * ldq + hi * 8;
#pragma unroll
  for (int d0 = 0; d0 < NQR; ++d0) qr[d0] = *reinterpret_cast<const bf16x8*>(Qw + d0 * 16);
  char* qrl = lds + OFF_QR + wid * QR_WAVE + lane * 16;
#pragma unroll
  for (int d0 = NQR; d0 < ND; ++d0) *reinterpret_cast<bf16x8*>(qrl + (d0 - NQR) * 1024) = *reinterpret_cast<const bf16x8*>(Qw + d0 * 16);
  const int sr = tid >> 4, sc = (tid & 15) * 8, vst0 = v_st(sr, sc), vst1 = v_st(32 + sr, sc);
  const int krr = tid >> 3, krc = (tid & 7) * 8;
  const int vb0 = (int)(uintptr_t)V_lds + v_rd_base(lane);
  bf16x8 vs0[SDEPTH], vs1[SDEPTH], ks0[SDEPTH], ks1[SDEPTH], kr0[SDEPTH];
  const unsigned voffV = (unsigned)((sr * ldv + sc) * 2), voffK = (unsigned)((sr * ldk + sc) * 2), voffR = (unsigned)((krr * 64 + krc) * 2);
#define SLOAD(i, k0) do { const char* vb_ = (const char*)Vh + (size_t)(k0) * (ldv * 2); const char* kb_ = (const char*)Kh + (size_t)(k0) * (ldk * 2); \
    vs0[i] = *(const bf16x8*)(vb_ + voffV); vs1[i] = *(const bf16x8*)(vb_ + 32 * ldv * 2 + voffV); \
    ks0[i] = *(const bf16x8*)(kb_ + voffK); ks1[i] = *(const bf16x8*)(kb_ + 32 * ldk * 2 + voffK); \
    if constexpr (DK == 192) kr0[i] = *(const bf16x8*)((const char*)Krp + (size_t)(k0) * 128 + voffR); } while (0)
#define SWRITE(b, i) do { *(bf16x8*)(V_lds + (b) * SHM_V + vst0) = vs0[i];          \
    *(bf16x8*)(V_lds + (b) * SHM_V + vst1) = vs1[i]; int kc = sc * 2;               \
    *(bf16x8*)(K_lds + (b) * SHM_K + KSWZ(sr, kc)) = ks0[i];                       \
    *(bf16x8*)(K_lds + (b) * SHM_K + KSWZ(32 + sr, kc)) = ks1[i];                  \
    if constexpr (DK == 192) *(bf16x8*)(KR_lds + (b) * SHM_KR + KRSWZ(krr, krc * 2)) = kr0[i]; } while (0)
#define SWAIT() do { if constexpr (SDEPTH == 1) asm volatile("s_waitcnt vmcnt(0)" ::: "memory"); else if constexpr (DK == 192) asm volatile("s_waitcnt vmcnt(5)" ::: "memory"); else asm volatile("s_waitcnt vmcnt(4)" ::: "memory"); } while (0)
#define RESC(a) do { if (__any((a) < 1.f)) { if (hi == 0) al_l[r32] = (a); asm volatile("s_waitcnt lgkmcnt(0)" ::: "memory"); \
    _Pragma("unroll") for (int d = 0; d < 4; ++d) _Pragma("unroll") for (int r = 0; r < 16; ++r) o[d][r] *= al_l[crow(r, hi)]; } } while (0)
  f32x16 pA0, pA1, pB0, pB1; float mnA, mnB, alA, alB; bf16x8 pa0, pa1, pa2, pa3; const int NT = seq / KVBLK;
  constexpr int SE = 0, SO = SDEPTH - 1;
  SLOAD(SE, 0); asm volatile("s_waitcnt vmcnt(0)" ::: "memory"); SWRITE(0, SE); __syncthreads();
  qkt<DK, NQR>(pA0, pA1, K_lds, KR_lds, qr, qrl, r32, hi); partialSM(pA0, pA1, m_reg, mnA, alA, C, THRS);
  SLOAD(SO, KVBLK); if constexpr (SDEPTH == 2) { if (2 < NT) SLOAD(SE, 2 * KVBLK); }
  SWAIT(); SWRITE(1, SO); __syncthreads();
  for (int j = 1; j + 1 < NT; j += 2) {
    SBAR(); qkt<DK, NQR>(pB0, pB1, K_lds + SHM_K, KR_lds + SHM_KR, qr, qrl, r32, hi);
    finishSM(pA0, pA1, alA, l_reg, pa0, pa1, pa2, pa3); SBAR();
    SLOAD(SO, (j + SDEPTH) * KVBLK); SBAR();
    pv_d0(o, vb0, pa0, pa1, pa2, pa3); partialSM(pB0, pB1, m_reg, mnB, alB, C, THRS);
    __syncthreads(); SWAIT(); SWRITE(0, SE);
    RESC(alB); __syncthreads();
    SBAR(); qkt<DK, NQR>(pA0, pA1, K_lds, KR_lds, qr, qrl, r32, hi);
    finishSM(pB0, pB1, alB, l_reg, pa0, pa1, pa2, pa3); SBAR();
    if (SDEPTH == 1 || j + 3 < NT) SLOAD(SE, (j + 1 + SDEPTH) * KVBLK); SBAR();
    pv_d0(o, vb0 + SHM_V, pa0, pa1, pa2, pa3); partialSM(pA0, pA1, m_reg, mnA, alA, C, THRS);
    __syncthreads(); SWAIT(); SWRITE(1, SO);
    RESC(alA); __syncthreads();
  }
  SBAR(); qkt<DK, NQR>(pB0, pB1, K_lds + SHM_K, KR_lds + SHM_KR, qr, qrl, r32, hi);
  finishSM(pA0, pA1, alA, l_reg, pa0, pa1, pa2, pa3); SBAR();
  pv_d0(o, vb0, pa0, pa1, pa2, pa3); partialSM(pB0, pB1, m_reg, mnB, alB, C, THRS);
  __syncthreads(); RESC(alB);
  finishSM(pB0, pB1, alB, l_reg, pa0, pa1, pa2, pa3); SBAR();
  pv_d0(o, vb0 + SHM_V, pa0, pa1, pa2, pa3);
  if (hi == 0) li_l[r32] = l_reg; asm volatile("s_waitcnt lgkmcnt(0)" ::: "memory");
  float rli[16];
#pragma unroll
  for (int r = 0; r < 16; ++r) rli[r] = __builtin_amdgcn_rcpf(li_l[crow(r, hi)]);
  bf16_t* Ow = Ob + (long)(wid * QBLK) * ldo;
#pragma unroll
  for (int r = 0; r < 16; ++r) { int orow = crow(r, hi);
#pragma unroll
    for (int d0 = 0; d0 < 4; ++d0) Ow[(long)orow * ldo + d0 * 32 + r32] = f2bf(o[d0][r] * rli[r]); }
#undef SLOAD
#undef SWRITE
#undef SWAIT
#undef RESC
}
}

struct TrItem { const float* W; bf16_t* WT; int ldw, k0, n0, ldt, drow0, dk0; const float* gain; };
__device__ __forceinline__ void tr_load(f32x4 (&v)[16], const TrItem& t, int lane) {
    const int lr = lane >> 4, lc = (lane & 15) * 4;
#pragma unroll
    for (int i = 0; i < 16; ++i) v[i] = *(const f32x4*)(t.W + (size_t)(t.k0 + 4 * i + lr) * t.ldw + t.n0 + lc);
}
__device__ __forceinline__ void tr_store(const f32x4 (&v)[16], const TrItem& t, LAS float* scr, int lane) {
    const int lr = lane >> 4, lc = (lane & 15) * 4;
#pragma unroll
    for (int i = 0; i < 16; ++i) { LAS float* d = scr + (4 * i + lr) * 65 + lc; const float gk = t.gain ? t.gain[t.k0 + 4 * i + lr] : 1.f;
        d[0] = v[i].x * gk; d[1] = v[i].y * gk; d[2] = v[i].z * gk; d[3] = v[i].w * gk; }
    asm volatile("s_waitcnt lgkmcnt(0)" ::: "memory");
    const int c = lane & 7;
#pragma unroll
    for (int j = 0; j < 8; ++j) { const int n = (lane >> 3) + 8 * j; const LAS float* s = scr + (8 * c) * 65 + n;
        u32x4 o; o.x = cvt_pk_bf16(s[0], s[65]); o.y = cvt_pk_bf16(s[130], s[195]); o.z = cvt_pk_bf16(s[260], s[325]); o.w = cvt_pk_bf16(s[390], s[455]);
        *(u32x4*)(t.WT + (size_t)(t.drow0 + n) * t.ldt + t.dk0 + 8 * c) = o; }
    asm volatile("s_waitcnt lgkmcnt(0)" ::: "memory");
}
__device__ __forceinline__ void tr_item(const float* __restrict__ W, int ldw, int k0, int n0, bf16_t* __restrict__ WT, int ldt, int drow0, int dk0, LAS float* scr, int lane) {
    TrItem t{W, WT, ldw, k0, n0, ldt, drow0, dk0, nullptr}; f32x4 v[16]; tr_load(v, t, lane); tr_store(v, t, scr, lane);
}
__device__ __forceinline__ void rms_row_to_bf16(const float* __restrict__ xrow, const float* __restrict__ g, bf16_t* __restrict__ orow, int lane) {
    f32x4 v[8]; float s = 0.f;
#pragma unroll
    for (int j = 0; j < 8; ++j) { v[j] = *(const f32x4*)(xrow + 4 * lane + 256 * j); s += (v[j].x * v[j].x + v[j].y * v[j].y) + (v[j].z * v[j].z + v[j].w * v[j].w); }
    const float r = 1.0f / sqrtf(wave_sum(s) * (1.f / DM) + EPS);
#pragma unroll
    for (int j = 0; j < 8; ++j) { const f32x4 gg = *(const f32x4*)(g + 4 * lane + 256 * j);
        u32x2 o; o.x = cvt_pk_bf16(v[j].x * r * gg.x, v[j].y * r * gg.y); o.y = cvt_pk_bf16(v[j].z * r * gg.z, v[j].w * r * gg.w);
        *(u32x2*)(orow + 4 * lane + 256 * j) = o; }
}

#define XB_TMO      128
#define XB_XCNT(j)  (256  + 64 * (j))
#define XB_XSUB(j)  (1280 + 64 * (j))
#define XB_XGEN(j)  (2304 + 64 * (j))
#define XB_TOP      3328
#define XB_TOPGEN   3392
#define XCD_BAR_WORDS 3456
#define XB_SPIN_CAP (1u << 18)
__device__ __forceinline__ unsigned xb_ld(unsigned* p)              { return __hip_atomic_load(p, __ATOMIC_RELAXED, __HIP_MEMORY_SCOPE_AGENT); }
__device__ __forceinline__ unsigned xb_add(unsigned* p, unsigned v) { return __hip_atomic_fetch_add(p, v, __ATOMIC_RELAXED, __HIP_MEMORY_SCOPE_AGENT); }
__device__ __forceinline__ unsigned xb_xcc_id() { return (unsigned)__builtin_amdgcn_s_getreg((3 << 11) | 20) & 0xFu; }
#define XB_SPIN(cond, bar) do { unsigned _sp = 0; while (cond) { __builtin_amdgcn_s_sleep(1); \
    if ((++_sp & 255u) == 0u) { if (xb_ld(&(bar)[XB_TMO])) break; if (_sp > XB_SPIN_CAP) { atomicAdd(&(bar)[XB_TMO], 1u); break; } } } } while (0)
struct XcdBarrier { unsigned* bar; unsigned x; volatile LAS unsigned* st; };
__device__ __forceinline__ XcdBarrier xcd_barrier_post(unsigned* bar, volatile LAS unsigned* st) {
    XcdBarrier b; b.bar = bar; b.x = xb_xcc_id(); b.st = st;
    if (threadIdx.x == 0) (void)xb_add(&bar[XB_XCNT(b.x)], 1u);
    return b;
}
__device__ __forceinline__ void xcd_barrier_complete(unsigned* bar, unsigned x, unsigned& nloc, unsigned& nx) {
    const unsigned G = gridDim.x * gridDim.y * gridDim.z;
    unsigned sum, cnt, mine, sp = 0u;
    for (;;) {
        sum = 0u; cnt = 0u; mine = 0u;
#pragma unroll
        for (unsigned j = 0; j < 16; ++j) { const unsigned c = xb_ld(&bar[XB_XCNT(j)]); sum += c; cnt += (c > 0u) ? 1u : 0u; mine = (j == x) ? c : mine; }
        if (sum == G) break;
        __builtin_amdgcn_s_sleep(1);
        if ((++sp & 255u) == 0u) { if (xb_ld(&bar[XB_TMO])) break; if (sp > XB_SPIN_CAP) { atomicAdd(&bar[XB_TMO], 1u); break; } }
    }
    nloc = mine > 0u ? mine : 1u; nx = cnt > 0u ? cnt : 1u;
}
__device__ __forceinline__ void xcd_barrier(const XcdBarrier& b) {
    asm volatile("s_waitcnt vmcnt(0)" ::: "memory");
    __syncthreads();
    if (threadIdx.x == 0) {
        unsigned* bar = b.bar;
        __builtin_amdgcn_s_waitcnt(0);
        unsigned nloc = b.st[0], nx = b.st[1];
        if (nloc == 0u) { xcd_barrier_complete(bar, b.x, nloc, nx); b.st[0] = nloc; b.st[1] = nx; }
        const unsigned old = xb_add(&bar[XB_XSUB(b.x)], 1u);
        const unsigned gen = old / nloc;
        if (old + 1u == (gen + 1u) * nloc) {
            __builtin_amdgcn_fence(__ATOMIC_RELEASE, "agent");
            asm volatile("s_waitcnt vmcnt(0)" ::: "memory");
            const unsigned og = xb_add(&bar[XB_TOP], 1u);
            const unsigned tg = og / nx;
            if (og + 1u == (tg + 1u) * nx) xb_add(&bar[XB_TOPGEN], 1u);
            else XB_SPIN(xb_ld(&bar[XB_TOPGEN]) == tg, bar);
            __builtin_amdgcn_fence(__ATOMIC_ACQUIRE, "agent");
            xb_add(&bar[XB_XGEN(b.x)], 1u);
            asm volatile("s_waitcnt vmcnt(0)" ::: "memory");
        } else {
            XB_SPIN(xb_ld(&bar[XB_XGEN(b.x)]) == gen, bar);
            __builtin_amdgcn_fence(__ATOMIC_ACQUIRE, "agent");
            asm volatile("s_waitcnt vmcnt(0)" ::: "memory");
        }
    }
    __syncthreads();
}

struct Args {
    const float *x, *p, *g_mix, *w_in, *q_norm_a, *k_norm_a, *q_a_norm, *w_q_b, *kv_a_norm, *w_kv_b, *w_a_out, *w_b_out, *w_o, *g_ffn, *w_gate_up, *w_down, *g_ple,
                *w_ple_gate, *w_ple_proj, *g_ple_post, *g_final;
    float* out; unsigned char* ws; int ph_lo, ph_hi;
};

constexpr int NPHASE = 14;

__global__ void __launch_bounds__(NTHREADS, 2) mk_fwd(Args a) {
    extern __shared__ __attribute__((aligned(16))) unsigned char lds_raw[];
    LAS unsigned char* lds = (LAS unsigned char*)lds_raw;
    const int tid = threadIdx.x, lane = tid & 63, wave = __builtin_amdgcn_readfirstlane(tid >> 6);
    const int G = gridDim.x, bx = blockIdx.x;
    const int gw = bx * NWAVES + wave, NGW = G * NWAVES;
    unsigned char* ws = a.ws;
    bf16_t* WinT = (bf16_t*)(ws + WS_WIN); bf16_t* WqbT = (bf16_t*)(ws + WS_WQB); bf16_t* WkvbT = (bf16_t*)(ws + WS_WKVB); bf16_t* WabT = (bf16_t*)(ws + WS_WAB);
    bf16_t* WoT = (bf16_t*)(ws + WS_WO); bf16_t* WguT = (bf16_t*)(ws + WS_WGU); bf16_t* WdT = (bf16_t*)(ws + WS_WD); bf16_t* WpgT = (bf16_t*)(ws + WS_WPG);
    bf16_t* WppT = (bf16_t*)(ws + WS_WPP); bf16_t* PB = (bf16_t*)(ws + WS_PB); bf16_t* KR = (bf16_t*)(ws + WS_KR); bf16_t* U = (bf16_t*)(ws + WS_U);
    bf16_t* ZS = (bf16_t*)(ws + WS_ZS); bf16_t* SG = (bf16_t*)(ws + WS_SG); bf16_t* QA = (bf16_t*)(ws + WS_QA); bf16_t* QB = (bf16_t*)(ws + WS_QB);
    bf16_t* KVB = (bf16_t*)(ws + WS_KVB); bf16_t* CQN = (bf16_t*)(ws + WS_CQN); bf16_t* CKVN = (bf16_t*)(ws + WS_CKVN); bf16_t* KA = (bf16_t*)(ws + WS_KA);
    bf16_t* KPE = (bf16_t*)(ws + WS_KPE); bf16_t* OAB = (bf16_t*)(ws + WS_OAB); bf16_t* MERGED = (bf16_t*)(ws + WS_MERGED); bf16_t* ACT = (bf16_t*)(ws + WS_ACT);
    bf16_t* GATE = (bf16_t*)(ws + WS_GATE); bf16_t* ERAW = (bf16_t*)(ws + WS_ERAW); float* H = a.out;
    float* SSQ1 = (float*)(ws + 65536); float* SSQ2 = (float*)(ws + 131072);
    const int lo = a.ph_lo, hi = a.ph_hi;
#define IN(k) (lo <= (k) && (k) < hi)
#define SEAM(k) do { if (IN(k) && IN((k) + 1)) { xcd_barrier(xbar); } } while (0)
    volatile LAS unsigned* xst = (volatile LAS unsigned*)(lds + LDS_BYTES - 64);
    if (tid == 0) { xst[0] = 0u; xst[1] = 0u; }
    __syncthreads();
    XcdBarrier xbar = xcd_barrier_post((unsigned*)ws, xst);
    if (a.ph_lo < 0) cg::this_grid().sync();

    constexpr int I0 = 32 * 105, I1 = 8 * 24, I2 = 8 * 32, I3 = 16 * 32, I4 = 16 * 32, I5 = 32 * 32, I6 = 32 * 176, I7 = 88 * 32, I8 = 32 * 32, I9 = 4 * 32;
    constexpr int NREST = I1 + I2 + I3 + I4 + I5 + I6 + I7 + I8 + I9;
    if (IN(0)) {
        LAS float* scr = (LAS float*)(lds + wave * 16640);
        for (int it = gw; it < I0; it += NGW) {
            const int kb = it / 105, nb = it % 105, n0 = nb * 64; const int dr = n0 < 2560 ? n0 : (n0 < 2624 ? 6656 + (n0 - 2560) : n0 - 64);
            tr_item(a.w_in, NIN, kb * 64, n0, WinT, 2048, dr, kb * 64, scr, lane);
        }
        for (int m = gw; m < M; m += NGW) {
            rms_row_to_bf16(a.x + (size_t)m * DM, a.g_mix, U + (size_t)m * DM, lane);
            const f32x4 pv = *(const f32x4*)(a.p + (size_t)m * PLE + 4 * lane);
            u32x2 o; o.x = cvt_pk_bf16(pv.x, pv.y); o.y = cvt_pk_bf16(pv.z, pv.w);
            *(u32x2*)(PB + (size_t)m * PLE + 4 * lane) = o;
        }
        for (int i = bx * NTHREADS + tid; i < (NINP - NIN) * 2048 / 8; i += G * NTHREADS) *(u32x4*)(WinT + (size_t)NIN * 2048 + (size_t)i * 8) = (u32x4){0u, 0u, 0u, 0u};
        __syncthreads();
    }
    SEAM(0);
    if (IN(1)) {
        constexpr int NU = (M / 256) * (NINP / 256);
        const int GG = (G >= 256) ? 216 : G;
        if (bx < GG) {
            pg8::Gemm g{U, WinT, M, NINP, DM, DM, 0}; pg8::StaticOrder S; S.init(M, NINP, GG, bx);
            pg8::EpiIn E{ZS, SG, KR};
            pg8::gemm_phase<pg8::EpiIn, pg8::StaticOrder, true, true, false>(lds, g, S, E);
        }
        {
            int idx = bx - GG, cnt = G - GG; if (cnt <= 0) { idx = bx; cnt = G; }
            if (idx >= 0) {
                LAS float* scr = (LAS float*)(lds + wave * 16640);
                auto decode = [&](int r) -> TrItem {
                    if (r < I1) { const int kb = r / 24, nb = r % 24; return TrItem{a.w_q_b, WqbT, 1536, kb * 64, nb * 64, 512, nb * 64, kb * 64, nullptr}; } r -= I1;
                    if (r < I2) { const int kb = r / 32, nb = r % 32; return TrItem{a.w_kv_b, WkvbT, 2048, kb * 64, nb * 64, 512, nb * 64, kb * 64, nullptr}; } r -= I2;
                    if (r < I3) { const int kb = r / 32, nb = r % 32; return TrItem{a.w_a_out, WabT, 2048, kb * 64, nb * 64, 2048, nb * 64, kb * 64, nullptr}; } r -= I3;
                    if (r < I4) { const int kb = r / 32, nb = r % 32; return TrItem{a.w_b_out, WabT, 2048, kb * 64, nb * 64, 2048, nb * 64, 1024 + kb * 64, nullptr}; } r -= I4;
                    if (r < I5) { const int kb = r / 32, nb = r % 32; return TrItem{a.w_o, WoT, 2048, kb * 64, nb * 64, 2048, nb * 64, kb * 64, nullptr}; } r -= I5;
                    if (r < I6) { const int kb = r / 176, nb = r % 176, n0 = nb * 64; const int s_ = n0 >= DFF ? 1 : 0, j = n0 - s_ * DFF; const int dr = 256 * (j >> 7) + 128 * s_ + (j & 127);
                        return TrItem{a.w_gate_up, WguT, 2 * DFF, kb * 64, n0, 2048, dr, kb * 64, a.g_ffn}; } r -= I6;
                    if (r < I7) { const int kb = r / 32, nb = r % 32; return TrItem{a.w_down, WdT, 2048, kb * 64, nb * 64, DFF, nb * 64, kb * 64, nullptr}; } r -= I7;
                    if (r < I8) { const int kb = r / 32, nb = r % 32; return TrItem{a.w_ple_gate, WpgT, 2048, kb * 64, nb * 64, 2048, nb * 64, kb * 64, a.g_ple}; } r -= I8;
                    { const int kb = r / 32, nb = r % 32; return TrItem{a.w_ple_proj, WppT, 2048, kb * 64, nb * 64, 256, nb * 64, kb * 64, nullptr}; }
                };
                const int stride = cnt * NWAVES; int it = idx * NWAVES + wave;
                f32x4 va[16], vb[16]; TrItem ta{}, tb{};
                if (it < NREST) { ta = decode(it); tr_load(va, ta, lane); }
                while (it < NREST) {
                    int it2 = it + stride; if (it2 < NREST) { tb = decode(it2); tr_load(vb, tb, lane); }
                    tr_store(va, ta, scr, lane);
                    it = it2; if (it >= NREST) break;
                    it2 = it + stride; if (it2 < NREST) { ta = decode(it2); tr_load(va, ta, lane); }
                    tr_store(vb, tb, scr, lane);
                    it = it2;
                }
            }
            __syncthreads();
        }
        (void)NU;
    }
    SEAM(1);
    if (IN(2)) {
        const int l5 = lane & 31, hsel = lane >> 5, d0 = l5 * 4, isx2 = (l5 >> 3) & 1, halfc = (l5 >> 4) & 1;
        float invA4[4]; f32x4 gq, gk;
#pragma unroll
        for (int i = 0; i < 4; ++i) invA4[i] = powf(10000.f, -(float)(2 * ((d0 & 31) + i)) / 64.f);
        gq = *(const f32x4*)(a.q_norm_a + d0); gk = *(const f32x4*)(a.k_norm_a + d0);
        const int hfb = (lane >> 4) & 1, jb = lane & 15;
        const float invB = powf(10000.f, -(float)(2 * jb) / 32.f);
        for (int m = gw; m < M; m += NGW) {
            const int s = m & (SEQ - 1); const float prow = (float)(s >> 6), pcol = (float)(s & 63);
            const float posA = halfc ? pcol : prow; float cA[4], sA[4];
#pragma unroll
            for (int i = 0; i < 4; ++i) { const float ang = posA * invA4[i]; cA[i] = cosf(ang); sA[i] = sinf(ang); }
            const bf16_t* zr = ZS + (size_t)m * 2560;
#pragma unroll
            for (int it = 0; it < 5; ++it) {
                const int head = 2 * it + hsel;
                const u32x2 w = *(const u32x2*)(zr + head * 128 + d0);
                const float x[4] = {bf_lo(w.x), bf_hi(w.x), bf_lo(w.y), bf_hi(w.y)};
                float ss = (x[0] * x[0] + x[1] * x[1]) + (x[2] * x[2] + x[3] * x[3]);
#pragma unroll
                for (int o2 = 1; o2 < 32; o2 <<= 1) ss += __shfl_xor(ss, o2);
                const float r = 1.0f / sqrtf(ss * (1.f / 128.f) + EPS);
                const f32x4 g = (it < 4) ? gq : gk; float o[4];
#pragma unroll
                for (int i = 0; i < 4; ++i) { const float y = x[i] * r * g[i]; const float p = __shfl_xor(y, 8);
                    o[i] = isx2 ? (y * cA[i] + p * sA[i]) : (y * cA[i] - p * sA[i]); }
                u32x2 ow; ow.x = cvt_pk_bf16(o[0], o[1]); ow.y = cvt_pk_bf16(o[2], o[3]);
                bf16_t* dst = (it < 4) ? (QA + (size_t)m * 1024 + head * 128 + d0) : (KA + (size_t)m * 256 + (head - 8) * 128 + d0);
                *(u32x2*)dst = ow;
            }
#pragma unroll
            for (int t = 0; t < 2; ++t) {
                const u32x4 w = *(const u32x4*)(zr + 1536 + t * 512 + lane * 8);
                float v[8] = {bf_lo(w.x), bf_hi(w.x), bf_lo(w.y), bf_hi(w.y), bf_lo(w.z), bf_hi(w.z), bf_lo(w.w), bf_hi(w.w)};
                float ss = 0.f;
#pragma unroll
                for (int i = 0; i < 8; ++i) ss += v[i] * v[i];
                const float r = 1.0f / sqrtf(wave_sum(ss) * (1.f / 512.f) + EPS);
                const float* gg = (t == 0 ? a.q_a_norm : a.kv_a_norm) + lane * 8;
                const f32x4 g0 = *(const f32x4*)gg, g1 = *(const f32x4*)(gg + 4);
                u32x4 o; o.x = cvt_pk_bf16(v[0] * r * g0.x, v[1] * r * g0.y); o.y = cvt_pk_bf16(v[2] * r * g0.z, v[3] * r * g0.w);
                o.z = cvt_pk_bf16(v[4] * r * g1.x, v[5] * r * g1.y); o.w = cvt_pk_bf16(v[6] * r * g1.z, v[7] * r * g1.w);
                *(u32x4*)((t == 0 ? CQN : CKVN) + (size_t)m * 512 + lane * 8) = o;
            }
            if (lane < 32) {
                const float angB = (hfb ? pcol : prow) * invB; const float cB = cosf(angB), sB = sinf(angB);
                const bf16_t* kr = KR + (size_t)m * 64 + hfb * 32 + jb;
                const float x1 = bf1(kr[0]), x2 = bf1(kr[16]);
                bf16_t* dst = KPE + (size_t)m * 64 + hfb * 32 + jb;
                dst[0] = f2bf(x1 * cB - x2 * sB); dst[16] = f2bf(x2 * cB + x1 * sB);
            }
        }
    }
    SEAM(2);
    if (IN(3)) {
        { pg8::Gemm g{CQN, WqbT, M, 1536, 512, 512, 0}; pg8::StaticOrder S; S.init(M, 1536, G, bx); pg8::EpiQB E{QB};
          pg8::gemm_phase<pg8::EpiQB, pg8::StaticOrder, true, true, false>(lds, g, S, E); }
        { pg8::Gemm g{CKVN, WkvbT, M, 2048, 512, 512, 0}; pg8::StaticOrder S; S.init(M, 2048, G, bx); pg8::EpiBf16<0> E{KVB, 2048, nullptr};
          pg8::gemm_phase<pg8::EpiBf16<0>, pg8::StaticOrder, true, true, false>(lds, g, S, E); }
    }
    SEAM(3);
    if (IN(5)) {
        char* lds_g = (char*)lds_raw;
        const int x = bx & 7, i = bx >> 3;
        for (int c = bx; c < 256; c += G) {
            const int xx = c & 7, ii = c >> 3;
            {
                const int combo = xx >> 1, w = (xx & 1) * 32 + ii, b = combo >> 1, kvh = combo & 1, hq = kvh * 4 + (w >> 4), qb = w & 15;
                const size_t row0 = (size_t)b * SEQ;
                __syncthreads();
                att::attn_unit<128, ATT_SD_A, 1024, 256, 2560, 2048, SEQ>(QA + (row0 + qb * 256) * 1024 + hq * 128, KA + row0 * 256 + kvh * 128, nullptr,
                                    ZS + row0 * 2560 + 1280 + kvh * 128, OAB + (row0 + qb * 256) * 2048 + hq * 128, lds_g);
            }
            {
                const int unit = xx * 32 + ii, bh = unit >> 4, qb = unit & 15, b = bh >> 3, h = bh & 7;
                const size_t row0 = (size_t)b * SEQ;
                __syncthreads();
                att::attn_unit<192, ATT_SD_B, 1536, 2048, 2048, 2048, SEQ>(QB + (row0 + qb * 256) * 1536 + h * 192, KVB + row0 * 2048 + h * 256, KPE + row0 * 64,
                                    KVB + row0 * 2048 + h * 256 + 128, OAB + (row0 + qb * 256) * 2048 + 1024 + h * 128, lds_g);
            }
        }
        (void)x; (void)i;
        __syncthreads();
    }
    SEAM(5);
    if (IN(6)) {
        bf16_t* T1 = (bf16_t*)(ws + WS_T1);
        { pg8::Gemm g{OAB, WabT, M, 2048, 1024, 2048, 0}; pg8::StaticOrder S; S.init(M, 2048, G, bx); pg8::EpiGate<false> E{SG, T1, MERGED};
          pg8::gemm_phase<pg8::EpiGate<false>, pg8::StaticOrder, true, true, false>(lds, g, S, E); }
        { pg8::Gemm g{OAB + 1024, WabT + 1024, M, 2048, 1024, 2048, 0}; pg8::StaticOrder S; S.init(M, 2048, G, bx); pg8::EpiGate<true> E{SG, T1, MERGED};
          pg8::gemm_phase<pg8::EpiGate<true>, pg8::StaticOrder, true, true, false>(lds, g, S, E); }
    }
    SEAM(6);
    if (IN(7)) {
        pg8::Gemm g{MERGED, WoT, M, 2048, 2048, 2048, 0}; pg8::StaticOrder S; S.init(M, 2048, G, bx); pg8::EpiResid<false> E{a.x, nullptr, U, SSQ1};
        pg8::gemm_phase<pg8::EpiResid<false>, pg8::StaticOrder, true, true, false>(lds, g, S, E);
    }
    SEAM(7);
    if (IN(9)) {
        pg8::Gemm g{U, WguT, M, 2 * DFF, DM, DM, 0}; pg8::StaticOrder S; S.init(M, 2 * DFF, G, bx); pg8::EpiSwiglu E{ACT, SSQ1};
        pg8::gemm_phase<pg8::EpiSwiglu, pg8::StaticOrder, true, true, false>(lds, g, S, E);
        {
            constexpr int NU = (M / 256) * (2 * DFF / 256);
            const int nr = (NU + G - 1) / G, nbusy = NU - (nr - 1) * G; int idx = bx - nbusy, cnt = G - nbusy; if (cnt < 32) { idx = bx; cnt = G; }
            if (idx >= 0) { pg8::Gemm g2{PB, WppT, M, 2048, PLE, PLE, 0}; pg8::StaticOrder S2; S2.init(M, 2048, cnt, idx); pg8::EpiBf16<0> E2{ERAW, 2048, nullptr};
                pg8::gemm_phase<pg8::EpiBf16<0>, pg8::StaticOrder, true, true, false>(lds, g2, S2, E2); }
        }
    }
    SEAM(9);
    if (IN(10)) {
        pg8::Gemm g{ACT, WdT, M, 2048, DFF, DFF, 0}; pg8::StaticOrder S; S.init(M, 2048, G, bx); pg8::EpiResid<true> E{nullptr, U, U, SSQ2};
        pg8::gemm_phase<pg8::EpiResid<true>, pg8::StaticOrder, true, true, false>(lds, g, S, E);
    }
    SEAM(10);
    if (IN(12)) {
        { pg8::Gemm g{U, WpgT, M, 2048, DM, DM, 0}; pg8::StaticOrder S; S.init(M, 2048, G, bx); pg8::EpiBf16<1> E{GATE, 2048, SSQ2};
          pg8::gemm_phase<pg8::EpiBf16<1>, pg8::StaticOrder, true, true, false>(lds, g, S, E); }
    }
    SEAM(12);
    if (IN(13)) {
        u32x2 nh[8], ne[8], ng[8];
        int m = gw;
        if (m < M) {
#pragma unroll
            for (int j = 0; j < 8; ++j) { const size_t o = (size_t)m * DM + 4 * lane + 256 * j; nh[j] = *(const u32x2*)(U + o); ne[j] = *(const u32x2*)(ERAW + o); ng[j] = *(const u32x2*)(GATE + o); }
        }
        for (; m < M; m += NGW) {
            f32x4 h[8], e[8]; u32x2 gtw[8]; float se = 0.f;
#pragma unroll
            for (int j = 0; j < 8; ++j) { h[j] = (f32x4){bf_lo(nh[j].x), bf_hi(nh[j].x), bf_lo(nh[j].y), bf_hi(nh[j].y)}; e[j] = (f32x4){bf_lo(ne[j].x), bf_hi(ne[j].x), bf_lo(ne[j].y), bf_hi(ne[j].y)}; gtw[j] = ng[j];
                se += (e[j].x * e[j].x + e[j].y * e[j].y) + (e[j].z * e[j].z + e[j].w * e[j].w); }
            const int m2 = m + NGW;
            if (m2 < M) {
#pragma unroll
                for (int j = 0; j < 8; ++j) { const size_t o = (size_t)m2 * DM + 4 * lane + 256 * j; nh[j] = *(const u32x2*)(U + o); ne[j] = *(const u32x2*)(ERAW + o); ng[j] = *(const u32x2*)(GATE + o); }
            }
            const float re = 1.0f / sqrtf(wave_sum(se) * (1.f / DM) + EPS);
            float sh = 0.f;
#pragma unroll
            for (int j = 0; j < 8; ++j) { const u32x2 gt = gtw[j];
                const f32x4 gp = *(const f32x4*)(a.g_ple_post + 4 * lane + 256 * j);
                h[j].x += bf_lo(gt.x) * (e[j].x * re * gp.x); h[j].y += bf_hi(gt.x) * (e[j].y * re * gp.y);
                h[j].z += bf_lo(gt.y) * (e[j].z * re * gp.z); h[j].w += bf_hi(gt.y) * (e[j].w * re * gp.w);
                sh += (h[j].x * h[j].x + h[j].y * h[j].y) + (h[j].z * h[j].z + h[j].w * h[j].w); }
            const float rh = 1.0f / sqrtf(wave_sum(sh) * (1.f / DM) + EPS);
#pragma unroll
            for (int j = 0; j < 8; ++j) { const f32x4 gf = *(const f32x4*)(a.g_final + 4 * lane + 256 * j);
                f32x4 o; o.x = h[j].x * rh * gf.x; o.y = h[j].y * rh * gf.y; o.z = h[j].z * rh * gf.z; o.w = h[j].w * rh * gf.w;
                *(f32x4*)(a.out + (size_t)m * DM + 4 * lane + 256 * j) = o;
            }
        }
    }
#undef IN
#undef SEAM
}

extern "C" void kernel_launch(void* const* d_in, const int* in_sizes, int n_in, void* d_out, int out_size, void* d_ws, size_t ws_size, hipStream_t stream) {
    static int grid = 0;
    if (grid == 0) {
        if (n_in != 21 || in_sizes[0] != M * DM || out_size != M * DM || ws_size < WS_END) {
            fprintf(stderr, "kernel_launch: unexpected shapes: n_in %d in0 %d out %d ws %zu (need %zu)\n", n_in, n_in > 0 ? in_sizes[0] : -1, out_size, ws_size, (size_t)WS_END); grid = -1; return; }
        int dev = 0, cus = 0, per_cu = 0;
        if (hipGetDevice(&dev) != hipSuccess || hipDeviceGetAttribute(&cus, hipDeviceAttributeMultiprocessorCount, dev) != hipSuccess) { grid = -1; return; }
        if (hipFuncSetAttribute((const void*)mk_fwd, hipFuncAttributeMaxDynamicSharedMemorySize, LDS_BYTES) != hipSuccess) { fprintf(stderr, "kernel_launch: hipFuncSetAttribute failed\n"); grid = -1; return; }
        if (hipOccupancyMaxActiveBlocksPerMultiprocessor(&per_cu, (const void*)mk_fwd, NTHREADS, LDS_BYTES) != hipSuccess || per_cu < 1) { fprintf(stderr, "kernel_launch: occupancy query says %d\n", per_cu); per_cu = 1; }
        (void)hipGetLastError();
        grid = cus * 1;
    }
    if (grid < 0) return;
    Args a{};
    const float** f = (const float**)&a;
    for (int i = 0; i < 21; ++i) f[i] = (const float*)d_in[i];
    a.out = (float*)d_out; a.ws = (unsigned char*)d_ws;
#if MK_ONE_LAUNCH
    if (hipMemsetAsync(d_ws, 0, 196608, stream) != hipSuccess) { fprintf(stderr, "kernel_launch: memset failed\n"); return; }
    a.ph_lo = 0; a.ph_hi = NPHASE;
    void* args[] = {&a};
    hipError_t e = hipLaunchCooperativeKernel((const void*)mk_fwd, dim3(grid), dim3(NTHREADS), args, LDS_BYTES, stream);
    if (e != hipSuccess) fprintf(stderr, "kernel_launch: cooperative launch failed: %s (grid %d)\n", hipGetErrorString(e), grid);
#else
    for (int ph = 0; ph < NPHASE; ++ph) {
        a.ph_lo = ph; a.ph_hi = ph + 1;
        hipLaunchKernelGGL(mk_fwd, dim3(grid), dim3(NTHREADS), LDS_BYTES, stream, a);
    }
#endif
}
```

```cpp
#include <hip/hip_runtime.h>
#include <hip/hip_cooperative_groups.h>
#include <cstdio>
#include <cstdint>
namespace cg = cooperative_groups;

#ifndef ATT_SD_A
#define ATT_SD_A 1
#endif
#ifndef ATT_SD_B
#define ATT_SD_B 1
#endif
#ifndef MK_ONE_LAUNCH
#define MK_ONE_LAUNCH 1
#endif

#define LAS __attribute__((address_space(3)))
typedef unsigned short bf16_t;
typedef short bf16x8 __attribute__((ext_vector_type(8)));
typedef short s16x4 __attribute__((ext_vector_type(4)));
typedef float f32x4 __attribute__((ext_vector_type(4)));
typedef float f32x16 __attribute__((ext_vector_type(16)));
typedef unsigned u32x4 __attribute__((ext_vector_type(4)));
typedef unsigned u32x2 __attribute__((ext_vector_type(2)));
typedef int v4i_t __attribute__((ext_vector_type(4)));
constexpr float Q8_SU = 20.f, Q8_SW = 900.f;

constexpr int DM = 2048, SEQ = 4096, M = 8192, DFF = 5632, PLE = 256, NIN = 6720, NINP = 6912;
constexpr float EPS = 1e-6f;
constexpr int NWAVES = 8, NTHREADS = 512;
constexpr int LDS_BYTES = 139264;

constexpr size_t MiB = 1u << 20;
constexpr size_t WS_WIN = 1 * MiB, WS_WQB = 28 * MiB, WS_WKVB = 30 * MiB, WS_WAB = 32 * MiB, WS_WO = 40 * MiB, WS_WGU = 48 * MiB, WS_WD = 92 * MiB,
                 WS_WPG = 114 * MiB, WS_WPP = 122 * MiB, WS_PB = 123 * MiB, WS_KR = 127 * MiB, WS_U = 128 * MiB, WS_ZS = 160 * MiB, WS_SG = 200 * MiB,
                 WS_QA = 264 * MiB, WS_QB = 280 * MiB, WS_KVB = 304 * MiB, WS_END = 344 * MiB;
constexpr size_t WS_CQN = 1 * MiB, WS_CKVN = 9 * MiB, WS_KA = 17 * MiB, WS_KPE = 21 * MiB;
constexpr size_t WS_T1 = 264 * MiB;
constexpr size_t WS_OAB = WS_U, WS_MERGED = WS_ZS, WS_ACT = 160 * MiB, WS_GATE = 160 * MiB, WS_ERAW = 280 * MiB;

typedef float f32x2_t __attribute__((ext_vector_type(2)));
typedef __bf16 bf16x2_t __attribute__((ext_vector_type(2)));
__device__ __forceinline__ unsigned cvt_pk_bf16(float lo, float hi) { f32x2_t v = {lo, hi}; bf16x2_t b = __builtin_convertvector(v, bf16x2_t); return __builtin_bit_cast(unsigned, b); }
__device__ __forceinline__ float bf_lo(unsigned w) { return __uint_as_float(w << 16); }
__device__ __forceinline__ float bf_hi(unsigned w) { return __uint_as_float(w & 0xffff0000u); }
__device__ __forceinline__ float bf1(bf16_t h) { return __uint_as_float(((unsigned)h) << 16); }
__device__ __forceinline__ bf16_t f2bf(float f) { unsigned u = __float_as_uint(f); return (bf16_t)((u + 0x7fffu + ((u >> 16) & 1u)) >> 16); }
__device__ __forceinline__ float sigmoidf_(float x) { return __builtin_amdgcn_rcpf(1.f + __expf(-x)); }
__device__ __forceinline__ float wave_sum(float v) {
#pragma unroll
    for (int o = 1; o < 64; o <<= 1) v += __shfl_xor(v, o);
    return v;
}

namespace pg8 {
constexpr int BM = 256, BK = 64, HALF = 128, HTB = HALF * BK * 2, STAGE_BYTES = 8 * HTB, NXCD = 8, WGM = 8;
__host__ __device__ __forceinline__ int lds_byte(int r, int c) { const int st = (r >> 4) * 2 + (c >> 5), rr = r & 15, cc = c & 31, ob = rr * 64 + cc * 2; return st * 1024 + (ob ^ (((ob >> 9) & 1) << 5)); }
__host__ __device__ __forceinline__ void stage_rc(int b, int& R, int& C) { const int st = b / 1024, sb = b % 1024, swz = sb ^ (((sb >> 9) & 1) << 5); R = (st >> 1) * 16 + swz / 64; C = (st & 1) * 32 + (swz % 64) / 2; }
__host__ __device__ __forceinline__ int perm32(int rho) { const int n = rho >> 4, i = rho & 15; return 8 * (i >> 2) + 4 * n + (i & 3); }
struct Unit { int pm, pn, kh; };
struct Gemm { const bf16_t* A; const bf16_t* Bt; int M, N, K, ld, koff; };
struct StaticOrder {
    int nM, nN, nwg, G, c;
    __host__ __device__ void init(int M_, int N_, int G_, int c_) { nM = M_ / BM; nN = N_ / BM; nwg = nM * nN; G = G_; c = c_; }
    __host__ __device__ bool next(int i, Unit& u) const {
        const long L = (long)i * G + c; if (L >= nwg) return false;
        int wgid = (int)L; { const int q = nwg / NXCD, r = nwg % NXCD, xcd = wgid % NXCD, off = wgid / NXCD; wgid = (xcd < r ? xcd * (q + 1) : r * (q + 1) + (xcd - r) * q) + off; }
        const int nig = WGM * nN, gid = wgid / nig, fm = gid * WGM, gsz = (nM - fm) < WGM ? (nM - fm) : WGM;
        u.pm = fm + ((wgid % nig) % gsz); u.pn = (wgid % nig) / gsz; u.kh = 0; return true;
    }
    __device__ __forceinline__ void a_ready(const Unit&) const {}
    __device__ __forceinline__ void done(const Unit&) const {}
};
struct DualOrder : StaticOrder {
    __host__ __device__ bool next(int i, Unit& u) const { if (!StaticOrder::next(i >> 1, u)) return false; u.kh = i & 1; return true; }
};
typedef f32x4 Acc[2][2][4][2];

__device__ __forceinline__ void store8(bf16_t* p, f32x4 v0, f32x4 v1) {
    u32x4 w; w.x = cvt_pk_bf16(v0[0], v0[1]); w.y = cvt_pk_bf16(v0[2], v0[3]); w.z = cvt_pk_bf16(v1[0], v1[1]); w.w = cvt_pk_bf16(v1[2], v1[3]);
    *(u32x4*)p = w;
}
struct EpiIn {
    static constexpr bool PERM = true, AFTER_DRAIN = false;
    bf16_t *ZS, *SG, *KR;
    __device__ __forceinline__ void operator()(const Acc& acc, const Unit& u, int wr, int wc, int fr, int fq) const {
        const int pn = u.pn; bf16_t* base; int ldc, colt; bool sig = false;
        if (pn < 10) { base = ZS; ldc = 2560; colt = pn * 256; }
        else if (pn < 26) { base = SG; ldc = 4096; colt = (pn - 10) * 256; sig = true; }
        else { base = KR; ldc = 64; colt = 0; }
        const int row0 = u.pm * BM + wr * 64 + fr, col0 = colt + wc * 32 + 8 * fq;
#pragma unroll
        for (int ai = 0; ai < 2; ++ai)
#pragma unroll
            for (int m = 0; m < 4; ++m) { bf16_t* rowp = base + (size_t)(row0 + ai * HALF + m * 16) * ldc + col0;
#pragma unroll
                for (int bj = 0; bj < 2; ++bj) {
                    if (pn == 26 && (bj == 1 || wc >= 2)) continue;
                    f32x4 v0 = __builtin_convertvector(__builtin_bit_cast(v4i_t, acc[ai][bj][m][0]), f32x4) * (1.f / (Q8_SU * Q8_SW));
                    f32x4 v1 = __builtin_convertvector(__builtin_bit_cast(v4i_t, acc[ai][bj][m][1]), f32x4) * (1.f / (Q8_SU * Q8_SW));
                    if (sig) {
#pragma unroll
                        for (int j = 0; j < 4; ++j) { v0[j] = sigmoidf_(v0[j]); v1[j] = sigmoidf_(v1[j]); } }
                    store8(rowp + bj * HALF, v0, v1); } }
    }
};
template <int ACT  > struct EpiBf16 {
    static constexpr bool PERM = true, AFTER_DRAIN = false;
    bf16_t* O; int ldc; const float* ssq;
    __device__ __forceinline__ void operator()(const Acc& acc, const Unit& u, int wr, int wc, int fr, int fq) const {
        const int row0 = u.pm * BM + wr * 64 + fr, col0 = u.pn * BM + wc * 32 + 8 * fq;
#pragma unroll
        for (int ai = 0; ai < 2; ++ai)
#pragma unroll
            for (int m = 0; m < 4; ++m) { bf16_t* rowp = O + (size_t)(row0 + ai * HALF + m * 16) * ldc + col0;
                const float r = ssq ? 1.0f / sqrtf(ssq[row0 + ai * HALF + m * 16] * (1.f / DM) + EPS) : 1.f;
#pragma unroll
                for (int bj = 0; bj < 2; ++bj) { f32x4 v0 = acc[ai][bj][m][0] * r, v1 = acc[ai][bj][m][1] * r;
                    if (ACT == 1) {
#pragma unroll
                        for (int j = 0; j < 4; ++j) { v0[j] = sigmoidf_(v0[j]); v1[j] = sigmoidf_(v1[j]); } }
                    store8(rowp + bj * HALF, v0, v1); } }
    }
};
struct EpiQB {
    static constexpr bool PERM = true, AFTER_DRAIN = false;
    bf16_t* O;
    __device__ __forceinline__ void operator()(const Acc& acc, const Unit& u, int wr, int wc, int fr, int fq) const {
        const int row0 = u.pm * BM + wr * 64 + fr, col0 = u.pn * BM + wc * 32 + 8 * fq;
        float inv[8];
#pragma unroll
        for (int t = 0; t < 8; ++t) inv[t] = __builtin_amdgcn_exp2f(-(float)(2 * ((fq & 1) * 8 + t)) * (13.287712379549449f / 32.f));
        const float sgn = (fq >= 2) ? 1.f : -1.f;
#pragma unroll
        for (int ai = 0; ai < 2; ++ai)
#pragma unroll
            for (int m = 0; m < 4; ++m) { const int row = row0 + ai * HALF + m * 16, sq = row & (SEQ - 1); const float prow = (float)(sq >> 6), pcol = (float)(sq & 63);
#pragma unroll
                for (int bj = 0; bj < 2; ++bj) { f32x4 v0 = acc[ai][bj][m][0], v1 = acc[ai][bj][m][1];
                    const int rel = (u.pn * BM + bj * HALF + wc * 32) % 192;
                    if (rel >= 128) { const float pos = (rel >= 160) ? pcol : prow;
#pragma unroll
                        for (int t = 0; t < 4; ++t) {
                            const float a0 = pos * inv[t], a1 = pos * inv[4 + t];
                            const float p0 = __shfl_xor(v0[t], 32), p1 = __shfl_xor(v1[t], 32);
                            v0[t] = v0[t] * __cosf(a0) + sgn * p0 * __sinf(a0); v1[t] = v1[t] * __cosf(a1) + sgn * p1 * __sinf(a1); } }
                    store8(O + (size_t)row * 1536 + col0 + bj * HALF, v0, v1); } }
    }
};
template <bool SECOND> struct EpiGate {
    static constexpr bool PERM = true, AFTER_DRAIN = false;
    const bf16_t* SG; bf16_t* T1; bf16_t* O;
    __device__ __forceinline__ void operator()(const Acc& acc, const Unit& u, int wr, int wc, int fr, int fq) const {
        const int row0 = u.pm * BM + wr * 64 + fr, col0 = u.pn * BM + wc * 32 + 8 * fq;
#pragma unroll
        for (int ai = 0; ai < 2; ++ai)
#pragma unroll
            for (int m = 0; m < 4; ++m) { const size_t ro = (size_t)(row0 + ai * HALF + m * 16);
#pragma unroll
                for (int bj = 0; bj < 2; ++bj) {
                    const u32x4 b = *(const u32x4*)(SG + ro * 4096 + (SECOND ? 2048 : 0) + col0 + bj * HALF);
                    f32x4 s0, s1;
                    s0[0] = bf_lo(b.x); s0[1] = bf_hi(b.x); s0[2] = bf_lo(b.y); s0[3] = bf_hi(b.y);
                    s1[0] = bf_lo(b.z); s1[1] = bf_hi(b.z); s1[2] = bf_lo(b.w); s1[3] = bf_hi(b.w);
                    bf16_t* tp = T1 + ro * 2048 + col0 + bj * HALF;
                    if constexpr (!SECOND) { store8(tp, acc[ai][bj][m][0] * s0, acc[ai][bj][m][1] * s1); }
                    else { const u32x4 tw = *(const u32x4*)tp; f32x4 t0, t1;
                        t0[0] = bf_lo(tw.x); t0[1] = bf_hi(tw.x); t0[2] = bf_lo(tw.y); t0[3] = bf_hi(tw.y); t1[0] = bf_lo(tw.z); t1[1] = bf_hi(tw.z); t1[2] = bf_lo(tw.w); t1[3] = bf_hi(tw.w);
                        store8(O + ro * 2048 + col0 + bj * HALF, t0 + acc[ai][bj][m][0] * s0, t1 + acc[ai][bj][m][1] * s1); } } }
    }
};
template <bool BASEBF> struct EpiResid {
    static constexpr bool PERM = false, AFTER_DRAIN = false;
    const float* basef; const bf16_t* baseb; bf16_t* HB; float* ssq;
    __device__ __forceinline__ void operator()(const Acc& acc, const Unit& u, int wr, int wc, int fr, int fq) const {
        const int row0 = u.pm * BM + wr * 64 + fr, col0 = u.pn * BM + wc * 32 + 4 * fq;
#pragma unroll
        for (int ai = 0; ai < 2; ++ai)
#pragma unroll
            for (int m = 0; m < 4; ++m) { const int row = row0 + ai * HALF + m * 16; const size_t ro = (size_t)row * DM + col0; float ss = 0.f;
#pragma unroll
                for (int bj = 0; bj < 2; ++bj)
#pragma unroll
                    for (int n = 0; n < 2; ++n) { const size_t o = ro + bj * HALF + n * 16;
                        f32x4 v = acc[ai][bj][m][n];
                        if constexpr (BASEBF) { const u32x2 bw = *(const u32x2*)(baseb + o); v = v + (f32x4){bf_lo(bw.x), bf_hi(bw.x), bf_lo(bw.y), bf_hi(bw.y)}; }
                        else v = v + *(const f32x4*)(basef + o);
                        u32x2 w; w.x = cvt_pk_bf16(v.x, v.y); w.y = cvt_pk_bf16(v.z, v.w);
                        *(u32x2*)(HB + o) = w; ss += (v.x * v.x + v.y * v.y) + (v.z * v.z + v.w * v.w); }
                ss += __shfl_xor(ss, 16); ss += __shfl_xor(ss, 32);
                if (fq == 0) (void)__hip_atomic_fetch_add((__attribute__((address_space(1))) float*)(ssq + row), ss, __ATOMIC_RELAXED, __HIP_MEMORY_SCOPE_AGENT); }
    }
};
struct EpiSwiglu {
    static constexpr bool PERM = true, AFTER_DRAIN = false;
    bf16_t* O; const float* ssq;
    __device__ __forceinline__ void operator()(const Acc& acc, const Unit& u, int wr, int wc, int fr, int fq) const {
        const int row0 = u.pm * BM + wr * 64 + fr, col0 = u.pn * HALF + wc * 32 + 8 * fq;
#pragma unroll
        for (int ai = 0; ai < 2; ++ai)
#pragma unroll
            for (int m = 0; m < 4; ++m) {
                f32x4 a0, a1; const float r = 1.0f / sqrtf(ssq[row0 + ai * HALF + m * 16] * (1.f / DM) + EPS);
#pragma unroll
                for (int j = 0; j < 4; ++j) { const float g0 = acc[ai][0][m][0][j] * r, g1 = acc[ai][0][m][1][j] * r;
                    a0[j] = g0 * sigmoidf_(g0) * (acc[ai][1][m][0][j] * r); a1[j] = g1 * sigmoidf_(g1) * (acc[ai][1][m][1][j] * r); }
                store8(O + (size_t)(row0 + ai * HALF + m * 16) * DFF + col0, a0, a1); }
    }
};

template <class Epi, class Sched, bool ALIGN_EPI, bool SP2, bool MID, bool I8 = false>
__device__ __forceinline__ void gemm_phase(LAS unsigned char* lds, const Gemm g, const Sched S, const Epi E) {
    const int tid = threadIdx.x, wid = __builtin_amdgcn_readfirstlane(tid >> 6), lane = tid & 63, wr = wid >> 2, wc = wid & 3, fr = lane & 15, fq = lane >> 4;
    const int K = g.ld, nt = g.K / BK;
    unsigned voffA[2], voffB[2];
#pragma unroll
    for (int i = 0; i < 2; ++i) { int R, C; stage_rc(tid * 16 + i * 8192, R, C); const int Rb = Epi::PERM ? ((R & ~31) + perm32(R & 31)) : R;
        voffA[i] = (unsigned)(R * K + C) * 2u; voffB[i] = (unsigned)(Rb * K + C) * 2u; }
    const size_t kstep = (size_t)(BK * 2);
    const size_t hstep = (size_t)HALF * K * 2;
    const size_t tstep = 2 * hstep;
    const unsigned ldsw = (unsigned)wid * 1024u;
    const int aoff = lds_byte(wr * 64 + fr, fq * 8), boff = lds_byte(wc * 32 + fr, fq * 8);
#define PG8_SA(b, h) (((b) * 2 + (h)) * HTB)
#define PG8_SB(b, h) ((4 + (b) * 2 + (h)) * HTB)
#define PG8_STAGE(bufoff, gbase, voff) do { _Pragma("unroll") for (int _i = 0; _i < 2; ++_i) \
        __builtin_amdgcn_global_load_lds((const unsigned*)((const char*)(gbase) + (voff)[_i]), (LAS unsigned*)(lds + (bufoff) + ldsw + _i * 8192), 16, 0, 0); } while (0)
#define PG8_LDA(dst, b, h) do { _Pragma("unroll") for (int m = 0; m < 4; ++m) _Pragma("unroll") for (int k = 0; k < 2; ++k) dst[m][k] = *(const LAS bf16x8*)(lds + PG8_SA(b, h) + aoff + m * 2048 + k * 1024); } while (0)
#define PG8_LDB(dst, b, h) do { _Pragma("unroll") for (int n = 0; n < 2; ++n) _Pragma("unroll") for (int k = 0; k < 2; ++k) dst[n][k] = *(const LAS bf16x8*)(lds + PG8_SB(b, h) + boff + n * 2048 + k * 1024); } while (0)
#define PG8_MMA(ai, bj, At, Bt) do { __builtin_amdgcn_s_setprio(1); _Pragma("unroll") for (int m = 0; m < 4; ++m) _Pragma("unroll") for (int n = 0; n < 2; ++n) _Pragma("unroll") for (int k = 0; k < 2; ++k) { \
        if constexpr (I8) acc[ai][bj][m][n] = __builtin_bit_cast(f32x4, __builtin_amdgcn_mfma_i32_16x16x64_i8(__builtin_bit_cast(v4i_t, Bt[n][k]), __builtin_bit_cast(v4i_t, At[m][k]), __builtin_bit_cast(v4i_t, acc[ai][bj][m][n]), 0, 0, 0)); \
        else acc[ai][bj][m][n] = __builtin_amdgcn_mfma_f32_16x16x32_bf16(Bt[n][k], At[m][k], acc[ai][bj][m][n], 0, 0, 0); } __builtin_amdgcn_s_setprio(0); } while (0)
#define PG8_WAIT_V(n) asm volatile("s_waitcnt vmcnt(" #n ")" ::: "memory")
#define PG8_WAIT_L(n) asm volatile("s_waitcnt lgkmcnt(" #n ")" ::: "memory")
#define PG8_BAR __builtin_amdgcn_s_barrier()
#define PG8_SCHED __builtin_amdgcn_sched_barrier(0)
    Unit cur, nxt; int ui = 0;
    if (!S.next(0, cur)) return;
    Acc acc;
#pragma unroll
    for (int a = 0; a < 2; ++a)
#pragma unroll
        for (int b = 0; b < 2; ++b)
#pragma unroll
            for (int m = 0; m < 4; ++m)
#pragma unroll
                for (int n = 0; n < 2; ++n) acc[a][b][m][n] = (f32x4){0.f, 0.f, 0.f, 0.f};
    bf16x8 At[4][2], B0[2][2], B1[2][2];
    const char* cA = (const char*)g.A + (size_t)cur.pm * tstep + (size_t)cur.kh * g.koff; const char* cB = (const char*)g.Bt + (size_t)cur.pn * tstep + (size_t)cur.kh * g.koff;
    S.a_ready(cur);
    if constexpr (SP2) {
        PG8_STAGE(PG8_SB(0, 0), cB, voffB); PG8_STAGE(PG8_SB(0, 1), cB + hstep, voffB); PG8_STAGE(PG8_SA(0, 0), cA, voffA); PG8_STAGE(PG8_SA(0, 1), cA + hstep, voffA);
        if (wr == 1) PG8_BAR;
        PG8_WAIT_V(2); PG8_BAR;
        PG8_STAGE(PG8_SB(1, 0), cB + kstep, voffB); PG8_STAGE(PG8_SA(1, 0), cA + kstep, voffA); PG8_STAGE(PG8_SB(1, 1), cB + hstep + kstep, voffB);
        PG8_WAIT_V(6); PG8_BAR;
    } else {
        PG8_STAGE(PG8_SB(0, 0), cB, voffB); PG8_STAGE(PG8_SA(0, 0), cA, voffA); PG8_STAGE(PG8_SB(0, 1), cB + hstep, voffB); PG8_STAGE(PG8_SA(0, 1), cA + hstep, voffA);
        if (wr == 1) PG8_BAR;
        PG8_WAIT_V(4); PG8_BAR;
        PG8_STAGE(PG8_SB(1, 0), cB + kstep, voffB); PG8_STAGE(PG8_SA(1, 0), cA + kstep, voffA); PG8_STAGE(PG8_SB(1, 1), cB + hstep + kstep, voffB);
        PG8_WAIT_V(6); PG8_BAR;
    }
    for (;;) {
        const bool has_next = S.next(ui + 1, nxt);
        const char* nA = has_next ? (const char*)g.A + (size_t)nxt.pm * tstep + (size_t)nxt.kh * g.koff : cA; const char* nB = has_next ? (const char*)g.Bt + (size_t)nxt.pn * tstep + (size_t)nxt.kh * g.koff : cB;
        for (int t = 0; t < nt; t += 2) {
            const bool last = (t == nt - 2);
            const char* a1 = cA + (size_t)(t + 1) * kstep;
            const char* a2 = last ? nA : cA + (size_t)(t + 2) * kstep; const char* b2 = last ? nB : cB + (size_t)(t + 2) * kstep;
            const char* a3 = a2 + kstep; const char* b3 = b2 + kstep;
            if (last && has_next) S.a_ready(nxt);
            if constexpr (SP2) {
            PG8_LDB(B0, 0, 0); PG8_LDB(B1, 0, 1); PG8_SCHED; PG8_LDA(At, 0, 0); PG8_STAGE(PG8_SA(1, 1), a1 + hstep, voffA);
            PG8_WAIT_V(8); PG8_WAIT_L(0); PG8_BAR; PG8_MMA(0, 0, At, B0); PG8_MMA(0, 1, At, B1); PG8_BAR; PG8_SCHED;
            PG8_LDA(At, 0, 1); PG8_STAGE(PG8_SB(0, 0), b2, voffB); PG8_STAGE(PG8_SB(0, 1), b2 + hstep, voffB); PG8_STAGE(PG8_SA(0, 0), a2, voffA);
            PG8_WAIT_V(8); PG8_WAIT_L(0); PG8_BAR; PG8_MMA(1, 0, At, B0); PG8_MMA(1, 1, At, B1); PG8_BAR; PG8_SCHED;
            PG8_LDB(B0, 1, 0); PG8_LDB(B1, 1, 1); PG8_SCHED; PG8_LDA(At, 1, 0); PG8_STAGE(PG8_SA(0, 1), a2 + hstep, voffA);
            PG8_WAIT_V(8); PG8_WAIT_L(0); PG8_BAR; PG8_MMA(0, 0, At, B0); PG8_MMA(0, 1, At, B1); PG8_BAR; PG8_SCHED;
            PG8_LDA(At, 1, 1); PG8_STAGE(PG8_SB(1, 0), b3, voffB); PG8_STAGE(PG8_SB(1, 1), b3 + hstep, voffB); PG8_STAGE(PG8_SA(1, 0), a3, voffA);
            PG8_WAIT_V(8); PG8_WAIT_L(0); PG8_BAR; PG8_MMA(1, 0, At, B0); PG8_MMA(1, 1, At, B1); PG8_BAR; PG8_SCHED;
            } else {
            PG8_LDB(B0, 0, 0); PG8_SCHED; PG8_LDA(At, 0, 0); PG8_STAGE(PG8_SA(1, 1), a1 + hstep, voffA);
            PG8_WAIT_L(8); PG8_BAR; PG8_WAIT_L(0); PG8_MMA(0, 0, At, B0); PG8_BAR; PG8_SCHED;
            PG8_LDB(B1, 0, 1); PG8_STAGE(PG8_SB(0, 0), b2, voffB);
            PG8_BAR; PG8_WAIT_L(0); PG8_MMA(0, 1, At, B1); PG8_BAR;
            PG8_LDA(At, 0, 1); PG8_STAGE(PG8_SA(0, 0), a2, voffA);
            PG8_BAR; PG8_WAIT_L(0); PG8_MMA(1, 0, At, B0); PG8_BAR; PG8_SCHED;
            PG8_STAGE(PG8_SB(0, 1), b2 + hstep, voffB);
            PG8_WAIT_V(6); PG8_BAR; PG8_MMA(1, 1, At, B1); PG8_BAR;
            PG8_LDB(B0, 1, 0); PG8_SCHED; PG8_LDA(At, 1, 0); PG8_STAGE(PG8_SA(0, 1), a2 + hstep, voffA);
            PG8_WAIT_L(8); PG8_BAR; PG8_WAIT_L(0); PG8_MMA(0, 0, At, B0); PG8_BAR; PG8_SCHED;
            PG8_LDB(B1, 1, 1); PG8_STAGE(PG8_SB(1, 0), b3, voffB);
            PG8_BAR; PG8_WAIT_L(0); PG8_MMA(0, 1, At, B1); PG8_BAR;
            PG8_LDA(At, 1, 1); PG8_STAGE(PG8_SA(1, 0), a3, voffA);
            PG8_BAR; PG8_WAIT_L(0); PG8_MMA(1, 0, At, B0); PG8_BAR; PG8_SCHED;
            PG8_STAGE(PG8_SB(1, 1), b3 + hstep, voffB);
            PG8_WAIT_V(6); PG8_BAR; PG8_MMA(1, 1, At, B1); PG8_BAR;
            }
        }
        if constexpr (ALIGN_EPI) { if (wr == 0) PG8_BAR; }
        { E(acc, cur, wr, wc, fr, fq); S.done(cur);
#pragma unroll
        for (int a = 0; a < 2; ++a)
#pragma unroll
            for (int b = 0; b < 2; ++b)
#pragma unroll
                for (int m = 0; m < 4; ++m)
#pragma unroll
                    for (int n = 0; n < 2; ++n) acc[a][b][m][n] = (f32x4){0.f, 0.f, 0.f, 0.f};
        }
        if (!has_next) break;
        cur = nxt; cA = nA; cB = nB; ++ui;
        if constexpr (ALIGN_EPI) { if (wr == 1) PG8_BAR; }
    }
    PG8_WAIT_V(0);
    if constexpr (!ALIGN_EPI) { if (wr == 0) PG8_BAR; }
    PG8_BAR;
#undef PG8_SA
#undef PG8_SB
#undef PG8_STAGE
#undef PG8_LDA
#undef PG8_LDB
#undef PG8_MMA
#undef PG8_WAIT_V
#undef PG8_WAIT_L
#undef PG8_BAR
#undef PG8_SCHED
}
}

namespace att {
constexpr int NW = 8, QBLK = 32, KVBLK = 64;
constexpr int SHM_V = KVBLK * 128 * 2, SHM_K = KVBLK * 128 * 2, SHM_KR = KVBLK * 64 * 2;
constexpr int OFF_V = 0, OFF_K = 2 * SHM_V, OFF_WS = OFF_K + 2 * SHM_K, OFF_KR = OFF_WS + NW * 64 * 4, OFF_QR = OFF_KR + 2 * SHM_KR, QR_WAVE = 6144, ATT_LDS = OFF_QR + NW * QR_WAVE;
constexpr float THR = 8.f;
#define KSWZ(row, colB) ((row) * 256 + ((colB) ^ (((row) & 7) << 4)))
#define KRSWZ(row, colB) ((row) * 128 + ((colB) ^ ((((row) >> 1) & 7) << 4)))
#define SBAR() __builtin_amdgcn_sched_barrier(0)
__device__ __forceinline__ int crow(int r, int hi) { return (r & 3) + 8 * (r >> 2) + 4 * hi; }

__device__ __forceinline__ void partialSM(f32x16& p0, f32x16& p1, float& m_reg, float& mn, float& alpha, const float C, const float THRS) {
  float pmax = p0[0];
#pragma unroll
  for (int r = 1; r < 16; ++r) pmax = fmaxf(pmax, p0[r]);
#pragma unroll
  for (int r = 0; r < 16; ++r) pmax = fmaxf(pmax, p1[r]);
  { auto rr = __builtin_amdgcn_permlane32_swap(__float_as_uint(pmax), __float_as_uint(pmax), false, false);
    pmax = fmaxf(__uint_as_float(rr[0]), __uint_as_float(rr[1])); }
  if (__builtin_expect(__all(pmax - m_reg <= THRS), 1)) { mn = m_reg; alpha = 1.f; }
  else { mn = fmaxf(m_reg, pmax); alpha = __builtin_amdgcn_exp2f((m_reg - mn) * C); m_reg = mn; }
  float mnC = -mn * C;
#pragma unroll
  for (int r = 0; r < 16; ++r) p0[r] = fmaf(p0[r], C, mnC);
#pragma unroll
  for (int r = 0; r < 16; ++r) p1[r] = fmaf(p1[r], C, mnC);
#pragma unroll
  for (int r = 0; r < 16; ++r) p0[r] = __builtin_amdgcn_exp2f(p0[r]);
}
__device__ __forceinline__ void finishSM(f32x16& p0, f32x16& p1, float alpha, float& l_reg, bf16x8& pa0, bf16x8& pa1, bf16x8& pa2, bf16x8& pa3) {
#pragma unroll
  for (int r = 0; r < 16; ++r) p1[r] = __builtin_amdgcn_exp2f(p1[r]);
  float ps = 0;
#pragma unroll
  for (int r = 0; r < 16; ++r) ps += p0[r];
#pragma unroll
  for (int r = 0; r < 16; ++r) ps += p1[r];
  { auto rr = __builtin_amdgcn_permlane32_swap(__float_as_uint(ps), __float_as_uint(ps), false, false);
    ps = __uint_as_float(rr[0]) + __uint_as_float(rr[1]); }
  l_reg = l_reg * alpha + ps;
#define PK4(P, BASE, OUT) do { unsigned a0 = cvt_pk_bf16(P[BASE + 0], P[BASE + 1]), a1 = cvt_pk_bf16(P[BASE + 2], P[BASE + 3]);   \
    unsigned b0 = cvt_pk_bf16(P[BASE + 4], P[BASE + 5]), b1 = cvt_pk_bf16(P[BASE + 6], P[BASE + 7]);                              \
    auto r0 = __builtin_amdgcn_permlane32_swap(a0, b0, false, false); auto r1 = __builtin_amdgcn_permlane32_swap(a1, b1, false, false); \
    u32x4 w = {r0[0], r1[0], r0[1], r1[1]}; OUT = *reinterpret_cast<bf16x8*>(&w); } while (0)
  PK4(p0, 0, pa0); PK4(p0, 8, pa1); PK4(p1, 0, pa2); PK4(p1, 8, pa3);
#undef PK4
}
template <int DK, int NQR>
__device__ __forceinline__ void qkt(f32x16& p0, f32x16& p1, const char* Ks, const char* Krs, const bf16x8* qr, const char* qrl, int r32, int hi) {
  p0 = f32x16{}; p1 = f32x16{};
#pragma unroll
  for (int d0 = 0; d0 < 8; ++d0) { int cb = (d0 * 16 + hi * 8) * 2;
    bf16x8 b0 = *reinterpret_cast<const bf16x8*>(Ks + KSWZ(r32, cb));
    bf16x8 b1 = *reinterpret_cast<const bf16x8*>(Ks + KSWZ(32 + r32, cb));
    bf16x8 qv; if (d0 < NQR) qv = qr[d0 < NQR ? d0 : 0]; else qv = *reinterpret_cast<const bf16x8*>(qrl + (d0 - NQR) * 1024);
    p0 = __builtin_amdgcn_mfma_f32_32x32x16_bf16(b0, qv, p0, 0, 0, 0);
    p1 = __builtin_amdgcn_mfma_f32_32x32x16_bf16(b1, qv, p1, 0, 0, 0); }
  if constexpr (DK == 192) {
#pragma unroll
    for (int d0 = 0; d0 < 4; ++d0) { int cb = (d0 * 16 + hi * 8) * 2;
      bf16x8 b0 = *reinterpret_cast<const bf16x8*>(Krs + KRSWZ(r32, cb));
      bf16x8 b1 = *reinterpret_cast<const bf16x8*>(Krs + KRSWZ(32 + r32, cb));
      const bf16x8 qv = *reinterpret_cast<const bf16x8*>(qrl + (8 - NQR + d0) * 1024);
      p0 = __builtin_amdgcn_mfma_f32_32x32x16_bf16(b0, qv, p0, 0, 0, 0);
      p1 = __builtin_amdgcn_mfma_f32_32x32x16_bf16(b1, qv, p1, 0, 0, 0); }
  }
}
__device__ __forceinline__ int v_st(int k, int c) { const int kk = (k & ~0xC) | ((k & 4) << 1) | ((k & 8) >> 1); return ((kk >> 3) * 4 + (c >> 5)) * 512 + ((kk & 7) * 32 + (c & 31)) * 2; }
__device__ __forceinline__ int v_rd_base(int lane) { return ((lane & 3) << 3) | (((lane >> 2) & 3) << 6) | (((lane >> 4) & 1) << 5) | (((lane >> 5) & 1) << 8); }
constexpr int v_rd_off(int d0, int ks, int half) { return d0 * 512 + ks * 4096 + half * 2048; }
template <int OFF> __device__ __forceinline__ s16x4 tr_read(int vb) {
  s16x4 r; asm volatile("ds_read_b64_tr_b16 %0, %1 offset:%2" : "=&v"(r) : "v"(vb), "i"(OFF) : "memory"); return r;
}
template <int D0> __device__ __forceinline__ void pv_one(f32x16& od, int vb, bf16x8 pa0, bf16x8 pa1, bf16x8 pa2, bf16x8 pa3) {
  const s16x4 l0 = tr_read<v_rd_off(D0, 0, 0)>(vb), h0 = tr_read<v_rd_off(D0, 0, 1)>(vb), l1 = tr_read<v_rd_off(D0, 1, 0)>(vb), h1 = tr_read<v_rd_off(D0, 1, 1)>(vb);
  const s16x4 l2 = tr_read<v_rd_off(D0, 2, 0)>(vb), h2 = tr_read<v_rd_off(D0, 2, 1)>(vb), l3 = tr_read<v_rd_off(D0, 3, 0)>(vb), h3 = tr_read<v_rd_off(D0, 3, 1)>(vb);
  asm volatile("s_waitcnt lgkmcnt(0)" ::: "memory"); SBAR();
#define PK(L, H) (bf16x8){L[0], L[1], L[2], L[3], H[0], H[1], H[2], H[3]}
  od = __builtin_amdgcn_mfma_f32_32x32x16_bf16(pa0, PK(l0, h0), od, 0, 0, 0);
  od = __builtin_amdgcn_mfma_f32_32x32x16_bf16(pa1, PK(l1, h1), od, 0, 0, 0);
  od = __builtin_amdgcn_mfma_f32_32x32x16_bf16(pa2, PK(l2, h2), od, 0, 0, 0);
  od = __builtin_amdgcn_mfma_f32_32x32x16_bf16(pa3, PK(l3, h3), od, 0, 0, 0);
#undef PK
}
__device__ __forceinline__ void pv_d0(f32x16* o, int vb, bf16x8 pa0, bf16x8 pa1, bf16x8 pa2, bf16x8 pa3) {
  pv_one<0>(o[0], vb, pa0, pa1, pa2, pa3); pv_one<1>(o[1], vb, pa0, pa1, pa2, pa3); pv_one<2>(o[2], vb, pa0, pa1, pa2, pa3); pv_one<3>(o[3], vb, pa0, pa1, pa2, pa3);
}

template <int DK, int SDEPTH, int ldq, int ldk, int ldv, int ldo, int seq>
__device__ __forceinline__ void attn_unit(const bf16_t* __restrict__ Qb, const bf16_t* __restrict__ Kh, const bf16_t* __restrict__ Krp,
                                          const bf16_t* __restrict__ Vh, bf16_t* __restrict__ Ob, char* lds) {
  constexpr float SCALE = (DK == 128) ? 0.088388347648318440f : 0.072168783648703220f;
  constexpr float C = SCALE * 1.4426950408889634f, THRS = THR / SCALE;
  constexpr int ND = DK / 16, NQR = (DK == 128) ? 8 : 6;
  const int tid = threadIdx.x, wid = tid >> 6, lane = tid & 63, r32 = lane & 31, hi = lane >> 5;
  char* V_lds = lds + OFF_V; char* K_lds = lds + OFF_K; char* KR_lds = lds + OFF_KR;
  float* ws = (float*)(lds + OFF_WS) + wid * 64; float* li_l = ws; float* al_l = ws + 32;
  float m_reg = -1e30f, l_reg = 0; f32x16 o[4] = {}; bf16x8 qr[NQR];
  const bf16_t* Qw = Qb + (long)(wid * QBLK + r32) * ldq + hi * 8;
#pragma unroll
  for (int d0 = 0; d0 < NQR; ++d0) qr[d0] = *reinterpret_cast<const bf16x8*>(Qw + d0 * 16);
  char* qrl = lds + OFF_QR + wid * QR_WAVE + lane * 16;
#pragma unroll
  for (int d0 = NQR; d0 < ND; ++d0) *reinterpret_cast<bf16x8*>(qrl + (d0 - NQR) * 1024) = *reinterpret_cast<const bf16x8*>(Qw + d0 * 16);
  const int sr = tid >> 4, sc = (tid & 15) * 8, vst0 = v_st(sr, sc), vst1 = v_st(32 + sr, sc);
  const int krr = tid >> 3, krc = (tid & 7) * 8;
  const int vb0 = (int)(uintptr_t)V_lds + v_rd_base(lane);
  bf16x8 vs0[SDEPTH], vs1[SDEPTH], ks0[SDEPTH], ks1[SDEPTH], kr0[SDEPTH];
  const unsigned voffV = (unsigned)((sr * ldv + sc) * 2), voffK = (unsigned)((sr * ldk + sc) * 2), voffR = (unsigned)((krr * 64 + krc) * 2);
#define SLOAD(i, k0) do { const char* vb_ = (const char*)Vh + (size_t)(k0) * (ldv * 2); const char* kb_ = (const char*)Kh + (size_t)(k0) * (ldk * 2); \
    vs0[i] = *(const bf16x8*)(vb_ + voffV); vs1[i] = *(const bf16x8*)(vb_ + 32 * ldv * 2 + voffV); \
    ks0[i] = *(const bf16x8*)(kb_ + voffK); ks1[i] = *(const bf16x8*)(kb_ + 32 * ldk * 2 + voffK); \
    if constexpr (DK == 192) kr0[i] = *(const bf16x8*)((const char*)Krp + (size_t)(k0) * 128 + voffR); } while (0)
#define SWRITE(b, i) do { *(bf16x8*)(V_lds + (b) * SHM_V + vst0) = vs0[i];          \
    *(bf16x8*)(V_lds + (b) * SHM_V + vst1) = vs1[i]; int kc = sc * 2;               \
    *(bf16x8*)(K_lds + (b) * SHM_K + KSWZ(sr, kc)) = ks0[i];                       \
    *(bf16x8*)(K_lds + (b) * SHM_K + KSWZ(32 + sr, kc)) = ks1[i];                  \
    if constexpr (DK == 192) *(bf16x8*)(KR_lds + (b) * SHM_KR + KRSWZ(krr, krc * 2)) = kr0[i]; } while (0)
#define SWAIT() do { if constexpr (SDEPTH == 1) asm volatile("s_waitcnt vmcnt(0)" ::: "memory"); else if constexpr (DK == 192) asm volatile("s_waitcnt vmcnt(5)" ::: "memory"); else asm volatile("s_waitcnt vmcnt(4)" ::: "memory"); } while (0)
#define RESC(a) do { if (__any((a) < 1.f)) { if (hi == 0) al_l[r32] = (a); asm volatile("s_waitcnt lgkmcnt(0)" ::: "memory"); \
    _Pragma("unroll") for (int d = 0; d < 4; ++d) _Pragma("unroll") for (int r = 0; r < 16; ++r) o[d][r] *= al_l[crow(r, hi)]; } } while (0)
  f32x16 pA0, pA1, pB0, pB1; float mnA, mnB, alA, alB; bf16x8 pa0, pa1, pa2, pa3; const int NT = seq / KVBLK;
  constexpr int SE = 0, SO = SDEPTH - 1;
  SLOAD(SE, 0); asm volatile("s_waitcnt vmcnt(0)" ::: "memory"); SWRITE(0, SE); __syncthreads();
  qkt<DK, NQR>(pA0, pA1, K_lds, KR_lds, qr, qrl, r32, hi); partialSM(pA0, pA1, m_reg, mnA, alA, C, THRS);
  SLOAD(SO, KVBLK); if constexpr (SDEPTH == 2) { if (2 < NT) SLOAD(SE, 2 * KVBLK); }
  SWAIT(); SWRITE(1, SO); __syncthreads();
  for (int j = 1; j + 1 < NT; j += 2) {
    SBAR(); qkt<DK, NQR>(pB0, pB1, K_lds + SHM_K, KR_lds + SHM_KR, qr, qrl, r32, hi);
    finishSM(pA0, pA1, alA, l_reg, pa0, pa1, pa2, pa3); SBAR();
    SLOAD(SO, (j + SDEPTH) * KVBLK); SBAR();
    pv_d0(o, vb0, pa0, pa1, pa2, pa3); partialSM(pB0, pB1, m_reg, mnB, alB, C, THRS);
    __syncthreads(); SWAIT(); SWRITE(0, SE);
    RESC(alB); __syncthreads();
    SBAR(); qkt<DK, NQR>(pA0, pA1, K_lds, KR_lds, qr, qrl, r32, hi);
    finishSM(pB0, pB1, alB, l_reg, pa0, pa1, pa2, pa3); SBAR();
    if (SDEPTH == 1 || j + 3 < NT) SLOAD(SE, (j + 1 + SDEPTH) * KVBLK); SBAR();
    pv_d0(o, vb0 + SHM_V, pa0, pa1, pa2, pa3); partialSM(pA0, pA1, m_reg, mnA, alA, C, THRS);
    __syncthreads(); SWAIT(); SWRITE(1, SO);
    RESC(alA); __syncthreads();
  }
  SBAR(); qkt<DK, NQR>(pB0, pB1, K_lds + SHM_K, KR_lds + SHM_KR, qr, qrl, r32, hi);
  finishSM(pA0, pA1, alA, l_reg, pa0, pa1, pa2, pa3); SBAR();
  pv_d0(o, vb0, pa0, pa1, pa2, pa3); partialSM(pB0, pB1, m_reg, mnB, alB, C, THRS);
  __syncthreads(); RESC(alB);
  finishSM(pB0, pB1, alB, l_reg, pa0, pa1, pa2, pa3); SBAR();
  pv_d0(o, vb0 + SHM_V, pa0, pa1, pa2, pa3);
  if (hi == 0) li_l[r32] = l_reg; asm volatile("s_waitcnt lgkmcnt(0)" ::: "memory");
  float rli[16];
#pragma unroll
  for (int r = 0; r < 16; ++r) rli[r] = __builtin_amdgcn_rcpf(li_l[crow(r, hi)]);
  bf16_t* Ow = Ob + (long)(wid * QBLK) * ldo;
#pragma unroll
  for (int r = 0; r < 16; ++r) { int orow = crow(r, hi);
#pragma unroll
    for (int d0 = 0; d0 < 4; ++d0) Ow[(long)orow * ldo + d0 * 32 + r32] = f2bf(o[d0][r] * rli[r]); }
#undef SLOAD
#undef SWRITE
#undef SWAIT
#undef RESC
}
}

struct TrItem { const float* W; bf16_t* WT; int ldw, k0, n0, ldt, drow0, dk0; const float* gain; };
__device__ __forceinline__ void tr_load(f32x4 (&v)[16], const TrItem& t, int lane) {
    const int lr = lane >> 4, lc = (lane & 15) * 4;
#pragma unroll
    for (int i = 0; i < 16; ++i) v[i] = *(const f32x4*)(t.W + (size_t)(t.k0 + 4 * i + lr) * t.ldw + t.n0 + lc);
}
__device__ __forceinline__ void tr_store(const f32x4 (&v)[16], const TrItem& t, LAS float* scr, int lane) {
    const int lr = lane >> 4, lc = (lane & 15) * 4;
#pragma unroll
    for (int i = 0; i < 16; ++i) { LAS float* d = scr + (4 * i + lr) * 65 + lc; const float gk = t.gain ? t.gain[t.k0 + 4 * i + lr] : 1.f;
        d[0] = v[i].x * gk; d[1] = v[i].y * gk; d[2] = v[i].z * gk; d[3] = v[i].w * gk; }
    asm volatile("s_waitcnt lgkmcnt(0)" ::: "memory");
    const int c = lane & 7;
#pragma unroll
    for (int j = 0; j < 8; ++j) { const int n = (lane >> 3) + 8 * j; const LAS float* s = scr + (8 * c) * 65 + n;
        u32x4 o; o.x = cvt_pk_bf16(s[0], s[65]); o.y = cvt_pk_bf16(s[130], s[195]); o.z = cvt_pk_bf16(s[260], s[325]); o.w = cvt_pk_bf16(s[390], s[455]);
        *(u32x4*)(t.WT + (size_t)(t.drow0 + n) * t.ldt + t.dk0 + 8 * c) = o; }
    asm volatile("s_waitcnt lgkmcnt(0)" ::: "memory");
}
__device__ __forceinline__ void tr_item(const float* __restrict__ W, int ldw, int k0, int n0, bf16_t* __restrict__ WT, int ldt, int drow0, int dk0, LAS float* scr, int lane) {
    TrItem t{W, WT, ldw, k0, n0, ldt, drow0, dk0, nullptr}; f32x4 v[16]; tr_load(v, t, lane); tr_store(v, t, scr, lane);
}
__device__ __forceinline__ void rms_row_to_bf16(const float* __restrict__ xrow, const float* __restrict__ g, bf16_t* __restrict__ orow, int lane) {
    f32x4 v[8]; float s = 0.f;
#pragma unroll
    for (int j = 0; j < 8; ++j) { v[j] = *(const f32x4*)(xrow + 4 * lane + 256 * j); s += (v[j].x * v[j].x + v[j].y * v[j].y) + (v[j].z * v[j].z + v[j].w * v[j].w); }
    const float r = 1.0f / sqrtf(wave_sum(s) * (1.f / DM) + EPS);
#pragma unroll
    for (int j = 0; j < 8; ++j) { const f32x4 gg = *(const f32x4*)(g + 4 * lane + 256 * j);
        u32x2 o; o.x = cvt_pk_bf16(v[j].x * r * gg.x, v[j].y * r * gg.y); o.y = cvt_pk_bf16(v[j].z * r * gg.z, v[j].w * r * gg.w);
        *(u32x2*)(orow + 4 * lane + 256 * j) = o; }
}

__device__ __forceinline__ unsigned q8(float v) { int q = (int)__builtin_rintf(v); q = q < -127 ? -127 : (q > 127 ? 127 : q); return (unsigned)q & 0xffu; }
__device__ __forceinline__ unsigned q8x4(float a, float b, float c, float d) { return q8(a) | (q8(b) << 8) | (q8(c) << 16) | (q8(d) << 24); }
__device__ __forceinline__ void tr_item8(const float* __restrict__ W, int ldw, int k0, int n0, unsigned char* __restrict__ WT8, int ldt, int drow0, int dk0, LAS float* scr, int lane) {
    const int lr = lane >> 4, lc = (lane & 15) * 4;
    f32x4 v[16];
#pragma unroll
    for (int i = 0; i < 16; ++i) v[i] = *(const f32x4*)(W + (size_t)(k0 + 4 * i + lr) * ldw + n0 + lc);
#pragma unroll
    for (int i = 0; i < 16; ++i) { LAS float* d = scr + (4 * i + lr) * 65 + lc; d[0] = v[i].x * Q8_SW; d[1] = v[i].y * Q8_SW; d[2] = v[i].z * Q8_SW; d[3] = v[i].w * Q8_SW; }
    asm volatile("s_waitcnt lgkmcnt(0)" ::: "memory");
    const int c = lane & 7;
#pragma unroll
    for (int j = 0; j < 8; ++j) { const int n = (lane >> 3) + 8 * j; const LAS float* s = scr + (8 * c) * 65 + n;
        u32x2 o; o.x = q8x4(s[0], s[65], s[130], s[195]); o.y = q8x4(s[260], s[325], s[390], s[455]);
        *(u32x2*)(WT8 + (size_t)(drow0 + n) * ldt + dk0 + 8 * c) = o; }
    asm volatile("s_waitcnt lgkmcnt(0)" ::: "memory");
}
__device__ __forceinline__ void rms_row_to_i8(const float* __restrict__ xrow, const float* __restrict__ g, unsigned char* __restrict__ orow, int lane) {
    f32x4 v[8]; float s = 0.f;
#pragma unroll
    for (int j = 0; j < 8; ++j) { v[j] = *(const f32x4*)(xrow + 4 * lane + 256 * j); s += (v[j].x * v[j].x + v[j].y * v[j].y) + (v[j].z * v[j].z + v[j].w * v[j].w); }
    const float r = Q8_SU / sqrtf(wave_sum(s) * (1.f / DM) + EPS);
#pragma unroll
    for (int j = 0; j < 8; ++j) { const f32x4 gg = *(const f32x4*)(g + 4 * lane + 256 * j);
        *(unsigned*)(orow + 4 * lane + 256 * j) = q8x4(v[j].x * r * gg.x, v[j].y * r * gg.y, v[j].z * r * gg.z, v[j].w * r * gg.w); }
}

#define XB_TMO      128
#define XB_XCNT(j)  (256  + 64 * (j))
#define XB_XSUB(j)  (1280 + 64 * (j))
#define XB_XGEN(j)  (2304 + 64 * (j))
#define XB_TOP      3328
#define XB_TOPGEN   3392
#define XCD_BAR_WORDS 3456
#define XB_SPIN_CAP (1u << 18)
__device__ __forceinline__ unsigned xb_ld(unsigned* p)              { return __hip_atomic_load(p, __ATOMIC_RELAXED, __HIP_MEMORY_SCOPE_AGENT); }
__device__ __forceinline__ unsigned xb_add(unsigned* p, unsigned v) { return __hip_atomic_fetch_add(p, v, __ATOMIC_RELAXED, __HIP_MEMORY_SCOPE_AGENT); }
__device__ __forceinline__ unsigned xb_xcc_id() { return (unsigned)__builtin_amdgcn_s_getreg((3 << 11) | 20) & 0xFu; }
#define XB_SPIN(cond, bar) do { unsigned _sp = 0; while (cond) { __builtin_amdgcn_s_sleep(1); \
    if ((++_sp & 255u) == 0u) { if (xb_ld(&(bar)[XB_TMO])) break; if (_sp > XB_SPIN_CAP) { atomicAdd(&(bar)[XB_TMO], 1u); break; } } } } while (0)
struct XcdBarrier { unsigned* bar; unsigned x; volatile LAS unsigned* st; };
__device__ __forceinline__ XcdBarrier xcd_barrier_post(unsigned* bar, volatile LAS unsigned* st) {
    XcdBarrier b; b.bar = bar; b.x = xb_xcc_id(); b.st = st;
    if (threadIdx.x == 0) (void)xb_add(&bar[XB_XCNT(b.x)], 1u);
    return b;
}
__device__ __forceinline__ void xcd_barrier_complete(unsigned* bar, unsigned x, unsigned& nloc, unsigned& nx) {
    const unsigned G = gridDim.x * gridDim.y * gridDim.z;
    unsigned sum, cnt, mine, sp = 0u;
    for (;;) {
        sum = 0u; cnt = 0u; mine = 0u;
#pragma unroll
        for (unsigned j = 0; j < 16; ++j) { const unsigned c = xb_ld(&bar[XB_XCNT(j)]); sum += c; cnt += (c > 0u) ? 1u : 0u; mine = (j == x) ? c : mine; }
        if (sum == G) break;
        __builtin_amdgcn_s_sleep(1);
        if ((++sp & 255u) == 0u) { if (xb_ld(&bar[XB_TMO])) break; if (sp > XB_SPIN_CAP) { atomicAdd(&bar[XB_TMO], 1u); break; } }
    }
    nloc = mine > 0u ? mine : 1u; nx = cnt > 0u ? cnt : 1u;
}
__device__ __forceinline__ void xcd_barrier(const XcdBarrier& b) {
    asm volatile("s_waitcnt vmcnt(0)" ::: "memory");
    __syncthreads();
    if (threadIdx.x == 0) {
        unsigned* bar = b.bar;
        __builtin_amdgcn_s_waitcnt(0);
        unsigned nloc = b.st[0], nx = b.st[1];
        if (nloc == 0u) { xcd_barrier_complete(bar, b.x, nloc, nx); b.st[0] = nloc; b.st[1] = nx; }
        const unsigned old = xb_add(&bar[XB_XSUB(b.x)], 1u);
        const unsigned gen = old / nloc;
        if (old + 1u == (gen + 1u) * nloc) {
            __builtin_amdgcn_fence(__ATOMIC_RELEASE, "agent");
            asm volatile("s_waitcnt vmcnt(0)" ::: "memory");
            const unsigned og = xb_add(&bar[XB_TOP], 1u);
            const unsigned tg = og / nx;
            if (og + 1u == (tg + 1u) * nx) xb_add(&bar[XB_TOPGEN], 1u);
            else XB_SPIN(xb_ld(&bar[XB_TOPGEN]) == tg, bar);
            __builtin_amdgcn_fence(__ATOMIC_ACQUIRE, "agent");
            xb_add(&bar[XB_XGEN(b.x)], 1u);
            asm volatile("s_waitcnt vmcnt(0)" ::: "memory");
        } else {
            XB_SPIN(xb_ld(&bar[XB_XGEN(b.x)]) == gen, bar);
            __builtin_amdgcn_fence(__ATOMIC_ACQUIRE, "agent");
            asm volatile("s_waitcnt vmcnt(0)" ::: "memory");
        }
    }
    __syncthreads();
}

struct Args {
    const float *x, *p, *g_mix, *w_in, *q_norm_a, *k_norm_a, *q_a_norm, *w_q_b, *kv_a_norm, *w_kv_b, *w_a_out, *w_b_out, *w_o, *g_ffn, *w_gate_up, *w_down, *g_ple,
                *w_ple_gate, *w_ple_proj, *g_ple_post, *g_final;
    float* out; unsigned char* ws; int ph_lo, ph_hi;
};

constexpr int NPHASE = 14;

__global__ void __launch_bounds__(NTHREADS, 2) mk_fwd(Args a) {
    extern __shared__ __attribute__((aligned(16))) unsigned char lds_raw[];
    LAS unsigned char* lds = (LAS unsigned char*)lds_raw;
    const int tid = threadIdx.x, lane = tid & 63, wave = __builtin_amdgcn_readfirstlane(tid >> 6);
    const int G = gridDim.x, bx = blockIdx.x;
    const int gw = bx * NWAVES + wave, NGW = G * NWAVES;
    unsigned char* ws = a.ws;
    bf16_t* WinT = (bf16_t*)(ws + WS_WIN); bf16_t* WqbT = (bf16_t*)(ws + WS_WQB); bf16_t* WkvbT = (bf16_t*)(ws + WS_WKVB); bf16_t* WabT = (bf16_t*)(ws + WS_WAB);
    bf16_t* WoT = (bf16_t*)(ws + WS_WO); bf16_t* WguT = (bf16_t*)(ws + WS_WGU); bf16_t* WdT = (bf16_t*)(ws + WS_WD); bf16_t* WpgT = (bf16_t*)(ws + WS_WPG);
    bf16_t* WppT = (bf16_t*)(ws + WS_WPP); bf16_t* PB = (bf16_t*)(ws + WS_PB); bf16_t* KR = (bf16_t*)(ws + WS_KR); bf16_t* U = (bf16_t*)(ws + WS_U);
    bf16_t* ZS = (bf16_t*)(ws + WS_ZS); bf16_t* SG = (bf16_t*)(ws + WS_SG); bf16_t* QA = (bf16_t*)(ws + WS_QA); bf16_t* QB = (bf16_t*)(ws + WS_QB);
    bf16_t* KVB = (bf16_t*)(ws + WS_KVB); bf16_t* CQN = (bf16_t*)(ws + WS_CQN); bf16_t* CKVN = (bf16_t*)(ws + WS_CKVN); bf16_t* KA = (bf16_t*)(ws + WS_KA);
    bf16_t* KPE = (bf16_t*)(ws + WS_KPE); bf16_t* OAB = (bf16_t*)(ws + WS_OAB); bf16_t* MERGED = (bf16_t*)(ws + WS_MERGED); bf16_t* ACT = (bf16_t*)(ws + WS_ACT);
    bf16_t* GATE = (bf16_t*)(ws + WS_GATE); bf16_t* ERAW = (bf16_t*)(ws + WS_ERAW); float* H = a.out;
    float* SSQ1 = (float*)(ws + 65536); float* SSQ2 = (float*)(ws + 131072);
    const int lo = a.ph_lo, hi = a.ph_hi;
#define IN(k) (lo <= (k) && (k) < hi)
#define SEAM(k) do { if (IN(k) && IN((k) + 1)) { xcd_barrier(xbar); } } while (0)
    volatile LAS unsigned* xst = (volatile LAS unsigned*)(lds + LDS_BYTES - 64);
    if (tid == 0) { xst[0] = 0u; xst[1] = 0u; }
    __syncthreads();
    XcdBarrier xbar = xcd_barrier_post((unsigned*)ws, xst);
    if (a.ph_lo < 0) cg::this_grid().sync();

    constexpr int I0 = 32 * 105, I1 = 8 * 24, I2 = 8 * 32, I3 = 16 * 32, I4 = 16 * 32, I5 = 32 * 32, I6 = 32 * 176, I7 = 88 * 32, I8 = 32 * 32, I9 = 4 * 32;
    constexpr int NREST = I1 + I2 + I3 + I4 + I5 + I6 + I7 + I8 + I9;
    if (IN(0)) {
        LAS float* scr = (LAS float*)(lds + wave * 16640);
        for (int it = gw; it < I0; it += NGW) {
            const int kb = it / 105, nb = it % 105, n0 = nb * 64; const int dr = n0 < 2560 ? n0 : (n0 < 2624 ? 6656 + (n0 - 2560) : n0 - 64);
            tr_item8(a.w_in, NIN, kb * 64, n0, (unsigned char*)WinT, 2048, dr, kb * 64, scr, lane);
        }
        for (int m = gw; m < M; m += NGW) {
            rms_row_to_i8(a.x + (size_t)m * DM, a.g_mix, (unsigned char*)U + (size_t)m * DM, lane);
            const f32x4 pv = *(const f32x4*)(a.p + (size_t)m * PLE + 4 * lane);
            u32x2 o; o.x = cvt_pk_bf16(pv.x, pv.y); o.y = cvt_pk_bf16(pv.z, pv.w);
            *(u32x2*)(PB + (size_t)m * PLE + 4 * lane) = o;
        }
        for (int i = bx * NTHREADS + tid; i < (NINP - NIN) * 2048 / 16; i += G * NTHREADS) *(u32x4*)((unsigned char*)WinT + (size_t)NIN * 2048 + (size_t)i * 16) = (u32x4){0u, 0u, 0u, 0u};
        __syncthreads();
    }
    SEAM(0);
    if (IN(1)) {
        constexpr int NU = (M / 256) * (NINP / 256);
        const int GG = (G >= 256) ? 216 : G;
        if (bx < GG) {
            pg8::Gemm g{U, WinT, M, NINP, DM / 2, DM / 2, 0}; pg8::StaticOrder S; S.init(M, NINP, GG, bx);
            pg8::EpiIn E{ZS, SG, KR};
            pg8::gemm_phase<pg8::EpiIn, pg8::StaticOrder, true, true, false, true>(lds, g, S, E);
        }
        {
            {
                LAS float* scr = (LAS float*)(lds + wave * 16640);
                unsigned* qctr = (unsigned*)(ws + 262144);
                auto decode = [&](int r) -> TrItem {
                    if (r < I1) { const int kb = r / 24, nb = r % 24; return TrItem{a.w_q_b, WqbT, 1536, kb * 64, nb * 64, 512, nb * 64, kb * 64, nullptr}; } r -= I1;
                    if (r < I2) { const int kb = r / 32, nb = r % 32; return TrItem{a.w_kv_b, WkvbT, 2048, kb * 64, nb * 64, 512, nb * 64, kb * 64, nullptr}; } r -= I2;
                    if (r < I3) { const int kb = r / 32, nb = r % 32; return TrItem{a.w_a_out, WabT, 2048, kb * 64, nb * 64, 2048, nb * 64, kb * 64, nullptr}; } r -= I3;
                    if (r < I4) { const int kb = r / 32, nb = r % 32; return TrItem{a.w_b_out, WabT, 2048, kb * 64, nb * 64, 2048, nb * 64, 1024 + kb * 64, nullptr}; } r -= I4;
                    if (r < I5) { const int kb = r / 32, nb = r % 32; return TrItem{a.w_o, WoT, 2048, kb * 64, nb * 64, 2048, nb * 64, kb * 64, nullptr}; } r -= I5;
                    if (r < I6) { const int kb = r / 176, nb = r % 176, n0 = nb * 64; const int s_ = n0 >= DFF ? 1 : 0, j = n0 - s_ * DFF; const int dr = 256 * (j >> 7) + 128 * s_ + (j & 127);
                        return TrItem{a.w_gate_up, WguT, 2 * DFF, kb * 64, n0, 2048, dr, kb * 64, a.g_ffn}; } r -= I6;
                    if (r < I7) { const int kb = r / 32, nb = r % 32; return TrItem{a.w_down, WdT, 2048, kb * 64, nb * 64, DFF, nb * 64, kb * 64, nullptr}; } r -= I7;
                    if (r < I8) { const int kb = r / 32, nb = r % 32; return TrItem{a.w_ple_gate, WpgT, 2048, kb * 64, nb * 64, 2048, nb * 64, kb * 64, a.g_ple}; } r -= I8;
                    { const int kb = r / 32, nb = r % 32; return TrItem{a.w_ple_proj, WppT, 2048, kb * 64, nb * 64, 256, nb * 64, kb * 64, nullptr}; }
                };
                auto grab = [&]() -> int { unsigned v = 0u; if (lane == 0) v = __hip_atomic_fetch_add((__attribute__((address_space(1))) unsigned*)qctr, 1u, __ATOMIC_RELAXED, __HIP_MEMORY_SCOPE_AGENT); return (int)__builtin_amdgcn_readfirstlane(v); };
                f32x4 va[16], vb[16]; TrItem ta{}, tb{};
                int it = grab();
                if (it < NREST) { ta = decode(it); tr_load(va, ta, lane); }
                while (it < NREST) {
                    int it2 = grab(); if (it2 < NREST) { tb = decode(it2); tr_load(vb, tb, lane); }
                    tr_store(va, ta, scr, lane);
                    it = it2; if (it >= NREST) break;
                    it2 = grab(); if (it2 < NREST) { ta = decode(it2); tr_load(va, ta, lane); }
                    tr_store(vb, tb, scr, lane);
                    it = it2;
                }
            }
            __syncthreads();
        }
        (void)NU;
    }
    SEAM(1);
    if (IN(2)) {
        const int l5 = lane & 31, hsel = lane >> 5, d0 = l5 * 4, isx2 = (l5 >> 3) & 1, halfc = (l5 >> 4) & 1;
        float invA4[4]; f32x4 gq, gk;
#pragma unroll
        for (int i = 0; i < 4; ++i) invA4[i] = powf(10000.f, -(float)(2 * ((d0 & 31) + i)) / 64.f);
        gq = *(const f32x4*)(a.q_norm_a + d0); gk = *(const f32x4*)(a.k_norm_a + d0);
        const int hfb = (lane >> 4) & 1, jb = lane & 15;
        const float invB = powf(10000.f, -(float)(2 * jb) / 32.f);
        for (int m = gw; m < M; m += NGW) {
            const int s = m & (SEQ - 1); const float prow = (float)(s >> 6), pcol = (float)(s & 63);
            const float posA = halfc ? pcol : prow; float cA[4], sA[4];
#pragma unroll
            for (int i = 0; i < 4; ++i) { const float ang = posA * invA4[i]; cA[i] = cosf(ang); sA[i] = sinf(ang); }
            const bf16_t* zr = ZS + (size_t)m * 2560;
#pragma unroll
            for (int it = 0; it < 5; ++it) {
                const int head = 2 * it + hsel;
                const u32x2 w = *(const u32x2*)(zr + head * 128 + d0);
                const float x[4] = {bf_lo(w.x), bf_hi(w.x), bf_lo(w.y), bf_hi(w.y)};
                float ss = (x[0] * x[0] + x[1] * x[1]) + (x[2] * x[2] + x[3] * x[3]);
#pragma unroll
                for (int o2 = 1; o2 < 32; o2 <<= 1) ss += __shfl_xor(ss, o2);
                const float r = 1.0f / sqrtf(ss * (1.f / 128.f) + EPS);
                const f32x4 g = (it < 4) ? gq : gk; float o[4];
#pragma unroll
                for (int i = 0; i < 4; ++i) { const float y = x[i] * r * g[i]; const float p = __shfl_xor(y, 8);
                    o[i] = isx2 ? (y * cA[i] + p * sA[i]) : (y * cA[i] - p * sA[i]); }
                u32x2 ow; ow.x = cvt_pk_bf16(o[0], o[1]); ow.y = cvt_pk_bf16(o[2], o[3]);
                bf16_t* dst = (it < 4) ? (QA + (size_t)m * 1024 + head * 128 + d0) : (KA + (size_t)m * 256 + (head - 8) * 128 + d0);
                *(u32x2*)dst = ow;
            }
#pragma unroll
            for (int t = 0; t < 2; ++t) {
                const u32x4 w = *(const u32x4*)(zr + 1536 + t * 512 + lane * 8);
                float v[8] = {bf_lo(w.x), bf_hi(w.x), bf_lo(w.y), bf_hi(w.y), bf_lo(w.z), bf_hi(w.z), bf_lo(w.w), bf_hi(w.w)};
                float ss = 0.f;
#pragma unroll
                for (int i = 0; i < 8; ++i) ss += v[i] * v[i];
                const float r = 1.0f / sqrtf(wave_sum(ss) * (1.f / 512.f) + EPS);
                const float* gg = (t == 0 ? a.q_a_norm : a.kv_a_norm) + lane * 8;
                const f32x4 g0 = *(const f32x4*)gg, g1 = *(const f32x4*)(gg + 4);
                u32x4 o; o.x = cvt_pk_bf16(v[0] * r * g0.x, v[1] * r * g0.y); o.y = cvt_pk_bf16(v[2] * r * g0.z, v[3] * r * g0.w);
                o.z = cvt_pk_bf16(v[4] * r * g1.x, v[5] * r * g1.y); o.w = cvt_pk_bf16(v[6] * r * g1.z, v[7] * r * g1.w);
                *(u32x4*)((t == 0 ? CQN : CKVN) + (size_t)m * 512 + lane * 8) = o;
            }
            if (lane < 32) {
                const float angB = (hfb ? pcol : prow) * invB; const float cB = cosf(angB), sB = sinf(angB);
                const bf16_t* kr = KR + (size_t)m * 64 + hfb * 32 + jb;
                const float x1 = bf1(kr[0]), x2 = bf1(kr[16]);
                bf16_t* dst = KPE + (size_t)m * 64 + hfb * 32 + jb;
                dst[0] = f2bf(x1 * cB - x2 * sB); dst[16] = f2bf(x2 * cB + x1 * sB);
            }
        }
    }
    SEAM(2);
    if (IN(3)) {
        { pg8::Gemm g{CQN, WqbT, M, 1536, 512, 512, 0}; pg8::StaticOrder S; S.init(M, 1536, G, bx); pg8::EpiQB E{QB};
          pg8::gemm_phase<pg8::EpiQB, pg8::StaticOrder, true, true, false>(lds, g, S, E); }
        { pg8::Gemm g{CKVN, WkvbT, M, 2048, 512, 512, 0}; pg8::StaticOrder S; S.init(M, 2048, G, bx); pg8::EpiBf16<0> E{KVB, 2048, nullptr};
          pg8::gemm_phase<pg8::EpiBf16<0>, pg8::StaticOrder, true, true, false>(lds, g, S, E); }
    }
    SEAM(3);
    if (IN(5)) {
        char* lds_g = (char*)lds_raw;
        const int x = bx & 7, i = bx >> 3;
        for (int c = bx; c < 256; c += G) {
            const int xx = c & 7, ii = c >> 3;
            {
                const int combo = xx >> 1, w = (xx & 1) * 32 + ii, b = combo >> 1, kvh = combo & 1, hq = kvh * 4 + (w >> 4), qb = w & 15;
                const size_t row0 = (size_t)b * SEQ;
                __syncthreads();
                att::attn_unit<128, ATT_SD_A, 1024, 256, 2560, 2048, SEQ>(QA + (row0 + qb * 256) * 1024 + hq * 128, KA + row0 * 256 + kvh * 128, nullptr,
                                    ZS + row0 * 2560 + 1280 + kvh * 128, OAB + (row0 + qb * 256) * 2048 + hq * 128, lds_g);
            }
            {
                const int unit = xx * 32 + ii, bh = unit >> 4, qb = unit & 15, b = bh >> 3, h = bh & 7;
                const size_t row0 = (size_t)b * SEQ;
                __syncthreads();
                att::attn_unit<192, ATT_SD_B, 1536, 2048, 2048, 2048, SEQ>(QB + (row0 + qb * 256) * 1536 + h * 192, KVB + row0 * 2048 + h * 256, KPE + row0 * 64,
                                    KVB + row0 * 2048 + h * 256 + 128, OAB + (row0 + qb * 256) * 2048 + 1024 + h * 128, lds_g);
            }
        }
        (void)x; (void)i;
        __syncthreads();
    }
    SEAM(5);
    if (IN(6)) {
        bf16_t* T1 = (bf16_t*)(ws + WS_T1);
        { pg8::Gemm g{OAB, WabT, M, 2048, 1024, 2048, 0}; pg8::StaticOrder S; S.init(M, 2048, G, bx); pg8::EpiGate<false> E{SG, T1, MERGED};
          pg8::gemm_phase<pg8::EpiGate<false>, pg8::StaticOrder, true, true, false>(lds, g, S, E); }
        { pg8::Gemm g{OAB + 1024, WabT + 1024, M, 2048, 1024, 2048, 0}; pg8::StaticOrder S; S.init(M, 2048, G, bx); pg8::EpiGate<true> E{SG, T1, MERGED};
          pg8::gemm_phase<pg8::EpiGate<true>, pg8::StaticOrder, true, true, false>(lds, g, S, E); }
    }
    SEAM(6);
    if (IN(7)) {
        pg8::Gemm g{MERGED, WoT, M, 2048, 2048, 2048, 0}; pg8::StaticOrder S; S.init(M, 2048, G, bx); pg8::EpiResid<false> E{a.x, nullptr, U, SSQ1};
        pg8::gemm_phase<pg8::EpiResid<false>, pg8::StaticOrder, true, true, false>(lds, g, S, E);
    }
    SEAM(7);
    if (IN(9)) {
        pg8::Gemm g{U, WguT, M, 2 * DFF, DM, DM, 0}; pg8::StaticOrder S; S.init(M, 2 * DFF, G, bx); pg8::EpiSwiglu E{ACT, SSQ1};
        pg8::gemm_phase<pg8::EpiSwiglu, pg8::StaticOrder, true, true, false>(lds, g, S, E);
        {
            constexpr int NU = (M / 256) * (2 * DFF / 256);
            const int nr = (NU + G - 1) / G, nbusy = NU - (nr - 1) * G; int idx = bx - nbusy, cnt = G - nbusy; if (cnt < 32) { idx = bx; cnt = G; }
            if (idx >= 0) { pg8::Gemm g2{PB, WppT, M, 2048, PLE, PLE, 0}; pg8::StaticOrder S2; S2.init(M, 2048, cnt, idx); pg8::EpiBf16<0> E2{ERAW, 2048, nullptr};
                pg8::gemm_phase<pg8::EpiBf16<0>, pg8::StaticOrder, true, true, false>(lds, g2, S2, E2); }
        }
    }
    SEAM(9);
    if (IN(10)) {
        pg8::Gemm g{ACT, WdT, M, 2048, DFF, DFF, 0}; pg8::StaticOrder S; S.init(M, 2048, G, bx); pg8::EpiResid<true> E{nullptr, U, U, SSQ2};
        pg8::gemm_phase<pg8::EpiResid<true>, pg8::StaticOrder, true, true, false>(lds, g, S, E);
    }
    SEAM(10);
    if (IN(12)) {
        { pg8::Gemm g{U, WpgT, M, 2048, DM, DM, 0}; pg8::StaticOrder S; S.init(M, 2048, G, bx); pg8::EpiBf16<1> E{GATE, 2048, SSQ2};
          pg8::gemm_phase<pg8::EpiBf16<1>, pg8::StaticOrder, true, true, false>(lds, g, S, E); }
    }
    SEAM(12);
    if (IN(13)) {
        u32x2 nh[8], ne[8], ng[8];
        int m = gw;
        if (m < M) {
#pragma unroll
            for (int j = 0; j < 8; ++j) { const size_t o = (size_t)m * DM + 4 * lane + 256 * j; nh[j] = *(const u32x2*)(U + o); ne[j] = *(const u32x2*)(ERAW + o); ng[j] = *(const u32x2*)(GATE + o); }
        }
        for (; m < M; m += NGW) {
            f32x4 h[8], e[8]; u32x2 gtw[8]; float se = 0.f;
#pragma unroll
            for (int j = 0; j < 8; ++j) { h[j] = (f32x4){bf_lo(nh[j].x), bf_hi(nh[j].x), bf_lo(nh[j].y), bf_hi(nh[j].y)}; e[j] = (f32x4){bf_lo(ne[j].x), bf_hi(ne[j].x), bf_lo(ne[j].y), bf_hi(ne[j].y)}; gtw[j] = ng[j];
                se += (e[j].x * e[j].x + e[j].y * e[j].y) + (e[j].z * e[j].z + e[j].w * e[j].w); }
            const int m2 = m + NGW;
            if (m2 < M) {
#pragma unroll
                for (int j = 0; j < 8; ++j) { const size_t o = (size_t)m2 * DM + 4 * lane + 256 * j; nh[j] = *(const u32x2*)(U + o); ne[j] = *(const u32x2*)(ERAW + o); ng[j] = *(const u32x2*)(GATE + o); }
            }
            const float re = 1.0f / sqrtf(wave_sum(se) * (1.f / DM) + EPS);
            float sh = 0.f;
#pragma unroll
            for (int j = 0; j < 8; ++j) { const u32x2 gt = gtw[j];
                const f32x4 gp = *(const f32x4*)(a.g_ple_post + 4 * lane + 256 * j);
                h[j].x += bf_lo(gt.x) * (e[j].x * re * gp.x); h[j].y += bf_hi(gt.x) * (e[j].y * re * gp.y);
                h[j].z += bf_lo(gt.y) * (e[j].z * re * gp.z); h[j].w += bf_hi(gt.y) * (e[j].w * re * gp.w);
                sh += (h[j].x * h[j].x + h[j].y * h[j].y) + (h[j].z * h[j].z + h[j].w * h[j].w); }
            const float rh = 1.0f / sqrtf(wave_sum(sh) * (1.f / DM) + EPS);
#pragma unroll
            for (int j = 0; j < 8; ++j) { const f32x4 gf = *(const f32x4*)(a.g_final + 4 * lane + 256 * j);
                f32x4 o; o.x = h[j].x * rh * gf.x; o.y = h[j].y * rh * gf.y; o.z = h[j].z * rh * gf.z; o.w = h[j].w * rh * gf.w;
                *(f32x4*)(a.out + (size_t)m * DM + 4 * lane + 256 * j) = o;
            }
        }
    }
#undef IN
#undef SEAM
}

extern "C" void kernel_launch(void* const* d_in, const int* in_sizes, int n_in, void* d_out, int out_size, void* d_ws, size_t ws_size, hipStream_t stream) {
    static int grid = 0;
    if (grid == 0) {
        if (n_in != 21 || in_sizes[0] != M * DM || out_size != M * DM || ws_size < WS_END) {
            fprintf(stderr, "kernel_launch: unexpected shapes: n_in %d in0 %d out %d ws %zu (need %zu)\n", n_in, n_in > 0 ? in_sizes[0] : -1, out_size, ws_size, (size_t)WS_END); grid = -1; return; }
        int dev = 0, cus = 0, per_cu = 0;
        if (hipGetDevice(&dev) != hipSuccess || hipDeviceGetAttribute(&cus, hipDeviceAttributeMultiprocessorCount, dev) != hipSuccess) { grid = -1; return; }
        if (hipFuncSetAttribute((const void*)mk_fwd, hipFuncAttributeMaxDynamicSharedMemorySize, LDS_BYTES) != hipSuccess) { fprintf(stderr, "kernel_launch: hipFuncSetAttribute failed\n"); grid = -1; return; }
        if (hipOccupancyMaxActiveBlocksPerMultiprocessor(&per_cu, (const void*)mk_fwd, NTHREADS, LDS_BYTES) != hipSuccess || per_cu < 1) { fprintf(stderr, "kernel_launch: occupancy query says %d\n", per_cu); per_cu = 1; }
        (void)hipGetLastError();
        grid = cus * 1;
    }
    if (grid < 0) return;
    Args a{};
    const float** f = (const float**)&a;
    for (int i = 0; i < 21; ++i) f[i] = (const float*)d_in[i];
    a.out = (float*)d_out; a.ws = (unsigned char*)d_ws;
#if MK_ONE_LAUNCH
    if (hipMemsetAsync(d_ws, 0, 262144 + 256, stream) != hipSuccess) { fprintf(stderr, "kernel_launch: memset failed\n"); return; }
    a.ph_lo = 0; a.ph_hi = NPHASE;
    void* args[] = {&a};
    hipError_t e = hipLaunchCooperativeKernel((const void*)mk_fwd, dim3(grid), dim3(NTHREADS), args, LDS_BYTES, stream);
    if (e != hipSuccess) fprintf(stderr, "kernel_launch: cooperative launch failed: %s (grid %d)\n", hipGetErrorString(e), grid);
#else
    for (int ph = 0; ph < NPHASE; ++ph) {
        a.ph_lo = ph; a.ph_hi = ph + 1;
        hipLaunchKernelGGL(mk_fwd, dim3(grid), dim3(NTHREADS), LDS_BYTES, stream, a);
    }
#endif
}
```

```cpp
#include <hip/hip_runtime.h>
#include <hip/hip_cooperative_groups.h>
#include <cstdio>
#include <cstdint>
namespace cg = cooperative_groups;

#ifndef ATT_SD_A
#define ATT_SD_A 1
#endif
#ifndef ATT_SD_B
#define ATT_SD_B 1
#endif
#ifndef MK_ONE_LAUNCH
#define MK_ONE_LAUNCH 1
#endif

#define LAS __attribute__((address_space(3)))
typedef unsigned short bf16_t;
typedef short bf16x8 __attribute__((ext_vector_type(8)));
typedef short s16x4 __attribute__((ext_vector_type(4)));
typedef float f32x4 __attribute__((ext_vector_type(4)));
typedef float f32x16 __attribute__((ext_vector_type(16)));
typedef unsigned u32x4 __attribute__((ext_vector_type(4)));
typedef unsigned u32x2 __attribute__((ext_vector_type(2)));
typedef int v4i_t __attribute__((ext_vector_type(4)));
constexpr float Q8_SU = 20.f, Q8_SW = 900.f;

constexpr int DM = 2048, SEQ = 4096, M = 8192, DFF = 5632, PLE = 256, NIN = 6720, NINP = 6912;
constexpr float EPS = 1e-6f;
constexpr int NWAVES = 8, NTHREADS = 512;
constexpr int LDS_BYTES = 139264;

constexpr size_t MiB = 1u << 20;
constexpr size_t WS_WIN = 1 * MiB, WS_WQB = 28 * MiB, WS_WKVB = 30 * MiB, WS_WAB = 32 * MiB, WS_WO = 40 * MiB, WS_WGU = 48 * MiB, WS_WD = 92 * MiB,
                 WS_WPG = 114 * MiB, WS_WPP = 122 * MiB, WS_PB = 123 * MiB, WS_KR = 127 * MiB, WS_U = 128 * MiB, WS_ZS = 160 * MiB, WS_SG = 200 * MiB,
                 WS_QA = 264 * MiB, WS_QB = 280 * MiB, WS_KVB = 304 * MiB, WS_END = 344 * MiB;
constexpr size_t WS_CQN = 1 * MiB, WS_CKVN = 9 * MiB, WS_KA = 17 * MiB, WS_KPE = 21 * MiB;
constexpr size_t WS_T1 = 264 * MiB;
constexpr size_t WS_OAB = WS_U, WS_MERGED = WS_ZS, WS_ACT = 160 * MiB, WS_GATE = 160 * MiB, WS_ERAW = 280 * MiB;

typedef float f32x2_t __attribute__((ext_vector_type(2)));
typedef __bf16 bf16x2_t __attribute__((ext_vector_type(2)));
__device__ __forceinline__ unsigned cvt_pk_bf16(float lo, float hi) { f32x2_t v = {lo, hi}; bf16x2_t b = __builtin_convertvector(v, bf16x2_t); return __builtin_bit_cast(unsigned, b); }
__device__ __forceinline__ float bf_lo(unsigned w) { return __uint_as_float(w << 16); }
__device__ __forceinline__ float bf_hi(unsigned w) { return __uint_as_float(w & 0xffff0000u); }
__device__ __forceinline__ float bf1(bf16_t h) { return __uint_as_float(((unsigned)h) << 16); }
__device__ __forceinline__ bf16_t f2bf(float f) { unsigned u = __float_as_uint(f); return (bf16_t)((u + 0x7fffu + ((u >> 16) & 1u)) >> 16); }
__device__ __forceinline__ float sigmoidf_(float x) { return __builtin_amdgcn_rcpf(1.f + __expf(-x)); }
__device__ __forceinline__ float wave_sum(float v) {
#pragma unroll
    for (int o = 1; o < 64; o <<= 1) v += __shfl_xor(v, o);
    return v;
}

namespace pg8 {
constexpr int BM = 256, BK = 64, HALF = 128, HTB = HALF * BK * 2, STAGE_BYTES = 8 * HTB, NXCD = 8, WGM = 8;
__host__ __device__ __forceinline__ int lds_byte(int r, int c) { const int st = (r >> 4) * 2 + (c >> 5), rr = r & 15, cc = c & 31, ob = rr * 64 + cc * 2; return st * 1024 + (ob ^ (((ob >> 9) & 1) << 5)); }
__host__ __device__ __forceinline__ void stage_rc(int b, int& R, int& C) { const int st = b / 1024, sb = b % 1024, swz = sb ^ (((sb >> 9) & 1) << 5); R = (st >> 1) * 16 + swz / 64; C = (st & 1) * 32 + (swz % 64) / 2; }
__host__ __device__ __forceinline__ int perm32(int rho) { const int n = rho >> 4, i = rho & 15; return 8 * (i >> 2) + 4 * n + (i & 3); }
struct Unit { int pm, pn, kh; };
struct Gemm { const bf16_t* A; const bf16_t* Bt; int M, N, K, ld, koff; };
struct StaticOrder {
    int nM, nN, nwg, G, c;
    __host__ __device__ void init(int M_, int N_, int G_, int c_) { nM = M_ / BM; nN = N_ / BM; nwg = nM * nN; G = G_; c = c_; }
    __host__ __device__ bool next(int i, Unit& u) const {
        const long L = (long)i * G + c; if (L >= nwg) return false;
        int wgid = (int)L; { const int q = nwg / NXCD, r = nwg % NXCD, xcd = wgid % NXCD, off = wgid / NXCD; wgid = (xcd < r ? xcd * (q + 1) : r * (q + 1) + (xcd - r) * q) + off; }
        const int nig = WGM * nN, gid = wgid / nig, fm = gid * WGM, gsz = (nM - fm) < WGM ? (nM - fm) : WGM;
        u.pm = fm + ((wgid % nig) % gsz); u.pn = (wgid % nig) / gsz; u.kh = 0; return true;
    }
    __device__ __forceinline__ void a_ready(const Unit&) const {}
    __device__ __forceinline__ void done(const Unit&) const {}
};
struct DualOrder : StaticOrder {
    __host__ __device__ bool next(int i, Unit& u) const { if (!StaticOrder::next(i >> 1, u)) return false; u.kh = i & 1; return true; }
};
typedef f32x4 Acc[2][2][4][2];

__device__ __forceinline__ void store8(bf16_t* p, f32x4 v0, f32x4 v1) {
    u32x4 w; w.x = cvt_pk_bf16(v0[0], v0[1]); w.y = cvt_pk_bf16(v0[2], v0[3]); w.z = cvt_pk_bf16(v1[0], v1[1]); w.w = cvt_pk_bf16(v1[2], v1[3]);
    *(u32x4*)p = w;
}
struct EpiIn {
    static constexpr bool PERM = true, AFTER_DRAIN = false;
    bf16_t *ZS, *SG, *KR;
    __device__ __forceinline__ void operator()(const Acc& acc, const Unit& u, int wr, int wc, int fr, int fq) const {
        const int pn = u.pn; bf16_t* base; int ldc, colt; bool sig = false;
        if (pn < 10) { base = ZS; ldc = 2560; colt = pn * 256; }
        else if (pn < 26) { base = SG; ldc = 4096; colt = (pn - 10) * 256; sig = true; }
        else { base = KR; ldc = 64; colt = 0; }
        const int row0 = u.pm * BM + wr * 64 + fr, col0 = colt + wc * 32 + 8 * fq;
#pragma unroll
        for (int ai = 0; ai < 2; ++ai)
#pragma unroll
            for (int m = 0; m < 4; ++m) { bf16_t* rowp = base + (size_t)(row0 + ai * HALF + m * 16) * ldc + col0;
#pragma unroll
                for (int bj = 0; bj < 2; ++bj) {
                    if (pn == 26 && (bj == 1 || wc >= 2)) continue;
                    f32x4 v0 = __builtin_convertvector(__builtin_bit_cast(v4i_t, acc[ai][bj][m][0]), f32x4) * (1.f / (Q8_SU * Q8_SW));
                    f32x4 v1 = __builtin_convertvector(__builtin_bit_cast(v4i_t, acc[ai][bj][m][1]), f32x4) * (1.f / (Q8_SU * Q8_SW));
                    if (sig) {
#pragma unroll
                        for (int j = 0; j < 4; ++j) { v0[j] = sigmoidf_(v0[j]); v1[j] = sigmoidf_(v1[j]); } }
                    store8(rowp + bj * HALF, v0, v1); } }
    }
};
template <int ACT  > struct EpiBf16 {
    static constexpr bool PERM = true, AFTER_DRAIN = false;
    bf16_t* O; int ldc; const float* ssq;
    __device__ __forceinline__ void operator()(const Acc& acc, const Unit& u, int wr, int wc, int fr, int fq) const {
        const int row0 = u.pm * BM + wr * 64 + fr, col0 = u.pn * BM + wc * 32 + 8 * fq;
#pragma unroll
        for (int ai = 0; ai < 2; ++ai)
#pragma unroll
            for (int m = 0; m < 4; ++m) { bf16_t* rowp = O + (size_t)(row0 + ai * HALF + m * 16) * ldc + col0;
                const float r = ssq ? 1.0f / sqrtf(ssq[row0 + ai * HALF + m * 16] * (1.f / DM) + EPS) : 1.f;
#pragma unroll
                for (int bj = 0; bj < 2; ++bj) { f32x4 v0 = acc[ai][bj][m][0] * r, v1 = acc[ai][bj][m][1] * r;
                    if (ACT == 1) {
#pragma unroll
                        for (int j = 0; j < 4; ++j) { v0[j] = sigmoidf_(v0[j]); v1[j] = sigmoidf_(v1[j]); } }
                    store8(rowp + bj * HALF, v0, v1); } }
    }
};
struct EpiQB {
    static constexpr bool PERM = true, AFTER_DRAIN = false;
    bf16_t* O;
    __device__ __forceinline__ void operator()(const Acc& acc, const Unit& u, int wr, int wc, int fr, int fq) const {
        const int row0 = u.pm * BM + wr * 64 + fr, col0 = u.pn * BM + wc * 32 + 8 * fq;
        float inv[8];
#pragma unroll
        for (int t = 0; t < 8; ++t) inv[t] = __builtin_amdgcn_exp2f(-(float)(2 * ((fq & 1) * 8 + t)) * (13.287712379549449f / 32.f));
        const float sgn = (fq >= 2) ? 1.f : -1.f;
#pragma unroll
        for (int ai = 0; ai < 2; ++ai)
#pragma unroll
            for (int m = 0; m < 4; ++m) { const int row = row0 + ai * HALF + m * 16, sq = row & (SEQ - 1); const float prow = (float)(sq >> 6), pcol = (float)(sq & 63);
#pragma unroll
                for (int bj = 0; bj < 2; ++bj) { f32x4 v0 = acc[ai][bj][m][0], v1 = acc[ai][bj][m][1];
                    const int rel = (u.pn * BM + bj * HALF + wc * 32) % 192;
                    if (rel >= 128) { const float pos = (rel >= 160) ? pcol : prow;
#pragma unroll
                        for (int t = 0; t < 4; ++t) {
                            const float a0 = pos * inv[t], a1 = pos * inv[4 + t];
                            const float p0 = __shfl_xor(v0[t], 32), p1 = __shfl_xor(v1[t], 32);
                            v0[t] = v0[t] * __cosf(a0) + sgn * p0 * __sinf(a0); v1[t] = v1[t] * __cosf(a1) + sgn * p1 * __sinf(a1); } }
                    store8(O + (size_t)row * 1536 + col0 + bj * HALF, v0, v1); } }
    }
};
template <bool SECOND> struct EpiGate {
    static constexpr bool PERM = true, AFTER_DRAIN = false;
    const bf16_t* SG; bf16_t* T1; bf16_t* O;
    __device__ __forceinline__ void operator()(const Acc& acc, const Unit& u, int wr, int wc, int fr, int fq) const {
        const int row0 = u.pm * BM + wr * 64 + fr, col0 = u.pn * BM + wc * 32 + 8 * fq;
#pragma unroll
        for (int ai = 0; ai < 2; ++ai)
#pragma unroll
            for (int m = 0; m < 4; ++m) { const size_t ro = (size_t)(row0 + ai * HALF + m * 16);
#pragma unroll
                for (int bj = 0; bj < 2; ++bj) {
                    const u32x4 b = *(const u32x4*)(SG + ro * 4096 + (SECOND ? 2048 : 0) + col0 + bj * HALF);
                    f32x4 s0, s1;
                    s0[0] = bf_lo(b.x); s0[1] = bf_hi(b.x); s0[2] = bf_lo(b.y); s0[3] = bf_hi(b.y);
                    s1[0] = bf_lo(b.z); s1[1] = bf_hi(b.z); s1[2] = bf_lo(b.w); s1[3] = bf_hi(b.w);
                    bf16_t* tp = T1 + ro * 2048 + col0 + bj * HALF;
                    if constexpr (!SECOND) { store8(tp, acc[ai][bj][m][0] * s0, acc[ai][bj][m][1] * s1); }
                    else { const u32x4 tw = *(const u32x4*)tp; f32x4 t0, t1;
                        t0[0] = bf_lo(tw.x); t0[1] = bf_hi(tw.x); t0[2] = bf_lo(tw.y); t0[3] = bf_hi(tw.y); t1[0] = bf_lo(tw.z); t1[1] = bf_hi(tw.z); t1[2] = bf_lo(tw.w); t1[3] = bf_hi(tw.w);
                        store8(O + ro * 2048 + col0 + bj * HALF, t0 + acc[ai][bj][m][0] * s0, t1 + acc[ai][bj][m][1] * s1); } } }
    }
};
template <bool BASEBF> struct EpiResid {
    static constexpr bool PERM = false, AFTER_DRAIN = false;
    const float* basef; const bf16_t* baseb; bf16_t* HB; float* ssq;
    __device__ __forceinline__ void operator()(const Acc& acc, const Unit& u, int wr, int wc, int fr, int fq) const {
        const int row0 = u.pm * BM + wr * 64 + fr, col0 = u.pn * BM + wc * 32 + 4 * fq;
#pragma unroll
        for (int ai = 0; ai < 2; ++ai)
#pragma unroll
            for (int m = 0; m < 4; ++m) { const int row = row0 + ai * HALF + m * 16; const size_t ro = (size_t)row * DM + col0; float ss = 0.f;
#pragma unroll
                for (int bj = 0; bj < 2; ++bj)
#pragma unroll
                    for (int n = 0; n < 2; ++n) { const size_t o = ro + bj * HALF + n * 16;
                        f32x4 v = acc[ai][bj][m][n];
                        if constexpr (BASEBF) { const u32x2 bw = *(const u32x2*)(baseb + o); v = v + (f32x4){bf_lo(bw.x), bf_hi(bw.x), bf_lo(bw.y), bf_hi(bw.y)}; }
                        else v = v + *(const f32x4*)(basef + o);
                        u32x2 w; w.x = cvt_pk_bf16(v.x, v.y); w.y = cvt_pk_bf16(v.z, v.w);
                        *(u32x2*)(HB + o) = w; ss += (v.x * v.x + v.y * v.y) + (v.z * v.z + v.w * v.w); }
                ss += __shfl_xor(ss, 16); ss += __shfl_xor(ss, 32);
                if (fq == 0) (void)__hip_atomic_fetch_add((__attribute__((address_space(1))) float*)(ssq + row), ss, __ATOMIC_RELAXED, __HIP_MEMORY_SCOPE_AGENT); }
    }
};
struct EpiSwiglu {
    static constexpr bool PERM = true, AFTER_DRAIN = false;
    bf16_t* O; const float* ssq;
    __device__ __forceinline__ void operator()(const Acc& acc, const Unit& u, int wr, int wc, int fr, int fq) const {
        const int row0 = u.pm * BM + wr * 64 + fr, col0 = u.pn * HALF + wc * 32 + 8 * fq;
#pragma unroll
        for (int ai = 0; ai < 2; ++ai)
#pragma unroll
            for (int m = 0; m < 4; ++m) {
                f32x4 a0, a1; const float r = 1.0f / sqrtf(ssq[row0 + ai * HALF + m * 16] * (1.f / DM) + EPS);
#pragma unroll
                for (int j = 0; j < 4; ++j) { const float g0 = acc[ai][0][m][0][j] * r, g1 = acc[ai][0][m][1][j] * r;
                    a0[j] = g0 * sigmoidf_(g0) * (acc[ai][1][m][0][j] * r); a1[j] = g1 * sigmoidf_(g1) * (acc[ai][1][m][1][j] * r); }
                store8(O + (size_t)(row0 + ai * HALF + m * 16) * DFF + col0, a0, a1); }
    }
};

template <class Epi, class Sched, bool ALIGN_EPI, bool SP2, bool MID, bool I8 = false>
__device__ __forceinline__ void gemm_phase(LAS unsigned char* lds, const Gemm g, const Sched S, const Epi E) {
    const int tid = threadIdx.x, wid = __builtin_amdgcn_readfirstlane(tid >> 6), lane = tid & 63, wr = wid >> 2, wc = wid & 3, fr = lane & 15, fq = lane >> 4;
    const int K = g.ld, nt = g.K / BK;
    unsigned voffA[2], voffB[2];
#pragma unroll
    for (int i = 0; i < 2; ++i) { int R, C; stage_rc(tid * 16 + i * 8192, R, C); const int Rb = Epi::PERM ? ((R & ~31) + perm32(R & 31)) : R;
        voffA[i] = (unsigned)(R * K + C) * 2u; voffB[i] = (unsigned)(Rb * K + C) * 2u; }
    const size_t kstep = (size_t)(BK * 2);
    const size_t hstep = (size_t)HALF * K * 2;
    const size_t tstep = 2 * hstep;
    const unsigned ldsw = (unsigned)wid * 1024u;
    const int aoff = lds_byte(wr * 64 + fr, fq * 8), boff = lds_byte(wc * 32 + fr, fq * 8);
#define PG8_SA(b, h) (((b) * 2 + (h)) * HTB)
#define PG8_SB(b, h) ((4 + (b) * 2 + (h)) * HTB)
#define PG8_STAGE(bufoff, gbase, voff) do { _Pragma("unroll") for (int _i = 0; _i < 2; ++_i) \
        __builtin_amdgcn_global_load_lds((const unsigned*)((const char*)(gbase) + (voff)[_i]), (LAS unsigned*)(lds + (bufoff) + ldsw + _i * 8192), 16, 0, 0); } while (0)
#define PG8_LDA(dst, b, h) do { _Pragma("unroll") for (int m = 0; m < 4; ++m) _Pragma("unroll") for (int k = 0; k < 2; ++k) dst[m][k] = *(const LAS bf16x8*)(lds + PG8_SA(b, h) + aoff + m * 2048 + k * 1024); } while (0)
#define PG8_LDB(dst, b, h) do { _Pragma("unroll") for (int n = 0; n < 2; ++n) _Pragma("unroll") for (int k = 0; k < 2; ++k) dst[n][k] = *(const LAS bf16x8*)(lds + PG8_SB(b, h) + boff + n * 2048 + k * 1024); } while (0)
#define PG8_MMA(ai, bj, At, Bt) do { __builtin_amdgcn_s_setprio(1); _Pragma("unroll") for (int m = 0; m < 4; ++m) _Pragma("unroll") for (int n = 0; n < 2; ++n) _Pragma("unroll") for (int k = 0; k < 2; ++k) { \
        if constexpr (I8) acc[ai][bj][m][n] = __builtin_bit_cast(f32x4, __builtin_amdgcn_mfma_i32_16x16x64_i8(__builtin_bit_cast(v4i_t, Bt[n][k]), __builtin_bit_cast(v4i_t, At[m][k]), __builtin_bit_cast(v4i_t, acc[ai][bj][m][n]), 0, 0, 0)); \
        else acc[ai][bj][m][n] = __builtin_amdgcn_mfma_f32_16x16x32_bf16(Bt[n][k], At[m][k], acc[ai][bj][m][n], 0, 0, 0); } __builtin_amdgcn_s_setprio(0); } while (0)
#define PG8_WAIT_V(n) asm volatile("s_waitcnt vmcnt(" #n ")" ::: "memory")
#define PG8_WAIT_L(n) asm volatile("s_waitcnt lgkmcnt(" #n ")" ::: "memory")
#define PG8_BAR __builtin_amdgcn_s_barrier()
#define PG8_SCHED __builtin_amdgcn_sched_barrier(0)
    Unit cur, nxt; int ui = 0;
    if (!S.next(0, cur)) return;
    Acc acc;
#pragma unroll
    for (int a = 0; a < 2; ++a)
#pragma unroll
        for (int b = 0; b < 2; ++b)
#pragma unroll
            for (int m = 0; m < 4; ++m)
#pragma unroll
                for (int n = 0; n < 2; ++n) acc[a][b][m][n] = (f32x4){0.f, 0.f, 0.f, 0.f};
    bf16x8 At[4][2], B0[2][2], B1[2][2];
    const char* cA = (const char*)g.A + (size_t)cur.pm * tstep + (size_t)cur.kh * g.koff; const char* cB = (const char*)g.Bt + (size_t)cur.pn * tstep + (size_t)cur.kh * g.koff;
    S.a_ready(cur);
    if constexpr (SP2) {
        PG8_STAGE(PG8_SB(0, 0), cB, voffB); PG8_STAGE(PG8_SB(0, 1), cB + hstep, voffB); PG8_STAGE(PG8_SA(0, 0), cA, voffA); PG8_STAGE(PG8_SA(0, 1), cA + hstep, voffA);
        if (wr == 1) PG8_BAR;
        PG8_WAIT_V(2); PG8_BAR;
        PG8_STAGE(PG8_SB(1, 0), cB + kstep, voffB); PG8_STAGE(PG8_SA(1, 0), cA + kstep, voffA); PG8_STAGE(PG8_SB(1, 1), cB + hstep + kstep, voffB);
        PG8_WAIT_V(6); PG8_BAR;
    } else {
        PG8_STAGE(PG8_SB(0, 0), cB, voffB); PG8_STAGE(PG8_SA(0, 0), cA, voffA); PG8_STAGE(PG8_SB(0, 1), cB + hstep, voffB); PG8_STAGE(PG8_SA(0, 1), cA + hstep, voffA);
        if (wr == 1) PG8_BAR;
        PG8_WAIT_V(4); PG8_BAR;
        PG8_STAGE(PG8_SB(1, 0), cB + kstep, voffB); PG8_STAGE(PG8_SA(1, 0), cA + kstep, voffA); PG8_STAGE(PG8_SB(1, 1), cB + hstep + kstep, voffB);
        PG8_WAIT_V(6); PG8_BAR;
    }
    for (;;) {
        const bool has_next = S.next(ui + 1, nxt);
        const char* nA = has_next ? (const char*)g.A + (size_t)nxt.pm * tstep + (size_t)nxt.kh * g.koff : cA; const char* nB = has_next ? (const char*)g.Bt + (size_t)nxt.pn * tstep + (size_t)nxt.kh * g.koff : cB;
        for (int t = 0; t < nt; t += 2) {
            const bool last = (t == nt - 2);
            const char* a1 = cA + (size_t)(t + 1) * kstep;
            const char* a2 = last ? nA : cA + (size_t)(t + 2) * kstep; const char* b2 = last ? nB : cB + (size_t)(t + 2) * kstep;
            const char* a3 = a2 + kstep; const char* b3 = b2 + kstep;
            if (last && has_next) S.a_ready(nxt);
            if constexpr (SP2) {
            PG8_LDB(B0, 0, 0); PG8_LDB(B1, 0, 1); PG8_SCHED; PG8_LDA(At, 0, 0); PG8_STAGE(PG8_SA(1, 1), a1 + hstep, voffA);
            PG8_WAIT_V(8); PG8_WAIT_L(0); PG8_BAR; PG8_MMA(0, 0, At, B0); PG8_MMA(0, 1, At, B1); PG8_BAR; PG8_SCHED;
            PG8_LDA(At, 0, 1); PG8_STAGE(PG8_SB(0, 0), b2, voffB); PG8_STAGE(PG8_SB(0, 1), b2 + hstep, voffB); PG8_STAGE(PG8_SA(0, 0), a2, voffA);
            PG8_WAIT_V(8); PG8_WAIT_L(0); PG8_BAR; PG8_MMA(1, 0, At, B0); PG8_MMA(1, 1, At, B1); PG8_BAR; PG8_SCHED;
            PG8_LDB(B0, 1, 0); PG8_LDB(B1, 1, 1); PG8_SCHED; PG8_LDA(At, 1, 0); PG8_STAGE(PG8_SA(0, 1), a2 + hstep, voffA);
            PG8_WAIT_V(8); PG8_WAIT_L(0); PG8_BAR; PG8_MMA(0, 0, At, B0); PG8_MMA(0, 1, At, B1); PG8_BAR; PG8_SCHED;
            PG8_LDA(At, 1, 1); PG8_STAGE(PG8_SB(1, 0), b3, voffB); PG8_STAGE(PG8_SB(1, 1), b3 + hstep, voffB); PG8_STAGE(PG8_SA(1, 0), a3, voffA);
            PG8_WAIT_V(8); PG8_WAIT_L(0); PG8_BAR; PG8_MMA(1, 0, At, B0); PG8_MMA(1, 1, At, B1); PG8_BAR; PG8_SCHED;
            } else {
            PG8_LDB(B0, 0, 0); PG8_SCHED; PG8_LDA(At, 0, 0); PG8_STAGE(PG8_SA(1, 1), a1 + hstep, voffA);
            PG8_WAIT_L(8); PG8_BAR; PG8_WAIT_L(0); PG8_MMA(0, 0, At, B0); PG8_BAR; PG8_SCHED;
            PG8_LDB(B1, 0, 1); PG8_STAGE(PG8_SB(0, 0), b2, voffB);
            PG8_BAR; PG8_WAIT_L(0); PG8_MMA(0, 1, At, B1); PG8_BAR;
            PG8_LDA(At, 0, 1); PG8_STAGE(PG8_SA(0, 0), a2, voffA);
            PG8_BAR; PG8_WAIT_L(0); PG8_MMA(1, 0, At, B0); PG8_BAR; PG8_SCHED;
            PG8_STAGE(PG8_SB(0, 1), b2 + hstep, voffB);
            PG8_WAIT_V(6); PG8_BAR; PG8_MMA(1, 1, At, B1); PG8_BAR;
            PG8_LDB(B0, 1, 0); PG8_SCHED; PG8_LDA(At, 1, 0); PG8_STAGE(PG8_SA(0, 1), a2 + hstep, voffA);
            PG8_WAIT_L(8); PG8_BAR; PG8_WAIT_L(0); PG8_MMA(0, 0, At, B0); PG8_BAR; PG8_SCHED;
            PG8_LDB(B1, 1, 1); PG8_STAGE(PG8_SB(1, 0), b3, voffB);
            PG8_BAR; PG8_WAIT_L(0); PG8_MMA(0, 1, At, B1); PG8_BAR;
            PG8_LDA(At, 1, 1); PG8_STAGE(PG8_SA(1, 0), a3, voffA);
            PG8_BAR; PG8_WAIT_L(0); PG8_MMA(1, 0, At, B0); PG8_BAR; PG8_SCHED;
            PG8_STAGE(PG8_SB(1, 1), b3 + hstep, voffB);
            PG8_WAIT_V(6); PG8_BAR; PG8_MMA(1, 1, At, B1); PG8_BAR;
            }
        }
        if constexpr (ALIGN_EPI) { if (wr == 0) PG8_BAR; }
        { E(acc, cur, wr, wc, fr, fq); S.done(cur);
#pragma unroll
        for (int a = 0; a < 2; ++a)
#pragma unroll
            for (int b = 0; b < 2; ++b)
#pragma unroll
                for (int m = 0; m < 4; ++m)
#pragma unroll
                    for (int n = 0; n < 2; ++n) acc[a][b][m][n] = (f32x4){0.f, 0.f, 0.f, 0.f};
        }
        if (!has_next) break;
        cur = nxt; cA = nA; cB = nB; ++ui;
        if constexpr (ALIGN_EPI) { if (wr == 1) PG8_BAR; }
    }
    PG8_WAIT_V(0);
    if constexpr (!ALIGN_EPI) { if (wr == 0) PG8_BAR; }
    PG8_BAR;
#undef PG8_SA
#undef PG8_SB
#undef PG8_STAGE
#undef PG8_LDA
#undef PG8_LDB
#undef PG8_MMA
#undef PG8_WAIT_V
#undef PG8_WAIT_L
#undef PG8_BAR
#undef PG8_SCHED
}
}

namespace att {
constexpr int NW = 8, QBLK = 32, KVBLK = 64;
constexpr int SHM_V = KVBLK * 128 * 2, SHM_K = KVBLK * 128 * 2, SHM_KR = KVBLK * 64 * 2;
constexpr int OFF_V = 0, OFF_K = 2 * SHM_V, OFF_WS = OFF_K + 2 * SHM_K, OFF_KR = OFF_WS + NW * 64 * 4, OFF_QR = OFF_KR + 2 * SHM_KR, QR_WAVE = 6144, ATT_LDS = OFF_QR + NW * QR_WAVE;
constexpr float THR = 8.f;
#define KSWZ(row, colB) ((row) * 256 + ((colB) ^ (((row) & 7) << 4)))
#define KRSWZ(row, colB) ((row) * 128 + ((colB) ^ ((((row) >> 1) & 7) << 4)))
#define SBAR() __builtin_amdgcn_sched_barrier(0)
__device__ __forceinline__ int crow(int r, int hi) { return (r & 3) + 8 * (r >> 2) + 4 * hi; }

__device__ __forceinline__ void partialSM(f32x16& p0, f32x16& p1, float& m_reg, float& mn, float& alpha, const float C, const float THRS) {
  float pmax = p0[0];
#pragma unroll
  for (int r = 1; r < 16; ++r) pmax = fmaxf(pmax, p0[r]);
#pragma unroll
  for (int r = 0; r < 16; ++r) pmax = fmaxf(pmax, p1[r]);
  { auto rr = __builtin_amdgcn_permlane32_swap(__float_as_uint(pmax), __float_as_uint(pmax), false, false);
    pmax = fmaxf(__uint_as_float(rr[0]), __uint_as_float(rr[1])); }
  if (__builtin_expect(__all(pmax - m_reg <= THRS), 1)) { mn = m_reg; alpha = 1.f; }
  else { mn = fmaxf(m_reg, pmax); alpha = __builtin_amdgcn_exp2f((m_reg - mn) * C); m_reg = mn; }
  float mnC = -mn * C;
#pragma unroll
  for (int r = 0; r < 16; ++r) p0[r] = fmaf(p0[r], C, mnC);
#pragma unroll
  for (int r = 0; r < 16; ++r) p1[r] = fmaf(p1[r], C, mnC);
#pragma unroll
  for (int r = 0; r < 16; ++r) p0[r] = __builtin_amdgcn_exp2f(p0[r]);
}
__device__ __forceinline__ void finishSM(f32x16& p0, f32x16& p1, float alpha, float& l_reg, bf16x8& pa0, bf16x8& pa1, bf16x8& pa2, bf16x8& pa3) {
#pragma unroll
  for (int r = 0; r < 16; ++r) p1[r] = __builtin_amdgcn_exp2f(p1[r]);
  float ps = 0;
#pragma unroll
  for (int r = 0; r < 16; ++r) ps += p0[r];
#pragma unroll
  for (int r = 0; r < 16; ++r) ps += p1[r];
  { auto rr = __builtin_amdgcn_permlane32_swap(__float_as_uint(ps), __float_as_uint(ps), false, false);
    ps = __uint_as_float(rr[0]) + __uint_as_float(rr[1]); }
  l_reg = l_reg * alpha + ps;
#define PK4(P, BASE, OUT) do { unsigned a0 = cvt_pk_bf16(P[BASE + 0], P[BASE + 1]), a1 = cvt_pk_bf16(P[BASE + 2], P[BASE + 3]);   \
    unsigned b0 = cvt_pk_bf16(P[BASE + 4], P[BASE + 5]), b1 = cvt_pk_bf16(P[BASE + 6], P[BASE + 7]);                              \
    auto r0 = __builtin_amdgcn_permlane32_swap(a0, b0, false, false); auto r1 = __builtin_amdgcn_permlane32_swap(a1, b1, false, false); \
    u32x4 w = {r0[0], r1[0], r0[1], r1[1]}; OUT = *reinterpret_cast<bf16x8*>(&w); } while (0)
  PK4(p0, 0, pa0); PK4(p0, 8, pa1); PK4(p1, 0, pa2); PK4(p1, 8, pa3);
#undef PK4
}
template <int DK, int NQR>
__device__ __forceinline__ void qkt(f32x16& p0, f32x16& p1, const char* Ks, const char* Krs, const bf16x8* qr, const char* qrl, int r32, int hi) {
  p0 = f32x16{}; p1 = f32x16{};
#pragma unroll
  for (int d0 = 0; d0 < 8; ++d0) { int cb = (d0 * 16 + hi * 8) * 2;
    bf16x8 b0 = *reinterpret_cast<const bf16x8*>(Ks + KSWZ(r32, cb));
    bf16x8 b1 = *reinterpret_cast<const bf16x8*>(Ks + KSWZ(32 + r32, cb));
    bf16x8 qv; if (d0 < NQR) qv = qr[d0 < NQR ? d0 : 0]; else qv = *reinterpret_cast<const bf16x8*>(qrl + (d0 - NQR) * 1024);
    p0 = __builtin_amdgcn_mfma_f32_32x32x16_bf16(b0, qv, p0, 0, 0, 0);
    p1 = __builtin_amdgcn_mfma_f32_32x32x16_bf16(b1, qv, p1, 0, 0, 0); }
  if constexpr (DK == 192) {
#pragma unroll
    for (int d0 = 0; d0 < 4; ++d0) { int cb = (d0 * 16 + hi * 8) * 2;
      bf16x8 b0 = *reinterpret_cast<const bf16x8*>(Krs + KRSWZ(r32, cb));
      bf16x8 b1 = *reinterpret_cast<const bf16x8*>(Krs + KRSWZ(32 + r32, cb));
      const bf16x8 qv = *reinterpret_cast<const bf16x8*>(qrl + (8 - NQR + d0) * 1024);
      p0 = __builtin_amdgcn_mfma_f32_32x32x16_bf16(b0, qv, p0, 0, 0, 0);
      p1 = __builtin_amdgcn_mfma_f32_32x32x16_bf16(b1, qv, p1, 0, 0, 0); }
  }
}
__device__ __forceinline__ int v_st(int k, int c) { const int kk = (k & ~0xC) | ((k & 4) << 1) | ((k & 8) >> 1); return ((kk >> 3) * 4 + (c >> 5)) * 512 + ((kk & 7) * 32 + (c & 31)) * 2; }
__device__ __forceinline__ int v_rd_base(int lane) { return ((lane & 3) << 3) | (((lane >> 2) & 3) << 6) | (((lane >> 4) & 1) << 5) | (((lane >> 5) & 1) << 8); }
constexpr int v_rd_off(int d0, int ks, int half) { return d0 * 512 + ks * 4096 + half * 2048; }
template <int OFF> __device__ __forceinline__ s16x4 tr_read(int vb) {
  s16x4 r; asm volatile("ds_read_b64_tr_b16 %0, %1 offset:%2" : "=&v"(r) : "v"(vb), "i"(OFF) : "memory"); return r;
}
template <int D0> __device__ __forceinline__ void pv_one(f32x16& od, int vb, bf16x8 pa0, bf16x8 pa1, bf16x8 pa2, bf16x8 pa3) {
  const s16x4 l0 = tr_read<v_rd_off(D0, 0, 0)>(vb), h0 = tr_read<v_rd_off(D0, 0, 1)>(vb), l1 = tr_read<v_rd_off(D0, 1, 0)>(vb), h1 = tr_read<v_rd_off(D0, 1, 1)>(vb);
  const s16x4 l2 = tr_read<v_rd_off(D0, 2, 0)>(vb), h2 = tr_read<v_rd_off(D0, 2, 1)>(vb), l3 = tr_read<v_rd_off(D0, 3, 0)>(vb), h3 = tr_read<v_rd_off(D0, 3, 1)>(vb);
  asm volatile("s_waitcnt lgkmcnt(0)" ::: "memory"); SBAR();
#define PK(L, H) (bf16x8){L[0], L[1], L[2], L[3], H[0], H[1], H[2], H[3]}
  od = __builtin_amdgcn_mfma_f32_32x32x16_bf16(pa0, PK(l0, h0), od, 0, 0, 0);
  od = __builtin_amdgcn_mfma_f32_32x32x16_bf16(pa1, PK(l1, h1), od, 0, 0, 0);
  od = __builtin_amdgcn_mfma_f32_32x32x16_bf16(pa2, PK(l2, h2), od, 0, 0, 0);
  od = __builtin_amdgcn_mfma_f32_32x32x16_bf16(pa3, PK(l3, h3), od, 0, 0, 0);
#undef PK
}
__device__ __forceinline__ void pv_d0(f32x16* o, int vb, bf16x8 pa0, bf16x8 pa1, bf16x8 pa2, bf16x8 pa3) {
  pv_one<0>(o[0], vb, pa0, pa1, pa2, pa3); pv_one<1>(o[1], vb, pa0, pa1, pa2, pa3); pv_one<2>(o[2], vb, pa0, pa1, pa2, pa3); pv_one<3>(o[3], vb, pa0, pa1, pa2, pa3);
}

template <int DK, int SDEPTH, int ldq, int ldk, int ldv, int ldo, int seq>
__device__ __forceinline__ void attn_unit(const bf16_t* __restrict__ Qb, const bf16_t* __restrict__ Kh, const bf16_t* __restrict__ Krp,
                                          const bf16_t* __restrict__ Vh, bf16_t* __restrict__ Ob, char* lds) {
  constexpr float SCALE = (DK == 128) ? 0.088388347648318440f : 0.072168783648703220f;
  constexpr float C = SCALE * 1.4426950408889634f, THRS = THR / SCALE;
  constexpr int ND = DK / 16, NQR = (DK == 128) ? 8 : 6;
  const int tid = threadIdx.x, wid = tid >> 6, lane = tid & 63, r32 = lane & 31, hi = lane >> 5;
  char* V_lds = lds + OFF_V; char* K_lds = lds + OFF_K; char* KR_lds = lds + OFF_KR;
  float* ws = (float*)(lds + OFF_WS) + wid * 64; float* li_l = ws; float* al_l = ws + 32;
  float m_reg = -1e30f, l_reg = 0; f32x16 o[4] = {}; bf16x8 qr[NQR];
  const bf16_t* Qw = Qb + (long)(wid * QBLK + r32) * ldq + hi * 8;
#pragma unroll
  for (int d0 = 0; d0 < NQR; ++d0) qr[d0] = *reinterpret_cast<const bf16x8*>(Qw + d0 * 16);
  char* qrl = lds + OFF_QR + wid * QR_WAVE + lane * 16;
#pragma unroll
  for (int d0 = NQR; d0 < ND; ++d0) *reinterpret_cast<bf16x8*>(qrl + (d0 - NQR) * 1024) = *reinterpret_cast<const bf16x8*>(Qw + d0 * 16);
  const int sr = tid >> 4, sc = (tid & 15) * 8, vst0 = v_st(sr, sc), vst1 = v_st(32 + sr, sc);
  const int krr = tid >> 3, krc = (tid & 7) * 8;
  const int vb0 = (int)(uintptr_t)V_lds + v_rd_base(lane);
  bf16x8 vs0[SDEPTH], vs1[SDEPTH], ks0[SDEPTH], ks1[SDEPTH], kr0[SDEPTH];
  const unsigned voffV = (unsigned)((sr * ldv + sc) * 2), voffK = (unsigned)((sr * ldk + sc) * 2), voffR = (unsigned)((krr * 64 + krc) * 2);
#define SLOAD(i, k0) do { const char* vb_ = (const char*)Vh + (size_t)(k0) * (ldv * 2); const char* kb_ = (const char*)Kh + (size_t)(k0) * (ldk * 2); \
    vs0[i] = *(const bf16x8*)(vb_ + voffV); vs1[i] = *(const bf16x8*)(vb_ + 32 * ldv * 2 + voffV); \
    ks0[i] = *(const bf16x8*)(kb_ + voffK); ks1[i] = *(const bf16x8*)(kb_ + 32 * ldk * 2 + voffK); \
    if constexpr (DK == 192) kr0[i] = *(const bf16x8*)((const char*)Krp + (size_t)(k0) * 128 + voffR); } while (0)
#define SWRITE(b, i) do { *(bf16x8*)(V_lds + (b) * SHM_V + vst0) = vs0[i];          \
    *(bf16x8*)(V_lds + (b) * SHM_V + vst1) = vs1[i]; int kc = sc * 2;               \
    *(bf16x8*)(K_lds + (b) * SHM_K + KSWZ(sr, kc)) = ks0[i];                       \
    *(bf16x8*)(K_lds + (b) * SHM_K + KSWZ(32 + sr, kc)) = ks1[i];                  \
    if constexpr (DK == 192) *(bf16x8*)(KR_lds + (b) * SHM_KR + KRSWZ(krr, krc * 2)) = kr0[i]; } while (0)
#define SWAIT() do { if constexpr (SDEPTH == 1) asm volatile("s_waitcnt vmcnt(0)" ::: "memory"); else if constexpr (DK == 192) asm volatile("s_waitcnt vmcnt(5)" ::: "memory"); else asm volatile("s_waitcnt vmcnt(4)" ::: "memory"); } while (0)
#define RESC(a) do { if (__any((a) < 1.f)) { if (hi == 0) al_l[r32] = (a); asm volatile("s_waitcnt lgkmcnt(0)" ::: "memory"); \
    _Pragma("unroll") for (int d = 0; d < 4; ++d) _Pragma("unroll") for (int r = 0; r < 16; ++r) o[d][r] *= al_l[crow(r, hi)]; } } while (0)
  f32x16 pA0, pA1, pB0, pB1; float mnA, mnB, alA, alB; bf16x8 pa0, pa1, pa2, pa3; const int NT = seq / KVBLK;
  constexpr int SE = 0, SO = SDEPTH - 1;
  SLOAD(SE, 0); asm volatile("s_waitcnt vmcnt(0)" ::: "memory"); SWRITE(0, SE); __syncthreads();
  qkt<DK, NQR>(pA0, pA1, K_lds, KR_lds, qr, qrl, r32, hi); partialSM(pA0, pA1, m_reg, mnA, alA, C, THRS);
  SLOAD(SO, KVBLK); if constexpr (SDEPTH == 2) { if (2 < NT) SLOAD(SE, 2 * KVBLK); }
  SWAIT(); SWRITE(1, SO); __syncthreads();
  for (int j = 1; j + 1 < NT; j += 2) {
    SBAR(); qkt<DK, NQR>(pB0, pB1, K_lds + SHM_K, KR_lds + SHM_KR, qr, qrl, r32, hi);
    finishSM(pA0, pA1, alA, l_reg, pa0, pa1, pa2, pa3); SBAR();
    SLOAD(SO, (j + SDEPTH) * KVBLK); SBAR();
    pv_d0(o, vb0, pa0, pa1, pa2, pa3); partialSM(pB0, pB1, m_reg, mnB, alB, C, THRS);
    __syncthreads(); SWAIT(); SWRITE(0, SE);
    RESC(alB); __syncthreads();
    SBAR(); qkt<DK, NQR>(pA0, pA1, K_lds, KR_lds, qr, qrl, r32, hi);
    finishSM(pB0, pB1, alB, l_reg, pa0, pa1, pa2, pa3); SBAR();
    if (SDEPTH == 1 || j + 3 < NT) SLOAD(SE, (j + 1 + SDEPTH) * KVBLK); SBAR();
    pv_d0(o, vb0 + SHM_V, pa0, pa1, pa2, pa3); partialSM(pA0, pA1, m_reg, mnA, alA, C, THRS);
    __syncthreads(); SWAIT(); SWRITE(1, SO);
    RESC(alA); __syncthreads();
  }
  SBAR(); qkt<DK, NQR>(pB0, pB1, K_lds + SHM_K, KR_lds + SHM_KR, qr, qrl, r32, hi);
  finishSM(pA0, pA1, alA, l_reg, pa0, pa1, pa2, pa3); SBAR();
  pv_d0(o, vb0, pa0, pa1, pa2, pa3); partialSM(pB0, pB1, m_reg, mnB, alB, C, THRS);
  __syncthreads(); RESC(alB);
  finishSM(pB0, pB1, alB, l_reg, pa0, pa1, pa2, pa3); SBAR();
  pv_d0(o, vb0 + SHM_V, pa0, pa1, pa2, pa3);
  if (hi == 0) li_l[r32] = l_reg; asm volatile("s_waitcnt lgkmcnt(0)" ::: "memory");
  float rli[16];
#pragma unroll
  for (int r = 0; r < 16; ++r) rli[r] = __builtin_amdgcn_rcpf(li_l[crow(r, hi)]);
  bf16_t* Ow = Ob + (long)(wid * QBLK) * ldo;
#pragma unroll
  for (int r = 0; r < 16; ++r) { int orow = crow(r, hi);
#pragma unroll
    for (int d0 = 0; d0 < 4; ++d0) Ow[(long)orow * ldo + d0 * 32 + r32] = f2bf(o[d0][r] * rli[r]); }
#undef SLOAD
#undef SWRITE
#undef SWAIT
#undef RESC
}
}

struct TrItem { const float* W; bf16_t* WT; int ldw, k0, n0, ldt, drow0, dk0; const float* gain; };
__device__ __forceinline__ void tr_load(f32x4 (&v)[16], const TrItem& t, int lane) {
    const int lr = lane >> 4, lc = (lane & 15) * 4;
#pragma unroll
    for (int i = 0; i < 16; ++i) v[i] = *(const f32x4*)(t.W + (size_t)(t.k0 + 4 * i + lr) * t.ldw + t.n0 + lc);
}
__device__ __forceinline__ void tr_store(const f32x4 (&v)[16], const TrItem& t, LAS float* scr, int lane) {
    const int lr = lane >> 4, lc = (lane & 15) * 4;
#pragma unroll
    for (int i = 0; i < 16; ++i) { LAS float* d = scr + (4 * i + lr) * 65 + lc; const float gk = t.gain ? t.gain[t.k0 + 4 * i + lr] : 1.f;
        d[0] = v[i].x * gk; d[1] = v[i].y * gk; d[2] = v[i].z * gk; d[3] = v[i].w * gk; }
    asm volatile("s_waitcnt lgkmcnt(0)" ::: "memory");
    const int c = lane & 7;
#pragma unroll
    for (int j = 0; j < 8; ++j) { const int n = (lane >> 3) + 8 * j; const LAS float* s = scr + (8 * c) * 65 + n;
        u32x4 o; o.x = cvt_pk_bf16(s[0], s[65]); o.y = cvt_pk_bf16(s[130], s[195]); o.z = cvt_pk_bf16(s[260], s[325]); o.w = cvt_pk_bf16(s[390], s[455]);
        *(u32x4*)(t.WT + (size_t)(t.drow0 + n) * t.ldt + t.dk0 + 8 * c) = o; }
    asm volatile("s_waitcnt lgkmcnt(0)" ::: "memory");
}
__device__ __forceinline__ void tr_item(const float* __restrict__ W, int ldw, int k0, int n0, bf16_t* __restrict__ WT, int ldt, int drow0, int dk0, LAS float* scr, int lane) {
    TrItem t{W, WT, ldw, k0, n0, ldt, drow0, dk0, nullptr}; f32x4 v[16]; tr_load(v, t, lane); tr_store(v, t, scr, lane);
}
__device__ __forceinline__ void rms_row_to_bf16(const float* __restrict__ xrow, const float* __restrict__ g, bf16_t* __restrict__ orow, int lane) {
    f32x4 v[8]; float s = 0.f;
#pragma unroll
    for (int j = 0; j < 8; ++j) { v[j] = *(const f32x4*)(xrow + 4 * lane + 256 * j); s += (v[j].x * v[j].x + v[j].y * v[j].y) + (v[j].z * v[j].z + v[j].w * v[j].w); }
    const float r = 1.0f / sqrtf(wave_sum(s) * (1.f / DM) + EPS);
#pragma unroll
    for (int j = 0; j < 8; ++j) { const f32x4 gg = *(const f32x4*)(g + 4 * lane + 256 * j);
        u32x2 o; o.x = cvt_pk_bf16(v[j].x * r * gg.x, v[j].y * r * gg.y); o.y = cvt_pk_bf16(v[j].z * r * gg.z, v[j].w * r * gg.w);
        *(u32x2*)(orow + 4 * lane + 256 * j) = o; }
}

__device__ __forceinline__ unsigned q8(float v) { int q = (int)__builtin_rintf(v); q = q < -127 ? -127 : (q > 127 ? 127 : q); return (unsigned)q & 0xffu; }
__device__ __forceinline__ unsigned q8x4(float a, float b, float c, float d) { return q8(a) | (q8(b) << 8) | (q8(c) << 16) | (q8(d) << 24); }
__device__ __forceinline__ void tr_item8(const float* __restrict__ W, int ldw, int k0, int n0, unsigned char* __restrict__ WT8, int ldt, int drow0, int dk0, LAS float* scr, int lane) {
    const int lr = lane >> 4, lc = (lane & 15) * 4;
    f32x4 v[16];
#pragma unroll
    for (int i = 0; i < 16; ++i) v[i] = *(const f32x4*)(W + (size_t)(k0 + 4 * i + lr) * ldw + n0 + lc);
#pragma unroll
    for (int i = 0; i < 16; ++i) { LAS float* d = scr + (4 * i + lr) * 65 + lc; d[0] = v[i].x * Q8_SW; d[1] = v[i].y * Q8_SW; d[2] = v[i].z * Q8_SW; d[3] = v[i].w * Q8_SW; }
    asm volatile("s_waitcnt lgkmcnt(0)" ::: "memory");
    const int c = lane & 7;
#pragma unroll
    for (int j = 0; j < 8; ++j) { const int n = (lane >> 3) + 8 * j; const LAS float* s = scr + (8 * c) * 65 + n;
        u32x2 o; o.x = q8x4(s[0], s[65], s[130], s[195]); o.y = q8x4(s[260], s[325], s[390], s[455]);
        *(u32x2*)(WT8 + (size_t)(drow0 + n) * ldt + dk0 + 8 * c) = o; }
    asm volatile("s_waitcnt lgkmcnt(0)" ::: "memory");
}
__device__ __forceinline__ void rms_row_to_i8(const float* __restrict__ xrow, const float* __restrict__ g, unsigned char* __restrict__ orow, int lane) {
    f32x4 v[8]; float s = 0.f;
#pragma unroll
    for (int j = 0; j < 8; ++j) { v[j] = *(const f32x4*)(xrow + 4 * lane + 256 * j); s += (v[j].x * v[j].x + v[j].y * v[j].y) + (v[j].z * v[j].z + v[j].w * v[j].w); }
    const float r = Q8_SU / sqrtf(wave_sum(s) * (1.f / DM) + EPS);
#pragma unroll
    for (int j = 0; j < 8; ++j) { const f32x4 gg = *(const f32x4*)(g + 4 * lane + 256 * j);
        *(unsigned*)(orow + 4 * lane + 256 * j) = q8x4(v[j].x * r * gg.x, v[j].y * r * gg.y, v[j].z * r * gg.z, v[j].w * r * gg.w); }
}

#define XB_TMO      128
#define XB_XCNT(j)  (256  + 64 * (j))
#define XB_XSUB(j)  (1280 + 64 * (j))
#define XB_XGEN(j)  (2304 + 64 * (j))
#define XB_TOP      3328
#define XB_TOPGEN   3392
#define XCD_BAR_WORDS 3456
#define XB_SPIN_CAP (1u << 18)
__device__ __forceinline__ unsigned xb_ld(unsigned* p)              { return __hip_atomic_load(p, __ATOMIC_RELAXED, __HIP_MEMORY_SCOPE_AGENT); }
__device__ __forceinline__ unsigned xb_add(unsigned* p, unsigned v) { return __hip_atomic_fetch_add(p, v, __ATOMIC_RELAXED, __HIP_MEMORY_SCOPE_AGENT); }
__device__ __forceinline__ unsigned xb_xcc_id() { return (unsigned)__builtin_amdgcn_s_getreg((3 << 11) | 20) & 0xFu; }
#define XB_SPIN(cond, bar) do { unsigned _sp = 0; while (cond) { __builtin_amdgcn_s_sleep(1); \
    if ((++_sp & 255u) == 0u) { if (xb_ld(&(bar)[XB_TMO])) break; if (_sp > XB_SPIN_CAP) { atomicAdd(&(bar)[XB_TMO], 1u); break; } } } } while (0)
struct XcdBarrier { unsigned* bar; unsigned x; volatile LAS unsigned* st; };
__device__ __forceinline__ XcdBarrier xcd_barrier_post(unsigned* bar, volatile LAS unsigned* st) {
    XcdBarrier b; b.bar = bar; b.x = xb_xcc_id(); b.st = st;
    if (threadIdx.x == 0) (void)xb_add(&bar[XB_XCNT(b.x)], 1u);
    return b;
}
__device__ __forceinline__ void xcd_barrier_complete(unsigned* bar, unsigned x, unsigned& nloc, unsigned& nx) {
    const unsigned G = gridDim.x * gridDim.y * gridDim.z;
    unsigned sum, cnt, mine, sp = 0u;
    for (;;) {
        sum = 0u; cnt = 0u; mine = 0u;
#pragma unroll
        for (unsigned j = 0; j < 16; ++j) { const unsigned c = xb_ld(&bar[XB_XCNT(j)]); sum += c; cnt += (c > 0u) ? 1u : 0u; mine = (j == x) ? c : mine; }
        if (sum == G) break;
        __builtin_amdgcn_s_sleep(1);
        if ((++sp & 255u) == 0u) { if (xb_ld(&bar[XB_TMO])) break; if (sp > XB_SPIN_CAP) { atomicAdd(&bar[XB_TMO], 1u); break; } }
    }
    nloc = mine > 0u ? mine : 1u; nx = cnt > 0u ? cnt : 1u;
}
__device__ __forceinline__ void xcd_barrier(const XcdBarrier& b) {
    asm volatile("s_waitcnt vmcnt(0)" ::: "memory");
    __syncthreads();
    if (threadIdx.x == 0) {
        unsigned* bar = b.bar;
        __builtin_amdgcn_s_waitcnt(0);
        unsigned nloc = b.st[0], nx = b.st[1];
        if (nloc == 0u) { xcd_barrier_complete(bar, b.x, nloc, nx); b.st[0] = nloc; b.st[1] = nx; }
        const unsigned old = xb_add(&bar[XB_XSUB(b.x)], 1u);
        const unsigned gen = old / nloc;
        if (old + 1u == (gen + 1u) * nloc) {
            __builtin_amdgcn_fence(__ATOMIC_RELEASE, "agent");
            asm volatile("s_waitcnt vmcnt(0)" ::: "memory");
            const unsigned og = xb_add(&bar[XB_TOP], 1u);
            const unsigned tg = og / nx;
            if (og + 1u == (tg + 1u) * nx) xb_add(&bar[XB_TOPGEN], 1u);
            else XB_SPIN(xb_ld(&bar[XB_TOPGEN]) == tg, bar);
            __builtin_amdgcn_fence(__ATOMIC_ACQUIRE, "agent");
            xb_add(&bar[XB_XGEN(b.x)], 1u);
            asm volatile("s_waitcnt vmcnt(0)" ::: "memory");
        } else {
            XB_SPIN(xb_ld(&bar[XB_XGEN(b.x)]) == gen, bar);
            __builtin_amdgcn_fence(__ATOMIC_ACQUIRE, "agent");
            asm volatile("s_waitcnt vmcnt(0)" ::: "memory");
        }
    }
    __syncthreads();
}

struct Args {
    const float *x, *p, *g_mix, *w_in, *q_norm_a, *k_norm_a, *q_a_norm, *w_q_b, *kv_a_norm, *w_kv_b, *w_a_out, *w_b_out, *w_o, *g_ffn, *w_gate_up, *w_down, *g_ple,
                *w_ple_gate, *w_ple_proj, *g_ple_post, *g_final;
    float* out; unsigned char* ws; int ph_lo, ph_hi;
};

constexpr int NPHASE = 14;

__global__ void __launch_bounds__(NTHREADS, 2) mk_fwd(Args a) {
    extern __shared__ __attribute__((aligned(16))) unsigned char lds_raw[];
    LAS unsigned char* lds = (LAS unsigned char*)lds_raw;
    const int tid = threadIdx.x, lane = tid & 63, wave = __builtin_amdgcn_readfirstlane(tid >> 6);
    const int G = gridDim.x, bx = blockIdx.x;
    const int gw = bx * NWAVES + wave, NGW = G * NWAVES;
    unsigned char* ws = a.ws;
    bf16_t* WinT = (bf16_t*)(ws + WS_WIN); bf16_t* WqbT = (bf16_t*)(ws + WS_WQB); bf16_t* WkvbT = (bf16_t*)(ws + WS_WKVB); bf16_t* WabT = (bf16_t*)(ws + WS_WAB);
    bf16_t* WoT = (bf16_t*)(ws + WS_WO); bf16_t* WguT = (bf16_t*)(ws + WS_WGU); bf16_t* WdT = (bf16_t*)(ws + WS_WD); bf16_t* WpgT = (bf16_t*)(ws + WS_WPG);
    bf16_t* WppT = (bf16_t*)(ws + WS_WPP); bf16_t* PB = (bf16_t*)(ws + WS_PB); bf16_t* KR = (bf16_t*)(ws + WS_KR); bf16_t* U = (bf16_t*)(ws + WS_U);
    bf16_t* ZS = (bf16_t*)(ws + WS_ZS); bf16_t* SG = (bf16_t*)(ws + WS_SG); bf16_t* QA = (bf16_t*)(ws + WS_QA); bf16_t* QB = (bf16_t*)(ws + WS_QB);
    bf16_t* KVB = (bf16_t*)(ws + WS_KVB); bf16_t* CQN = (bf16_t*)(ws + WS_CQN); bf16_t* CKVN = (bf16_t*)(ws + WS_CKVN); bf16_t* KA = (bf16_t*)(ws + WS_KA);
    bf16_t* KPE = (bf16_t*)(ws + WS_KPE); bf16_t* OAB = (bf16_t*)(ws + WS_OAB); bf16_t* MERGED = (bf16_t*)(ws + WS_MERGED); bf16_t* ACT = (bf16_t*)(ws + WS_ACT);
    bf16_t* GATE = (bf16_t*)(ws + WS_GATE); bf16_t* ERAW = (bf16_t*)(ws + WS_ERAW); float* H = a.out;
    float* SSQ1 = (float*)(ws + 65536); float* SSQ2 = (float*)(ws + 131072);
    const int lo = a.ph_lo, hi = a.ph_hi;
#define IN(k) (lo <= (k) && (k) < hi)
#define SEAM(k) do { if (IN(k) && IN((k) + 1)) { xcd_barrier(xbar); } } while (0)
    volatile LAS unsigned* xst = (volatile LAS unsigned*)(lds + LDS_BYTES - 64);
    if (tid == 0) { xst[0] = 0u; xst[1] = 0u; }
    __syncthreads();
    XcdBarrier xbar = xcd_barrier_post((unsigned*)ws, xst);
    if (a.ph_lo < 0) cg::this_grid().sync();

    constexpr int I0 = 32 * 105, I1 = 8 * 24, I2 = 8 * 32, I3 = 16 * 32, I4 = 16 * 32, I5 = 32 * 32, I6 = 32 * 176, I7 = 88 * 32, I8 = 32 * 32, I9 = 4 * 32;
    constexpr int NREST = I1 + I2 + I3 + I4 + I5 + I6 + I7 + I8 + I9;
    if (IN(0)) {
        LAS float* scr = (LAS float*)(lds + wave * 16640);
        for (int it = gw; it < I0; it += NGW) {
            const int kb = it / 105, nb = it % 105, n0 = nb * 64; const int dr = n0 < 2560 ? n0 : (n0 < 2624 ? 6656 + (n0 - 2560) : n0 - 64);
            tr_item8(a.w_in, NIN, kb * 64, n0, (unsigned char*)WinT, 2048, dr, kb * 64, scr, lane);
        }
        for (int m = gw; m < M; m += NGW) {
            rms_row_to_i8(a.x + (size_t)m * DM, a.g_mix, (unsigned char*)U + (size_t)m * DM, lane);
            const f32x4 pv = *(const f32x4*)(a.p + (size_t)m * PLE + 4 * lane);
            u32x2 o; o.x = cvt_pk_bf16(pv.x, pv.y); o.y = cvt_pk_bf16(pv.z, pv.w);
            *(u32x2*)(PB + (size_t)m * PLE + 4 * lane) = o;
        }
        for (int i = bx * NTHREADS + tid; i < (NINP - NIN) * 2048 / 16; i += G * NTHREADS) *(u32x4*)((unsigned char*)WinT + (size_t)NIN * 2048 + (size_t)i * 16) = (u32x4){0u, 0u, 0u, 0u};
        __syncthreads();
    }
    SEAM(0);
    if (IN(1)) {
        constexpr int NU = (M / 256) * (NINP / 256);
        const int GG = (G >= 256) ? 173 : G;
        if (bx < GG) {
            pg8::Gemm g{U, WinT, M, NINP, DM / 2, DM / 2, 0}; pg8::StaticOrder S; S.init(M, NINP, GG, bx);
            pg8::EpiIn E{ZS, SG, KR};
            pg8::gemm_phase<pg8::EpiIn, pg8::StaticOrder, true, true, false, true>(lds, g, S, E);
        }
        {
            {
                LAS float* scr = (LAS float*)(lds + wave * 16640);
                unsigned* qctr = (unsigned*)(ws + 262144);
                auto decode = [&](int r) -> TrItem {
                    if (r < I1) { const int kb = r / 24, nb = r % 24; return TrItem{a.w_q_b, WqbT, 1536, kb * 64, nb * 64, 512, nb * 64, kb * 64, nullptr}; } r -= I1;
                    if (r < I2) { const int kb = r / 32, nb = r % 32; return TrItem{a.w_kv_b, WkvbT, 2048, kb * 64, nb * 64, 512, nb * 64, kb * 64, nullptr}; } r -= I2;
                    if (r < I3) { const int kb = r / 32, nb = r % 32; return TrItem{a.w_a_out, WabT, 2048, kb * 64, nb * 64, 2048, nb * 64, kb * 64, nullptr}; } r -= I3;
                    if (r < I4) { const int kb = r / 32, nb = r % 32; return TrItem{a.w_b_out, WabT, 2048, kb * 64, nb * 64, 2048, nb * 64, 1024 + kb * 64, nullptr}; } r -= I4;
                    if (r < I5) { const int kb = r / 32, nb = r % 32; return TrItem{a.w_o, WoT, 2048, kb * 64, nb * 64, 2048, nb * 64, kb * 64, nullptr}; } r -= I5;
                    if (r < I6) { const int kb = r / 176, nb = r % 176, n0 = nb * 64; const int s_ = n0 >= DFF ? 1 : 0, j = n0 - s_ * DFF; const int dr = 256 * (j >> 7) + 128 * s_ + (j & 127);
                        return TrItem{a.w_gate_up, WguT, 2 * DFF, kb * 64, n0, 2048, dr, kb * 64, a.g_ffn}; } r -= I6;
                    if (r < I7) { const int kb = r / 32, nb = r % 32; return TrItem{a.w_down, WdT, 2048, kb * 64, nb * 64, DFF, nb * 64, kb * 64, nullptr}; } r -= I7;
                    if (r < I8) { const int kb = r / 32, nb = r % 32; return TrItem{a.w_ple_gate, WpgT, 2048, kb * 64, nb * 64, 2048, nb * 64, kb * 64, a.g_ple}; } r -= I8;
                    { const int kb = r / 32, nb = r % 32; return TrItem{a.w_ple_proj, WppT, 2048, kb * 64, nb * 64, 256, nb * 64, kb * 64, nullptr}; }
                };
                auto grab = [&]() -> int { unsigned v = 0u; if (lane == 0) v = __hip_atomic_fetch_add((__attribute__((address_space(1))) unsigned*)qctr, 1u, __ATOMIC_RELAXED, __HIP_MEMORY_SCOPE_AGENT); return (int)__builtin_amdgcn_readfirstlane(v); };
                f32x4 va[16], vb[16]; TrItem ta{}, tb{};
                int it = grab();
                if (it < NREST) { ta = decode(it); tr_load(va, ta, lane); }
                while (it < NREST) {
                    int it2 = grab(); if (it2 < NREST) { tb = decode(it2); tr_load(vb, tb, lane); }
                    tr_store(va, ta, scr, lane);
                    it = it2; if (it >= NREST) break;
                    it2 = grab(); if (it2 < NREST) { ta = decode(it2); tr_load(va, ta, lane); }
                    tr_store(vb, tb, scr, lane);
                    it = it2;
                }
            }
            __syncthreads();
        }
        (void)NU;
    }
    SEAM(1);
    if (IN(2)) {
        const int l5 = lane & 31, hsel = lane >> 5, d0 = l5 * 4, isx2 = (l5 >> 3) & 1, halfc = (l5 >> 4) & 1;
        float invA4[4]; f32x4 gq, gk;
#pragma unroll
        for (int i = 0; i < 4; ++i) invA4[i] = powf(10000.f, -(float)(2 * ((d0 & 31) + i)) / 64.f);
        gq = *(const f32x4*)(a.q_norm_a + d0); gk = *(const f32x4*)(a.k_norm_a + d0);
        const int hfb = (lane >> 4) & 1, jb = lane & 15;
        const float invB = powf(10000.f, -(float)(2 * jb) / 32.f);
        for (int m = gw; m < M; m += NGW) {
            const int s = m & (SEQ - 1); const float prow = (float)(s >> 6), pcol = (float)(s & 63);
            const float posA = halfc ? pcol : prow; float cA[4], sA[4];
#pragma unroll
            for (int i = 0; i < 4; ++i) { const float ang = posA * invA4[i]; cA[i] = cosf(ang); sA[i] = sinf(ang); }
            const bf16_t* zr = ZS + (size_t)m * 2560;
#pragma unroll
            for (int it = 0; it < 5; ++it) {
                const int head = 2 * it + hsel;
                const u32x2 w = *(const u32x2*)(zr + head * 128 + d0);
                const float x[4] = {bf_lo(w.x), bf_hi(w.x), bf_lo(w.y), bf_hi(w.y)};
                float ss = (x[0] * x[0] + x[1] * x[1]) + (x[2] * x[2] + x[3] * x[3]);
#pragma unroll
                for (int o2 = 1; o2 < 32; o2 <<= 1) ss += __shfl_xor(ss, o2);
                const float r = 1.0f / sqrtf(ss * (1.f / 128.f) + EPS);
                const f32x4 g = (it < 4) ? gq : gk; float o[4];
#pragma unroll
                for (int i = 0; i < 4; ++i) { const float y = x[i] * r * g[i]; const float p = __shfl_xor(y, 8);
                    o[i] = isx2 ? (y * cA[i] + p * sA[i]) : (y * cA[i] - p * sA[i]); }
                u32x2 ow; ow.x = cvt_pk_bf16(o[0], o[1]); ow.y = cvt_pk_bf16(o[2], o[3]);
                bf16_t* dst = (it < 4) ? (QA + (size_t)m * 1024 + head * 128 + d0) : (KA + (size_t)m * 256 + (head - 8) * 128 + d0);
                *(u32x2*)dst = ow;
            }
#pragma unroll
            for (int t = 0; t < 2; ++t) {
                const u32x4 w = *(const u32x4*)(zr + 1536 + t * 512 + lane * 8);
                float v[8] = {bf_lo(w.x), bf_hi(w.x), bf_lo(w.y), bf_hi(w.y), bf_lo(w.z), bf_hi(w.z), bf_lo(w.w), bf_hi(w.w)};
                float ss = 0.f;
#pragma unroll
                for (int i = 0; i < 8; ++i) ss += v[i] * v[i];
                const float r = 1.0f / sqrtf(wave_sum(ss) * (1.f / 512.f) + EPS);
                const float* gg = (t == 0 ? a.q_a_norm : a.kv_a_norm) + lane * 8;
                const f32x4 g0 = *(const f32x4*)gg, g1 = *(const f32x4*)(gg + 4);
                u32x4 o; o.x = cvt_pk_bf16(v[0] * r * g0.x, v[1] * r * g0.y); o.y = cvt_pk_bf16(v[2] * r * g0.z, v[3] * r * g0.w);
                o.z = cvt_pk_bf16(v[4] * r * g1.x, v[5] * r * g1.y); o.w = cvt_pk_bf16(v[6] * r * g1.z, v[7] * r * g1.w);
                *(u32x4*)((t == 0 ? CQN : CKVN) + (size_t)m * 512 + lane * 8) = o;
            }
            if (lane < 32) {
                const float angB = (hfb ? pcol : prow) * invB; const float cB = cosf(angB), sB = sinf(angB);
                const bf16_t* kr = KR + (size_t)m * 64 + hfb * 32 + jb;
                const float x1 = bf1(kr[0]), x2 = bf1(kr[16]);
                bf16_t* dst = KPE + (size_t)m * 64 + hfb * 32 + jb;
                dst[0] = f2bf(x1 * cB - x2 * sB); dst[16] = f2bf(x2 * cB + x1 * sB);
            }
        }
    }
    SEAM(2);
    if (IN(3)) {
        { pg8::Gemm g{CQN, WqbT, M, 1536, 512, 512, 0}; pg8::StaticOrder S; S.init(M, 1536, G, bx); pg8::EpiQB E{QB};
          pg8::gemm_phase<pg8::EpiQB, pg8::StaticOrder, true, true, false>(lds, g, S, E); }
        { pg8::Gemm g{CKVN, WkvbT, M, 2048, 512, 512, 0}; pg8::StaticOrder S; S.init(M, 2048, G, bx); pg8::EpiBf16<0> E{KVB, 2048, nullptr};
          pg8::gemm_phase<pg8::EpiBf16<0>, pg8::StaticOrder, true, true, false>(lds, g, S, E); }
    }
    SEAM(3);
    if (IN(5)) {
        char* lds_g = (char*)lds_raw;
        const int x = bx & 7, i = bx >> 3;
        for (int c = bx; c < 256; c += G) {
            const int xx = c & 7, ii = c >> 3;
            {
                const int combo = xx >> 1, w = (xx & 1) * 32 + ii, b = combo >> 1, kvh = combo & 1, hq = kvh * 4 + (w >> 4), qb = w & 15;
                const size_t row0 = (size_t)b * SEQ;
                __syncthreads();
                att::attn_unit<128, ATT_SD_A, 1024, 256, 2560, 2048, SEQ>(QA + (row0 + qb * 256) * 1024 + hq * 128, KA + row0 * 256 + kvh * 128, nullptr,
                                    ZS + row0 * 2560 + 1280 + kvh * 128, OAB + (row0 + qb * 256) * 2048 + hq * 128, lds_g);
            }
            {
                const int unit = xx * 32 + ii, bh = unit >> 4, qb = unit & 15, b = bh >> 3, h = bh & 7;
                const size_t row0 = (size_t)b * SEQ;
                __syncthreads();
                att::attn_unit<192, ATT_SD_B, 1536, 2048, 2048, 2048, SEQ>(QB + (row0 + qb * 256) * 1536 + h * 192, KVB + row0 * 2048 + h * 256, KPE + row0 * 64,
                                    KVB + row0 * 2048 + h * 256 + 128, OAB + (row0 + qb * 256) * 2048 + 1024 + h * 128, lds_g);
            }
        }
        (void)x; (void)i;
        __syncthreads();
    }
    SEAM(5);
    if (IN(6)) {
        bf16_t* T1 = (bf16_t*)(ws + WS_T1);
        { pg8::Gemm g{OAB, WabT, M, 2048, 1024, 2048, 0}; pg8::StaticOrder S; S.init(M, 2048, G, bx); pg8::EpiGate<false> E{SG, T1, MERGED};
          pg8::gemm_phase<pg8::EpiGate<false>, pg8::StaticOrder, true, true, false>(lds, g, S, E); }
        { pg8::Gemm g{OAB + 1024, WabT + 1024, M, 2048, 1024, 2048, 0}; pg8::StaticOrder S; S.init(M, 2048, G, bx); pg8::EpiGate<true> E{SG, T1, MERGED};
          pg8::gemm_phase<pg8::EpiGate<true>, pg8::StaticOrder, true, true, false>(lds, g, S, E); }
    }
    SEAM(6);
    if (IN(7)) {
        pg8::Gemm g{MERGED, WoT, M, 2048, 2048, 2048, 0}; pg8::StaticOrder S; S.init(M, 2048, G, bx); pg8::EpiResid<false> E{a.x, nullptr, U, SSQ1};
        pg8::gemm_phase<pg8::EpiResid<false>, pg8::StaticOrder, true, true, false>(lds, g, S, E);
    }
    SEAM(7);
    if (IN(9)) {
        pg8::Gemm g{U, WguT, M, 2 * DFF, DM, DM, 0}; pg8::StaticOrder S; S.init(M, 2 * DFF, G, bx); pg8::EpiSwiglu E{ACT, SSQ1};
        pg8::gemm_phase<pg8::EpiSwiglu, pg8::StaticOrder, true, true, false>(lds, g, S, E);
        {
            constexpr int NU = (M / 256) * (2 * DFF / 256);
            const int nr = (NU + G - 1) / G, nbusy = NU - (nr - 1) * G; int idx = bx - nbusy, cnt = G - nbusy; if (cnt < 32) { idx = bx; cnt = G; }
            if (idx >= 0) { pg8::Gemm g2{PB, WppT, M, 2048, PLE, PLE, 0}; pg8::StaticOrder S2; S2.init(M, 2048, cnt, idx); pg8::EpiBf16<0> E2{ERAW, 2048, nullptr};
                pg8::gemm_phase<pg8::EpiBf16<0>, pg8::StaticOrder, true, true, false>(lds, g2, S2, E2); }
        }
    }
    SEAM(9);
    if (IN(10)) {
        pg8::Gemm g{ACT, WdT, M, 2048, DFF, DFF, 0}; pg8::StaticOrder S; S.init(M, 2048, G, bx); pg8::EpiResid<true> E{nullptr, U, U, SSQ2};
        pg8::gemm_phase<pg8::EpiResid<true>, pg8::StaticOrder, true, true, false>(lds, g, S, E);
    }
    SEAM(10);
    if (IN(12)) {
        { pg8::Gemm g{U, WpgT, M, 2048, DM, DM, 0}; pg8::StaticOrder S; S.init(M, 2048, G, bx); pg8::EpiBf16<1> E{GATE, 2048, SSQ2};
          pg8::gemm_phase<pg8::EpiBf16<1>, pg8::StaticOrder, true, true, false>(lds, g, S, E); }
    }
    SEAM(12);
    if (IN(13)) {
        u32x2 nh[8], ne[8], ng[8];
        int m = gw;
        if (m < M) {
#pragma unroll
            for (int j = 0; j < 8; ++j) { const size_t o = (size_t)m * DM + 4 * lane + 256 * j; nh[j] = *(const u32x2*)(U + o); ne[j] = *(const u32x2*)(ERAW + o); ng[j] = *(const u32x2*)(GATE + o); }
        }
        for (; m < M; m += NGW) {
            f32x4 h[8], e[8]; u32x2 gtw[8]; float se = 0.f;
#pragma unroll
            for (int j = 0; j < 8; ++j) { h[j] = (f32x4){bf_lo(nh[j].x), bf_hi(nh[j].x), bf_lo(nh[j].y), bf_hi(nh[j].y)}; e[j] = (f32x4){bf_lo(ne[j].x), bf_hi(ne[j].x), bf_lo(ne[j].y), bf_hi(ne[j].y)}; gtw[j] = ng[j];
                se += (e[j].x * e[j].x + e[j].y * e[j].y) + (e[j].z * e[j].z + e[j].w * e[j].w); }
            const int m2 = m + NGW;
            if (m2 < M) {
#pragma unroll
                for (int j = 0; j < 8; ++j) { const size_t o = (size_t)m2 * DM + 4 * lane + 256 * j; nh[j] = *(const u32x2*)(U + o); ne[j] = *(const u32x2*)(ERAW + o); ng[j] = *(const u32x2*)(GATE + o); }
            }
            const float re = 1.0f / sqrtf(wave_sum(se) * (1.f / DM) + EPS);
            float sh = 0.f;
#pragma unroll
            for (int j = 0; j < 8; ++j) { const u32x2 gt = gtw[j];
                const f32x4 gp = *(const f32x4*)(a.g_ple_post + 4 * lane + 256 * j);
                h[j].x += bf_lo(gt.x) * (e[j].x * re * gp.x); h[j].y += bf_hi(gt.x) * (e[j].y * re * gp.y);
                h[j].z += bf_lo(gt.y) * (e[j].z * re * gp.z); h[j].w += bf_hi(gt.y) * (e[j].w * re * gp.w);
                sh += (h[j].x * h[j].x + h[j].y * h[j].y) + (h[j].z * h[j].z + h[j].w * h[j].w); }
            const float rh = 1.0f / sqrtf(wave_sum(sh) * (1.f / DM) + EPS);
#pragma unroll
            for (int j = 0; j < 8; ++j) { const f32x4 gf = *(const f32x4*)(a.g_final + 4 * lane + 256 * j);
                f32x4 o; o.x = h[j].x * rh * gf.x; o.y = h[j].y * rh * gf.y; o.z = h[j].z * rh * gf.z; o.w = h[j].w * rh * gf.w;
                *(f32x4*)(a.out + (size_t)m * DM + 4 * lane + 256 * j) = o;
            }
        }
    }
#undef IN
#undef SEAM
}

extern "C" void kernel_launch(void* const* d_in, const int* in_sizes, int n_in, void* d_out, int out_size, void* d_ws, size_t ws_size, hipStream_t stream) {
    static int grid = 0;
    if (grid == 0) {
        if (n_in != 21 || in_sizes[0] != M * DM || out_size != M * DM || ws_size < WS_END) {
            fprintf(stderr, "kernel_launch: unexpected shapes: n_in %d in0 %d out %d ws %zu (need %zu)\n", n_in, n_in > 0 ? in_sizes[0] : -1, out_size, ws_size, (size_t)WS_END); grid = -1; return; }
        int dev = 0, cus = 0, per_cu = 0;
        if (hipGetDevice(&dev) != hipSuccess || hipDeviceGetAttribute(&cus, hipDeviceAttributeMultiprocessorCount, dev) != hipSuccess) { grid = -1; return; }
        if (hipFuncSetAttribute((const void*)mk_fwd, hipFuncAttributeMaxDynamicSharedMemorySize, LDS_BYTES) != hipSuccess) { fprintf(stderr, "kernel_launch: hipFuncSetAttribute failed\n"); grid = -1; return; }
        if (hipOccupancyMaxActiveBlocksPerMultiprocessor(&per_cu, (const void*)mk_fwd, NTHREADS, LDS_BYTES) != hipSuccess || per_cu < 1) { fprintf(stderr, "kernel_launch: occupancy query says %d\n", per_cu); per_cu = 1; }
        (void)hipGetLastError();
        grid = cus * 1;
    }
    if (grid < 0) return;
    Args a{};
    const float** f = (const float**)&a;
    for (int i = 0; i < 21; ++i) f[i] = (const float*)d_in[i];
    a.out = (float*)d_out; a.ws = (unsigned char*)d_ws;
#if MK_ONE_LAUNCH
    if (hipMemsetAsync(d_ws, 0, 262144 + 256, stream) != hipSuccess) { fprintf(stderr, "kernel_launch: memset failed\n"); return; }
    a.ph_lo = 0; a.ph_hi = NPHASE;
    void* args[] = {&a};
    hipError_t e = hipLaunchCooperativeKernel((const void*)mk_fwd, dim3(grid), dim3(NTHREADS), args, LDS_BYTES, stream);
    if (e != hipSuccess) fprintf(stderr, "kernel_launch: cooperative launch failed: %s (grid %d)\n", hipGetErrorString(e), grid);
#else
    for (int ph = 0; ph < NPHASE; ++ph) {
        a.ph_lo = ph; a.ph_hi = ph + 1;
        hipLaunchKernelGGL(mk_fwd, dim3(grid), dim3(NTHREADS), LDS_BYTES, stream, a);
    }
#endif
}
```

```cpp
#include <hip/hip_runtime.h>
#include <hip/hip_cooperative_groups.h>
#include <cstdio>
#include <cstdint>
namespace cg = cooperative_groups;

#ifndef ATT_SD_A
#define ATT_SD_A 1
#endif
#ifndef ATT_SD_B
#define ATT_SD_B 1
#endif
#ifndef MK_ONE_LAUNCH
#define MK_ONE_LAUNCH 1
#endif

#define LAS __attribute__((address_space(3)))
typedef unsigned short bf16_t;
typedef short bf16x8 __attribute__((ext_vector_type(8)));
typedef short s16x4 __attribute__((ext_vector_type(4)));
typedef float f32x4 __attribute__((ext_vector_type(4)));
typedef float f32x16 __attribute__((ext_vector_type(16)));
typedef unsigned u32x4 __attribute__((ext_vector_type(4)));
typedef unsigned u32x2 __attribute__((ext_vector_type(2)));
typedef int v4i_t __attribute__((ext_vector_type(4)));
constexpr float Q8_SU = 20.f, Q8_SW = 900.f;

constexpr int DM = 2048, SEQ = 4096, M = 8192, DFF = 5632, PLE = 256, NIN = 6720, NINP = 6912;
constexpr float EPS = 1e-6f;
constexpr int NWAVES = 8, NTHREADS = 512;
constexpr int LDS_BYTES = 139264;

constexpr size_t MiB = 1u << 20;
constexpr size_t WS_WIN = 1 * MiB, WS_WQB = 28 * MiB, WS_WKVB = 30 * MiB, WS_WAB = 32 * MiB, WS_WO = 40 * MiB, WS_WGU = 48 * MiB, WS_WD = 92 * MiB,
                 WS_WPG = 114 * MiB, WS_WPP = 122 * MiB, WS_PB = 123 * MiB, WS_KR = 127 * MiB, WS_U = 128 * MiB, WS_ZS = 160 * MiB, WS_SG = 200 * MiB,
                 WS_QA = 264 * MiB, WS_QB = 280 * MiB, WS_KVB = 304 * MiB, WS_END = 344 * MiB;
constexpr size_t WS_CQN = 1 * MiB, WS_CKVN = 9 * MiB, WS_KA = 17 * MiB, WS_KPE = 21 * MiB;
constexpr size_t WS_T1 = 264 * MiB;
constexpr size_t WS_OAB = WS_U, WS_MERGED = WS_ZS, WS_ACT = 160 * MiB, WS_GATE = 160 * MiB, WS_ERAW = 280 * MiB;

typedef float f32x2_t __attribute__((ext_vector_type(2)));
typedef __bf16 bf16x2_t __attribute__((ext_vector_type(2)));
__device__ __forceinline__ unsigned cvt_pk_bf16(float lo, float hi) { f32x2_t v = {lo, hi}; bf16x2_t b = __builtin_convertvector(v, bf16x2_t); return __builtin_bit_cast(unsigned, b); }
__device__ __forceinline__ float bf_lo(unsigned w) { return __uint_as_float(w << 16); }
__device__ __forceinline__ float bf_hi(unsigned w) { return __uint_as_float(w & 0xffff0000u); }
__device__ __forceinline__ float bf1(bf16_t h) { return __uint_as_float(((unsigned)h) << 16); }
__device__ __forceinline__ bf16_t f2bf(float f) { unsigned u = __float_as_uint(f); return (bf16_t)((u + 0x7fffu + ((u >> 16) & 1u)) >> 16); }
__device__ __forceinline__ float sigmoidf_(float x) { return __builtin_amdgcn_rcpf(1.f + __expf(-x)); }
__device__ __forceinline__ float wave_sum(float v) {
#pragma unroll
    for (int o = 1; o < 64; o <<= 1) v += __shfl_xor(v, o);
    return v;
}

namespace pg8 {
constexpr int BM = 256, BK = 64, HALF = 128, HTB = HALF * BK * 2, STAGE_BYTES = 8 * HTB, NXCD = 8, WGM = 8;
__host__ __device__ __forceinline__ int lds_byte(int r, int c) { const int st = (r >> 4) * 2 + (c >> 5), rr = r & 15, cc = c & 31, ob = rr * 64 + cc * 2; return st * 1024 + (ob ^ (((ob >> 9) & 1) << 5)); }
__host__ __device__ __forceinline__ void stage_rc(int b, int& R, int& C) { const int st = b / 1024, sb = b % 1024, swz = sb ^ (((sb >> 9) & 1) << 5); R = (st >> 1) * 16 + swz / 64; C = (st & 1) * 32 + (swz % 64) / 2; }
__host__ __device__ __forceinline__ int perm32(int rho) { const int n = rho >> 4, i = rho & 15; return 8 * (i >> 2) + 4 * n + (i & 3); }
struct Unit { int pm, pn, kh; };
struct Gemm { const bf16_t* A; const bf16_t* Bt; int M, N, K, ld, koff, lda; };
struct StaticOrder {
    int nM, nN, nwg, G, c;
    __host__ __device__ void init(int M_, int N_, int G_, int c_) { nM = M_ / BM; nN = N_ / BM; nwg = nM * nN; G = G_; c = c_; }
    __host__ __device__ bool next(int i, Unit& u) const {
        const long L = (long)i * G + c; if (L >= nwg) return false;
        int wgid = (int)L; { const int q = nwg / NXCD, r = nwg % NXCD, xcd = wgid % NXCD, off = wgid / NXCD; wgid = (xcd < r ? xcd * (q + 1) : r * (q + 1) + (xcd - r) * q) + off; }
        const int nig = WGM * nN, gid = wgid / nig, fm = gid * WGM, gsz = (nM - fm) < WGM ? (nM - fm) : WGM;
        u.pm = fm + ((wgid % nig) % gsz); u.pn = (wgid % nig) / gsz; u.kh = 0; return true;
    }
    __device__ __forceinline__ void a_ready(const Unit&) const {}
    __device__ __forceinline__ void done(const Unit&) const {}
};
struct DualOrder : StaticOrder {
    __host__ __device__ bool next(int i, Unit& u) const { if (!StaticOrder::next(i >> 1, u)) return false; u.kh = i & 1; return true; }
};
typedef f32x4 Acc[2][2][4][2];

__device__ __forceinline__ void store8(bf16_t* p, f32x4 v0, f32x4 v1) {
    u32x4 w; w.x = cvt_pk_bf16(v0[0], v0[1]); w.y = cvt_pk_bf16(v0[2], v0[3]); w.z = cvt_pk_bf16(v1[0], v1[1]); w.w = cvt_pk_bf16(v1[2], v1[3]);
    *(u32x4*)p = w;
}
struct EpiIn {
    static constexpr bool PERM = true, AFTER_DRAIN = false;
    bf16_t *ZS, *SG, *KR; float *SSQC, *SSQK;
    __device__ __forceinline__ void operator()(const Acc& acc, const Unit& u, int wr, int wc, int fr, int fq) const {
        const int pn = u.pn; bf16_t* base; int ldc, colt; bool sig = false;
        if (pn < 10) { base = ZS; ldc = 2560; colt = pn * 256; }
        else if (pn < 26) { base = SG; ldc = 4096; colt = (pn - 10) * 256; sig = true; }
        else { base = KR; ldc = 64; colt = 0; }
        const int row0 = u.pm * BM + wr * 64 + fr, col0 = colt + wc * 32 + 8 * fq;
#pragma unroll
        for (int ai = 0; ai < 2; ++ai)
#pragma unroll
            for (int m = 0; m < 4; ++m) { bf16_t* rowp = base + (size_t)(row0 + ai * HALF + m * 16) * ldc + col0; float ss = 0.f;
#pragma unroll
                for (int bj = 0; bj < 2; ++bj) {
                    if (pn == 26 && (bj == 1 || wc >= 2)) continue;
                    f32x4 v0 = __builtin_convertvector(__builtin_bit_cast(v4i_t, acc[ai][bj][m][0]), f32x4) * (1.f / (Q8_SU * Q8_SW));
                    f32x4 v1 = __builtin_convertvector(__builtin_bit_cast(v4i_t, acc[ai][bj][m][1]), f32x4) * (1.f / (Q8_SU * Q8_SW));
                    if (sig) {
#pragma unroll
                        for (int j = 0; j < 4; ++j) { v0[j] = sigmoidf_(v0[j]); v1[j] = sigmoidf_(v1[j]); } }
                    ss += (v0[0] * v0[0] + v0[1] * v0[1]) + (v0[2] * v0[2] + v0[3] * v0[3]) + (v1[0] * v1[0] + v1[1] * v1[1]) + (v1[2] * v1[2] + v1[3] * v1[3]);
                    store8(rowp + bj * HALF, v0, v1); }
                if (pn >= 6 && pn < 10) { ss += __shfl_xor(ss, 16); ss += __shfl_xor(ss, 32);
                    if (fq == 0) (void)__hip_atomic_fetch_add((__attribute__((address_space(1))) float*)((pn < 8 ? SSQC : SSQK) + row0 + ai * HALF + m * 16), ss, __ATOMIC_RELAXED, __HIP_MEMORY_SCOPE_AGENT); } }
    }
};
template <int ACT  > struct EpiBf16 {
    static constexpr bool PERM = true, AFTER_DRAIN = false;
    bf16_t* O; int ldc; const float* ssq; float inv_n;
    __device__ __forceinline__ void operator()(const Acc& acc, const Unit& u, int wr, int wc, int fr, int fq) const {
        const int row0 = u.pm * BM + wr * 64 + fr, col0 = u.pn * BM + wc * 32 + 8 * fq;
#pragma unroll
        for (int ai = 0; ai < 2; ++ai)
#pragma unroll
            for (int m = 0; m < 4; ++m) { bf16_t* rowp = O + (size_t)(row0 + ai * HALF + m * 16) * ldc + col0;
                const float r = ssq ? 1.0f / sqrtf(ssq[row0 + ai * HALF + m * 16] * inv_n + EPS) : 1.f;
#pragma unroll
                for (int bj = 0; bj < 2; ++bj) { f32x4 v0 = acc[ai][bj][m][0] * r, v1 = acc[ai][bj][m][1] * r;
                    if (ACT == 1) {
#pragma unroll
                        for (int j = 0; j < 4; ++j) { v0[j] = sigmoidf_(v0[j]); v1[j] = sigmoidf_(v1[j]); } }
                    store8(rowp + bj * HALF, v0, v1); } }
    }
};
struct EpiQB {
    static constexpr bool PERM = true, AFTER_DRAIN = false;
    bf16_t* O; const float* ssq;
    __device__ __forceinline__ void operator()(const Acc& acc, const Unit& u, int wr, int wc, int fr, int fq) const {
        const int row0 = u.pm * BM + wr * 64 + fr, col0 = u.pn * BM + wc * 32 + 8 * fq;
        float inv[8];
#pragma unroll
        for (int t = 0; t < 8; ++t) inv[t] = __builtin_amdgcn_exp2f(-(float)(2 * ((fq & 1) * 8 + t)) * (13.287712379549449f / 32.f));
        const float sgn = (fq >= 2) ? 1.f : -1.f;
#pragma unroll
        for (int ai = 0; ai < 2; ++ai)
#pragma unroll
            for (int m = 0; m < 4; ++m) { const int row = row0 + ai * HALF + m * 16, sq = row & (SEQ - 1); const float prow = (float)(sq >> 6), pcol = (float)(sq & 63);
                const float rq = 1.0f / sqrtf(ssq[row] * (1.f / 512.f) + EPS);
#pragma unroll
                for (int bj = 0; bj < 2; ++bj) { f32x4 v0 = acc[ai][bj][m][0] * rq, v1 = acc[ai][bj][m][1] * rq;
                    const int rel = (u.pn * BM + bj * HALF + wc * 32) % 192;
                    if (rel >= 128) { const float pos = (rel >= 160) ? pcol : prow;
#pragma unroll
                        for (int t = 0; t < 4; ++t) {
                            const float a0 = pos * inv[t], a1 = pos * inv[4 + t];
                            const float p0 = __shfl_xor(v0[t], 32), p1 = __shfl_xor(v1[t], 32);
                            v0[t] = v0[t] * __cosf(a0) + sgn * p0 * __sinf(a0); v1[t] = v1[t] * __cosf(a1) + sgn * p1 * __sinf(a1); } }
                    store8(O + (size_t)row * 1536 + col0 + bj * HALF, v0, v1); } }
    }
};
template <bool SECOND> struct EpiGate {
    static constexpr bool PERM = true, AFTER_DRAIN = false;
    const bf16_t* SG; bf16_t* T1; bf16_t* O;
    __device__ __forceinline__ void operator()(const Acc& acc, const Unit& u, int wr, int wc, int fr, int fq) const {
        const int row0 = u.pm * BM + wr * 64 + fr, col0 = u.pn * BM + wc * 32 + 8 * fq;
#pragma unroll
        for (int ai = 0; ai < 2; ++ai)
#pragma unroll
            for (int m = 0; m < 4; ++m) { const size_t ro = (size_t)(row0 + ai * HALF + m * 16);
#pragma unroll
                for (int bj = 0; bj < 2; ++bj) {
                    const u32x4 b = *(const u32x4*)(SG + ro * 4096 + (SECOND ? 2048 : 0) + col0 + bj * HALF);
                    f32x4 s0, s1;
                    s0[0] = bf_lo(b.x); s0[1] = bf_hi(b.x); s0[2] = bf_lo(b.y); s0[3] = bf_hi(b.y);
                    s1[0] = bf_lo(b.z); s1[1] = bf_hi(b.z); s1[2] = bf_lo(b.w); s1[3] = bf_hi(b.w);
                    bf16_t* tp = T1 + ro * 2048 + col0 + bj * HALF;
                    if constexpr (!SECOND) { store8(tp, acc[ai][bj][m][0] * s0, acc[ai][bj][m][1] * s1); }
                    else { const u32x4 tw = *(const u32x4*)tp; f32x4 t0, t1;
                        t0[0] = bf_lo(tw.x); t0[1] = bf_hi(tw.x); t0[2] = bf_lo(tw.y); t0[3] = bf_hi(tw.y); t1[0] = bf_lo(tw.z); t1[1] = bf_hi(tw.z); t1[2] = bf_lo(tw.w); t1[3] = bf_hi(tw.w);
                        store8(O + ro * 2048 + col0 + bj * HALF, t0 + acc[ai][bj][m][0] * s0, t1 + acc[ai][bj][m][1] * s1); } } }
    }
};
template <bool BASEBF> struct EpiResid {
    static constexpr bool PERM = false, AFTER_DRAIN = false;
    const float* basef; const bf16_t* baseb; bf16_t* HB; float* ssq;
    __device__ __forceinline__ void operator()(const Acc& acc, const Unit& u, int wr, int wc, int fr, int fq) const {
        const int row0 = u.pm * BM + wr * 64 + fr, col0 = u.pn * BM + wc * 32 + 4 * fq;
#pragma unroll
        for (int ai = 0; ai < 2; ++ai)
#pragma unroll
            for (int m = 0; m < 4; ++m) { const int row = row0 + ai * HALF + m * 16; const size_t ro = (size_t)row * DM + col0; float ss = 0.f;
#pragma unroll
                for (int bj = 0; bj < 2; ++bj)
#pragma unroll
                    for (int n = 0; n < 2; ++n) { const size_t o = ro + bj * HALF + n * 16;
                        f32x4 v = acc[ai][bj][m][n];
                        if constexpr (BASEBF) { const u32x2 bw = *(const u32x2*)(baseb + o); v = v + (f32x4){bf_lo(bw.x), bf_hi(bw.x), bf_lo(bw.y), bf_hi(bw.y)}; }
                        else v = v + *(const f32x4*)(basef + o);
                        u32x2 w; w.x = cvt_pk_bf16(v.x, v.y); w.y = cvt_pk_bf16(v.z, v.w);
                        *(u32x2*)(HB + o) = w; ss += (v.x * v.x + v.y * v.y) + (v.z * v.z + v.w * v.w); }
                ss += __shfl_xor(ss, 16); ss += __shfl_xor(ss, 32);
                if (fq == 0) (void)__hip_atomic_fetch_add((__attribute__((address_space(1))) float*)(ssq + row), ss, __ATOMIC_RELAXED, __HIP_MEMORY_SCOPE_AGENT); }
    }
};
struct EpiSwiglu {
    static constexpr bool PERM = true, AFTER_DRAIN = false;
    bf16_t* O; const float* ssq;
    __device__ __forceinline__ void operator()(const Acc& acc, const Unit& u, int wr, int wc, int fr, int fq) const {
        const int row0 = u.pm * BM + wr * 64 + fr, col0 = u.pn * HALF + wc * 32 + 8 * fq;
#pragma unroll
        for (int ai = 0; ai < 2; ++ai)
#pragma unroll
            for (int m = 0; m < 4; ++m) {
                f32x4 a0, a1; const float r = 1.0f / sqrtf(ssq[row0 + ai * HALF + m * 16] * (1.f / DM) + EPS);
#pragma unroll
                for (int j = 0; j < 4; ++j) { const float g0 = acc[ai][0][m][0][j] * r, g1 = acc[ai][0][m][1][j] * r;
                    a0[j] = g0 * sigmoidf_(g0) * (acc[ai][1][m][0][j] * r); a1[j] = g1 * sigmoidf_(g1) * (acc[ai][1][m][1][j] * r); }
                store8(O + (size_t)(row0 + ai * HALF + m * 16) * DFF + col0, a0, a1); }
    }
};

template <class Epi, class Sched, bool ALIGN_EPI, bool SP2, bool MID, bool I8 = false>
__device__ __forceinline__ void gemm_phase(LAS unsigned char* lds, const Gemm g, const Sched S, const Epi E) {
    const int tid = threadIdx.x, wid = __builtin_amdgcn_readfirstlane(tid >> 6), lane = tid & 63, wr = wid >> 2, wc = wid & 3, fr = lane & 15, fq = lane >> 4;
    const int K = g.ld, nt = g.K / BK;
    unsigned voffA[2], voffB[2];
#pragma unroll
    for (int i = 0; i < 2; ++i) { int R, C; stage_rc(tid * 16 + i * 8192, R, C); const int Rb = Epi::PERM ? ((R & ~31) + perm32(R & 31)) : R;
        voffA[i] = (unsigned)(R * (g.lda ? g.lda : K) + C) * 2u; voffB[i] = (unsigned)(Rb * K + C) * 2u; }
    const size_t kstep = (size_t)(BK * 2);
    const int KA = g.lda ? g.lda : K;
    const size_t hstep = (size_t)HALF * K * 2, hstepA = (size_t)HALF * KA * 2;
    const size_t tstep = 2 * hstep, tstepA = 2 * hstepA;
    const unsigned ldsw = (unsigned)wid * 1024u;
    const int aoff = lds_byte(wr * 64 + fr, fq * 8), boff = lds_byte(wc * 32 + fr, fq * 8);
#define PG8_SA(b, h) (((b) * 2 + (h)) * HTB)
#define PG8_SB(b, h) ((4 + (b) * 2 + (h)) * HTB)
#define PG8_STAGE(bufoff, gbase, voff) do { _Pragma("unroll") for (int _i = 0; _i < 2; ++_i) \
        __builtin_amdgcn_global_load_lds((const unsigned*)((const char*)(gbase) + (voff)[_i]), (LAS unsigned*)(lds + (bufoff) + ldsw + _i * 8192), 16, 0, 0); } while (0)
#define PG8_LDA(dst, b, h) do { _Pragma("unroll") for (int m = 0; m < 4; ++m) _Pragma("unroll") for (int k = 0; k < 2; ++k) dst[m][k] = *(const LAS bf16x8*)(lds + PG8_SA(b, h) + aoff + m * 2048 + k * 1024); } while (0)
#define PG8_LDB(dst, b, h) do { _Pragma("unroll") for (int n = 0; n < 2; ++n) _Pragma("unroll") for (int k = 0; k < 2; ++k) dst[n][k] = *(const LAS bf16x8*)(lds + PG8_SB(b, h) + boff + n * 2048 + k * 1024); } while (0)
#define PG8_MMA(ai, bj, At, Bt) do { __builtin_amdgcn_s_setprio(1); _Pragma("unroll") for (int m = 0; m < 4; ++m) _Pragma("unroll") for (int n = 0; n < 2; ++n) _Pragma("unroll") for (int k = 0; k < 2; ++k) { \
        if constexpr (I8) acc[ai][bj][m][n] = __builtin_bit_cast(f32x4, __builtin_amdgcn_mfma_i32_16x16x64_i8(__builtin_bit_cast(v4i_t, Bt[n][k]), __builtin_bit_cast(v4i_t, At[m][k]), __builtin_bit_cast(v4i_t, acc[ai][bj][m][n]), 0, 0, 0)); \
        else acc[ai][bj][m][n] = __builtin_amdgcn_mfma_f32_16x16x32_bf16(Bt[n][k], At[m][k], acc[ai][bj][m][n], 0, 0, 0); } __builtin_amdgcn_s_setprio(0); } while (0)
#define PG8_WAIT_V(n) asm volatile("s_waitcnt vmcnt(" #n ")" ::: "memory")
#define PG8_WAIT_L(n) asm volatile("s_waitcnt lgkmcnt(" #n ")" ::: "memory")
#define PG8_BAR __builtin_amdgcn_s_barrier()
#define PG8_SCHED __builtin_amdgcn_sched_barrier(0)
    Unit cur, nxt; int ui = 0;
    if (!S.next(0, cur)) return;
    Acc acc;
#pragma unroll
    for (int a = 0; a < 2; ++a)
#pragma unroll
        for (int b = 0; b < 2; ++b)
#pragma unroll
            for (int m = 0; m < 4; ++m)
#pragma unroll
                for (int n = 0; n < 2; ++n) acc[a][b][m][n] = (f32x4){0.f, 0.f, 0.f, 0.f};
    bf16x8 At[4][2], B0[2][2], B1[2][2];
    const char* cA = (const char*)g.A + (size_t)cur.pm * tstepA + (size_t)cur.kh * g.koff; const char* cB = (const char*)g.Bt + (size_t)cur.pn * tstep + (size_t)cur.kh * g.koff;
    S.a_ready(cur);
    if constexpr (SP2) {
        PG8_STAGE(PG8_SB(0, 0), cB, voffB); PG8_STAGE(PG8_SB(0, 1), cB + hstep, voffB); PG8_STAGE(PG8_SA(0, 0), cA, voffA); PG8_STAGE(PG8_SA(0, 1), cA + hstepA, voffA);
        if (wr == 1) PG8_BAR;
        PG8_WAIT_V(2); PG8_BAR;
        PG8_STAGE(PG8_SB(1, 0), cB + kstep, voffB); PG8_STAGE(PG8_SA(1, 0), cA + kstep, voffA); PG8_STAGE(PG8_SB(1, 1), cB + hstep + kstep, voffB);
        PG8_WAIT_V(6); PG8_BAR;
    } else {
        PG8_STAGE(PG8_SB(0, 0), cB, voffB); PG8_STAGE(PG8_SA(0, 0), cA, voffA); PG8_STAGE(PG8_SB(0, 1), cB + hstep, voffB); PG8_STAGE(PG8_SA(0, 1), cA + hstepA, voffA);
        if (wr == 1) PG8_BAR;
        PG8_WAIT_V(4); PG8_BAR;
        PG8_STAGE(PG8_SB(1, 0), cB + kstep, voffB); PG8_STAGE(PG8_SA(1, 0), cA + kstep, voffA); PG8_STAGE(PG8_SB(1, 1), cB + hstep + kstep, voffB);
        PG8_WAIT_V(6); PG8_BAR;
    }
    for (;;) {
        const bool has_next = S.next(ui + 1, nxt);
        const char* nA = has_next ? (const char*)g.A + (size_t)nxt.pm * tstepA + (size_t)nxt.kh * g.koff : cA; const char* nB = has_next ? (const char*)g.Bt + (size_t)nxt.pn * tstep + (size_t)nxt.kh * g.koff : cB;
        for (int t = 0; t < nt; t += 2) {
            const bool last = (t == nt - 2);
            const char* a1 = cA + (size_t)(t + 1) * kstep;
            const char* a2 = last ? nA : cA + (size_t)(t + 2) * kstep; const char* b2 = last ? nB : cB + (size_t)(t + 2) * kstep;
            const char* a3 = a2 + kstep; const char* b3 = b2 + kstep;
            if (last && has_next) S.a_ready(nxt);
            if constexpr (SP2) {
            PG8_LDB(B0, 0, 0); PG8_LDB(B1, 0, 1); PG8_SCHED; PG8_LDA(At, 0, 0); PG8_STAGE(PG8_SA(1, 1), a1 + hstepA, voffA);
            PG8_WAIT_V(8); PG8_WAIT_L(0); PG8_BAR; PG8_MMA(0, 0, At, B0); PG8_MMA(0, 1, At, B1); PG8_BAR; PG8_SCHED;
            PG8_LDA(At, 0, 1); PG8_STAGE(PG8_SB(0, 0), b2, voffB); PG8_STAGE(PG8_SB(0, 1), b2 + hstep, voffB); PG8_STAGE(PG8_SA(0, 0), a2, voffA);
            PG8_WAIT_V(8); PG8_WAIT_L(0); PG8_BAR; PG8_MMA(1, 0, At, B0); PG8_MMA(1, 1, At, B1); PG8_BAR; PG8_SCHED;
            PG8_LDB(B0, 1, 0); PG8_LDB(B1, 1, 1); PG8_SCHED; PG8_LDA(At, 1, 0); PG8_STAGE(PG8_SA(0, 1), a2 + hstepA, voffA);
            PG8_WAIT_V(8); PG8_WAIT_L(0); PG8_BAR; PG8_MMA(0, 0, At, B0); PG8_MMA(0, 1, At, B1); PG8_BAR; PG8_SCHED;
            PG8_LDA(At, 1, 1); PG8_STAGE(PG8_SB(1, 0), b3, voffB); PG8_STAGE(PG8_SB(1, 1), b3 + hstep, voffB); PG8_STAGE(PG8_SA(1, 0), a3, voffA);
            PG8_WAIT_V(8); PG8_WAIT_L(0); PG8_BAR; PG8_MMA(1, 0, At, B0); PG8_MMA(1, 1, At, B1); PG8_BAR; PG8_SCHED;
            } else {
            PG8_LDB(B0, 0, 0); PG8_SCHED; PG8_LDA(At, 0, 0); PG8_STAGE(PG8_SA(1, 1), a1 + hstepA, voffA);
            PG8_WAIT_L(8); PG8_BAR; PG8_WAIT_L(0); PG8_MMA(0, 0, At, B0); PG8_BAR; PG8_SCHED;
            PG8_LDB(B1, 0, 1); PG8_STAGE(PG8_SB(0, 0), b2, voffB);
            PG8_BAR; PG8_WAIT_L(0); PG8_MMA(0, 1, At, B1); PG8_BAR;
            PG8_LDA(At, 0, 1); PG8_STAGE(PG8_SA(0, 0), a2, voffA);
            PG8_BAR; PG8_WAIT_L(0); PG8_MMA(1, 0, At, B0); PG8_BAR; PG8_SCHED;
            PG8_STAGE(PG8_SB(0, 1), b2 + hstep, voffB);
            PG8_WAIT_V(6); PG8_BAR; PG8_MMA(1, 1, At, B1); PG8_BAR;
            PG8_LDB(B0, 1, 0); PG8_SCHED; PG8_LDA(At, 1, 0); PG8_STAGE(PG8_SA(0, 1), a2 + hstepA, voffA);
            PG8_WAIT_L(8); PG8_BAR; PG8_WAIT_L(0); PG8_MMA(0, 0, At, B0); PG8_BAR; PG8_SCHED;
            PG8_LDB(B1, 1, 1); PG8_STAGE(PG8_SB(1, 0), b3, voffB);
            PG8_BAR; PG8_WAIT_L(0); PG8_MMA(0, 1, At, B1); PG8_BAR;
            PG8_LDA(At, 1, 1); PG8_STAGE(PG8_SA(1, 0), a3, voffA);
            PG8_BAR; PG8_WAIT_L(0); PG8_MMA(1, 0, At, B0); PG8_BAR; PG8_SCHED;
            PG8_STAGE(PG8_SB(1, 1), b3 + hstep, voffB);
            PG8_WAIT_V(6); PG8_BAR; PG8_MMA(1, 1, At, B1); PG8_BAR;
            }
        }
        if constexpr (ALIGN_EPI) { if (wr == 0) PG8_BAR; }
        { E(acc, cur, wr, wc, fr, fq); S.done(cur);
#pragma unroll
        for (int a = 0; a < 2; ++a)
#pragma unroll
            for (int b = 0; b < 2; ++b)
#pragma unroll
                for (int m = 0; m < 4; ++m)
#pragma unroll
                    for (int n = 0; n < 2; ++n) acc[a][b][m][n] = (f32x4){0.f, 0.f, 0.f, 0.f};
        }
        if (!has_next) break;
        cur = nxt; cA = nA; cB = nB; ++ui;
        if constexpr (ALIGN_EPI) { if (wr == 1) PG8_BAR; }
    }
    PG8_WAIT_V(0);
    if constexpr (!ALIGN_EPI) { if (wr == 0) PG8_BAR; }
    PG8_BAR;
#undef PG8_SA
#undef PG8_SB
#undef PG8_STAGE
#undef PG8_LDA
#undef PG8_LDB
#undef PG8_MMA
#undef PG8_WAIT_V
#undef PG8_WAIT_L
#undef PG8_BAR
#undef PG8_SCHED
}
}

namespace att {
constexpr int NW = 8, QBLK = 32, KVBLK = 64;
constexpr int SHM_V = KVBLK * 128 * 2, SHM_K = KVBLK * 128 * 2, SHM_KR = KVBLK * 64 * 2;
constexpr int OFF_V = 0, OFF_K = 2 * SHM_V, OFF_WS = OFF_K + 2 * SHM_K, OFF_KR = OFF_WS + NW * 64 * 4, OFF_QR = OFF_KR + 2 * SHM_KR, QR_WAVE = 6144, ATT_LDS = OFF_QR + NW * QR_WAVE;
constexpr float THR = 8.f;
#define KSWZ(row, colB) ((row) * 256 + ((colB) ^ (((row) & 7) << 4)))
#define KRSWZ(row, colB) ((row) * 128 + ((colB) ^ ((((row) >> 1) & 7) << 4)))
#define SBAR() __builtin_amdgcn_sched_barrier(0)
__device__ __forceinline__ int crow(int r, int hi) { return (r & 3) + 8 * (r >> 2) + 4 * hi; }

__device__ __forceinline__ void partialSM(f32x16& p0, f32x16& p1, float& m_reg, float& mn, float& alpha, const float C, const float THRS) {
  float pmax = p0[0];
#pragma unroll
  for (int r = 1; r < 16; ++r) pmax = fmaxf(pmax, p0[r]);
#pragma unroll
  for (int r = 0; r < 16; ++r) pmax = fmaxf(pmax, p1[r]);
  { auto rr = __builtin_amdgcn_permlane32_swap(__float_as_uint(pmax), __float_as_uint(pmax), false, false);
    pmax = fmaxf(__uint_as_float(rr[0]), __uint_as_float(rr[1])); }
  if (__builtin_expect(__all(pmax - m_reg <= THRS), 1)) { mn = m_reg; alpha = 1.f; }
  else { mn = fmaxf(m_reg, pmax); alpha = __builtin_amdgcn_exp2f((m_reg - mn) * C); m_reg = mn; }
  float mnC = -mn * C;
#pragma unroll
  for (int r = 0; r < 16; ++r) p0[r] = fmaf(p0[r], C, mnC);
#pragma unroll
  for (int r = 0; r < 16; ++r) p1[r] = fmaf(p1[r], C, mnC);
#pragma unroll
  for (int r = 0; r < 16; ++r) p0[r] = __builtin_amdgcn_exp2f(p0[r]);
}
__device__ __forceinline__ void finishSM(f32x16& p0, f32x16& p1, float alpha, float& l_reg, bf16x8& pa0, bf16x8& pa1, bf16x8& pa2, bf16x8& pa3) {
#pragma unroll
  for (int r = 0; r < 16; ++r) p1[r] = __builtin_amdgcn_exp2f(p1[r]);
  float ps = 0;
#pragma unroll
  for (int r = 0; r < 16; ++r) ps += p0[r];
#pragma unroll
  for (int r = 0; r < 16; ++r) ps += p1[r];
  { auto rr = __builtin_amdgcn_permlane32_swap(__float_as_uint(ps), __float_as_uint(ps), false, false);
    ps = __uint_as_float(rr[0]) + __uint_as_float(rr[1]); }
  l_reg = l_reg * alpha + ps;
#define PK4(P, BASE, OUT) do { unsigned a0 = cvt_pk_bf16(P[BASE + 0], P[BASE + 1]), a1 = cvt_pk_bf16(P[BASE + 2], P[BASE + 3]);   \
    unsigned b0 = cvt_pk_bf16(P[BASE + 4], P[BASE + 5]), b1 = cvt_pk_bf16(P[BASE + 6], P[BASE + 7]);                              \
    auto r0 = __builtin_amdgcn_permlane32_swap(a0, b0, false, false); auto r1 = __builtin_amdgcn_permlane32_swap(a1, b1, false, false); \
    u32x4 w = {r0[0], r1[0], r0[1], r1[1]}; OUT = *reinterpret_cast<bf16x8*>(&w); } while (0)
  PK4(p0, 0, pa0); PK4(p0, 8, pa1); PK4(p1, 0, pa2); PK4(p1, 8, pa3);
#undef PK4
}
template <int DK, int NQR>
__device__ __forceinline__ void qkt(f32x16& p0, f32x16& p1, const char* Ks, const char* Krs, const bf16x8* qr, const char* qrl, int r32, int hi) {
  p0 = f32x16{}; p1 = f32x16{};
#pragma unroll
  for (int d0 = 0; d0 < 8; ++d0) { int cb = (d0 * 16 + hi * 8) * 2;
    bf16x8 b0 = *reinterpret_cast<const bf16x8*>(Ks + KSWZ(r32, cb));
    bf16x8 b1 = *reinterpret_cast<const bf16x8*>(Ks + KSWZ(32 + r32, cb));
    bf16x8 qv; if (d0 < NQR) qv = qr[d0 < NQR ? d0 : 0]; else qv = *reinterpret_cast<const bf16x8*>(qrl + (d0 - NQR) * 1024);
    p0 = __builtin_amdgcn_mfma_f32_32x32x16_bf16(b0, qv, p0, 0, 0, 0);
    p1 = __builtin_amdgcn_mfma_f32_32x32x16_bf16(b1, qv, p1, 0, 0, 0); }
  if constexpr (DK == 192) {
#pragma unroll
    for (int d0 = 0; d0 < 4; ++d0) { int cb = (d0 * 16 + hi * 8) * 2;
      bf16x8 b0 = *reinterpret_cast<const bf16x8*>(Krs + KRSWZ(r32, cb));
      bf16x8 b1 = *reinterpret_cast<const bf16x8*>(Krs + KRSWZ(32 + r32, cb));
      const bf16x8 qv = *reinterpret_cast<const bf16x8*>(qrl + (8 - NQR + d0) * 1024);
      p0 = __builtin_amdgcn_mfma_f32_32x32x16_bf16(b0, qv, p0, 0, 0, 0);
      p1 = __builtin_amdgcn_mfma_f32_32x32x16_bf16(b1, qv, p1, 0, 0, 0); }
  }
}
__device__ __forceinline__ int v_st(int k, int c) { const int kk = (k & ~0xC) | ((k & 4) << 1) | ((k & 8) >> 1); return ((kk >> 3) * 4 + (c >> 5)) * 512 + ((kk & 7) * 32 + (c & 31)) * 2; }
__device__ __forceinline__ int v_rd_base(int lane) { return ((lane & 3) << 3) | (((lane >> 2) & 3) << 6) | (((lane >> 4) & 1) << 5) | (((lane >> 5) & 1) << 8); }
constexpr int v_rd_off(int d0, int ks, int half) { return d0 * 512 + ks * 4096 + half * 2048; }
template <int OFF> __device__ __forceinline__ s16x4 tr_read(int vb) {
  s16x4 r; asm volatile("ds_read_b64_tr_b16 %0, %1 offset:%2" : "=&v"(r) : "v"(vb), "i"(OFF) : "memory"); return r;
}
template <int D0> __device__ __forceinline__ void pv_one(f32x16& od, int vb, bf16x8 pa0, bf16x8 pa1, bf16x8 pa2, bf16x8 pa3) {
  const s16x4 l0 = tr_read<v_rd_off(D0, 0, 0)>(vb), h0 = tr_read<v_rd_off(D0, 0, 1)>(vb), l1 = tr_read<v_rd_off(D0, 1, 0)>(vb), h1 = tr_read<v_rd_off(D0, 1, 1)>(vb);
  const s16x4 l2 = tr_read<v_rd_off(D0, 2, 0)>(vb), h2 = tr_read<v_rd_off(D0, 2, 1)>(vb), l3 = tr_read<v_rd_off(D0, 3, 0)>(vb), h3 = tr_read<v_rd_off(D0, 3, 1)>(vb);
  asm volatile("s_waitcnt lgkmcnt(0)" ::: "memory"); SBAR();
#define PK(L, H) (bf16x8){L[0], L[1], L[2], L[3], H[0], H[1], H[2], H[3]}
  od = __builtin_amdgcn_mfma_f32_32x32x16_bf16(pa0, PK(l0, h0), od, 0, 0, 0);
  od = __builtin_amdgcn_mfma_f32_32x32x16_bf16(pa1, PK(l1, h1), od, 0, 0, 0);
  od = __builtin_amdgcn_mfma_f32_32x32x16_bf16(pa2, PK(l2, h2), od, 0, 0, 0);
  od = __builtin_amdgcn_mfma_f32_32x32x16_bf16(pa3, PK(l3, h3), od, 0, 0, 0);
#undef PK
}
__device__ __forceinline__ void pv_d0(f32x16* o, int vb, bf16x8 pa0, bf16x8 pa1, bf16x8 pa2, bf16x8 pa3) {
  pv_one<0>(o[0], vb, pa0, pa1, pa2, pa3); pv_one<1>(o[1], vb, pa0, pa1, pa2, pa3); pv_one<2>(o[2], vb, pa0, pa1, pa2, pa3); pv_one<3>(o[3], vb, pa0, pa1, pa2, pa3);
}

template <int DK, int SDEPTH, int ldq, int ldk, int ldv, int ldo, int seq>
__device__ __forceinline__ void attn_unit(const bf16_t* __restrict__ Qb, const bf16_t* __restrict__ Kh, const bf16_t* __restrict__ Krp,
                                          const bf16_t* __restrict__ Vh, bf16_t* __restrict__ Ob, char* lds) {
  constexpr float SCALE = (DK == 128) ? 0.088388347648318440f : 0.072168783648703220f;
  constexpr float C = SCALE * 1.4426950408889634f, THRS = THR / SCALE;
  constexpr int ND = DK / 16, NQR = (DK == 128) ? 8 : 6;
  const int tid = threadIdx.x, wid = tid >> 6, lane = tid & 63, r32 = lane & 31, hi = lane >> 5;
  char* V_lds = lds + OFF_V; char* K_lds = lds + OFF_K; char* KR_lds = lds + OFF_KR;
  float* ws = (float*)(lds + OFF_WS) + wid * 64; float* li_l = ws; float* al_l = ws + 32;
  float m_reg = -1e30f, l_reg = 0; f32x16 o[4] = {}; bf16x8 qr[NQR];
  const bf16_t* Qw = Qb + (long)(wid * QBLK + r32) * ldq + hi * 8;
#pragma unroll
  for (int d0 = 0; d0 < NQR; ++d0) qr[d0] = *reinterpret_cast<const bf16x8*>(Qw + d0 * 16);
  char* qrl = lds + OFF_QR + wid * QR_WAVE + lane * 16;
#pragma unroll
  for (int d0 = NQR; d0 < ND; ++d0) *reinterpret_cast<bf16x8*>(qrl + (d0 - NQR) * 1024) = *reinterpret_cast<const bf16x8*>(Qw + d0 * 16);
  const int sr = tid >> 4, sc = (tid & 15) * 8, vst0 = v_st(sr, sc), vst1 = v_st(32 + sr, sc);
  const int krr = tid >> 3, krc = (tid & 7) * 8;
  const int vb0 = (int)(uintptr_t)V_lds + v_rd_base(lane);
  bf16x8 vs0[SDEPTH], vs1[SDEPTH], ks0[SDEPTH], ks1[SDEPTH], kr0[SDEPTH];
  const unsigned voffV = (unsigned)((sr * ldv + sc) * 2), voffK = (unsigned)((sr * ldk + sc) * 2), voffR = (unsigned)((krr * 64 + krc) * 2);
#define SLOAD(i, k0) do { const char* vb_ = (const char*)Vh + (size_t)(k0) * (ldv * 2); const char* kb_ = (const char*)Kh + (size_t)(k0) * (ldk * 2); \
    vs0[i] = *(const bf16x8*)(vb_ + voffV); vs1[i] = *(const bf16x8*)(vb_ + 32 * ldv * 2 + voffV); \
    ks0[i] = *(const bf16x8*)(kb_ + voffK); ks1[i] = *(const bf16x8*)(kb_ + 32 * ldk * 2 + voffK); \
    if constexpr (DK == 192) kr0[i] = *(const bf16x8*)((const char*)Krp + (size_t)(k0) * 128 + voffR); } while (0)
#define SWRITE(b, i) do { *(bf16x8*)(V_lds + (b) * SHM_V + vst0) = vs0[i];          \
    *(bf16x8*)(V_lds + (b) * SHM_V + vst1) = vs1[i]; int kc = sc * 2;               \
    *(bf16x8*)(K_lds + (b) * SHM_K + KSWZ(sr, kc)) = ks0[i];                       \
    *(bf16x8*)(K_lds + (b) * SHM_K + KSWZ(32 + sr, kc)) = ks1[i];                  \
    if constexpr (DK == 192) *(bf16x8*)(KR_lds + (b) * SHM_KR + KRSWZ(krr, krc * 2)) = kr0[i]; } while (0)
#define SWAIT() do { if constexpr (SDEPTH == 1) asm volatile("s_waitcnt vmcnt(0)" ::: "memory"); else if constexpr (DK == 192) asm volatile("s_waitcnt vmcnt(5)" ::: "memory"); else asm volatile("s_waitcnt vmcnt(4)" ::: "memory"); } while (0)
#define RESC(a) do { if (__any((a) < 1.f)) { if (hi == 0) al_l[r32] = (a); asm volatile("s_waitcnt lgkmcnt(0)" ::: "memory"); \
    _Pragma("unroll") for (int d = 0; d < 4; ++d) _Pragma("unroll") for (int r = 0; r < 16; ++r) o[d][r] *= al_l[crow(r, hi)]; } } while (0)
  f32x16 pA0, pA1, pB0, pB1; float mnA, mnB, alA, alB; bf16x8 pa0, pa1, pa2, pa3; const int NT = seq / KVBLK;
  constexpr int SE = 0, SO = SDEPTH - 1;
  SLOAD(SE, 0); asm volatile("s_waitcnt vmcnt(0)" ::: "memory"); SWRITE(0, SE); __syncthreads();
  qkt<DK, NQR>(pA0, pA1, K_lds, KR_lds, qr, qrl, r32, hi); partialSM(pA0, pA1, m_reg, mnA, alA, C, THRS);
  SLOAD(SO, KVBLK); if constexpr (SDEPTH == 2) { if (2 < NT) SLOAD(SE, 2 * KVBLK); }
  SWAIT(); SWRITE(1, SO); __syncthreads();
  for (int j = 1; j + 1 < NT; j += 2) {
    SBAR(); qkt<DK, NQR>(pB0, pB1, K_lds + SHM_K, KR_lds + SHM_KR, qr, qrl, r32, hi);
    finishSM(pA0, pA1, alA, l_reg, pa0, pa1, pa2, pa3); SBAR();
    SLOAD(SO, (j + SDEPTH) * KVBLK); SBAR();
    pv_d0(o, vb0, pa0, pa1, pa2, pa3); partialSM(pB0, pB1, m_reg, mnB, alB, C, THRS);
    __syncthreads(); SWAIT(); SWRITE(0, SE);
    RESC(alB); __syncthreads();
    SBAR(); qkt<DK, NQR>(pA0, pA1, K_lds, KR_lds, qr, qrl, r32, hi);
    finishSM(pB0, pB1, alB, l_reg, pa0, pa1, pa2, pa3); SBAR();
    if (SDEPTH == 1 || j + 3 < NT) SLOAD(SE, (j + 1 + SDEPTH) * KVBLK); SBAR();
    pv_d0(o, vb0 + SHM_V, pa0, pa1, pa2, pa3); partialSM(pA0, pA1, m_reg, mnA, alA, C, THRS);
    __syncthreads(); SWAIT(); SWRITE(1, SO);
    RESC(alA); __syncthreads();
  }
  SBAR(); qkt<DK, NQR>(pB0, pB1, K_lds + SHM_K, KR_lds + SHM_KR, qr, qrl, r32, hi);
  finishSM(pA0, pA1, alA, l_reg, pa0, pa1, pa2, pa3); SBAR();
  pv_d0(o, vb0, pa0, pa1, pa2, pa3); partialSM(pB0, pB1, m_reg, mnB, alB, C, THRS);
  __syncthreads(); RESC(alB);
  finishSM(pB0, pB1, alB, l_reg, pa0, pa1, pa2, pa3); SBAR();
  pv_d0(o, vb0 + SHM_V, pa0, pa1, pa2, pa3);
  if (hi == 0) li_l[r32] = l_reg; asm volatile("s_waitcnt lgkmcnt(0)" ::: "memory");
  float rli[16];
#pragma unroll
  for (int r = 0; r < 16; ++r) rli[r] = __builtin_amdgcn_rcpf(li_l[crow(r, hi)]);
  bf16_t* Ow = Ob + (long)(wid * QBLK) * ldo;
#pragma unroll
  for (int r = 0; r < 16; ++r) { int orow = crow(r, hi);
#pragma unroll
    for (int d0 = 0; d0 < 4; ++d0) Ow[(long)orow * ldo + d0 * 32 + r32] = f2bf(o[d0][r] * rli[r]); }
#undef SLOAD
#undef SWRITE
#undef SWAIT
#undef RESC
}
}

struct TrItem { const float* W; bf16_t* WT; int ldw, k0, n0, ldt, drow0, dk0; const float* gain; };
__device__ __forceinline__ void tr_load(f32x4 (&v)[16], const TrItem& t, int lane) {
    const int lr = lane >> 4, lc = (lane & 15) * 4;
#pragma unroll
    for (int i = 0; i < 16; ++i) v[i] = *(const f32x4*)(t.W + (size_t)(t.k0 + 4 * i + lr) * t.ldw + t.n0 + lc);
}
__device__ __forceinline__ void tr_store(const f32x4 (&v)[16], const TrItem& t, LAS float* scr, int lane) {
    const int lr = lane >> 4, lc = (lane & 15) * 4;
#pragma unroll
    for (int i = 0; i < 16; ++i) { LAS float* d = scr + (4 * i + lr) * 65 + lc; const float gk = t.gain ? t.gain[t.k0 + 4 * i + lr] : 1.f;
        d[0] = v[i].x * gk; d[1] = v[i].y * gk; d[2] = v[i].z * gk; d[3] = v[i].w * gk; }
    asm volatile("s_waitcnt lgkmcnt(0)" ::: "memory");
    const int c = lane & 7;
#pragma unroll
    for (int j = 0; j < 8; ++j) { const int n = (lane >> 3) + 8 * j; const LAS float* s = scr + (8 * c) * 65 + n;
        u32x4 o; o.x = cvt_pk_bf16(s[0], s[65]); o.y = cvt_pk_bf16(s[130], s[195]); o.z = cvt_pk_bf16(s[260], s[325]); o.w = cvt_pk_bf16(s[390], s[455]);
        *(u32x4*)(t.WT + (size_t)(t.drow0 + n) * t.ldt + t.dk0 + 8 * c) = o; }
    asm volatile("s_waitcnt lgkmcnt(0)" ::: "memory");
}
__device__ __forceinline__ void tr_item(const float* __restrict__ W, int ldw, int k0, int n0, bf16_t* __restrict__ WT, int ldt, int drow0, int dk0, LAS float* scr, int lane) {
    TrItem t{W, WT, ldw, k0, n0, ldt, drow0, dk0, nullptr}; f32x4 v[16]; tr_load(v, t, lane); tr_store(v, t, scr, lane);
}
__device__ __forceinline__ void rms_row_to_bf16(const float* __restrict__ xrow, const float* __restrict__ g, bf16_t* __restrict__ orow, int lane) {
    f32x4 v[8]; float s = 0.f;
#pragma unroll
    for (int j = 0; j < 8; ++j) { v[j] = *(const f32x4*)(xrow + 4 * lane + 256 * j); s += (v[j].x * v[j].x + v[j].y * v[j].y) + (v[j].z * v[j].z + v[j].w * v[j].w); }
    const float r = 1.0f / sqrtf(wave_sum(s) * (1.f / DM) + EPS);
#pragma unroll
    for (int j = 0; j < 8; ++j) { const f32x4 gg = *(const f32x4*)(g + 4 * lane + 256 * j);
        u32x2 o; o.x = cvt_pk_bf16(v[j].x * r * gg.x, v[j].y * r * gg.y); o.y = cvt_pk_bf16(v[j].z * r * gg.z, v[j].w * r * gg.w);
        *(u32x2*)(orow + 4 * lane + 256 * j) = o; }
}

__device__ __forceinline__ unsigned q8(float v) { int q = (int)__builtin_rintf(v); q = q < -127 ? -127 : (q > 127 ? 127 : q); return (unsigned)q & 0xffu; }
__device__ __forceinline__ unsigned q8x4(float a, float b, float c, float d) { return q8(a) | (q8(b) << 8) | (q8(c) << 16) | (q8(d) << 24); }
__device__ __forceinline__ void tr_item8(const float* __restrict__ W, int ldw, int k0, int n0, unsigned char* __restrict__ WT8, int ldt, int drow0, int dk0, LAS float* scr, int lane) {
    const int lr = lane >> 4, lc = (lane & 15) * 4;
    f32x4 v[16];
#pragma unroll
    for (int i = 0; i < 16; ++i) v[i] = *(const f32x4*)(W + (size_t)(k0 + 4 * i + lr) * ldw + n0 + lc);
#pragma unroll
    for (int i = 0; i < 16; ++i) { LAS float* d = scr + (4 * i + lr) * 65 + lc; d[0] = v[i].x * Q8_SW; d[1] = v[i].y * Q8_SW; d[2] = v[i].z * Q8_SW; d[3] = v[i].w * Q8_SW; }
    asm volatile("s_waitcnt lgkmcnt(0)" ::: "memory");
    const int c = lane & 7;
#pragma unroll
    for (int j = 0; j < 8; ++j) { const int n = (lane >> 3) + 8 * j; const LAS float* s = scr + (8 * c) * 65 + n;
        u32x2 o; o.x = q8x4(s[0], s[65], s[130], s[195]); o.y = q8x4(s[260], s[325], s[390], s[455]);
        *(u32x2*)(WT8 + (size_t)(drow0 + n) * ldt + dk0 + 8 * c) = o; }
    asm volatile("s_waitcnt lgkmcnt(0)" ::: "memory");
}
__device__ __forceinline__ void rms_row_to_i8(const float* __restrict__ xrow, const float* __restrict__ g, unsigned char* __restrict__ orow, int lane) {
    f32x4 v[8]; float s = 0.f;
#pragma unroll
    for (int j = 0; j < 8; ++j) { v[j] = *(const f32x4*)(xrow + 4 * lane + 256 * j); s += (v[j].x * v[j].x + v[j].y * v[j].y) + (v[j].z * v[j].z + v[j].w * v[j].w); }
    const float r = Q8_SU / sqrtf(wave_sum(s) * (1.f / DM) + EPS);
#pragma unroll
    for (int j = 0; j < 8; ++j) { const f32x4 gg = *(const f32x4*)(g + 4 * lane + 256 * j);
        *(unsigned*)(orow + 4 * lane + 256 * j) = q8x4(v[j].x * r * gg.x, v[j].y * r * gg.y, v[j].z * r * gg.z, v[j].w * r * gg.w); }
}

#define XB_TMO      128
#define XB_XCNT(j)  (256  + 64 * (j))
#define XB_XSUB(j)  (1280 + 64 * (j))
#define XB_XGEN(j)  (2304 + 64 * (j))
#define XB_TOP      3328
#define XB_TOPGEN   3392
#define XCD_BAR_WORDS 3456
#define XB_SPIN_CAP (1u << 18)
__device__ __forceinline__ unsigned xb_ld(unsigned* p)              { return __hip_atomic_load(p, __ATOMIC_RELAXED, __HIP_MEMORY_SCOPE_AGENT); }
__device__ __forceinline__ unsigned xb_add(unsigned* p, unsigned v) { return __hip_atomic_fetch_add(p, v, __ATOMIC_RELAXED, __HIP_MEMORY_SCOPE_AGENT); }
__device__ __forceinline__ unsigned xb_xcc_id() { return (unsigned)__builtin_amdgcn_s_getreg((3 << 11) | 20) & 0xFu; }
#define XB_SPIN(cond, bar) do { unsigned _sp = 0; while (cond) { __builtin_amdgcn_s_sleep(1); \
    if ((++_sp & 255u) == 0u) { if (xb_ld(&(bar)[XB_TMO])) break; if (_sp > XB_SPIN_CAP) { atomicAdd(&(bar)[XB_TMO], 1u); break; } } } } while (0)
struct XcdBarrier { unsigned* bar; unsigned x; volatile LAS unsigned* st; };
__device__ __forceinline__ XcdBarrier xcd_barrier_post(unsigned* bar, volatile LAS unsigned* st) {
    XcdBarrier b; b.bar = bar; b.x = xb_xcc_id(); b.st = st;
    if (threadIdx.x == 0) (void)xb_add(&bar[XB_XCNT(b.x)], 1u);
    return b;
}
__device__ __forceinline__ void xcd_barrier_complete(unsigned* bar, unsigned x, unsigned& nloc, unsigned& nx) {
    const unsigned G = gridDim.x * gridDim.y * gridDim.z;
    unsigned sum, cnt, mine, sp = 0u;
    for (;;) {
        sum = 0u; cnt = 0u; mine = 0u;
#pragma unroll
        for (unsigned j = 0; j < 16; ++j) { const unsigned c = xb_ld(&bar[XB_XCNT(j)]); sum += c; cnt += (c > 0u) ? 1u : 0u; mine = (j == x) ? c : mine; }
        if (sum == G) break;
        __builtin_amdgcn_s_sleep(1);
        if ((++sp & 255u) == 0u) { if (xb_ld(&bar[XB_TMO])) break; if (sp > XB_SPIN_CAP) { atomicAdd(&bar[XB_TMO], 1u); break; } }
    }
    nloc = mine > 0u ? mine : 1u; nx = cnt > 0u ? cnt : 1u;
}
__device__ __forceinline__ void xcd_barrier(const XcdBarrier& b) {
    asm volatile("s_waitcnt vmcnt(0)" ::: "memory");
    __syncthreads();
    if (threadIdx.x == 0) {
        unsigned* bar = b.bar;
        __builtin_amdgcn_s_waitcnt(0);
        unsigned nloc = b.st[0], nx = b.st[1];
        if (nloc == 0u) { xcd_barrier_complete(bar, b.x, nloc, nx); b.st[0] = nloc; b.st[1] = nx; }
        const unsigned old = xb_add(&bar[XB_XSUB(b.x)], 1u);
        const unsigned gen = old / nloc;
        if (old + 1u == (gen + 1u) * nloc) {
            __builtin_amdgcn_fence(__ATOMIC_RELEASE, "agent");
            asm volatile("s_waitcnt vmcnt(0)" ::: "memory");
            const unsigned og = xb_add(&bar[XB_TOP], 1u);
            const unsigned tg = og / nx;
            if (og + 1u == (tg + 1u) * nx) xb_add(&bar[XB_TOPGEN], 1u);
            else XB_SPIN(xb_ld(&bar[XB_TOPGEN]) == tg, bar);
            __builtin_amdgcn_fence(__ATOMIC_ACQUIRE, "agent");
            xb_add(&bar[XB_XGEN(b.x)], 1u);
            asm volatile("s_waitcnt vmcnt(0)" ::: "memory");
        } else {
            XB_SPIN(xb_ld(&bar[XB_XGEN(b.x)]) == gen, bar);
            __builtin_amdgcn_fence(__ATOMIC_ACQUIRE, "agent");
            asm volatile("s_waitcnt vmcnt(0)" ::: "memory");
        }
    }
    __syncthreads();
}

struct Args {
    const float *x, *p, *g_mix, *w_in, *q_norm_a, *k_norm_a, *q_a_norm, *w_q_b, *kv_a_norm, *w_kv_b, *w_a_out, *w_b_out, *w_o, *g_ffn, *w_gate_up, *w_down, *g_ple,
                *w_ple_gate, *w_ple_proj, *g_ple_post, *g_final;
    float* out; unsigned char* ws; int ph_lo, ph_hi;
};

constexpr int NPHASE = 14;

__global__ void __launch_bounds__(NTHREADS, 2) mk_fwd(Args a) {
    extern __shared__ __attribute__((aligned(16))) unsigned char lds_raw[];
    LAS unsigned char* lds = (LAS unsigned char*)lds_raw;
    const int tid = threadIdx.x, lane = tid & 63, wave = __builtin_amdgcn_readfirstlane(tid >> 6);
    const int G = gridDim.x, bx = blockIdx.x;
    const int gw = bx * NWAVES + wave, NGW = G * NWAVES;
    unsigned char* ws = a.ws;
    bf16_t* WinT = (bf16_t*)(ws + WS_WIN); bf16_t* WqbT = (bf16_t*)(ws + WS_WQB); bf16_t* WkvbT = (bf16_t*)(ws + WS_WKVB); bf16_t* WabT = (bf16_t*)(ws + WS_WAB);
    bf16_t* WoT = (bf16_t*)(ws + WS_WO); bf16_t* WguT = (bf16_t*)(ws + WS_WGU); bf16_t* WdT = (bf16_t*)(ws + WS_WD); bf16_t* WpgT = (bf16_t*)(ws + WS_WPG);
    bf16_t* WppT = (bf16_t*)(ws + WS_WPP); bf16_t* PB = (bf16_t*)(ws + WS_PB); bf16_t* KR = (bf16_t*)(ws + WS_KR); bf16_t* U = (bf16_t*)(ws + WS_U);
    bf16_t* ZS = (bf16_t*)(ws + WS_ZS); bf16_t* SG = (bf16_t*)(ws + WS_SG); bf16_t* QA = (bf16_t*)(ws + WS_QA); bf16_t* QB = (bf16_t*)(ws + WS_QB);
    bf16_t* KVB = (bf16_t*)(ws + WS_KVB); bf16_t* CQN = (bf16_t*)(ws + WS_CQN); bf16_t* CKVN = (bf16_t*)(ws + WS_CKVN); bf16_t* KA = (bf16_t*)(ws + WS_KA);
    bf16_t* KPE = (bf16_t*)(ws + WS_KPE); bf16_t* OAB = (bf16_t*)(ws + WS_OAB); bf16_t* MERGED = (bf16_t*)(ws + WS_MERGED); bf16_t* ACT = (bf16_t*)(ws + WS_ACT);
    bf16_t* GATE = (bf16_t*)(ws + WS_GATE); bf16_t* ERAW = (bf16_t*)(ws + WS_ERAW); float* H = a.out;
    float* SSQC = (float*)(ws + 196608); float* SSQK = (float*)(ws + 229376);
    float* SSQ1 = (float*)(ws + 65536); float* SSQ2 = (float*)(ws + 131072);
    const int lo = a.ph_lo, hi = a.ph_hi;
#define IN(k) (lo <= (k) && (k) < hi)
#define SEAM(k) do { if (IN(k) && IN((k) + 1)) { xcd_barrier(xbar); } } while (0)
    volatile LAS unsigned* xst = (volatile LAS unsigned*)(lds + LDS_BYTES - 64);
    if (tid == 0) { xst[0] = 0u; xst[1] = 0u; }
    __syncthreads();
    XcdBarrier xbar = xcd_barrier_post((unsigned*)ws, xst);
    if (a.ph_lo < 0) cg::this_grid().sync();

    constexpr int I0 = 32 * 105, I1 = 8 * 24, I2 = 8 * 32, I3 = 16 * 32, I4 = 16 * 32, I5 = 32 * 32, I6 = 32 * 176, I7 = 88 * 32, I8 = 32 * 32, I9 = 4 * 32;
    constexpr int NREST = I1 + I2 + I3 + I4 + I5 + I6 + I7 + I8 + I9;
    if (IN(0)) {
        LAS float* scr = (LAS float*)(lds + wave * 16640);
        for (int it = gw; it < I0; it += NGW) {
            const int kb = it / 105, nb = it % 105, n0 = nb * 64; const int dr = n0 < 2560 ? n0 : (n0 < 2624 ? 6656 + (n0 - 2560) : n0 - 64);
            tr_item8(a.w_in, NIN, kb * 64, n0, (unsigned char*)WinT, 2048, dr, kb * 64, scr, lane);
        }
        for (int m = gw; m < M; m += NGW) {
            rms_row_to_i8(a.x + (size_t)m * DM, a.g_mix, (unsigned char*)U + (size_t)m * DM, lane);
            const f32x4 pv = *(const f32x4*)(a.p + (size_t)m * PLE + 4 * lane);
            u32x2 o; o.x = cvt_pk_bf16(pv.x, pv.y); o.y = cvt_pk_bf16(pv.z, pv.w);
            *(u32x2*)(PB + (size_t)m * PLE + 4 * lane) = o;
        }
        for (int i = bx * NTHREADS + tid; i < (NINP - NIN) * 2048 / 16; i += G * NTHREADS) *(u32x4*)((unsigned char*)WinT + (size_t)NIN * 2048 + (size_t)i * 16) = (u32x4){0u, 0u, 0u, 0u};
        __syncthreads();
    }
    SEAM(0);
    if (IN(1)) {
        constexpr int NU = (M / 256) * (NINP / 256);
        const int GG = (G >= 256) ? 173 : G;
        if (bx < GG) {
            pg8::Gemm g{U, WinT, M, NINP, DM / 2, DM / 2, 0}; pg8::StaticOrder S; S.init(M, NINP, GG, bx);
            pg8::EpiIn E{ZS, SG, KR, SSQC, SSQK};
            pg8::gemm_phase<pg8::EpiIn, pg8::StaticOrder, true, true, false, true>(lds, g, S, E);
        }
        {
            {
                LAS float* scr = (LAS float*)(lds + wave * 16640);
                unsigned* qctr = (unsigned*)(ws + 262144);
                auto decode = [&](int r) -> TrItem {
                    if (r < I1) { const int kb = r / 24, nb = r % 24; return TrItem{a.w_q_b, WqbT, 1536, kb * 64, nb * 64, 512, nb * 64, kb * 64, a.q_a_norm}; } r -= I1;
                    if (r < I2) { const int kb = r / 32, nb = r % 32; return TrItem{a.w_kv_b, WkvbT, 2048, kb * 64, nb * 64, 512, nb * 64, kb * 64, a.kv_a_norm}; } r -= I2;
                    if (r < I3) { const int kb = r / 32, nb = r % 32; return TrItem{a.w_a_out, WabT, 2048, kb * 64, nb * 64, 2048, nb * 64, kb * 64, nullptr}; } r -= I3;
                    if (r < I4) { const int kb = r / 32, nb = r % 32; return TrItem{a.w_b_out, WabT, 2048, kb * 64, nb * 64, 2048, nb * 64, 1024 + kb * 64, nullptr}; } r -= I4;
                    if (r < I5) { const int kb = r / 32, nb = r % 32; return TrItem{a.w_o, WoT, 2048, kb * 64, nb * 64, 2048, nb * 64, kb * 64, nullptr}; } r -= I5;
                    if (r < I6) { const int kb = r / 176, nb = r % 176, n0 = nb * 64; const int s_ = n0 >= DFF ? 1 : 0, j = n0 - s_ * DFF; const int dr = 256 * (j >> 7) + 128 * s_ + (j & 127);
                        return TrItem{a.w_gate_up, WguT, 2 * DFF, kb * 64, n0, 2048, dr, kb * 64, a.g_ffn}; } r -= I6;
                    if (r < I7) { const int kb = r / 32, nb = r % 32; return TrItem{a.w_down, WdT, 2048, kb * 64, nb * 64, DFF, nb * 64, kb * 64, nullptr}; } r -= I7;
                    if (r < I8) { const int kb = r / 32, nb = r % 32; return TrItem{a.w_ple_gate, WpgT, 2048, kb * 64, nb * 64, 2048, nb * 64, kb * 64, a.g_ple}; } r -= I8;
                    { const int kb = r / 32, nb = r % 32; return TrItem{a.w_ple_proj, WppT, 2048, kb * 64, nb * 64, 256, nb * 64, kb * 64, nullptr}; }
                };
                auto grab = [&]() -> int { unsigned v = 0u; if (lane == 0) v = __hip_atomic_fetch_add((__attribute__((address_space(1))) unsigned*)qctr, 1u, __ATOMIC_RELAXED, __HIP_MEMORY_SCOPE_AGENT); return (int)__builtin_amdgcn_readfirstlane(v); };
                f32x4 va[16], vb[16]; TrItem ta{}, tb{};
                int it = grab();
                if (it < NREST) { ta = decode(it); tr_load(va, ta, lane); }
                while (it < NREST) {
                    int it2 = grab(); if (it2 < NREST) { tb = decode(it2); tr_load(vb, tb, lane); }
                    tr_store(va, ta, scr, lane);
                    it = it2; if (it >= NREST) break;
                    it2 = grab(); if (it2 < NREST) { ta = decode(it2); tr_load(va, ta, lane); }
                    tr_store(vb, tb, scr, lane);
                    it = it2;
                }
            }
            __syncthreads();
        }
        (void)NU;
    }
    SEAM(1);
    if (IN(2)) {
        const int l5 = lane & 31, hsel = lane >> 5, d0 = l5 * 4, isx2 = (l5 >> 3) & 1, halfc = (l5 >> 4) & 1;
        float invA4[4]; f32x4 gq, gk;
#pragma unroll
        for (int i = 0; i < 4; ++i) invA4[i] = powf(10000.f, -(float)(2 * ((d0 & 31) + i)) / 64.f);
        gq = *(const f32x4*)(a.q_norm_a + d0); gk = *(const f32x4*)(a.k_norm_a + d0);
        const int hfb = (lane >> 4) & 1, jb = lane & 15;
        const float invB = powf(10000.f, -(float)(2 * jb) / 32.f);
        for (int m = gw; m < M; m += NGW) {
            const int s = m & (SEQ - 1); const float prow = (float)(s >> 6), pcol = (float)(s & 63);
            const float posA = halfc ? pcol : prow; float cA[4], sA[4];
#pragma unroll
            for (int i = 0; i < 4; ++i) { const float ang = posA * invA4[i]; cA[i] = cosf(ang); sA[i] = sinf(ang); }
            const bf16_t* zr = ZS + (size_t)m * 2560;
#pragma unroll
            for (int it = 0; it < 5; ++it) {
                const int head = 2 * it + hsel;
                const u32x2 w = *(const u32x2*)(zr + head * 128 + d0);
                const float x[4] = {bf_lo(w.x), bf_hi(w.x), bf_lo(w.y), bf_hi(w.y)};
                float ss = (x[0] * x[0] + x[1] * x[1]) + (x[2] * x[2] + x[3] * x[3]);
#pragma unroll
                for (int o2 = 1; o2 < 32; o2 <<= 1) ss += __shfl_xor(ss, o2);
                const float r = 1.0f / sqrtf(ss * (1.f / 128.f) + EPS);
                const f32x4 g = (it < 4) ? gq : gk; float o[4];
#pragma unroll
                for (int i = 0; i < 4; ++i) { const float y = x[i] * r * g[i]; const float p = __shfl_xor(y, 8);
                    o[i] = isx2 ? (y * cA[i] + p * sA[i]) : (y * cA[i] - p * sA[i]); }
                u32x2 ow; ow.x = cvt_pk_bf16(o[0], o[1]); ow.y = cvt_pk_bf16(o[2], o[3]);
                bf16_t* dst = (it < 4) ? (QA + (size_t)m * 1024 + head * 128 + d0) : (KA + (size_t)m * 256 + (head - 8) * 128 + d0);
                *(u32x2*)dst = ow;
            }
            if (lane < 32) {
                const float angB = (hfb ? pcol : prow) * invB; const float cB = cosf(angB), sB = sinf(angB);
                const bf16_t* kr = KR + (size_t)m * 64 + hfb * 32 + jb;
                const float x1 = bf1(kr[0]), x2 = bf1(kr[16]);
                bf16_t* dst = KPE + (size_t)m * 64 + hfb * 32 + jb;
                dst[0] = f2bf(x1 * cB - x2 * sB); dst[16] = f2bf(x2 * cB + x1 * sB);
            }
        }
    }
    if (IN(3)) {
        { pg8::Gemm g{ZS + 1536, WqbT, M, 1536, 512, 512, 0, 2560}; pg8::StaticOrder S; S.init(M, 1536, G, bx); pg8::EpiQB E{QB, SSQC};
          pg8::gemm_phase<pg8::EpiQB, pg8::StaticOrder, true, true, false>(lds, g, S, E); }
        { pg8::Gemm g{ZS + 2048, WkvbT, M, 2048, 512, 512, 0, 2560}; pg8::StaticOrder S; S.init(M, 2048, G, bx); pg8::EpiBf16<0> E{KVB, 2048, SSQK, 1.f / 512.f};
          pg8::gemm_phase<pg8::EpiBf16<0>, pg8::StaticOrder, true, true, false>(lds, g, S, E); }
    }
    SEAM(3);
    if (IN(5)) {
        char* lds_g = (char*)lds_raw;
        const int x = bx & 7, i = bx >> 3;
        for (int c = bx; c < 256; c += G) {
            const int xx = c & 7, ii = c >> 3;
            {
                const int combo = xx >> 1, w = (xx & 1) * 32 + ii, b = combo >> 1, kvh = combo & 1, hq = kvh * 4 + (w >> 4), qb = w & 15;
                const size_t row0 = (size_t)b * SEQ;
                __syncthreads();
                att::attn_unit<128, ATT_SD_A, 1024, 256, 2560, 2048, SEQ>(QA + (row0 + qb * 256) * 1024 + hq * 128, KA + row0 * 256 + kvh * 128, nullptr,
                                    ZS + row0 * 2560 + 1280 + kvh * 128, OAB + (row0 + qb * 256) * 2048 + hq * 128, lds_g);
            }
            {
                const int unit = xx * 32 + ii, bh = unit >> 4, qb = unit & 15, b = bh >> 3, h = bh & 7;
                const size_t row0 = (size_t)b * SEQ;
                __syncthreads();
                att::attn_unit<192, ATT_SD_B, 1536, 2048, 2048, 2048, SEQ>(QB + (row0 + qb * 256) * 1536 + h * 192, KVB + row0 * 2048 + h * 256, KPE + row0 * 64,
                                    KVB + row0 * 2048 + h * 256 + 128, OAB + (row0 + qb * 256) * 2048 + 1024 + h * 128, lds_g);
            }
        }
        (void)x; (void)i;
        __syncthreads();
    }
    SEAM(5);
    if (IN(6)) {
        bf16_t* T1 = (bf16_t*)(ws + WS_T1);
        { pg8::Gemm g{OAB, WabT, M, 2048, 1024, 2048, 0}; pg8::StaticOrder S; S.init(M, 2048, G, bx); pg8::EpiGate<false> E{SG, T1, MERGED};
          pg8::gemm_phase<pg8::EpiGate<false>, pg8::StaticOrder, true, true, false>(lds, g, S, E); }
        { pg8::Gemm g{OAB + 1024, WabT + 1024, M, 2048, 1024, 2048, 0}; pg8::StaticOrder S; S.init(M, 2048, G, bx); pg8::EpiGate<true> E{SG, T1, MERGED};
          pg8::gemm_phase<pg8::EpiGate<true>, pg8::StaticOrder, true, true, false>(lds, g, S, E); }
    }
    SEAM(6);
    if (IN(7)) {
        pg8::Gemm g{MERGED, WoT, M, 2048, 2048, 2048, 0}; pg8::StaticOrder S; S.init(M, 2048, G, bx); pg8::EpiResid<false> E{a.x, nullptr, U, SSQ1};
        pg8::gemm_phase<pg8::EpiResid<false>, pg8::StaticOrder, true, true, false>(lds, g, S, E);
    }
    SEAM(7);
    if (IN(9)) {
        pg8::Gemm g{U, WguT, M, 2 * DFF, DM, DM, 0}; pg8::StaticOrder S; S.init(M, 2 * DFF, G, bx); pg8::EpiSwiglu E{ACT, SSQ1};
        pg8::gemm_phase<pg8::EpiSwiglu, pg8::StaticOrder, true, true, false>(lds, g, S, E);
        {
            constexpr int NU = (M / 256) * (2 * DFF / 256);
            const int nr = (NU + G - 1) / G, nbusy = NU - (nr - 1) * G; int idx = bx - nbusy, cnt = G - nbusy; if (cnt < 32) { idx = bx; cnt = G; }
            if (idx >= 0) { pg8::Gemm g2{PB, WppT, M, 2048, PLE, PLE, 0}; pg8::StaticOrder S2; S2.init(M, 2048, cnt, idx); pg8::EpiBf16<0> E2{ERAW, 2048, nullptr, 0.f};
                pg8::gemm_phase<pg8::EpiBf16<0>, pg8::StaticOrder, true, true, false>(lds, g2, S2, E2); }
        }
    }
    SEAM(9);
    if (IN(10)) {
        pg8::Gemm g{ACT, WdT, M, 2048, DFF, DFF, 0}; pg8::StaticOrder S; S.init(M, 2048, G, bx); pg8::EpiResid<true> E{nullptr, U, U, SSQ2};
        pg8::gemm_phase<pg8::EpiResid<true>, pg8::StaticOrder, true, true, false>(lds, g, S, E);
    }
    SEAM(10);
    if (IN(12)) {
        { pg8::Gemm g{U, WpgT, M, 2048, DM, DM, 0}; pg8::StaticOrder S; S.init(M, 2048, G, bx); pg8::EpiBf16<1> E{GATE, 2048, SSQ2, 1.f / DM};
          pg8::gemm_phase<pg8::EpiBf16<1>, pg8::StaticOrder, true, true, false>(lds, g, S, E); }
    }
    SEAM(12);
    if (IN(13)) {
        u32x2 nh[8], ne[8], ng[8];
        int m = gw;
        if (m < M) {
#pragma unroll
            for (int j = 0; j < 8; ++j) { const size_t o = (size_t)m * DM + 4 * lane + 256 * j; nh[j] = *(const u32x2*)(U + o); ne[j] = *(const u32x2*)(ERAW + o); ng[j] = *(const u32x2*)(GATE + o); }
        }
        for (; m < M; m += NGW) {
            f32x4 h[8], e[8]; u32x2 gtw[8]; float se = 0.f;
#pragma unroll
            for (int j = 0; j < 8; ++j) { h[j] = (f32x4){bf_lo(nh[j].x), bf_hi(nh[j].x), bf_lo(nh[j].y), bf_hi(nh[j].y)}; e[j] = (f32x4){bf_lo(ne[j].x), bf_hi(ne[j].x), bf_lo(ne[j].y), bf_hi(ne[j].y)}; gtw[j] = ng[j];
                se += (e[j].x * e[j].x + e[j].y * e[j].y) + (e[j].z * e[j].z + e[j].w * e[j].w); }
            const int m2 = m + NGW;
            if (m2 < M) {
#pragma unroll
                for (int j = 0; j < 8; ++j) { const size_t o = (size_t)m2 * DM + 4 * lane + 256 * j; nh[j] = *(const u32x2*)(U + o); ne[j] = *(const u32x2*)(ERAW + o); ng[j] = *(const u32x2*)(GATE + o); }
            }
            const float re = 1.0f / sqrtf(wave_sum(se) * (1.f / DM) + EPS);
            float sh = 0.f;
#pragma unroll
            for (int j = 0; j < 8; ++j) { const u32x2 gt = gtw[j];
                const f32x4 gp = *(const f32x4*)(a.g_ple_post + 4 * lane + 256 * j);
                h[j].x += bf_lo(gt.x) * (e[j].x * re * gp.x); h[j].y += bf_hi(gt.x) * (e[j].y * re * gp.y);
                h[j].z += bf_lo(gt.y) * (e[j].z * re * gp.z); h[j].w += bf_hi(gt.y) * (e[j].w * re * gp.w);
                sh += (h[j].x * h[j].x + h[j].y * h[j].y) + (h[j].z * h[j].z + h[j].w * h[j].w); }
            const float rh = 1.0f / sqrtf(wave_sum(sh) * (1.f / DM) + EPS);
#pragma unroll
            for (int j = 0; j < 8; ++j) { const f32x4 gf = *(const f32x4*)(a.g_final + 4 * lane + 256 * j);
                f32x4 o; o.x = h[j].x * rh * gf.x; o.y = h[j].y * rh * gf.y; o.z = h[j].z * rh * gf.z; o.w = h[j].w * rh * gf.w;
                *(f32x4*)(a.out + (size_t)m * DM + 4 * lane + 256 * j) = o;
            }
        }
    }
#undef IN
#undef SEAM
}

extern "C" void kernel_launch(void* const* d_in, const int* in_sizes, int n_in, void* d_out, int out_size, void* d_ws, size_t ws_size, hipStream_t stream) {
    static int grid = 0;
    if (grid == 0) {
        if (n_in != 21 || in_sizes[0] != M * DM || out_size != M * DM || ws_size < WS_END) {
            fprintf(stderr, "kernel_launch: unexpected shapes: n_in %d in0 %d out %d ws %zu (need %zu)\n", n_in, n_in > 0 ? in_sizes[0] : -1, out_size, ws_size, (size_t)WS_END); grid = -1; return; }
        int dev = 0, cus = 0, per_cu = 0;
        if (hipGetDevice(&dev) != hipSuccess || hipDeviceGetAttribute(&cus, hipDeviceAttributeMultiprocessorCount, dev) != hipSuccess) { grid = -1; return; }
        if (hipFuncSetAttribute((const void*)mk_fwd, hipFuncAttributeMaxDynamicSharedMemorySize, LDS_BYTES) != hipSuccess) { fprintf(stderr, "kernel_launch: hipFuncSetAttribute failed\n"); grid = -1; return; }
        if (hipOccupancyMaxActiveBlocksPerMultiprocessor(&per_cu, (const void*)mk_fwd, NTHREADS, LDS_BYTES) != hipSuccess || per_cu < 1) { fprintf(stderr, "kernel_launch: occupancy query says %d\n", per_cu); per_cu = 1; }
        (void)hipGetLastError();
        grid = cus * 1;
    }
    if (grid < 0) return;
    Args a{};
    const float** f = (const float**)&a;
    for (int i = 0; i < 21; ++i) f[i] = (const float*)d_in[i];
    a.out = (float*)d_out; a.ws = (unsigned char*)d_ws;
#if MK_ONE_LAUNCH
    if (hipMemsetAsync(d_ws, 0, 262144 + 256, stream) != hipSuccess) { fprintf(stderr, "kernel_launch: memset failed\n"); return; }
    a.ph_lo = 0; a.ph_hi = NPHASE;
    void* args[] = {&a};
    hipError_t e = hipLaunchCooperativeKernel((const void*)mk_fwd, dim3(grid), dim3(NTHREADS), args, LDS_BYTES, stream);
    if (e != hipSuccess) fprintf(stderr, "kernel_launch: cooperative launch failed: %s (grid %d)\n", hipGetErrorString(e), grid);
#else
    for (int ph = 0; ph < NPHASE; ++ph) {
        a.ph_lo = ph; a.ph_hi = ph + 1;
        hipLaunchKernelGGL(mk_fwd, dim3(grid), dim3(NTHREADS), LDS_BYTES, stream, a);
    }
#endif
}
```

```cpp
#include <hip/hip_runtime.h>
#include <hip/hip_cooperative_groups.h>
#include <cstdio>
#include <cstdint>
namespace cg = cooperative_groups;

#ifndef ATT_SD_A
#define ATT_SD_A 1
#endif
#ifndef ATT_SD_B
#define ATT_SD_B 1
#endif
#ifndef MK_ONE_LAUNCH
#define MK_ONE_LAUNCH 1
#endif

#define LAS __attribute__((address_space(3)))
typedef unsigned short bf16_t;
typedef short bf16x8 __attribute__((ext_vector_type(8)));
typedef short s16x4 __attribute__((ext_vector_type(4)));
typedef float f32x4 __attribute__((ext_vector_type(4)));
typedef float f32x16 __attribute__((ext_vector_type(16)));
typedef unsigned u32x4 __attribute__((ext_vector_type(4)));
typedef unsigned u32x2 __attribute__((ext_vector_type(2)));
typedef int v4i_t __attribute__((ext_vector_type(4)));
constexpr float Q8_SU = 20.f, Q8_SW = 900.f;

constexpr int DM = 2048, SEQ = 4096, M = 8192, DFF = 5632, PLE = 256, NIN = 6720, NINP = 6912;
constexpr float EPS = 1e-6f;
constexpr int NWAVES = 8, NTHREADS = 512;
constexpr int LDS_BYTES = 139264;

constexpr size_t MiB = 1u << 20;
constexpr size_t WS_WIN = 1 * MiB, WS_WQB = 28 * MiB, WS_WKVB = 30 * MiB, WS_WAB = 32 * MiB, WS_WO = 40 * MiB, WS_WGU = 48 * MiB, WS_WD = 92 * MiB,
                 WS_WPG = 114 * MiB, WS_WPP = 122 * MiB, WS_PB = 123 * MiB, WS_KR = 127 * MiB, WS_U = 128 * MiB, WS_ZS = 160 * MiB, WS_SG = 200 * MiB,
                 WS_QA = 264 * MiB, WS_QB = 280 * MiB, WS_KVB = 304 * MiB, WS_END = 344 * MiB;
constexpr size_t WS_CQN = 1 * MiB, WS_CKVN = 9 * MiB, WS_KA = 17 * MiB, WS_KPE = 21 * MiB;
constexpr size_t WS_T1 = 264 * MiB;
constexpr size_t WS_OAB = WS_U, WS_MERGED = WS_ZS, WS_ACT = 160 * MiB, WS_GATE = 160 * MiB, WS_ERAW = 280 * MiB;

typedef float f32x2_t __attribute__((ext_vector_type(2)));
typedef __bf16 bf16x2_t __attribute__((ext_vector_type(2)));
__device__ __forceinline__ unsigned cvt_pk_bf16(float lo, float hi) { f32x2_t v = {lo, hi}; bf16x2_t b = __builtin_convertvector(v, bf16x2_t); return __builtin_bit_cast(unsigned, b); }
__device__ __forceinline__ float bf_lo(unsigned w) { return __uint_as_float(w << 16); }
__device__ __forceinline__ float bf_hi(unsigned w) { return __uint_as_float(w & 0xffff0000u); }
__device__ __forceinline__ float bf1(bf16_t h) { return __uint_as_float(((unsigned)h) << 16); }
__device__ __forceinline__ bf16_t f2bf(float f) { unsigned u = __float_as_uint(f); return (bf16_t)((u + 0x7fffu + ((u >> 16) & 1u)) >> 16); }
__device__ __forceinline__ float sigmoidf_(float x) { return __builtin_amdgcn_rcpf(1.f + __expf(-x)); }
__device__ __forceinline__ float wave_sum(float v) {
#pragma unroll
    for (int o = 1; o < 64; o <<= 1) v += __shfl_xor(v, o);
    return v;
}

namespace pg8 {
constexpr int BM = 256, BK = 64, HALF = 128, HTB = HALF * BK * 2, STAGE_BYTES = 8 * HTB, NXCD = 8, WGM = 8;
__host__ __device__ __forceinline__ int lds_byte(int r, int c) { const int st = (r >> 4) * 2 + (c >> 5), rr = r & 15, cc = c & 31, ob = rr * 64 + cc * 2; return st * 1024 + (ob ^ (((ob >> 9) & 1) << 5)); }
__host__ __device__ __forceinline__ void stage_rc(int b, int& R, int& C) { const int st = b / 1024, sb = b % 1024, swz = sb ^ (((sb >> 9) & 1) << 5); R = (st >> 1) * 16 + swz / 64; C = (st & 1) * 32 + (swz % 64) / 2; }
__host__ __device__ __forceinline__ int perm32(int rho) { const int n = rho >> 4, i = rho & 15; return 8 * (i >> 2) + 4 * n + (i & 3); }
struct Unit { int pm, pn, kh; };
struct Gemm { const bf16_t* A; const bf16_t* Bt; int M, N, K, ld, koff, lda; };
struct StaticOrder {
    int nM, nN, nwg, G, c;
    __host__ __device__ void init(int M_, int N_, int G_, int c_) { nM = M_ / BM; nN = N_ / BM; nwg = nM * nN; G = G_; c = c_; }
    __host__ __device__ bool next(int i, Unit& u) const {
        const long L = (long)i * G + c; if (L >= nwg) return false;
        int wgid = (int)L; { const int q = nwg / NXCD, r = nwg % NXCD, xcd = wgid % NXCD, off = wgid / NXCD; wgid = (xcd < r ? xcd * (q + 1) : r * (q + 1) + (xcd - r) * q) + off; }
        const int nig = WGM * nN, gid = wgid / nig, fm = gid * WGM, gsz = (nM - fm) < WGM ? (nM - fm) : WGM;
        u.pm = fm + ((wgid % nig) % gsz); u.pn = (wgid % nig) / gsz; u.kh = 0; return true;
    }
    __device__ __forceinline__ void a_ready(const Unit&) const {}
    __device__ __forceinline__ void done(const Unit&) const {}
};
struct DualOrder : StaticOrder {
    __host__ __device__ bool next(int i, Unit& u) const { if (!StaticOrder::next(i >> 1, u)) return false; u.kh = i & 1; return true; }
};
typedef f32x4 Acc[2][2][4][2];

__device__ __forceinline__ void store8(bf16_t* p, f32x4 v0, f32x4 v1) {
    u32x4 w; w.x = cvt_pk_bf16(v0[0], v0[1]); w.y = cvt_pk_bf16(v0[2], v0[3]); w.z = cvt_pk_bf16(v1[0], v1[1]); w.w = cvt_pk_bf16(v1[2], v1[3]);
    *(u32x4*)p = w;
}
struct EpiIn {
    static constexpr bool PERM = true, AFTER_DRAIN = false;
    bf16_t *ZS, *SG, *KR; float *SSQC, *SSQK;
    __device__ __forceinline__ void operator()(const Acc& acc, const Unit& u, int wr, int wc, int fr, int fq) const {
        const int pn = u.pn; bf16_t* base; int ldc, colt; bool sig = false;
        if (pn < 10) { base = ZS; ldc = 2560; colt = pn * 256; }
        else if (pn < 26) { base = SG; ldc = 4096; colt = (pn - 10) * 256; sig = true; }
        else { base = KR; ldc = 64; colt = 0; }
        const int row0 = u.pm * BM + wr * 64 + fr, col0 = colt + wc * 32 + 8 * fq;
#pragma unroll
        for (int ai = 0; ai < 2; ++ai)
#pragma unroll
            for (int m = 0; m < 4; ++m) { bf16_t* rowp = base + (size_t)(row0 + ai * HALF + m * 16) * ldc + col0; float ss = 0.f;
#pragma unroll
                for (int bj = 0; bj < 2; ++bj) {
                    if (pn == 26 && (bj == 1 || wc >= 2)) continue;
                    f32x4 v0 = __builtin_convertvector(__builtin_bit_cast(v4i_t, acc[ai][bj][m][0]), f32x4) * (1.f / (Q8_SU * Q8_SW));
                    f32x4 v1 = __builtin_convertvector(__builtin_bit_cast(v4i_t, acc[ai][bj][m][1]), f32x4) * (1.f / (Q8_SU * Q8_SW));
                    if (sig) {
#pragma unroll
                        for (int j = 0; j < 4; ++j) { v0[j] = sigmoidf_(v0[j]); v1[j] = sigmoidf_(v1[j]); } }
                    ss += (v0[0] * v0[0] + v0[1] * v0[1]) + (v0[2] * v0[2] + v0[3] * v0[3]) + (v1[0] * v1[0] + v1[1] * v1[1]) + (v1[2] * v1[2] + v1[3] * v1[3]);
                    store8(rowp + bj * HALF, v0, v1); }
                if (pn >= 6 && pn < 10) { ss += __shfl_xor(ss, 16); ss += __shfl_xor(ss, 32);
                    if (fq == 0) (void)__hip_atomic_fetch_add((__attribute__((address_space(1))) float*)((pn < 8 ? SSQC : SSQK) + row0 + ai * HALF + m * 16), ss, __ATOMIC_RELAXED, __HIP_MEMORY_SCOPE_AGENT); } }
    }
};
template <int ACT  > struct EpiBf16 {
    static constexpr bool PERM = true, AFTER_DRAIN = false;
    bf16_t* O; int ldc; const float* ssq; float inv_n;
    __device__ __forceinline__ void operator()(const Acc& acc, const Unit& u, int wr, int wc, int fr, int fq) const {
        const int row0 = u.pm * BM + wr * 64 + fr, col0 = u.pn * BM + wc * 32 + 8 * fq;
#pragma unroll
        for (int ai = 0; ai < 2; ++ai)
#pragma unroll
            for (int m = 0; m < 4; ++m) { bf16_t* rowp = O + (size_t)(row0 + ai * HALF + m * 16) * ldc + col0;
                const float r = ssq ? 1.0f / sqrtf(ssq[row0 + ai * HALF + m * 16] * inv_n + EPS) : 1.f;
#pragma unroll
                for (int bj = 0; bj < 2; ++bj) { f32x4 v0 = acc[ai][bj][m][0] * r, v1 = acc[ai][bj][m][1] * r;
                    if (ACT == 1) {
#pragma unroll
                        for (int j = 0; j < 4; ++j) { v0[j] = sigmoidf_(v0[j]); v1[j] = sigmoidf_(v1[j]); } }
                    store8(rowp + bj * HALF, v0, v1); } }
    }
};
struct EpiQB {
    static constexpr bool PERM = true, AFTER_DRAIN = false;
    bf16_t* O; const float* ssq;
    __device__ __forceinline__ void operator()(const Acc& acc, const Unit& u, int wr, int wc, int fr, int fq) const {
        const int row0 = u.pm * BM + wr * 64 + fr, col0 = u.pn * BM + wc * 32 + 8 * fq;
        float inv[8];
#pragma unroll
        for (int t = 0; t < 8; ++t) inv[t] = __builtin_amdgcn_exp2f(-(float)(2 * ((fq & 1) * 8 + t)) * (13.287712379549449f / 32.f));
        const float sgn = (fq >= 2) ? 1.f : -1.f;
#pragma unroll
        for (int ai = 0; ai < 2; ++ai)
#pragma unroll
            for (int m = 0; m < 4; ++m) { const int row = row0 + ai * HALF + m * 16, sq = row & (SEQ - 1); const float prow = (float)(sq >> 6), pcol = (float)(sq & 63);
                const float rq = 1.0f / sqrtf(ssq[row] * (1.f / 512.f) + EPS);
#pragma unroll
                for (int bj = 0; bj < 2; ++bj) { f32x4 v0 = acc[ai][bj][m][0] * rq, v1 = acc[ai][bj][m][1] * rq;
                    const int rel = (u.pn * BM + bj * HALF + wc * 32) % 192;
                    if (rel >= 128) { const float pos = (rel >= 160) ? pcol : prow;
#pragma unroll
                        for (int t = 0; t < 4; ++t) {
                            const float a0 = pos * inv[t], a1 = pos * inv[4 + t];
                            const float p0 = __shfl_xor(v0[t], 32), p1 = __shfl_xor(v1[t], 32);
                            v0[t] = v0[t] * __cosf(a0) + sgn * p0 * __sinf(a0); v1[t] = v1[t] * __cosf(a1) + sgn * p1 * __sinf(a1); } }
                    store8(O + (size_t)row * 1536 + col0 + bj * HALF, v0, v1); } }
    }
};
template <bool SECOND> struct EpiGate {
    static constexpr bool PERM = true, AFTER_DRAIN = false;
    const bf16_t* SG; bf16_t* T1; bf16_t* O;
    __device__ __forceinline__ void operator()(const Acc& acc, const Unit& u, int wr, int wc, int fr, int fq) const {
        const int row0 = u.pm * BM + wr * 64 + fr, col0 = u.pn * BM + wc * 32 + 8 * fq;
#pragma unroll
        for (int ai = 0; ai < 2; ++ai)
#pragma unroll
            for (int m = 0; m < 4; ++m) { const size_t ro = (size_t)(row0 + ai * HALF + m * 16);
#pragma unroll
                for (int bj = 0; bj < 2; ++bj) {
                    const u32x4 b = *(const u32x4*)(SG + ro * 4096 + (SECOND ? 2048 : 0) + col0 + bj * HALF);
                    f32x4 s0, s1;
                    s0[0] = bf_lo(b.x); s0[1] = bf_hi(b.x); s0[2] = bf_lo(b.y); s0[3] = bf_hi(b.y);
                    s1[0] = bf_lo(b.z); s1[1] = bf_hi(b.z); s1[2] = bf_lo(b.w); s1[3] = bf_hi(b.w);
                    bf16_t* tp = T1 + ro * 2048 + col0 + bj * HALF;
                    if constexpr (!SECOND) { store8(tp, acc[ai][bj][m][0] * s0, acc[ai][bj][m][1] * s1); }
                    else { const u32x4 tw = *(const u32x4*)tp; f32x4 t0, t1;
                        t0[0] = bf_lo(tw.x); t0[1] = bf_hi(tw.x); t0[2] = bf_lo(tw.y); t0[3] = bf_hi(tw.y); t1[0] = bf_lo(tw.z); t1[1] = bf_hi(tw.z); t1[2] = bf_lo(tw.w); t1[3] = bf_hi(tw.w);
                        store8(O + ro * 2048 + col0 + bj * HALF, t0 + acc[ai][bj][m][0] * s0, t1 + acc[ai][bj][m][1] * s1); } } }
    }
};
template <bool BASEBF> struct EpiResid {
    static constexpr bool PERM = false, AFTER_DRAIN = false;
    const float* basef; const bf16_t* baseb; bf16_t* HB; float* ssq;
    __device__ __forceinline__ void operator()(const Acc& acc, const Unit& u, int wr, int wc, int fr, int fq) const {
        const int row0 = u.pm * BM + wr * 64 + fr, col0 = u.pn * BM + wc * 32 + 4 * fq;
#pragma unroll
        for (int ai = 0; ai < 2; ++ai)
#pragma unroll
            for (int m = 0; m < 4; ++m) { const int row = row0 + ai * HALF + m * 16; const size_t ro = (size_t)row * DM + col0; float ss = 0.f;
#pragma unroll
                for (int bj = 0; bj < 2; ++bj)
#pragma unroll
                    for (int n = 0; n < 2; ++n) { const size_t o = ro + bj * HALF + n * 16;
                        f32x4 v = acc[ai][bj][m][n];
                        if constexpr (BASEBF) { const u32x2 bw = *(const u32x2*)(baseb + o); v = v + (f32x4){bf_lo(bw.x), bf_hi(bw.x), bf_lo(bw.y), bf_hi(bw.y)}; }
                        else v = v + *(const f32x4*)(basef + o);
                        u32x2 w; w.x = cvt_pk_bf16(v.x, v.y); w.y = cvt_pk_bf16(v.z, v.w);
                        *(u32x2*)(HB + o) = w; ss += (v.x * v.x + v.y * v.y) + (v.z * v.z + v.w * v.w); }
                ss += __shfl_xor(ss, 16); ss += __shfl_xor(ss, 32);
                if (fq == 0) (void)__hip_atomic_fetch_add((__attribute__((address_space(1))) float*)(ssq + row), ss, __ATOMIC_RELAXED, __HIP_MEMORY_SCOPE_AGENT); }
    }
};
struct EpiSwiglu {
    static constexpr bool PERM = true, AFTER_DRAIN = false;
    bf16_t* O; const float* ssq;
    __device__ __forceinline__ void operator()(const Acc& acc, const Unit& u, int wr, int wc, int fr, int fq) const {
        const int row0 = u.pm * BM + wr * 64 + fr, col0 = u.pn * HALF + wc * 32 + 8 * fq;
#pragma unroll
        for (int ai = 0; ai < 2; ++ai)
#pragma unroll
            for (int m = 0; m < 4; ++m) {
                f32x4 a0, a1; const float r = 1.0f / sqrtf(ssq[row0 + ai * HALF + m * 16] * (1.f / DM) + EPS);
#pragma unroll
                for (int j = 0; j < 4; ++j) { const float g0 = acc[ai][0][m][0][j] * r, g1 = acc[ai][0][m][1][j] * r;
                    a0[j] = g0 * sigmoidf_(g0) * (acc[ai][1][m][0][j] * r); a1[j] = g1 * sigmoidf_(g1) * (acc[ai][1][m][1][j] * r); }
                store8(O + (size_t)(row0 + ai * HALF + m * 16) * DFF + col0, a0, a1); }
    }
};

template <class Epi, class Sched, bool ALIGN_EPI, bool SP2, bool MID, bool I8 = false>
__device__ __forceinline__ void gemm_phase(LAS unsigned char* lds, const Gemm g, const Sched S, const Epi E) {
    const int tid = threadIdx.x, wid = __builtin_amdgcn_readfirstlane(tid >> 6), lane = tid & 63, wr = wid >> 2, wc = wid & 3, fr = lane & 15, fq = lane >> 4;
    const int K = g.ld, nt = g.K / BK;
    unsigned voffA[2], voffB[2];
#pragma unroll
    for (int i = 0; i < 2; ++i) { int R, C; stage_rc(tid * 16 + i * 8192, R, C); const int Rb = Epi::PERM ? ((R & ~31) + perm32(R & 31)) : R;
        voffA[i] = (unsigned)(R * (g.lda ? g.lda : K) + C) * 2u; voffB[i] = (unsigned)(Rb * K + C) * 2u; }
    const size_t kstep = (size_t)(BK * 2);
    const int KA = g.lda ? g.lda : K;
    const size_t hstep = (size_t)HALF * K * 2, hstepA = (size_t)HALF * KA * 2;
    const size_t tstep = 2 * hstep, tstepA = 2 * hstepA;
    const unsigned ldsw = (unsigned)wid * 1024u;
    const int aoff = lds_byte(wr * 64 + fr, fq * 8), boff = lds_byte(wc * 32 + fr, fq * 8);
#define PG8_SA(b, h) (((b) * 2 + (h)) * HTB)
#define PG8_SB(b, h) ((4 + (b) * 2 + (h)) * HTB)
#define PG8_STAGE(bufoff, gbase, voff) do { _Pragma("unroll") for (int _i = 0; _i < 2; ++_i) \
        __builtin_amdgcn_global_load_lds((const unsigned*)((const char*)(gbase) + (voff)[_i]), (LAS unsigned*)(lds + (bufoff) + ldsw + _i * 8192), 16, 0, 0); } while (0)
#define PG8_LDA(dst, b, h) do { _Pragma("unroll") for (int m = 0; m < 4; ++m) _Pragma("unroll") for (int k = 0; k < 2; ++k) dst[m][k] = *(const LAS bf16x8*)(lds + PG8_SA(b, h) + aoff + m * 2048 + k * 1024); } while (0)
#define PG8_LDB(dst, b, h) do { _Pragma("unroll") for (int n = 0; n < 2; ++n) _Pragma("unroll") for (int k = 0; k < 2; ++k) dst[n][k] = *(const LAS bf16x8*)(lds + PG8_SB(b, h) + boff + n * 2048 + k * 1024); } while (0)
#define PG8_MMA(ai, bj, At, Bt) do { __builtin_amdgcn_s_setprio(1); _Pragma("unroll") for (int m = 0; m < 4; ++m) _Pragma("unroll") for (int n = 0; n < 2; ++n) _Pragma("unroll") for (int k = 0; k < 2; ++k) { \
        if constexpr (I8) acc[ai][bj][m][n] = __builtin_bit_cast(f32x4, __builtin_amdgcn_mfma_i32_16x16x64_i8(__builtin_bit_cast(v4i_t, Bt[n][k]), __builtin_bit_cast(v4i_t, At[m][k]), __builtin_bit_cast(v4i_t, acc[ai][bj][m][n]), 0, 0, 0)); \
        else acc[ai][bj][m][n] = __builtin_amdgcn_mfma_f32_16x16x32_bf16(Bt[n][k], At[m][k], acc[ai][bj][m][n], 0, 0, 0); } __builtin_amdgcn_s_setprio(0); } while (0)
#define PG8_WAIT_V(n) asm volatile("s_waitcnt vmcnt(" #n ")" ::: "memory")
#define PG8_WAIT_L(n) asm volatile("s_waitcnt lgkmcnt(" #n ")" ::: "memory")
#define PG8_BAR __builtin_amdgcn_s_barrier()
#define PG8_SCHED __builtin_amdgcn_sched_barrier(0)
    Unit cur, nxt; int ui = 0;
    if (!S.next(0, cur)) return;
    Acc acc;
#pragma unroll
    for (int a = 0; a < 2; ++a)
#pragma unroll
        for (int b = 0; b < 2; ++b)
#pragma unroll
            for (int m = 0; m < 4; ++m)
#pragma unroll
                for (int n = 0; n < 2; ++n) acc[a][b][m][n] = (f32x4){0.f, 0.f, 0.f, 0.f};
    bf16x8 At[4][2], B0[2][2], B1[2][2];
    const char* cA = (const char*)g.A + (size_t)cur.pm * tstepA + (size_t)cur.kh * g.koff; const char* cB = (const char*)g.Bt + (size_t)cur.pn * tstep + (size_t)cur.kh * g.koff;
    S.a_ready(cur);
    if constexpr (SP2) {
        PG8_STAGE(PG8_SB(0, 0), cB, voffB); PG8_STAGE(PG8_SB(0, 1), cB + hstep, voffB); PG8_STAGE(PG8_SA(0, 0), cA, voffA); PG8_STAGE(PG8_SA(0, 1), cA + hstepA, voffA);
        if (wr == 1) PG8_BAR;
        PG8_WAIT_V(2); PG8_BAR;
        PG8_STAGE(PG8_SB(1, 0), cB + kstep, voffB); PG8_STAGE(PG8_SA(1, 0), cA + kstep, voffA); PG8_STAGE(PG8_SB(1, 1), cB + hstep + kstep, voffB);
        PG8_WAIT_V(6); PG8_BAR;
    } else {
        PG8_STAGE(PG8_SB(0, 0), cB, voffB); PG8_STAGE(PG8_SA(0, 0), cA, voffA); PG8_STAGE(PG8_SB(0, 1), cB + hstep, voffB); PG8_STAGE(PG8_SA(0, 1), cA + hstepA, voffA);
        if (wr == 1) PG8_BAR;
        PG8_WAIT_V(4); PG8_BAR;
        PG8_STAGE(PG8_SB(1, 0), cB + kstep, voffB); PG8_STAGE(PG8_SA(1, 0), cA + kstep, voffA); PG8_STAGE(PG8_SB(1, 1), cB + hstep + kstep, voffB);
        PG8_WAIT_V(6); PG8_BAR;
    }
    for (;;) {
        const bool has_next = S.next(ui + 1, nxt);
        const char* nA = has_next ? (const char*)g.A + (size_t)nxt.pm * tstepA + (size_t)nxt.kh * g.koff : cA; const char* nB = has_next ? (const char*)g.Bt + (size_t)nxt.pn * tstep + (size_t)nxt.kh * g.koff : cB;
        for (int t = 0; t < nt; t += 2) {
            const bool last = (t == nt - 2);
            const char* a1 = cA + (size_t)(t + 1) * kstep;
            const char* a2 = last ? nA : cA + (size_t)(t + 2) * kstep; const char* b2 = last ? nB : cB + (size_t)(t + 2) * kstep;
            const char* a3 = a2 + kstep; const char* b3 = b2 + kstep;
            if (last && has_next) S.a_ready(nxt);
            if constexpr (SP2) {
            PG8_LDB(B0, 0, 0); PG8_LDB(B1, 0, 1); PG8_SCHED; PG8_LDA(At, 0, 0); PG8_STAGE(PG8_SA(1, 1), a1 + hstepA, voffA);
            PG8_WAIT_V(8); PG8_WAIT_L(0); PG8_BAR; PG8_MMA(0, 0, At, B0); PG8_MMA(0, 1, At, B1); PG8_BAR; PG8_SCHED;
            PG8_LDA(At, 0, 1); PG8_STAGE(PG8_SB(0, 0), b2, voffB); PG8_STAGE(PG8_SB(0, 1), b2 + hstep, voffB); PG8_STAGE(PG8_SA(0, 0), a2, voffA);
            PG8_WAIT_V(8); PG8_WAIT_L(0); PG8_BAR; PG8_MMA(1, 0, At, B0); PG8_MMA(1, 1, At, B1); PG8_BAR; PG8_SCHED;
            PG8_LDB(B0, 1, 0); PG8_LDB(B1, 1, 1); PG8_SCHED; PG8_LDA(At, 1, 0); PG8_STAGE(PG8_SA(0, 1), a2 + hstepA, voffA);
            PG8_WAIT_V(8); PG8_WAIT_L(0); PG8_BAR; PG8_MMA(0, 0, At, B0); PG8_MMA(0, 1, At, B1); PG8_BAR; PG8_SCHED;
            PG8_LDA(At, 1, 1); PG8_STAGE(PG8_SB(1, 0), b3, voffB); PG8_STAGE(PG8_SB(1, 1), b3 + hstep, voffB); PG8_STAGE(PG8_SA(1, 0), a3, voffA);
            PG8_WAIT_V(8); PG8_WAIT_L(0); PG8_BAR; PG8_MMA(1, 0, At, B0); PG8_MMA(1, 1, At, B1); PG8_BAR; PG8_SCHED;
            } else {
            PG8_LDB(B0, 0, 0); PG8_SCHED; PG8_LDA(At, 0, 0); PG8_STAGE(PG8_SA(1, 1), a1 + hstepA, voffA);
            PG8_WAIT_L(8); PG8_BAR; PG8_WAIT_L(0); PG8_MMA(0, 0, At, B0); PG8_BAR; PG8_SCHED;
            PG8_LDB(B1, 0, 1); PG8_STAGE(PG8_SB(0, 0), b2, voffB);
            PG8_BAR; PG8_WAIT_L(0); PG8_MMA(0, 1, At, B1); PG8_BAR;
            PG8_LDA(At, 0, 1); PG8_STAGE(PG8_SA(0, 0), a2, voffA);
            PG8_BAR; PG8_WAIT_L(0); PG8_MMA(1, 0, At, B0); PG8_BAR; PG8_SCHED;
            PG8_STAGE(PG8_SB(0, 1), b2 + hstep, voffB);
            PG8_WAIT_V(6); PG8_BAR; PG8_MMA(1, 1, At, B1); PG8_BAR;
            PG8_LDB(B0, 1, 0); PG8_SCHED; PG8_LDA(At, 1, 0); PG8_STAGE(PG8_SA(0, 1), a2 + hstepA, voffA);
            PG8_WAIT_L(8); PG8_BAR; PG8_WAIT_L(0); PG8_MMA(0, 0, At, B0); PG8_BAR; PG8_SCHED;
            PG8_LDB(B1, 1, 1); PG8_STAGE(PG8_SB(1, 0), b3, voffB);
            PG8_BAR; PG8_WAIT_L(0); PG8_MMA(0, 1, At, B1); PG8_BAR;
            PG8_LDA(At, 1, 1); PG8_STAGE(PG8_SA(1, 0), a3, voffA);
            PG8_BAR; PG8_WAIT_L(0); PG8_MMA(1, 0, At, B0); PG8_BAR; PG8_SCHED;
            PG8_STAGE(PG8_SB(1, 1), b3 + hstep, voffB);
            PG8_WAIT_V(6); PG8_BAR; PG8_MMA(1, 1, At, B1); PG8_BAR;
            }
        }
        if constexpr (ALIGN_EPI) { if (wr == 0) PG8_BAR; }
        { E(acc, cur, wr, wc, fr, fq); S.done(cur);
#pragma unroll
        for (int a = 0; a < 2; ++a)
#pragma unroll
            for (int b = 0; b < 2; ++b)
#pragma unroll
                for (int m = 0; m < 4; ++m)
#pragma unroll
                    for (int n = 0; n < 2; ++n) acc[a][b][m][n] = (f32x4){0.f, 0.f, 0.f, 0.f};
        }
        if (!has_next) break;
        cur = nxt; cA = nA; cB = nB; ++ui;
        if constexpr (ALIGN_EPI) { if (wr == 1) PG8_BAR; }
    }
    PG8_WAIT_V(0);
    if constexpr (!ALIGN_EPI) { if (wr == 0) PG8_BAR; }
    PG8_BAR;
#undef PG8_SA
#undef PG8_SB
#undef PG8_STAGE
#undef PG8_LDA
#undef PG8_LDB
#undef PG8_MMA
#undef PG8_WAIT_V
#undef PG8_WAIT_L
#undef PG8_BAR
#undef PG8_SCHED
}
}

namespace att {
constexpr int NW = 8, QBLK = 32, KVBLK = 64;
constexpr int SHM_V = KVBLK * 128 * 2, SHM_K = KVBLK * 128 * 2, SHM_KR = KVBLK * 64 * 2;
constexpr int OFF_V = 0, OFF_K = 2 * SHM_V, OFF_WS = OFF_K + 2 * SHM_K, OFF_KR = OFF_WS + NW * 64 * 4, OFF_QR = OFF_KR + 2 * SHM_KR, QR_WAVE = 6144, ATT_LDS = OFF_QR + NW * QR_WAVE;
constexpr float THR = 8.f;
#define KSWZ(row, colB) ((row) * 256 + ((colB) ^ (((row) & 7) << 4)))
#define KRSWZ(row, colB) ((row) * 128 + ((colB) ^ ((((row) >> 1) & 7) << 4)))
#define SBAR() __builtin_amdgcn_sched_barrier(0)
__device__ __forceinline__ int crow(int r, int hi) { return (r & 3) + 8 * (r >> 2) + 4 * hi; }

__device__ __forceinline__ void partialSM(f32x16& p0, f32x16& p1, float& m_reg, float& mn, float& alpha, const float C, const float THRS) {
  float pmax = p0[0];
#pragma unroll
  for (int r = 1; r < 16; ++r) pmax = fmaxf(pmax, p0[r]);
#pragma unroll
  for (int r = 0; r < 16; ++r) pmax = fmaxf(pmax, p1[r]);
  { auto rr = __builtin_amdgcn_permlane32_swap(__float_as_uint(pmax), __float_as_uint(pmax), false, false);
    pmax = fmaxf(__uint_as_float(rr[0]), __uint_as_float(rr[1])); }
  if (__builtin_expect(__all(pmax - m_reg <= THRS), 1)) { mn = m_reg; alpha = 1.f; }
  else { mn = fmaxf(m_reg, pmax); alpha = __builtin_amdgcn_exp2f((m_reg - mn) * C); m_reg = mn; }
  float mnC = -mn * C;
#pragma unroll
  for (int r = 0; r < 16; ++r) p0[r] = fmaf(p0[r], C, mnC);
#pragma unroll
  for (int r = 0; r < 16; ++r) p1[r] = fmaf(p1[r], C, mnC);
#pragma unroll
  for (int r = 0; r < 16; ++r) p0[r] = __builtin_amdgcn_exp2f(p0[r]);
}
__device__ __forceinline__ void finishSM(f32x16& p0, f32x16& p1, float alpha, float& l_reg, bf16x8& pa0, bf16x8& pa1, bf16x8& pa2, bf16x8& pa3) {
#pragma unroll
  for (int r = 0; r < 16; ++r) p1[r] = __builtin_amdgcn_exp2f(p1[r]);
  float ps = 0;
#pragma unroll
  for (int r = 0; r < 16; ++r) ps += p0[r];
#pragma unroll
  for (int r = 0; r < 16; ++r) ps += p1[r];
  { auto rr = __builtin_amdgcn_permlane32_swap(__float_as_uint(ps), __float_as_uint(ps), false, false);
    ps = __uint_as_float(rr[0]) + __uint_as_float(rr[1]); }
  l_reg = l_reg * alpha + ps;
#define PK4(P, BASE, OUT) do { unsigned a0 = cvt_pk_bf16(P[BASE + 0], P[BASE + 1]), a1 = cvt_pk_bf16(P[BASE + 2], P[BASE + 3]);   \
    unsigned b0 = cvt_pk_bf16(P[BASE + 4], P[BASE + 5]), b1 = cvt_pk_bf16(P[BASE + 6], P[BASE + 7]);                              \
    auto r0 = __builtin_amdgcn_permlane32_swap(a0, b0, false, false); auto r1 = __builtin_amdgcn_permlane32_swap(a1, b1, false, false); \
    u32x4 w = {r0[0], r1[0], r0[1], r1[1]}; OUT = *reinterpret_cast<bf16x8*>(&w); } while (0)
  PK4(p0, 0, pa0); PK4(p0, 8, pa1); PK4(p1, 0, pa2); PK4(p1, 8, pa3);
#undef PK4
}
template <int DK, int NQR>
__device__ __forceinline__ void qkt(f32x16& p0, f32x16& p1, const char* Ks, const char* Krs, const bf16x8* qr, const char* qrl, int r32, int hi) {
  p0 = f32x16{}; p1 = f32x16{};
#pragma unroll
  for (int d0 = 0; d0 < 8; ++d0) { int cb = (d0 * 16 + hi * 8) * 2;
    bf16x8 b0 = *reinterpret_cast<const bf16x8*>(Ks + KSWZ(r32, cb));
    bf16x8 b1 = *reinterpret_cast<const bf16x8*>(Ks + KSWZ(32 + r32, cb));
    bf16x8 qv; if (d0 < NQR) qv = qr[d0 < NQR ? d0 : 0]; else qv = *reinterpret_cast<const bf16x8*>(qrl + (d0 - NQR) * 1024);
    p0 = __builtin_amdgcn_mfma_f32_32x32x16_bf16(b0, qv, p0, 0, 0, 0);
    p1 = __builtin_amdgcn_mfma_f32_32x32x16_bf16(b1, qv, p1, 0, 0, 0); }
  if constexpr (DK == 192) {
#pragma unroll
    for (int d0 = 0; d0 < 4; ++d0) { int cb = (d0 * 16 + hi * 8) * 2;
      bf16x8 b0 = *reinterpret_cast<const bf16x8*>(Krs + KRSWZ(r32, cb));
      bf16x8 b1 = *reinterpret_cast<const bf16x8*>(Krs + KRSWZ(32 + r32, cb));
      const bf16x8 qv = *reinterpret_cast<const bf16x8*>(qrl + (8 - NQR + d0) * 1024);
      p0 = __builtin_amdgcn_mfma_f32_32x32x16_bf16(b0, qv, p0, 0, 0, 0);
      p1 = __builtin_amdgcn_mfma_f32_32x32x16_bf16(b1, qv, p1, 0, 0, 0); }
  }
}
__device__ __forceinline__ int v_st(int k, int c) { const int kk = (k & ~0xC) | ((k & 4) << 1) | ((k & 8) >> 1); return ((kk >> 3) * 4 + (c >> 5)) * 512 + ((kk & 7) * 32 + (c & 31)) * 2; }
__device__ __forceinline__ int v_rd_base(int lane) { return ((lane & 3) << 3) | (((lane >> 2) & 3) << 6) | (((lane >> 4) & 1) << 5) | (((lane >> 5) & 1) << 8); }
constexpr int v_rd_off(int d0, int ks, int half) { return d0 * 512 + ks * 4096 + half * 2048; }
template <int OFF> __device__ __forceinline__ s16x4 tr_read(int vb) {
  s16x4 r; asm volatile("ds_read_b64_tr_b16 %0, %1 offset:%2" : "=&v"(r) : "v"(vb), "i"(OFF) : "memory"); return r;
}
template <int D0> __device__ __forceinline__ void pv_one(f32x16& od, int vb, bf16x8 pa0, bf16x8 pa1, bf16x8 pa2, bf16x8 pa3) {
  const s16x4 l0 = tr_read<v_rd_off(D0, 0, 0)>(vb), h0 = tr_read<v_rd_off(D0, 0, 1)>(vb), l1 = tr_read<v_rd_off(D0, 1, 0)>(vb), h1 = tr_read<v_rd_off(D0, 1, 1)>(vb);
  const s16x4 l2 = tr_read<v_rd_off(D0, 2, 0)>(vb), h2 = tr_read<v_rd_off(D0, 2, 1)>(vb), l3 = tr_read<v_rd_off(D0, 3, 0)>(vb), h3 = tr_read<v_rd_off(D0, 3, 1)>(vb);
  asm volatile("s_waitcnt lgkmcnt(0)" ::: "memory"); SBAR();
#define PK(L, H) (bf16x8){L[0], L[1], L[2], L[3], H[0], H[1], H[2], H[3]}
  od = __builtin_amdgcn_mfma_f32_32x32x16_bf16(pa0, PK(l0, h0), od, 0, 0, 0);
  od = __builtin_amdgcn_mfma_f32_32x32x16_bf16(pa1, PK(l1, h1), od, 0, 0, 0);
  od = __builtin_amdgcn_mfma_f32_32x32x16_bf16(pa2, PK(l2, h2), od, 0, 0, 0);
  od = __builtin_amdgcn_mfma_f32_32x32x16_bf16(pa3, PK(l3, h3), od, 0, 0, 0);
#undef PK
}
__device__ __forceinline__ void pv_d0(f32x16* o, int vb, bf16x8 pa0, bf16x8 pa1, bf16x8 pa2, bf16x8 pa3) {
  pv_one<0>(o[0], vb, pa0, pa1, pa2, pa3); pv_one<1>(o[1], vb, pa0, pa1, pa2, pa3); pv_one<2>(o[2], vb, pa0, pa1, pa2, pa3); pv_one<3>(o[3], vb, pa0, pa1, pa2, pa3);
}

#define K8SWZ(row, chunk) ((row) * 128 + ((((chunk) ^ (((row) >> 1) & 7))) << 4))
constexpr float ATT_SQK = 20.f;
typedef int v16i_t __attribute__((ext_vector_type(16)));
__device__ __forceinline__ void qkt8(f32x16& p0, f32x16& p1, const char* Ks, const v4i_t* qi, int r32, int hi) {
  p0 = f32x16{}; p1 = f32x16{};
#pragma unroll
  for (int d = 0; d < 4; ++d) {
    const v4i_t b0 = *reinterpret_cast<const v4i_t*>(Ks + K8SWZ(r32, 2 * d + hi));
    const v4i_t b1 = *reinterpret_cast<const v4i_t*>(Ks + K8SWZ(32 + r32, 2 * d + hi));
    p0 = __builtin_bit_cast(f32x16, __builtin_amdgcn_mfma_i32_32x32x32_i8(b0, qi[d], __builtin_bit_cast(v16i_t, p0), 0, 0, 0));
    p1 = __builtin_bit_cast(f32x16, __builtin_amdgcn_mfma_i32_32x32x32_i8(b1, qi[d], __builtin_bit_cast(v16i_t, p1), 0, 0, 0)); }
#pragma unroll
  for (int r = 0; r < 16; ++r) { p0[r] = (float)__float_as_int(p0[r]); p1[r] = (float)__float_as_int(p1[r]); }
}
template <int DK, int SDEPTH, int ldq, int ldk, int ldv, int ldo, int seq, bool QK8 = false>
__device__ __forceinline__ void attn_unit(const bf16_t* __restrict__ Qb, const bf16_t* __restrict__ Kh, const bf16_t* __restrict__ Krp,
                                          const bf16_t* __restrict__ Vh, bf16_t* __restrict__ Ob, char* lds) {
  constexpr float SCALE = (DK == 128) ? 0.088388347648318440f : 0.072168783648703220f;
  constexpr float QKS = QK8 ? (ATT_SQK * ATT_SQK) : 1.f;
  constexpr float C = SCALE * 1.4426950408889634f / QKS, THRS = THR / SCALE * QKS;
  constexpr int ND = QK8 ? 0 : DK / 16, NQR = QK8 ? 0 : ((DK == 128) ? 8 : 6);
  const int tid = threadIdx.x, wid = tid >> 6, lane = tid & 63, r32 = lane & 31, hi = lane >> 5;
  char* V_lds = lds + OFF_V; char* K_lds = lds + OFF_K; char* KR_lds = lds + OFF_KR;
  float* ws = (float*)(lds + OFF_WS) + wid * 64; float* li_l = ws; float* al_l = ws + 32;
  float m_reg = -1e30f, l_reg = 0; f32x16 o[4] = {}; bf16x8 qr[NQR ? NQR : 1]; v4i_t qi[4];
  if constexpr (QK8) { const unsigned char* Qw8 = (const unsigned char*)Qb + (long)(wid * QBLK + r32) * ldq + hi * 16;
#pragma unroll
    for (int d = 0; d < 4; ++d) qi[d] = *reinterpret_cast<const v4i_t*>(Qw8 + d * 32); }
  const bf16_t* Qw = Qb + (long)(wid * QBLK + r32) * ldq + hi * 8;
#pragma unroll
  for (int d0 = 0; d0 < NQR; ++d0) qr[d0] = *reinterpret_cast<const bf16x8*>(Qw + d0 * 16);
  char* qrl = lds + OFF_QR + wid * QR_WAVE + lane * 16;
#pragma unroll
  for (int d0 = NQR; d0 < ND; ++d0) *reinterpret_cast<bf16x8*>(qrl + (d0 - NQR) * 1024) = *reinterpret_cast<const bf16x8*>(Qw + d0 * 16);
  const int sr = tid >> 4, sc = (tid & 15) * 8, vst0 = v_st(sr, sc), vst1 = v_st(32 + sr, sc);
  const int krr = tid >> 3, krc = (tid & 7) * 8;
  const int vb0 = (int)(uintptr_t)V_lds + v_rd_base(lane);
  bf16x8 vs0[SDEPTH], vs1[SDEPTH], ks0[SDEPTH], ks1[SDEPTH], kr0[SDEPTH]; v4i_t k8[SDEPTH];
  const int k8off = K8SWZ(krr, tid & 7); const unsigned voffK8 = (unsigned)(krr * ldk + (tid & 7) * 16);
  const unsigned voffV = (unsigned)((sr * ldv + sc) * 2), voffK = (unsigned)((sr * ldk + sc) * 2), voffR = (unsigned)((krr * 64 + krc) * 2);
#define SLOAD(i, k0) do { const char* vb_ = (const char*)Vh + (size_t)(k0) * (ldv * 2); const char* kb_ = (const char*)Kh + (size_t)(k0) * (ldk * 2); \
    vs0[i] = *(const bf16x8*)(vb_ + voffV); vs1[i] = *(const bf16x8*)(vb_ + 32 * ldv * 2 + voffV); \
    if constexpr (QK8) k8[i] = *(const v4i_t*)((const char*)Kh + (size_t)(k0) * ldk + voffK8); \
    else { ks0[i] = *(const bf16x8*)(kb_ + voffK); ks1[i] = *(const bf16x8*)(kb_ + 32 * ldk * 2 + voffK); } \
    if constexpr (DK == 192) kr0[i] = *(const bf16x8*)((const char*)Krp + (size_t)(k0) * 128 + voffR); } while (0)
#define SWRITE(b, i) do { *(bf16x8*)(V_lds + (b) * SHM_V + vst0) = vs0[i];          \
    *(bf16x8*)(V_lds + (b) * SHM_V + vst1) = vs1[i]; int kc = sc * 2;               \
    if constexpr (QK8) *(v4i_t*)(K_lds + (b) * SHM_K + k8off) = k8[i];            \
    else { *(bf16x8*)(K_lds + (b) * SHM_K + KSWZ(sr, kc)) = ks0[i];                \
    *(bf16x8*)(K_lds + (b) * SHM_K + KSWZ(32 + sr, kc)) = ks1[i]; }               \
    if constexpr (DK == 192) *(bf16x8*)(KR_lds + (b) * SHM_KR + KRSWZ(krr, krc * 2)) = kr0[i]; } while (0)
#define SWAIT() do { if constexpr (SDEPTH == 1) asm volatile("s_waitcnt vmcnt(0)" ::: "memory"); else if constexpr (DK == 192) asm volatile("s_waitcnt vmcnt(5)" ::: "memory"); else asm volatile("s_waitcnt vmcnt(4)" ::: "memory"); } while (0)
#define QKT(P0, P1, KB, KRB) do { if constexpr (QK8) qkt8(P0, P1, KB, qi, r32, hi); else qkt<DK, (NQR ? NQR : 8)>(P0, P1, KB, KRB, qr, qrl, r32, hi); } while (0)
#define RESC(a) do { if (__any((a) < 1.f)) { if (hi == 0) al_l[r32] = (a); asm volatile("s_waitcnt lgkmcnt(0)" ::: "memory"); \
    _Pragma("unroll") for (int d = 0; d < 4; ++d) _Pragma("unroll") for (int r = 0; r < 16; ++r) o[d][r] *= al_l[crow(r, hi)]; } } while (0)
  f32x16 pA0, pA1, pB0, pB1; float mnA, mnB, alA, alB; bf16x8 pa0, pa1, pa2, pa3; const int NT = seq / KVBLK;
  constexpr int SE = 0, SO = SDEPTH - 1;
  SLOAD(SE, 0); asm volatile("s_waitcnt vmcnt(0)" ::: "memory"); SWRITE(0, SE); __syncthreads();
  QKT(pA0, pA1, K_lds, KR_lds); partialSM(pA0, pA1, m_reg, mnA, alA, C, THRS);
  SLOAD(SO, KVBLK); if constexpr (SDEPTH == 2) { if (2 < NT) SLOAD(SE, 2 * KVBLK); }
  SWAIT(); SWRITE(1, SO); __syncthreads();
  for (int j = 1; j + 1 < NT; j += 2) {
    SBAR(); QKT(pB0, pB1, K_lds + SHM_K, KR_lds + SHM_KR);
    finishSM(pA0, pA1, alA, l_reg, pa0, pa1, pa2, pa3); SBAR();
    SLOAD(SO, (j + SDEPTH) * KVBLK); SBAR();
    pv_d0(o, vb0, pa0, pa1, pa2, pa3); partialSM(pB0, pB1, m_reg, mnB, alB, C, THRS);
    __syncthreads(); SWAIT(); SWRITE(0, SE);
    RESC(alB); __syncthreads();
    SBAR(); QKT(pA0, pA1, K_lds, KR_lds);
    finishSM(pB0, pB1, alB, l_reg, pa0, pa1, pa2, pa3); SBAR();
    if (SDEPTH == 1 || j + 3 < NT) SLOAD(SE, (j + 1 + SDEPTH) * KVBLK); SBAR();
    pv_d0(o, vb0 + SHM_V, pa0, pa1, pa2, pa3); partialSM(pA0, pA1, m_reg, mnA, alA, C, THRS);
    __syncthreads(); SWAIT(); SWRITE(1, SO);
    RESC(alA); __syncthreads();
  }
  SBAR(); QKT(pB0, pB1, K_lds + SHM_K, KR_lds + SHM_KR);
  finishSM(pA0, pA1, alA, l_reg, pa0, pa1, pa2, pa3); SBAR();
  pv_d0(o, vb0, pa0, pa1, pa2, pa3); partialSM(pB0, pB1, m_reg, mnB, alB, C, THRS);
  __syncthreads(); RESC(alB);
  finishSM(pB0, pB1, alB, l_reg, pa0, pa1, pa2, pa3); SBAR();
  pv_d0(o, vb0 + SHM_V, pa0, pa1, pa2, pa3);
  if (hi == 0) li_l[r32] = l_reg; asm volatile("s_waitcnt lgkmcnt(0)" ::: "memory");
  float rli[16];
#pragma unroll
  for (int r = 0; r < 16; ++r) rli[r] = __builtin_amdgcn_rcpf(li_l[crow(r, hi)]);
  bf16_t* Ow = Ob + (long)(wid * QBLK) * ldo;
#pragma unroll
  for (int r = 0; r < 16; ++r) { int orow = crow(r, hi);
#pragma unroll
    for (int d0 = 0; d0 < 4; ++d0) Ow[(long)orow * ldo + d0 * 32 + r32] = f2bf(o[d0][r] * rli[r]); }
#undef QKT
#undef SLOAD
#undef SWRITE
#undef SWAIT
#undef RESC
}
}

struct TrItem { const float* W; bf16_t* WT; int ldw, k0, n0, ldt, drow0, dk0; const float* gain; };
__device__ __forceinline__ void tr_load(f32x4 (&v)[16], const TrItem& t, int lane) {
    const int lr = lane >> 4, lc = (lane & 15) * 4;
#pragma unroll
    for (int i = 0; i < 16; ++i) v[i] = *(const f32x4*)(t.W + (size_t)(t.k0 + 4 * i + lr) * t.ldw + t.n0 + lc);
}
__device__ __forceinline__ void tr_store(const f32x4 (&v)[16], const TrItem& t, LAS float* scr, int lane) {
    const int lr = lane >> 4, lc = (lane & 15) * 4;
#pragma unroll
    for (int i = 0; i < 16; ++i) { LAS float* d = scr + (4 * i + lr) * 65 + lc; const float gk = t.gain ? t.gain[t.k0 + 4 * i + lr] : 1.f;
        d[0] = v[i].x * gk; d[1] = v[i].y * gk; d[2] = v[i].z * gk; d[3] = v[i].w * gk; }
    asm volatile("s_waitcnt lgkmcnt(0)" ::: "memory");
    const int c = lane & 7;
#pragma unroll
    for (int j = 0; j < 8; ++j) { const int n = (lane >> 3) + 8 * j; const LAS float* s = scr + (8 * c) * 65 + n;
        u32x4 o; o.x = cvt_pk_bf16(s[0], s[65]); o.y = cvt_pk_bf16(s[130], s[195]); o.z = cvt_pk_bf16(s[260], s[325]); o.w = cvt_pk_bf16(s[390], s[455]);
        *(u32x4*)(t.WT + (size_t)(t.drow0 + n) * t.ldt + t.dk0 + 8 * c) = o; }
    asm volatile("s_waitcnt lgkmcnt(0)" ::: "memory");
}
__device__ __forceinline__ void tr_item(const float* __restrict__ W, int ldw, int k0, int n0, bf16_t* __restrict__ WT, int ldt, int drow0, int dk0, LAS float* scr, int lane) {
    TrItem t{W, WT, ldw, k0, n0, ldt, drow0, dk0, nullptr}; f32x4 v[16]; tr_load(v, t, lane); tr_store(v, t, scr, lane);
}
__device__ __forceinline__ void rms_row_to_bf16(const float* __restrict__ xrow, const float* __restrict__ g, bf16_t* __restrict__ orow, int lane) {
    f32x4 v[8]; float s = 0.f;
#pragma unroll
    for (int j = 0; j < 8; ++j) { v[j] = *(const f32x4*)(xrow + 4 * lane + 256 * j); s += (v[j].x * v[j].x + v[j].y * v[j].y) + (v[j].z * v[j].z + v[j].w * v[j].w); }
    const float r = 1.0f / sqrtf(wave_sum(s) * (1.f / DM) + EPS);
#pragma unroll
    for (int j = 0; j < 8; ++j) { const f32x4 gg = *(const f32x4*)(g + 4 * lane + 256 * j);
        u32x2 o; o.x = cvt_pk_bf16(v[j].x * r * gg.x, v[j].y * r * gg.y); o.y = cvt_pk_bf16(v[j].z * r * gg.z, v[j].w * r * gg.w);
        *(u32x2*)(orow + 4 * lane + 256 * j) = o; }
}

__device__ __forceinline__ unsigned q8(float v) { int q = (int)__builtin_rintf(v); q = q < -127 ? -127 : (q > 127 ? 127 : q); return (unsigned)q & 0xffu; }
__device__ __forceinline__ unsigned q8x4(float a, float b, float c, float d) { return q8(a) | (q8(b) << 8) | (q8(c) << 16) | (q8(d) << 24); }
__device__ __forceinline__ void tr_item8(const float* __restrict__ W, int ldw, int k0, int n0, unsigned char* __restrict__ WT8, int ldt, int drow0, int dk0, LAS float* scr, int lane) {
    const int lr = lane >> 4, lc = (lane & 15) * 4;
    f32x4 v[16];
#pragma unroll
    for (int i = 0; i < 16; ++i) v[i] = *(const f32x4*)(W + (size_t)(k0 + 4 * i + lr) * ldw + n0 + lc);
#pragma unroll
    for (int i = 0; i < 16; ++i) { LAS float* d = scr + (4 * i + lr) * 65 + lc; d[0] = v[i].x * Q8_SW; d[1] = v[i].y * Q8_SW; d[2] = v[i].z * Q8_SW; d[3] = v[i].w * Q8_SW; }
    asm volatile("s_waitcnt lgkmcnt(0)" ::: "memory");
    const int c = lane & 7;
#pragma unroll
    for (int j = 0; j < 8; ++j) { const int n = (lane >> 3) + 8 * j; const LAS float* s = scr + (8 * c) * 65 + n;
        u32x2 o; o.x = q8x4(s[0], s[65], s[130], s[195]); o.y = q8x4(s[260], s[325], s[390], s[455]);
        *(u32x2*)(WT8 + (size_t)(drow0 + n) * ldt + dk0 + 8 * c) = o; }
    asm volatile("s_waitcnt lgkmcnt(0)" ::: "memory");
}
__device__ __forceinline__ void rms_row_to_i8(const float* __restrict__ xrow, const float* __restrict__ g, unsigned char* __restrict__ orow, int lane) {
    f32x4 v[8]; float s = 0.f;
#pragma unroll
    for (int j = 0; j < 8; ++j) { v[j] = *(const f32x4*)(xrow + 4 * lane + 256 * j); s += (v[j].x * v[j].x + v[j].y * v[j].y) + (v[j].z * v[j].z + v[j].w * v[j].w); }
    const float r = Q8_SU / sqrtf(wave_sum(s) * (1.f / DM) + EPS);
#pragma unroll
    for (int j = 0; j < 8; ++j) { const f32x4 gg = *(const f32x4*)(g + 4 * lane + 256 * j);
        *(unsigned*)(orow + 4 * lane + 256 * j) = q8x4(v[j].x * r * gg.x, v[j].y * r * gg.y, v[j].z * r * gg.z, v[j].w * r * gg.w); }
}

#define XB_TMO      128
#define XB_XCNT(j)  (256  + 64 * (j))
#define XB_XSUB(j)  (1280 + 64 * (j))
#define XB_XGEN(j)  (2304 + 64 * (j))
#define XB_TOP      3328
#define XB_TOPGEN   3392
#define XCD_BAR_WORDS 3456
#define XB_SPIN_CAP (1u << 18)
__device__ __forceinline__ unsigned xb_ld(unsigned* p)              { return __hip_atomic_load(p, __ATOMIC_RELAXED, __HIP_MEMORY_SCOPE_AGENT); }
__device__ __forceinline__ unsigned xb_add(unsigned* p, unsigned v) { return __hip_atomic_fetch_add(p, v, __ATOMIC_RELAXED, __HIP_MEMORY_SCOPE_AGENT); }
__device__ __forceinline__ unsigned xb_xcc_id() { return (unsigned)__builtin_amdgcn_s_getreg((3 << 11) | 20) & 0xFu; }
#define XB_SPIN(cond, bar) do { unsigned _sp = 0; while (cond) { __builtin_amdgcn_s_sleep(1); \
    if ((++_sp & 255u) == 0u) { if (xb_ld(&(bar)[XB_TMO])) break; if (_sp > XB_SPIN_CAP) { atomicAdd(&(bar)[XB_TMO], 1u); break; } } } } while (0)
struct XcdBarrier { unsigned* bar; unsigned x; volatile LAS unsigned* st; };
__device__ __forceinline__ XcdBarrier xcd_barrier_post(unsigned* bar, volatile LAS unsigned* st) {
    XcdBarrier b; b.bar = bar; b.x = xb_xcc_id(); b.st = st;
    if (threadIdx.x == 0) (void)xb_add(&bar[XB_XCNT(b.x)], 1u);
    return b;
}
__device__ __forceinline__ void xcd_barrier_complete(unsigned* bar, unsigned x, unsigned& nloc, unsigned& nx) {
    const unsigned G = gridDim.x * gridDim.y * gridDim.z;
    unsigned sum, cnt, mine, sp = 0u;
    for (;;) {
        sum = 0u; cnt = 0u; mine = 0u;
#pragma unroll
        for (unsigned j = 0; j < 16; ++j) { const unsigned c = xb_ld(&bar[XB_XCNT(j)]); sum += c; cnt += (c > 0u) ? 1u : 0u; mine = (j == x) ? c : mine; }
        if (sum == G) break;
        __builtin_amdgcn_s_sleep(1);
        if ((++sp & 255u) == 0u) { if (xb_ld(&bar[XB_TMO])) break; if (sp > XB_SPIN_CAP) { atomicAdd(&bar[XB_TMO], 1u); break; } }
    }
    nloc = mine > 0u ? mine : 1u; nx = cnt > 0u ? cnt : 1u;
}
__device__ __forceinline__ void xcd_barrier(const XcdBarrier& b) {
    asm volatile("s_waitcnt vmcnt(0)" ::: "memory");
    __syncthreads();
    if (threadIdx.x == 0) {
        unsigned* bar = b.bar;
        __builtin_amdgcn_s_waitcnt(0);
        unsigned nloc = b.st[0], nx = b.st[1];
        if (nloc == 0u) { xcd_barrier_complete(bar, b.x, nloc, nx); b.st[0] = nloc; b.st[1] = nx; }
        const unsigned old = xb_add(&bar[XB_XSUB(b.x)], 1u);
        const unsigned gen = old / nloc;
        if (old + 1u == (gen + 1u) * nloc) {
            __builtin_amdgcn_fence(__ATOMIC_RELEASE, "agent");
            asm volatile("s_waitcnt vmcnt(0)" ::: "memory");
            const unsigned og = xb_add(&bar[XB_TOP], 1u);
            const unsigned tg = og / nx;
            if (og + 1u == (tg + 1u) * nx) xb_add(&bar[XB_TOPGEN], 1u);
            else XB_SPIN(xb_ld(&bar[XB_TOPGEN]) == tg, bar);
            __builtin_amdgcn_fence(__ATOMIC_ACQUIRE, "agent");
            xb_add(&bar[XB_XGEN(b.x)], 1u);
            asm volatile("s_waitcnt vmcnt(0)" ::: "memory");
        } else {
            XB_SPIN(xb_ld(&bar[XB_XGEN(b.x)]) == gen, bar);
            __builtin_amdgcn_fence(__ATOMIC_ACQUIRE, "agent");
            asm volatile("s_waitcnt vmcnt(0)" ::: "memory");
        }
    }
    __syncthreads();
}

struct Args {
    const float *x, *p, *g_mix, *w_in, *q_norm_a, *k_norm_a, *q_a_norm, *w_q_b, *kv_a_norm, *w_kv_b, *w_a_out, *w_b_out, *w_o, *g_ffn, *w_gate_up, *w_down, *g_ple,
                *w_ple_gate, *w_ple_proj, *g_ple_post, *g_final;
    float* out; unsigned char* ws; int ph_lo, ph_hi;
};

constexpr int NPHASE = 14;

__global__ void __launch_bounds__(NTHREADS, 2) mk_fwd(Args a) {
    extern __shared__ __attribute__((aligned(16))) unsigned char lds_raw[];
    LAS unsigned char* lds = (LAS unsigned char*)lds_raw;
    const int tid = threadIdx.x, lane = tid & 63, wave = __builtin_amdgcn_readfirstlane(tid >> 6);
    const int G = gridDim.x, bx = blockIdx.x;
    const int gw = bx * NWAVES + wave, NGW = G * NWAVES;
    unsigned char* ws = a.ws;
    bf16_t* WinT = (bf16_t*)(ws + WS_WIN); bf16_t* WqbT = (bf16_t*)(ws + WS_WQB); bf16_t* WkvbT = (bf16_t*)(ws + WS_WKVB); bf16_t* WabT = (bf16_t*)(ws + WS_WAB);
    bf16_t* WoT = (bf16_t*)(ws + WS_WO); bf16_t* WguT = (bf16_t*)(ws + WS_WGU); bf16_t* WdT = (bf16_t*)(ws + WS_WD); bf16_t* WpgT = (bf16_t*)(ws + WS_WPG);
    bf16_t* WppT = (bf16_t*)(ws + WS_WPP); bf16_t* PB = (bf16_t*)(ws + WS_PB); bf16_t* KR = (bf16_t*)(ws + WS_KR); bf16_t* U = (bf16_t*)(ws + WS_U);
    bf16_t* ZS = (bf16_t*)(ws + WS_ZS); bf16_t* SG = (bf16_t*)(ws + WS_SG); bf16_t* QA = (bf16_t*)(ws + WS_QA); bf16_t* QB = (bf16_t*)(ws + WS_QB);
    bf16_t* KVB = (bf16_t*)(ws + WS_KVB); bf16_t* CQN = (bf16_t*)(ws + WS_CQN); bf16_t* CKVN = (bf16_t*)(ws + WS_CKVN); bf16_t* KA = (bf16_t*)(ws + WS_KA);
    bf16_t* KPE = (bf16_t*)(ws + WS_KPE); bf16_t* OAB = (bf16_t*)(ws + WS_OAB); bf16_t* MERGED = (bf16_t*)(ws + WS_MERGED); bf16_t* ACT = (bf16_t*)(ws + WS_ACT);
    bf16_t* GATE = (bf16_t*)(ws + WS_GATE); bf16_t* ERAW = (bf16_t*)(ws + WS_ERAW); float* H = a.out;
    float* SSQC = (float*)(ws + 196608); float* SSQK = (float*)(ws + 229376);
    float* SSQ1 = (float*)(ws + 65536); float* SSQ2 = (float*)(ws + 131072);
    const int lo = a.ph_lo, hi = a.ph_hi;
#define IN(k) (lo <= (k) && (k) < hi)
#define SEAM(k) do { if (IN(k) && IN((k) + 1)) { xcd_barrier(xbar); } } while (0)
    volatile LAS unsigned* xst = (volatile LAS unsigned*)(lds + LDS_BYTES - 64);
    if (tid == 0) { xst[0] = 0u; xst[1] = 0u; }
    __syncthreads();
    XcdBarrier xbar = xcd_barrier_post((unsigned*)ws, xst);
    if (a.ph_lo < 0) cg::this_grid().sync();

    constexpr int I0 = 32 * 105, I1 = 8 * 24, I2 = 8 * 32, I3 = 16 * 32, I4 = 16 * 32, I5 = 32 * 32, I6 = 32 * 176, I7 = 88 * 32, I8 = 32 * 32, I9 = 4 * 32;
    constexpr int NREST = I1 + I2 + I3 + I4 + I5 + I6 + I7 + I8 + I9;
    if (IN(0)) {
        LAS float* scr = (LAS float*)(lds + wave * 16640);
        for (int it = gw; it < I0; it += NGW) {
            const int kb = it / 105, nb = it % 105, n0 = nb * 64; const int dr = n0 < 2560 ? n0 : (n0 < 2624 ? 6656 + (n0 - 2560) : n0 - 64);
            tr_item8(a.w_in, NIN, kb * 64, n0, (unsigned char*)WinT, 2048, dr, kb * 64, scr, lane);
        }
        for (int m = gw; m < M; m += NGW) {
            rms_row_to_i8(a.x + (size_t)m * DM, a.g_mix, (unsigned char*)U + (size_t)m * DM, lane);
            const f32x4 pv = *(const f32x4*)(a.p + (size_t)m * PLE + 4 * lane);
            u32x2 o; o.x = cvt_pk_bf16(pv.x, pv.y); o.y = cvt_pk_bf16(pv.z, pv.w);
            *(u32x2*)(PB + (size_t)m * PLE + 4 * lane) = o;
        }
        for (int i = bx * NTHREADS + tid; i < (NINP - NIN) * 2048 / 16; i += G * NTHREADS) *(u32x4*)((unsigned char*)WinT + (size_t)NIN * 2048 + (size_t)i * 16) = (u32x4){0u, 0u, 0u, 0u};
        __syncthreads();
    }
    SEAM(0);
    if (IN(1)) {
        constexpr int NU = (M / 256) * (NINP / 256);
        const int GG = (G >= 256) ? 173 : G;
        if (bx < GG) {
            pg8::Gemm g{U, WinT, M, NINP, DM / 2, DM / 2, 0}; pg8::StaticOrder S; S.init(M, NINP, GG, bx);
            pg8::EpiIn E{ZS, SG, KR, SSQC, SSQK};
            pg8::gemm_phase<pg8::EpiIn, pg8::StaticOrder, true, true, false, true>(lds, g, S, E);
        }
        {
            {
                LAS float* scr = (LAS float*)(lds + wave * 16640);
                unsigned* qctr = (unsigned*)(ws + 262144);
                auto decode = [&](int r) -> TrItem {
                    if (r < I1) { const int kb = r / 24, nb = r % 24; return TrItem{a.w_q_b, WqbT, 1536, kb * 64, nb * 64, 512, nb * 64, kb * 64, a.q_a_norm}; } r -= I1;
                    if (r < I2) { const int kb = r / 32, nb = r % 32; return TrItem{a.w_kv_b, WkvbT, 2048, kb * 64, nb * 64, 512, nb * 64, kb * 64, a.kv_a_norm}; } r -= I2;
                    if (r < I3) { const int kb = r / 32, nb = r % 32; return TrItem{a.w_a_out, WabT, 2048, kb * 64, nb * 64, 2048, nb * 64, kb * 64, nullptr}; } r -= I3;
                    if (r < I4) { const int kb = r / 32, nb = r % 32; return TrItem{a.w_b_out, WabT, 2048, kb * 64, nb * 64, 2048, nb * 64, 1024 + kb * 64, nullptr}; } r -= I4;
                    if (r < I5) { const int kb = r / 32, nb = r % 32; return TrItem{a.w_o, WoT, 2048, kb * 64, nb * 64, 2048, nb * 64, kb * 64, nullptr}; } r -= I5;
                    if (r < I6) { const int kb = r / 176, nb = r % 176, n0 = nb * 64; const int s_ = n0 >= DFF ? 1 : 0, j = n0 - s_ * DFF; const int dr = 256 * (j >> 7) + 128 * s_ + (j & 127);
                        return TrItem{a.w_gate_up, WguT, 2 * DFF, kb * 64, n0, 2048, dr, kb * 64, a.g_ffn}; } r -= I6;
                    if (r < I7) { const int kb = r / 32, nb = r % 32; return TrItem{a.w_down, WdT, 2048, kb * 64, nb * 64, DFF, nb * 64, kb * 64, nullptr}; } r -= I7;
                    if (r < I8) { const int kb = r / 32, nb = r % 32; return TrItem{a.w_ple_gate, WpgT, 2048, kb * 64, nb * 64, 2048, nb * 64, kb * 64, a.g_ple}; } r -= I8;
                    { const int kb = r / 32, nb = r % 32; return TrItem{a.w_ple_proj, WppT, 2048, kb * 64, nb * 64, 256, nb * 64, kb * 64, nullptr}; }
                };
                auto grab = [&]() -> int { unsigned v = 0u; if (lane == 0) v = __hip_atomic_fetch_add((__attribute__((address_space(1))) unsigned*)qctr, 1u, __ATOMIC_RELAXED, __HIP_MEMORY_SCOPE_AGENT); return (int)__builtin_amdgcn_readfirstlane(v); };
                f32x4 va[16], vb[16]; TrItem ta{}, tb{};
                int it = grab();
                if (it < NREST) { ta = decode(it); tr_load(va, ta, lane); }
                while (it < NREST) {
                    int it2 = grab(); if (it2 < NREST) { tb = decode(it2); tr_load(vb, tb, lane); }
                    tr_store(va, ta, scr, lane);
                    it = it2; if (it >= NREST) break;
                    it2 = grab(); if (it2 < NREST) { ta = decode(it2); tr_load(va, ta, lane); }
                    tr_store(vb, tb, scr, lane);
                    it = it2;
                }
            }
            __syncthreads();
        }
        (void)NU;
    }
    SEAM(1);
    if (IN(2)) {
        const int l5 = lane & 31, hsel = lane >> 5, d0 = l5 * 4, isx2 = (l5 >> 3) & 1, halfc = (l5 >> 4) & 1;
        float invA4[4]; f32x4 gq, gk;
#pragma unroll
        for (int i = 0; i < 4; ++i) invA4[i] = powf(10000.f, -(float)(2 * ((d0 & 31) + i)) / 64.f);
        gq = *(const f32x4*)(a.q_norm_a + d0); gk = *(const f32x4*)(a.k_norm_a + d0);
        const int hfb = (lane >> 4) & 1, jb = lane & 15;
        const float invB = powf(10000.f, -(float)(2 * jb) / 32.f);
        for (int m = gw; m < M; m += NGW) {
            const int s = m & (SEQ - 1); const float prow = (float)(s >> 6), pcol = (float)(s & 63);
            const float posA = halfc ? pcol : prow; float cA[4], sA[4];
#pragma unroll
            for (int i = 0; i < 4; ++i) { const float ang = posA * invA4[i]; cA[i] = cosf(ang); sA[i] = sinf(ang); }
            const bf16_t* zr = ZS + (size_t)m * 2560;
#pragma unroll
            for (int it = 0; it < 5; ++it) {
                const int head = 2 * it + hsel;
                const u32x2 w = *(const u32x2*)(zr + head * 128 + d0);
                const float x[4] = {bf_lo(w.x), bf_hi(w.x), bf_lo(w.y), bf_hi(w.y)};
                float ss = (x[0] * x[0] + x[1] * x[1]) + (x[2] * x[2] + x[3] * x[3]);
#pragma unroll
                for (int o2 = 1; o2 < 32; o2 <<= 1) ss += __shfl_xor(ss, o2);
                const float r = 1.0f / sqrtf(ss * (1.f / 128.f) + EPS);
                const f32x4 g = (it < 4) ? gq : gk; float o[4];
#pragma unroll
                for (int i = 0; i < 4; ++i) { const float y = x[i] * r * g[i]; const float p = __shfl_xor(y, 8);
                    o[i] = isx2 ? (y * cA[i] + p * sA[i]) : (y * cA[i] - p * sA[i]); }
                unsigned char* dst = (it < 4) ? ((unsigned char*)QA + (size_t)m * 1024 + head * 128 + d0) : ((unsigned char*)KA + (size_t)m * 256 + (head - 8) * 128 + d0);
                *(unsigned*)dst = q8x4(o[0] * att::ATT_SQK, o[1] * att::ATT_SQK, o[2] * att::ATT_SQK, o[3] * att::ATT_SQK);
            }
            if (lane < 32) {
                const float angB = (hfb ? pcol : prow) * invB; const float cB = cosf(angB), sB = sinf(angB);
                const bf16_t* kr = KR + (size_t)m * 64 + hfb * 32 + jb;
                const float x1 = bf1(kr[0]), x2 = bf1(kr[16]);
                bf16_t* dst = KPE + (size_t)m * 64 + hfb * 32 + jb;
                dst[0] = f2bf(x1 * cB - x2 * sB); dst[16] = f2bf(x2 * cB + x1 * sB);
            }
        }
    }
    if (IN(3)) {
        { pg8::Gemm g{ZS + 1536, WqbT, M, 1536, 512, 512, 0, 2560}; pg8::StaticOrder S; S.init(M, 1536, G, bx); pg8::EpiQB E{QB, SSQC};
          pg8::gemm_phase<pg8::EpiQB, pg8::StaticOrder, true, true, false>(lds, g, S, E); }
        { pg8::Gemm g{ZS + 2048, WkvbT, M, 2048, 512, 512, 0, 2560}; pg8::StaticOrder S; S.init(M, 2048, G, bx); pg8::EpiBf16<0> E{KVB, 2048, SSQK, 1.f / 512.f};
          pg8::gemm_phase<pg8::EpiBf16<0>, pg8::StaticOrder, true, true, false>(lds, g, S, E); }
    }
    SEAM(3);
    if (IN(5)) {
        char* lds_g = (char*)lds_raw;
        const int x = bx & 7, i = bx >> 3;
        for (int c = bx; c < 256; c += G) {
            const int xx = c & 7, ii = c >> 3;
            {
                const int combo = xx >> 1, w = (xx & 1) * 32 + ii, b = combo >> 1, kvh = combo & 1, hq = kvh * 4 + (w >> 4), qb = w & 15;
                const size_t row0 = (size_t)b * SEQ;
                __syncthreads();
                att::attn_unit<128, ATT_SD_A, 1024, 256, 2560, 2048, SEQ, true>((const bf16_t*)((const unsigned char*)QA + (row0 + qb * 256) * 1024 + hq * 128), (const bf16_t*)((const unsigned char*)KA + row0 * 256 + kvh * 128), nullptr,
                                    ZS + row0 * 2560 + 1280 + kvh * 128, OAB + (row0 + qb * 256) * 2048 + hq * 128, lds_g);
            }
            {
                const int unit = xx * 32 + ii, bh = unit >> 4, qb = unit & 15, b = bh >> 3, h = bh & 7;
                const size_t row0 = (size_t)b * SEQ;
                __syncthreads();
                att::attn_unit<192, ATT_SD_B, 1536, 2048, 2048, 2048, SEQ>(QB + (row0 + qb * 256) * 1536 + h * 192, KVB + row0 * 2048 + h * 256, KPE + row0 * 64,
                                    KVB + row0 * 2048 + h * 256 + 128, OAB + (row0 + qb * 256) * 2048 + 1024 + h * 128, lds_g);
            }
        }
        (void)x; (void)i;
        __syncthreads();
    }
    SEAM(5);
    if (IN(6)) {
        bf16_t* T1 = (bf16_t*)(ws + WS_T1);
        { pg8::Gemm g{OAB, WabT, M, 2048, 1024, 2048, 0}; pg8::StaticOrder S; S.init(M, 2048, G, bx); pg8::EpiGate<false> E{SG, T1, MERGED};
          pg8::gemm_phase<pg8::EpiGate<false>, pg8::StaticOrder, true, true, false>(lds, g, S, E); }
        { pg8::Gemm g{OAB + 1024, WabT + 1024, M, 2048, 1024, 2048, 0}; pg8::StaticOrder S; S.init(M, 2048, G, bx); pg8::EpiGate<true> E{SG, T1, MERGED};
          pg8::gemm_phase<pg8::EpiGate<true>, pg8::StaticOrder, true, true, false>(lds, g, S, E); }
    }
    SEAM(6);
    if (IN(7)) {
        pg8::Gemm g{MERGED, WoT, M, 2048, 2048, 2048, 0}; pg8::StaticOrder S; S.init(M, 2048, G, bx); pg8::EpiResid<false> E{a.x, nullptr, U, SSQ1};
        pg8::gemm_phase<pg8::EpiResid<false>, pg8::StaticOrder, true, true, false>(lds, g, S, E);
    }
    SEAM(7);
    if (IN(9)) {
        pg8::Gemm g{U, WguT, M, 2 * DFF, DM, DM, 0}; pg8::StaticOrder S; S.init(M, 2 * DFF, G, bx); pg8::EpiSwiglu E{ACT, SSQ1};
        pg8::gemm_phase<pg8::EpiSwiglu, pg8::StaticOrder, true, true, false>(lds, g, S, E);
        {
            constexpr int NU = (M / 256) * (2 * DFF / 256);
            const int nr = (NU + G - 1) / G, nbusy = NU - (nr - 1) * G; int idx = bx - nbusy, cnt = G - nbusy; if (cnt < 32) { idx = bx; cnt = G; }
            if (idx >= 0) { pg8::Gemm g2{PB, WppT, M, 2048, PLE, PLE, 0}; pg8::StaticOrder S2; S2.init(M, 2048, cnt, idx); pg8::EpiBf16<0> E2{ERAW, 2048, nullptr, 0.f};
                pg8::gemm_phase<pg8::EpiBf16<0>, pg8::StaticOrder, true, true, false>(lds, g2, S2, E2); }
        }
    }
    SEAM(9);
    if (IN(10)) {
        pg8::Gemm g{ACT, WdT, M, 2048, DFF, DFF, 0}; pg8::StaticOrder S; S.init(M, 2048, G, bx); pg8::EpiResid<true> E{nullptr, U, U, SSQ2};
        pg8::gemm_phase<pg8::EpiResid<true>, pg8::StaticOrder, true, true, false>(lds, g, S, E);
    }
    SEAM(10);
    if (IN(12)) {
        { pg8::Gemm g{U, WpgT, M, 2048, DM, DM, 0}; pg8::StaticOrder S; S.init(M, 2048, G, bx); pg8::EpiBf16<1> E{GATE, 2048, SSQ2, 1.f / DM};
          pg8::gemm_phase<pg8::EpiBf16<1>, pg8::StaticOrder, true, true, false>(lds, g, S, E); }
    }
    SEAM(12);
    if (IN(13)) {
        u32x2 nh[8], ne[8], ng[8];
        int m = gw;
        if (m < M) {
#pragma unroll
            for (int j = 0; j < 8; ++j) { const size_t o = (size_t)m * DM + 4 * lane + 256 * j; nh[j] = *(const u32x2*)(U + o); ne[j] = *(const u32x2*)(ERAW + o); ng[j] = *(const u32x2*)(GATE + o); }
        }
        for (; m < M; m += NGW) {
            f32x4 h[8], e[8]; u32x2 gtw[8]; float se = 0.f;
#pragma unroll
            for (int j = 0; j < 8; ++j) { h[j] = (f32x4){bf_lo(nh[j].x), bf_hi(nh[j].x), bf_lo(nh[j].y), bf_hi(nh[j].y)}; e[j] = (f32x4){bf_lo(ne[j].x), bf_hi(ne[j].x), bf_lo(ne[j].y), bf_hi(ne[j].y)}; gtw[j] = ng[j];
                se += (e[j].x * e[j].x + e[j].y * e[j].y) + (e[j].z * e[j].z + e[j].w * e[j].w); }
            const int m2 = m + NGW;
            if (m2 < M) {
#pragma unroll
                for (int j = 0; j < 8; ++j) { const size_t o = (size_t)m2 * DM + 4 * lane + 256 * j; nh[j] = *(const u32x2*)(U + o); ne[j] = *(const u32x2*)(ERAW + o); ng[j] = *(const u32x2*)(GATE + o); }
            }
            const float re = 1.0f / sqrtf(wave_sum(se) * (1.f / DM) + EPS);
            float sh = 0.f;
#pragma unroll
            for (int j = 0; j < 8; ++j) { const u32x2 gt = gtw[j];
                const f32x4 gp = *(const f32x4*)(a.g_ple_post + 4 * lane + 256 * j);
                h[j].x += bf_lo(gt.x) * (e[j].x * re * gp.x); h[j].y += bf_hi(gt.x) * (e[j].y * re * gp.y);
                h[j].z += bf_lo(gt.y) * (e[j].z * re * gp.z); h[j].w += bf_hi(gt.y) * (e[j].w * re * gp.w);
                sh += (h[j].x * h[j].x + h[j].y * h[j].y) + (h[j].z * h[j].z + h[j].w * h[j].w); }
            const float rh = 1.0f / sqrtf(wave_sum(sh) * (1.f / DM) + EPS);
#pragma unroll
            for (int j = 0; j < 8; ++j) { const f32x4 gf = *(const f32x4*)(a.g_final + 4 * lane + 256 * j);
                f32x4 o; o.x = h[j].x * rh * gf.x; o.y = h[j].y * rh * gf.y; o.z = h[j].z * rh * gf.z; o.w = h[j].w * rh * gf.w;
                *(f32x4*)(a.out + (size_t)m * DM + 4 * lane + 256 * j) = o;
            }
        }
    }
#undef IN
#undef SEAM
}

extern "C" void kernel_launch(void* const* d_in, const int* in_sizes, int n_in, void* d_out, int out_size, void* d_ws, size_t ws_size, hipStream_t stream) {
    static int grid = 0;
    if (grid == 0) {
        if (n_in != 21 || in_sizes[0] != M * DM || out_size != M * DM || ws_size < WS_END) {
            fprintf(stderr, "kernel_launch: unexpected shapes: n_in %d in0 %d out %d ws %zu (need %zu)\n", n_in, n_in > 0 ? in_sizes[0] : -1, out_size, ws_size, (size_t)WS_END); grid = -1; return; }
        int dev = 0, cus = 0, per_cu = 0;
        if (hipGetDevice(&dev) != hipSuccess || hipDeviceGetAttribute(&cus, hipDeviceAttributeMultiprocessorCount, dev) != hipSuccess) { grid = -1; return; }
        if (hipFuncSetAttribute((const void*)mk_fwd, hipFuncAttributeMaxDynamicSharedMemorySize, LDS_BYTES) != hipSuccess) { fprintf(stderr, "kernel_launch: hipFuncSetAttribute failed\n"); grid = -1; return; }
        if (hipOccupancyMaxActiveBlocksPerMultiprocessor(&per_cu, (const void*)mk_fwd, NTHREADS, LDS_BYTES) != hipSuccess || per_cu < 1) { fprintf(stderr, "kernel_launch: occupancy query says %d\n", per_cu); per_cu = 1; }
        (void)hipGetLastError();
        grid = cus * 1;
    }
    if (grid < 0) return;
    Args a{};
    const float** f = (const float**)&a;
    for (int i = 0; i < 21; ++i) f[i] = (const float*)d_in[i];
    a.out = (float*)d_out; a.ws = (unsigned char*)d_ws;
#if MK_ONE_LAUNCH
    if (hipMemsetAsync(d_ws, 0, 262144 + 256, stream) != hipSuccess) { fprintf(stderr, "kernel_launch: memset failed\n"); return; }
    a.ph_lo = 0; a.ph_hi = NPHASE;
    void* args[] = {&a};
    hipError_t e = hipLaunchCooperativeKernel((const void*)mk_fwd, dim3(grid), dim3(NTHREADS), args, LDS_BYTES, stream);
    if (e != hipSuccess) fprintf(stderr, "kernel_launch: cooperative launch failed: %s (grid %d)\n", hipGetErrorString(e), grid);
#else
    for (int ph = 0; ph < NPHASE; ++ph) {
        a.ph_lo = ph; a.ph_hi = ph + 1;
        hipLaunchKernelGGL(mk_fwd, dim3(grid), dim3(NTHREADS), LDS_BYTES, stream, a);
    }
#endif
}
```

```cpp
#include <hip/hip_runtime.h>
#include <hip/hip_cooperative_groups.h>
#include <cstdio>
#include <cstdint>
namespace cg = cooperative_groups;

#ifndef ATT_SD_A
#define ATT_SD_A 2
#endif
#ifndef ATT_SD_B
#define ATT_SD_B 1
#endif
#ifndef MK_ONE_LAUNCH
#define MK_ONE_LAUNCH 1
#endif

#define LAS __attribute__((address_space(3)))
typedef unsigned short bf16_t;
typedef short bf16x8 __attribute__((ext_vector_type(8)));
typedef short s16x4 __attribute__((ext_vector_type(4)));
typedef float f32x4 __attribute__((ext_vector_type(4)));
typedef float f32x16 __attribute__((ext_vector_type(16)));
typedef unsigned u32x4 __attribute__((ext_vector_type(4)));
typedef unsigned u32x2 __attribute__((ext_vector_type(2)));
typedef int v4i_t __attribute__((ext_vector_type(4)));
constexpr float Q8_SU = 20.f, Q8_SW = 900.f;

constexpr int DM = 2048, SEQ = 4096, M = 8192, DFF = 5632, PLE = 256, NIN = 6720, NINP = 6912;
constexpr float EPS = 1e-6f;
constexpr int NWAVES = 8, NTHREADS = 512;
constexpr int LDS_BYTES = 139264;

constexpr size_t MiB = 1u << 20;
constexpr size_t WS_WIN = 1 * MiB, WS_WQB = 28 * MiB, WS_WKVB = 30 * MiB, WS_WAB = 32 * MiB, WS_WO = 40 * MiB, WS_WGU = 48 * MiB, WS_WD = 92 * MiB,
                 WS_WPG = 114 * MiB, WS_WPP = 122 * MiB, WS_PB = 123 * MiB, WS_KR = 127 * MiB, WS_U = 128 * MiB, WS_ZS = 160 * MiB, WS_SG = 200 * MiB,
                 WS_QA = 264 * MiB, WS_QB = 280 * MiB, WS_KVB = 304 * MiB, WS_END = 344 * MiB;
constexpr size_t WS_CQN = 1 * MiB, WS_CKVN = 9 * MiB, WS_KA = 17 * MiB, WS_KPE = 21 * MiB;
constexpr size_t WS_T1 = 264 * MiB;
constexpr size_t WS_OAB = WS_U, WS_MERGED = WS_ZS, WS_ACT = 160 * MiB, WS_GATE = 160 * MiB, WS_ERAW = 280 * MiB;

typedef float f32x2_t __attribute__((ext_vector_type(2)));
typedef __bf16 bf16x2_t __attribute__((ext_vector_type(2)));
__device__ __forceinline__ unsigned cvt_pk_bf16(float lo, float hi) { f32x2_t v = {lo, hi}; bf16x2_t b = __builtin_convertvector(v, bf16x2_t); return __builtin_bit_cast(unsigned, b); }
__device__ __forceinline__ float bf_lo(unsigned w) { return __uint_as_float(w << 16); }
__device__ __forceinline__ float bf_hi(unsigned w) { return __uint_as_float(w & 0xffff0000u); }
__device__ __forceinline__ float bf1(bf16_t h) { return __uint_as_float(((unsigned)h) << 16); }
__device__ __forceinline__ bf16_t f2bf(float f) { unsigned u = __float_as_uint(f); return (bf16_t)((u + 0x7fffu + ((u >> 16) & 1u)) >> 16); }
__device__ __forceinline__ float sigmoidf_(float x) { return __builtin_amdgcn_rcpf(1.f + __expf(-x)); }
__device__ __forceinline__ float wave_sum(float v) {
#pragma unroll
    for (int o = 1; o < 64; o <<= 1) v += __shfl_xor(v, o);
    return v;
}

__device__ __forceinline__ unsigned q8(float v) { int q = (int)__builtin_rintf(v); q = q < -127 ? -127 : (q > 127 ? 127 : q); return (unsigned)q & 0xffu; }
__device__ __forceinline__ unsigned q8x4(float a, float b, float c, float d) { return q8(a) | (q8(b) << 8) | (q8(c) << 16) | (q8(d) << 24); }
constexpr float QKSB = 20.f;

namespace pg8 {
constexpr int BM = 256, BK = 64, HALF = 128, HTB = HALF * BK * 2, STAGE_BYTES = 8 * HTB, NXCD = 8, WGM = 8;
__host__ __device__ __forceinline__ int lds_byte(int r, int c) { const int st = (r >> 4) * 2 + (c >> 5), rr = r & 15, cc = c & 31, ob = rr * 64 + cc * 2; return st * 1024 + (ob ^ (((ob >> 9) & 1) << 5)); }
__host__ __device__ __forceinline__ void stage_rc(int b, int& R, int& C) { const int st = b / 1024, sb = b % 1024, swz = sb ^ (((sb >> 9) & 1) << 5); R = (st >> 1) * 16 + swz / 64; C = (st & 1) * 32 + (swz % 64) / 2; }
__host__ __device__ __forceinline__ int perm32(int rho) { const int n = rho >> 4, i = rho & 15; return 8 * (i >> 2) + 4 * n + (i & 3); }
struct Unit { int pm, pn, kh; };
struct Gemm { const bf16_t* A; const bf16_t* Bt; int M, N, K, ld, koff, lda; };
struct StaticOrder {
    int nM, nN, nwg, G, c;
    __host__ __device__ void init(int M_, int N_, int G_, int c_) { nM = M_ / BM; nN = N_ / BM; nwg = nM * nN; G = G_; c = c_; }
    __host__ __device__ bool next(int i, Unit& u) const {
        const long L = (long)i * G + c; if (L >= nwg) return false;
        int wgid = (int)L; { const int q = nwg / NXCD, r = nwg % NXCD, xcd = wgid % NXCD, off = wgid / NXCD; wgid = (xcd < r ? xcd * (q + 1) : r * (q + 1) + (xcd - r) * q) + off; }
        const int nig = WGM * nN, gid = wgid / nig, fm = gid * WGM, gsz = (nM - fm) < WGM ? (nM - fm) : WGM;
        u.pm = fm + ((wgid % nig) % gsz); u.pn = (wgid % nig) / gsz; u.kh = 0; return true;
    }
    __device__ __forceinline__ void a_ready(const Unit&) const {}
    __device__ __forceinline__ void done(const Unit&) const {}
};
struct DualOrder : StaticOrder {
    __host__ __device__ bool next(int i, Unit& u) const { if (!StaticOrder::next(i >> 1, u)) return false; u.kh = i & 1; return true; }
};
typedef f32x4 Acc[2][2][4][2];

__device__ __forceinline__ void store8(bf16_t* p, f32x4 v0, f32x4 v1) {
    u32x4 w; w.x = cvt_pk_bf16(v0[0], v0[1]); w.y = cvt_pk_bf16(v0[2], v0[3]); w.z = cvt_pk_bf16(v1[0], v1[1]); w.w = cvt_pk_bf16(v1[2], v1[3]);
    *(u32x4*)p = w;
}
struct EpiIn {
    static constexpr bool PERM = true, AFTER_DRAIN = false;
    bf16_t *ZS, *SG, *KR; float *SSQC, *SSQK;
    __device__ __forceinline__ void operator()(const Acc& acc, const Unit& u, int wr, int wc, int fr, int fq) const {
        const int pn = u.pn; bf16_t* base; int ldc, colt; bool sig = false;
        if (pn < 10) { base = ZS; ldc = 2560; colt = pn * 256; }
        else if (pn < 26) { base = SG; ldc = 4096; colt = (pn - 10) * 256; sig = true; }
        else { base = KR; ldc = 64; colt = 0; }
        const int row0 = u.pm * BM + wr * 64 + fr, col0 = colt + wc * 32 + 8 * fq;
#pragma unroll
        for (int ai = 0; ai < 2; ++ai)
#pragma unroll
            for (int m = 0; m < 4; ++m) { bf16_t* rowp = base + (size_t)(row0 + ai * HALF + m * 16) * ldc + col0; float ss = 0.f;
#pragma unroll
                for (int bj = 0; bj < 2; ++bj) {
                    if (pn == 26 && (bj == 1 || wc >= 2)) continue;
                    f32x4 v0 = __builtin_convertvector(__builtin_bit_cast(v4i_t, acc[ai][bj][m][0]), f32x4) * (1.f / (Q8_SU * Q8_SW));
                    f32x4 v1 = __builtin_convertvector(__builtin_bit_cast(v4i_t, acc[ai][bj][m][1]), f32x4) * (1.f / (Q8_SU * Q8_SW));
                    if (sig) {
#pragma unroll
                        for (int j = 0; j < 4; ++j) { v0[j] = sigmoidf_(v0[j]); v1[j] = sigmoidf_(v1[j]); } }
                    ss += (v0[0] * v0[0] + v0[1] * v0[1]) + (v0[2] * v0[2] + v0[3] * v0[3]) + (v1[0] * v1[0] + v1[1] * v1[1]) + (v1[2] * v1[2] + v1[3] * v1[3]);
                    store8(rowp + bj * HALF, v0, v1); }
                if (pn >= 6 && pn < 10) { ss += __shfl_xor(ss, 16); ss += __shfl_xor(ss, 32);
                    if (fq == 0) (void)__hip_atomic_fetch_add((__attribute__((address_space(1))) float*)((pn < 8 ? SSQC : SSQK) + row0 + ai * HALF + m * 16), ss, __ATOMIC_RELAXED, __HIP_MEMORY_SCOPE_AGENT); } }
    }
};
template <int ACT  > struct EpiBf16 {
    static constexpr bool PERM = true, AFTER_DRAIN = false;
    bf16_t* O; int ldc; const float* ssq; float inv_n;
    __device__ __forceinline__ void operator()(const Acc& acc, const Unit& u, int wr, int wc, int fr, int fq) const {
        const int row0 = u.pm * BM + wr * 64 + fr, col0 = u.pn * BM + wc * 32 + 8 * fq;
#pragma unroll
        for (int ai = 0; ai < 2; ++ai)
#pragma unroll
            for (int m = 0; m < 4; ++m) { bf16_t* rowp = O + (size_t)(row0 + ai * HALF + m * 16) * ldc + col0;
                const float r = ssq ? 1.0f / sqrtf(ssq[row0 + ai * HALF + m * 16] * inv_n + EPS) : 1.f;
#pragma unroll
                for (int bj = 0; bj < 2; ++bj) { f32x4 v0 = acc[ai][bj][m][0] * r, v1 = acc[ai][bj][m][1] * r;
                    if (ACT == 1) {
#pragma unroll
                        for (int j = 0; j < 4; ++j) { v0[j] = sigmoidf_(v0[j]); v1[j] = sigmoidf_(v1[j]); } }
                    store8(rowp + bj * HALF, v0, v1); } }
    }
};
struct EpiQB {
    static constexpr bool PERM = true, AFTER_DRAIN = false;
    bf16_t* O; const float* ssq;
    __device__ __forceinline__ void operator()(const Acc& acc, const Unit& u, int wr, int wc, int fr, int fq) const {
        const int row0 = u.pm * BM + wr * 64 + fr, col0 = u.pn * BM + wc * 32 + 8 * fq;
        float inv[8];
#pragma unroll
        for (int t = 0; t < 8; ++t) inv[t] = __builtin_amdgcn_exp2f(-(float)(2 * ((fq & 1) * 8 + t)) * (13.287712379549449f / 32.f));
        const float sgn = (fq >= 2) ? 1.f : -1.f;
#pragma unroll
        for (int ai = 0; ai < 2; ++ai)
#pragma unroll
            for (int m = 0; m < 4; ++m) { const int row = row0 + ai * HALF + m * 16, sq = row & (SEQ - 1); const float prow = (float)(sq >> 6), pcol = (float)(sq & 63);
                const float rq = 1.0f / sqrtf(ssq[row] * (1.f / 512.f) + EPS);
#pragma unroll
                for (int bj = 0; bj < 2; ++bj) { f32x4 v0 = acc[ai][bj][m][0] * rq, v1 = acc[ai][bj][m][1] * rq;
                    const int rel = (u.pn * BM + bj * HALF + wc * 32) % 192;
                    if (rel >= 128) { const float pos = (rel >= 160) ? pcol : prow;
#pragma unroll
                        for (int t = 0; t < 4; ++t) {
                            const float a0 = pos * inv[t], a1 = pos * inv[4 + t];
                            const float p0 = __shfl_xor(v0[t], 32), p1 = __shfl_xor(v1[t], 32);
                            v0[t] = v0[t] * __cosf(a0) + sgn * p0 * __sinf(a0); v1[t] = v1[t] * __cosf(a1) + sgn * p1 * __sinf(a1); } }
                    u32x2 w; w.x = q8x4(v0[0] * QKSB, v0[1] * QKSB, v0[2] * QKSB, v0[3] * QKSB); w.y = q8x4(v1[0] * QKSB, v1[1] * QKSB, v1[2] * QKSB, v1[3] * QKSB);
                    *(u32x2*)((unsigned char*)O + (size_t)row * 1536 + col0 + bj * HALF) = w; } }
    }
};
struct EpiKV {
    static constexpr bool PERM = true, AFTER_DRAIN = false;
    unsigned char* KN8; bf16_t* VB; const float* ssq;
    __device__ __forceinline__ void operator()(const Acc& acc, const Unit& u, int wr, int wc, int fr, int fq) const {
        const int row0 = u.pm * BM + wr * 64 + fr, colh = u.pn * HALF + wc * 32 + 8 * fq;
#pragma unroll
        for (int ai = 0; ai < 2; ++ai)
#pragma unroll
            for (int m = 0; m < 4; ++m) { const int row = row0 + ai * HALF + m * 16; const float r = 1.0f / sqrtf(ssq[row] * (1.f / 512.f) + EPS);
                const f32x4 k0 = acc[ai][0][m][0] * (r * QKSB), k1 = acc[ai][0][m][1] * (r * QKSB);
                u32x2 w; w.x = q8x4(k0[0], k0[1], k0[2], k0[3]); w.y = q8x4(k1[0], k1[1], k1[2], k1[3]);
                *(u32x2*)(KN8 + (size_t)row * 1024 + colh) = w;
                store8(VB + (size_t)row * 1024 + colh, acc[ai][1][m][0] * r, acc[ai][1][m][1] * r); }
    }
};
template <bool SECOND> struct EpiGate {
    static constexpr bool PERM = true, AFTER_DRAIN = false;
    const bf16_t* SG; bf16_t* T1; bf16_t* O;
    __device__ __forceinline__ void operator()(const Acc& acc, const Unit& u, int wr, int wc, int fr, int fq) const {
        const int row0 = u.pm * BM + wr * 64 + fr, col0 = u.pn * BM + wc * 32 + 8 * fq;
#pragma unroll
        for (int ai = 0; ai < 2; ++ai)
#pragma unroll
            for (int m = 0; m < 4; ++m) { const size_t ro = (size_t)(row0 + ai * HALF + m * 16);
#pragma unroll
                for (int bj = 0; bj < 2; ++bj) {
                    const u32x4 b = *(const u32x4*)(SG + ro * 4096 + (SECOND ? 2048 : 0) + col0 + bj * HALF);
                    f32x4 s0, s1;
                    s0[0] = bf_lo(b.x); s0[1] = bf_hi(b.x); s0[2] = bf_lo(b.y); s0[3] = bf_hi(b.y);
                    s1[0] = bf_lo(b.z); s1[1] = bf_hi(b.z); s1[2] = bf_lo(b.w); s1[3] = bf_hi(b.w);
                    bf16_t* tp = T1 + ro * 2048 + col0 + bj * HALF;
                    if constexpr (!SECOND) { store8(tp, acc[ai][bj][m][0] * s0, acc[ai][bj][m][1] * s1); }
                    else { const u32x4 tw = *(const u32x4*)tp; f32x4 t0, t1;
                        t0[0] = bf_lo(tw.x); t0[1] = bf_hi(tw.x); t0[2] = bf_lo(tw.y); t0[3] = bf_hi(tw.y); t1[0] = bf_lo(tw.z); t1[1] = bf_hi(tw.z); t1[2] = bf_lo(tw.w); t1[3] = bf_hi(tw.w);
                        store8(O + ro * 2048 + col0 + bj * HALF, t0 + acc[ai][bj][m][0] * s0, t1 + acc[ai][bj][m][1] * s1); } } }
    }
};
template <bool BASEBF> struct EpiResid {
    static constexpr bool PERM = false, AFTER_DRAIN = false;
    const float* basef; const bf16_t* baseb; bf16_t* HB; float* ssq;
    __device__ __forceinline__ void operator()(const Acc& acc, const Unit& u, int wr, int wc, int fr, int fq) const {
        const int row0 = u.pm * BM + wr * 64 + fr, col0 = u.pn * BM + wc * 32 + 4 * fq;
#pragma unroll
        for (int ai = 0; ai < 2; ++ai)
#pragma unroll
            for (int m = 0; m < 4; ++m) { const int row = row0 + ai * HALF + m * 16; const size_t ro = (size_t)row * DM + col0; float ss = 0.f;
#pragma unroll
                for (int bj = 0; bj < 2; ++bj)
#pragma unroll
                    for (int n = 0; n < 2; ++n) { const size_t o = ro + bj * HALF + n * 16;
                        f32x4 v = acc[ai][bj][m][n];
                        if constexpr (BASEBF) { const u32x2 bw = *(const u32x2*)(baseb + o); v = v + (f32x4){bf_lo(bw.x), bf_hi(bw.x), bf_lo(bw.y), bf_hi(bw.y)}; }
                        else v = v + *(const f32x4*)(basef + o);
                        u32x2 w; w.x = cvt_pk_bf16(v.x, v.y); w.y = cvt_pk_bf16(v.z, v.w);
                        *(u32x2*)(HB + o) = w; ss += (v.x * v.x + v.y * v.y) + (v.z * v.z + v.w * v.w); }
                ss += __shfl_xor(ss, 16); ss += __shfl_xor(ss, 32);
                if (fq == 0) (void)__hip_atomic_fetch_add((__attribute__((address_space(1))) float*)(ssq + row), ss, __ATOMIC_RELAXED, __HIP_MEMORY_SCOPE_AGENT); }
    }
};
struct EpiSwiglu {
    static constexpr bool PERM = true, AFTER_DRAIN = false;
    bf16_t* O; const float* ssq;
    __device__ __forceinline__ void operator()(const Acc& acc, const Unit& u, int wr, int wc, int fr, int fq) const {
        const int row0 = u.pm * BM + wr * 64 + fr, col0 = u.pn * HALF + wc * 32 + 8 * fq;
#pragma unroll
        for (int ai = 0; ai < 2; ++ai)
#pragma unroll
            for (int m = 0; m < 4; ++m) {
                f32x4 a0, a1; const float r = 1.0f / sqrtf(ssq[row0 + ai * HALF + m * 16] * (1.f / DM) + EPS);
#pragma unroll
                for (int j = 0; j < 4; ++j) { const float g0 = acc[ai][0][m][0][j] * r, g1 = acc[ai][0][m][1][j] * r;
                    a0[j] = g0 * sigmoidf_(g0) * (acc[ai][1][m][0][j] * r); a1[j] = g1 * sigmoidf_(g1) * (acc[ai][1][m][1][j] * r); }
                store8(O + (size_t)(row0 + ai * HALF + m * 16) * DFF + col0, a0, a1); }
    }
};

template <class Epi, class Sched, bool ALIGN_EPI, bool SP2, bool MID, bool I8 = false>
__device__ __forceinline__ void gemm_phase(LAS unsigned char* lds, const Gemm g, const Sched S, const Epi E) {
    const int tid = threadIdx.x, wid = __builtin_amdgcn_readfirstlane(tid >> 6), lane = tid & 63, wr = wid >> 2, wc = wid & 3, fr = lane & 15, fq = lane >> 4;
    const int K = g.ld, nt = g.K / BK;
    unsigned voffA[2], voffB[2];
#pragma unroll
    for (int i = 0; i < 2; ++i) { int R, C; stage_rc(tid * 16 + i * 8192, R, C); const int Rb = Epi::PERM ? ((R & ~31) + perm32(R & 31)) : R;
        voffA[i] = (unsigned)(R * (g.lda ? g.lda : K) + C) * 2u; voffB[i] = (unsigned)(Rb * K + C) * 2u; }
    const size_t kstep = (size_t)(BK * 2);
    const int KA = g.lda ? g.lda : K;
    const size_t hstep = (size_t)HALF * K * 2, hstepA = (size_t)HALF * KA * 2;
    const size_t tstep = 2 * hstep, tstepA = 2 * hstepA;
    const unsigned ldsw = (unsigned)wid * 1024u;
    const int aoff = lds_byte(wr * 64 + fr, fq * 8), boff = lds_byte(wc * 32 + fr, fq * 8);
#define PG8_SA(b, h) (((b) * 2 + (h)) * HTB)
#define PG8_SB(b, h) ((4 + (b) * 2 + (h)) * HTB)
#define PG8_STAGE(bufoff, gbase, voff) do { _Pragma("unroll") for (int _i = 0; _i < 2; ++_i) \
        __builtin_amdgcn_global_load_lds((const unsigned*)((const char*)(gbase) + (voff)[_i]), (LAS unsigned*)(lds + (bufoff) + ldsw + _i * 8192), 16, 0, 0); } while (0)
#define PG8_LDA(dst, b, h) do { _Pragma("unroll") for (int m = 0; m < 4; ++m) _Pragma("unroll") for (int k = 0; k < 2; ++k) dst[m][k] = *(const LAS bf16x8*)(lds + PG8_SA(b, h) + aoff + m * 2048 + k * 1024); } while (0)
#define PG8_LDB(dst, b, h) do { _Pragma("unroll") for (int n = 0; n < 2; ++n) _Pragma("unroll") for (int k = 0; k < 2; ++k) dst[n][k] = *(const LAS bf16x8*)(lds + PG8_SB(b, h) + boff + n * 2048 + k * 1024); } while (0)
#define PG8_MMA(ai, bj, At, Bt) do { __builtin_amdgcn_s_setprio(1); _Pragma("unroll") for (int m = 0; m < 4; ++m) _Pragma("unroll") for (int n = 0; n < 2; ++n) _Pragma("unroll") for (int k = 0; k < 2; ++k) { \
        if constexpr (I8) acc[ai][bj][m][n] = __builtin_bit_cast(f32x4, __builtin_amdgcn_mfma_i32_16x16x64_i8(__builtin_bit_cast(v4i_t, Bt[n][k]), __builtin_bit_cast(v4i_t, At[m][k]), __builtin_bit_cast(v4i_t, acc[ai][bj][m][n]), 0, 0, 0)); \
        else acc[ai][bj][m][n] = __builtin_amdgcn_mfma_f32_16x16x32_bf16(Bt[n][k], At[m][k], acc[ai][bj][m][n], 0, 0, 0); } __builtin_amdgcn_s_setprio(0); } while (0)
#define PG8_WAIT_V(n) asm volatile("s_waitcnt vmcnt(" #n ")" ::: "memory")
#define PG8_WAIT_L(n) asm volatile("s_waitcnt lgkmcnt(" #n ")" ::: "memory")
#define PG8_BAR __builtin_amdgcn_s_barrier()
#define PG8_SCHED __builtin_amdgcn_sched_barrier(0)
    Unit cur, nxt; int ui = 0;
    if (!S.next(0, cur)) return;
    Acc acc;
#pragma unroll
    for (int a = 0; a < 2; ++a)
#pragma unroll
        for (int b = 0; b < 2; ++b)
#pragma unroll
            for (int m = 0; m < 4; ++m)
#pragma unroll
                for (int n = 0; n < 2; ++n) acc[a][b][m][n] = (f32x4){0.f, 0.f, 0.f, 0.f};
    bf16x8 At[4][2], B0[2][2], B1[2][2];
    const char* cA = (const char*)g.A + (size_t)cur.pm * tstepA + (size_t)cur.kh * g.koff; const char* cB = (const char*)g.Bt + (size_t)cur.pn * tstep + (size_t)cur.kh * g.koff;
    S.a_ready(cur);
    if constexpr (SP2) {
        PG8_STAGE(PG8_SB(0, 0), cB, voffB); PG8_STAGE(PG8_SB(0, 1), cB + hstep, voffB); PG8_STAGE(PG8_SA(0, 0), cA, voffA); PG8_STAGE(PG8_SA(0, 1), cA + hstepA, voffA);
        if (wr == 1) PG8_BAR;
        PG8_WAIT_V(2); PG8_BAR;
        PG8_STAGE(PG8_SB(1, 0), cB + kstep, voffB); PG8_STAGE(PG8_SA(1, 0), cA + kstep, voffA); PG8_STAGE(PG8_SB(1, 1), cB + hstep + kstep, voffB);
        PG8_WAIT_V(6); PG8_BAR;
    } else {
        PG8_STAGE(PG8_SB(0, 0), cB, voffB); PG8_STAGE(PG8_SA(0, 0), cA, voffA); PG8_STAGE(PG8_SB(0, 1), cB + hstep, voffB); PG8_STAGE(PG8_SA(0, 1), cA + hstepA, voffA);
        if (wr == 1) PG8_BAR;
        PG8_WAIT_V(4); PG8_BAR;
        PG8_STAGE(PG8_SB(1, 0), cB + kstep, voffB); PG8_STAGE(PG8_SA(1, 0), cA + kstep, voffA); PG8_STAGE(PG8_SB(1, 1), cB + hstep + kstep, voffB);
        PG8_WAIT_V(6); PG8_BAR;
    }
    for (;;) {
        const bool has_next = S.next(ui + 1, nxt);
        const char* nA = has_next ? (const char*)g.A + (size_t)nxt.pm * tstepA + (size_t)nxt.kh * g.koff : cA; const char* nB = has_next ? (const char*)g.Bt + (size_t)nxt.pn * tstep + (size_t)nxt.kh * g.koff : cB;
        for (int t = 0; t < nt; t += 2) {
            const bool last = (t == nt - 2);
            const char* a1 = cA + (size_t)(t + 1) * kstep;
            const char* a2 = last ? nA : cA + (size_t)(t + 2) * kstep; const char* b2 = last ? nB : cB + (size_t)(t + 2) * kstep;
            const char* a3 = a2 + kstep; const char* b3 = b2 + kstep;
            if (last && has_next) S.a_ready(nxt);
            if constexpr (SP2) {
            PG8_LDB(B0, 0, 0); PG8_LDB(B1, 0, 1); PG8_SCHED; PG8_LDA(At, 0, 0); PG8_STAGE(PG8_SA(1, 1), a1 + hstepA, voffA);
            PG8_WAIT_V(8); PG8_WAIT_L(0); PG8_BAR; PG8_MMA(0, 0, At, B0); PG8_MMA(0, 1, At, B1); PG8_BAR; PG8_SCHED;
            PG8_LDA(At, 0, 1); PG8_STAGE(PG8_SB(0, 0), b2, voffB); PG8_STAGE(PG8_SB(0, 1), b2 + hstep, voffB); PG8_STAGE(PG8_SA(0, 0), a2, voffA);
            PG8_WAIT_V(8); PG8_WAIT_L(0); PG8_BAR; PG8_MMA(1, 0, At, B0); PG8_MMA(1, 1, At, B1); PG8_BAR; PG8_SCHED;
            PG8_LDB(B0, 1, 0); PG8_LDB(B1, 1, 1); PG8_SCHED; PG8_LDA(At, 1, 0); PG8_STAGE(PG8_SA(0, 1), a2 + hstepA, voffA);
            PG8_WAIT_V(8); PG8_WAIT_L(0); PG8_BAR; PG8_MMA(0, 0, At, B0); PG8_MMA(0, 1, At, B1); PG8_BAR; PG8_SCHED;
            PG8_LDA(At, 1, 1); PG8_STAGE(PG8_SB(1, 0), b3, voffB); PG8_STAGE(PG8_SB(1, 1), b3 + hstep, voffB); PG8_STAGE(PG8_SA(1, 0), a3, voffA);
            PG8_WAIT_V(8); PG8_WAIT_L(0); PG8_BAR; PG8_MMA(1, 0, At, B0); PG8_MMA(1, 1, At, B1); PG8_BAR; PG8_SCHED;
            } else {
            PG8_LDB(B0, 0, 0); PG8_SCHED; PG8_LDA(At, 0, 0); PG8_STAGE(PG8_SA(1, 1), a1 + hstepA, voffA);
            PG8_WAIT_L(8); PG8_BAR; PG8_WAIT_L(0); PG8_MMA(0, 0, At, B0); PG8_BAR; PG8_SCHED;
            PG8_LDB(B1, 0, 1); PG8_STAGE(PG8_SB(0, 0), b2, voffB);
            PG8_BAR; PG8_WAIT_L(0); PG8_MMA(0, 1, At, B1); PG8_BAR;
            PG8_LDA(At, 0, 1); PG8_STAGE(PG8_SA(0, 0), a2, voffA);
            PG8_BAR; PG8_WAIT_L(0); PG8_MMA(1, 0, At, B0); PG8_BAR; PG8_SCHED;
            PG8_STAGE(PG8_SB(0, 1), b2 + hstep, voffB);
            PG8_WAIT_V(6); PG8_BAR; PG8_MMA(1, 1, At, B1); PG8_BAR;
            PG8_LDB(B0, 1, 0); PG8_SCHED; PG8_LDA(At, 1, 0); PG8_STAGE(PG8_SA(0, 1), a2 + hstepA, voffA);
            PG8_WAIT_L(8); PG8_BAR; PG8_WAIT_L(0); PG8_MMA(0, 0, At, B0); PG8_BAR; PG8_SCHED;
            PG8_LDB(B1, 1, 1); PG8_STAGE(PG8_SB(1, 0), b3, voffB);
            PG8_BAR; PG8_WAIT_L(0); PG8_MMA(0, 1, At, B1); PG8_BAR;
            PG8_LDA(At, 1, 1); PG8_STAGE(PG8_SA(1, 0), a3, voffA);
            PG8_BAR; PG8_WAIT_L(0); PG8_MMA(1, 0, At, B0); PG8_BAR; PG8_SCHED;
            PG8_STAGE(PG8_SB(1, 1), b3 + hstep, voffB);
            PG8_WAIT_V(6); PG8_BAR; PG8_MMA(1, 1, At, B1); PG8_BAR;
            }
        }
        if constexpr (ALIGN_EPI) { if (wr == 0) PG8_BAR; }
        { E(acc, cur, wr, wc, fr, fq); S.done(cur);
#pragma unroll
        for (int a = 0; a < 2; ++a)
#pragma unroll
            for (int b = 0; b < 2; ++b)
#pragma unroll
                for (int m = 0; m < 4; ++m)
#pragma unroll
                    for (int n = 0; n < 2; ++n) acc[a][b][m][n] = (f32x4){0.f, 0.f, 0.f, 0.f};
        }
        if (!has_next) break;
        cur = nxt; cA = nA; cB = nB; ++ui;
        if constexpr (ALIGN_EPI) { if (wr == 1) PG8_BAR; }
    }
    PG8_WAIT_V(0);
    if constexpr (!ALIGN_EPI) { if (wr == 0) PG8_BAR; }
    PG8_BAR;
#undef PG8_SA
#undef PG8_SB
#undef PG8_STAGE
#undef PG8_LDA
#undef PG8_LDB
#undef PG8_MMA
#undef PG8_WAIT_V
#undef PG8_WAIT_L
#undef PG8_BAR
#undef PG8_SCHED
}
}

namespace att {
constexpr int NW = 8, QBLK = 32, KVBLK = 64;
constexpr int SHM_V = KVBLK * 128 * 2, SHM_K = KVBLK * 128 * 2, SHM_KR = KVBLK * 64 * 2;
constexpr int OFF_V = 0, OFF_K = 2 * SHM_V, OFF_WS = OFF_K + 2 * SHM_K, OFF_KR = OFF_WS + NW * 64 * 4, OFF_QR = OFF_KR + 2 * SHM_KR, QR_WAVE = 6144, ATT_LDS = OFF_QR + NW * QR_WAVE;
constexpr float THR = 8.f;
#define KSWZ(row, colB) ((row) * 256 + ((colB) ^ (((row) & 7) << 4)))
#define KRSWZ(row, colB) ((row) * 128 + ((colB) ^ ((((row) >> 1) & 7) << 4)))
#define SBAR() __builtin_amdgcn_sched_barrier(0)
__device__ __forceinline__ int crow(int r, int hi) { return (r & 3) + 8 * (r >> 2) + 4 * hi; }

__device__ __forceinline__ void partialSM(f32x16& p0, f32x16& p1, float& m_reg, float& mn, float& alpha, const float C, const float THRS) {
  float pmax = p0[0];
#pragma unroll
  for (int r = 1; r < 16; ++r) pmax = fmaxf(pmax, p0[r]);
#pragma unroll
  for (int r = 0; r < 16; ++r) pmax = fmaxf(pmax, p1[r]);
  { auto rr = __builtin_amdgcn_permlane32_swap(__float_as_uint(pmax), __float_as_uint(pmax), false, false);
    pmax = fmaxf(__uint_as_float(rr[0]), __uint_as_float(rr[1])); }
  if (__builtin_expect(__all(pmax - m_reg <= THRS), 1)) { mn = m_reg; alpha = 1.f; }
  else { mn = fmaxf(m_reg, pmax); alpha = __builtin_amdgcn_exp2f((m_reg - mn) * C); m_reg = mn; }
  float mnC = -mn * C;
#pragma unroll
  for (int r = 0; r < 16; ++r) p0[r] = fmaf(p0[r], C, mnC);
#pragma unroll
  for (int r = 0; r < 16; ++r) p1[r] = fmaf(p1[r], C, mnC);
#pragma unroll
  for (int r = 0; r < 16; ++r) p0[r] = __builtin_amdgcn_exp2f(p0[r]);
}
__device__ __forceinline__ void finishSM(f32x16& p0, f32x16& p1, float alpha, float& l_reg, bf16x8& pa0, bf16x8& pa1, bf16x8& pa2, bf16x8& pa3) {
#pragma unroll
  for (int r = 0; r < 16; ++r) p1[r] = __builtin_amdgcn_exp2f(p1[r]);
  float ps = 0;
#pragma unroll
  for (int r = 0; r < 16; ++r) ps += p0[r];
#pragma unroll
  for (int r = 0; r < 16; ++r) ps += p1[r];
  { auto rr = __builtin_amdgcn_permlane32_swap(__float_as_uint(ps), __float_as_uint(ps), false, false);
    ps = __uint_as_float(rr[0]) + __uint_as_float(rr[1]); }
  l_reg = l_reg * alpha + ps;
#define PK4(P, BASE, OUT) do { unsigned a0 = cvt_pk_bf16(P[BASE + 0], P[BASE + 1]), a1 = cvt_pk_bf16(P[BASE + 2], P[BASE + 3]);   \
    unsigned b0 = cvt_pk_bf16(P[BASE + 4], P[BASE + 5]), b1 = cvt_pk_bf16(P[BASE + 6], P[BASE + 7]);                              \
    auto r0 = __builtin_amdgcn_permlane32_swap(a0, b0, false, false); auto r1 = __builtin_amdgcn_permlane32_swap(a1, b1, false, false); \
    u32x4 w = {r0[0], r1[0], r0[1], r1[1]}; OUT = *reinterpret_cast<bf16x8*>(&w); } while (0)
  PK4(p0, 0, pa0); PK4(p0, 8, pa1); PK4(p1, 0, pa2); PK4(p1, 8, pa3);
#undef PK4
}
template <int DK, int NQR>
__device__ __forceinline__ void qkt(f32x16& p0, f32x16& p1, const char* Ks, const char* Krs, const bf16x8* qr, const char* qrl, int r32, int hi) {
  p0 = f32x16{}; p1 = f32x16{};
#pragma unroll
  for (int d0 = 0; d0 < 8; ++d0) { int cb = (d0 * 16 + hi * 8) * 2;
    bf16x8 b0 = *reinterpret_cast<const bf16x8*>(Ks + KSWZ(r32, cb));
    bf16x8 b1 = *reinterpret_cast<const bf16x8*>(Ks + KSWZ(32 + r32, cb));
    bf16x8 qv; if (d0 < NQR) qv = qr[d0 < NQR ? d0 : 0]; else qv = *reinterpret_cast<const bf16x8*>(qrl + (d0 - NQR) * 1024);
    p0 = __builtin_amdgcn_mfma_f32_32x32x16_bf16(b0, qv, p0, 0, 0, 0);
    p1 = __builtin_amdgcn_mfma_f32_32x32x16_bf16(b1, qv, p1, 0, 0, 0); }
  if constexpr (DK == 192) {
#pragma unroll
    for (int d0 = 0; d0 < 4; ++d0) { int cb = (d0 * 16 + hi * 8) * 2;
      bf16x8 b0 = *reinterpret_cast<const bf16x8*>(Krs + KRSWZ(r32, cb));
      bf16x8 b1 = *reinterpret_cast<const bf16x8*>(Krs + KRSWZ(32 + r32, cb));
      const bf16x8 qv = *reinterpret_cast<const bf16x8*>(qrl + (8 - NQR + d0) * 1024);
      p0 = __builtin_amdgcn_mfma_f32_32x32x16_bf16(b0, qv, p0, 0, 0, 0);
      p1 = __builtin_amdgcn_mfma_f32_32x32x16_bf16(b1, qv, p1, 0, 0, 0); }
  }
}
__device__ __forceinline__ int v_st(int k, int c) { const int kk = (k & ~0xC) | ((k & 4) << 1) | ((k & 8) >> 1); return ((kk >> 3) * 4 + (c >> 5)) * 512 + ((kk & 7) * 32 + (c & 31)) * 2; }
__device__ __forceinline__ int v_rd_base(int lane) { return ((lane & 3) << 3) | (((lane >> 2) & 3) << 6) | (((lane >> 4) & 1) << 5) | (((lane >> 5) & 1) << 8); }
constexpr int v_rd_off(int d0, int ks, int half) { return d0 * 512 + ks * 4096 + half * 2048; }
template <int OFF> __device__ __forceinline__ s16x4 tr_read(int vb) {
  s16x4 r; asm volatile("ds_read_b64_tr_b16 %0, %1 offset:%2" : "=&v"(r) : "v"(vb), "i"(OFF) : "memory"); return r;
}
template <int D0> __device__ __forceinline__ void pv_one(f32x16& od, int vb, bf16x8 pa0, bf16x8 pa1, bf16x8 pa2, bf16x8 pa3) {
  const s16x4 l0 = tr_read<v_rd_off(D0, 0, 0)>(vb), h0 = tr_read<v_rd_off(D0, 0, 1)>(vb), l1 = tr_read<v_rd_off(D0, 1, 0)>(vb), h1 = tr_read<v_rd_off(D0, 1, 1)>(vb);
  const s16x4 l2 = tr_read<v_rd_off(D0, 2, 0)>(vb), h2 = tr_read<v_rd_off(D0, 2, 1)>(vb), l3 = tr_read<v_rd_off(D0, 3, 0)>(vb), h3 = tr_read<v_rd_off(D0, 3, 1)>(vb);
  asm volatile("s_waitcnt lgkmcnt(0)" ::: "memory"); SBAR();
#define PK(L, H) (bf16x8){L[0], L[1], L[2], L[3], H[0], H[1], H[2], H[3]}
  od = __builtin_amdgcn_mfma_f32_32x32x16_bf16(pa0, PK(l0, h0), od, 0, 0, 0);
  od = __builtin_amdgcn_mfma_f32_32x32x16_bf16(pa1, PK(l1, h1), od, 0, 0, 0);
  od = __builtin_amdgcn_mfma_f32_32x32x16_bf16(pa2, PK(l2, h2), od, 0, 0, 0);
  od = __builtin_amdgcn_mfma_f32_32x32x16_bf16(pa3, PK(l3, h3), od, 0, 0, 0);
#undef PK
}
__device__ __forceinline__ void pv_d0(f32x16* o, int vb, bf16x8 pa0, bf16x8 pa1, bf16x8 pa2, bf16x8 pa3) {
  pv_one<0>(o[0], vb, pa0, pa1, pa2, pa3); pv_one<1>(o[1], vb, pa0, pa1, pa2, pa3); pv_one<2>(o[2], vb, pa0, pa1, pa2, pa3); pv_one<3>(o[3], vb, pa0, pa1, pa2, pa3);
}

#define K8SWZ(row, chunk) ((row) * 128 + ((((chunk) ^ (((row) >> 1) & 7))) << 4))
#define KR8SWZ(row, chunk) ((row) * 64 + ((((chunk) ^ (((row) >> 2) & 3))) << 4))
constexpr float ATT_SQK = 20.f;
typedef int v16i_t __attribute__((ext_vector_type(16)));
template <int DK>
__device__ __forceinline__ void qkt8(f32x16& p0, f32x16& p1, const char* Ks, const char* Krs, const v4i_t* qi, int r32, int hi) {
  p0 = f32x16{}; p1 = f32x16{};
#pragma unroll
  for (int d = 0; d < 4; ++d) {
    const v4i_t b0 = *reinterpret_cast<const v4i_t*>(Ks + K8SWZ(r32, 2 * d + hi));
    const v4i_t b1 = *reinterpret_cast<const v4i_t*>(Ks + K8SWZ(32 + r32, 2 * d + hi));
    p0 = __builtin_bit_cast(f32x16, __builtin_amdgcn_mfma_i32_32x32x32_i8(b0, qi[d], __builtin_bit_cast(v16i_t, p0), 0, 0, 0));
    p1 = __builtin_bit_cast(f32x16, __builtin_amdgcn_mfma_i32_32x32x32_i8(b1, qi[d], __builtin_bit_cast(v16i_t, p1), 0, 0, 0)); }
  if constexpr (DK == 192) {
#pragma unroll
    for (int d = 0; d < 2; ++d) {
      const v4i_t b0 = *reinterpret_cast<const v4i_t*>(Krs + KR8SWZ(r32, 2 * d + hi));
      const v4i_t b1 = *reinterpret_cast<const v4i_t*>(Krs + KR8SWZ(32 + r32, 2 * d + hi));
      p0 = __builtin_bit_cast(f32x16, __builtin_amdgcn_mfma_i32_32x32x32_i8(b0, qi[4 + d], __builtin_bit_cast(v16i_t, p0), 0, 0, 0));
      p1 = __builtin_bit_cast(f32x16, __builtin_amdgcn_mfma_i32_32x32x32_i8(b1, qi[4 + d], __builtin_bit_cast(v16i_t, p1), 0, 0, 0)); }
  }
#pragma unroll
  for (int r = 0; r < 16; ++r) { p0[r] = (float)__float_as_int(p0[r]); p1[r] = (float)__float_as_int(p1[r]); }
}
template <int DK, int SDEPTH, int ldq, int ldk, int ldv, int ldo, int seq, bool QK8 = false>
__device__ __forceinline__ void attn_unit(const bf16_t* __restrict__ Qb, const bf16_t* __restrict__ Kh, const bf16_t* __restrict__ Krp,
                                          const bf16_t* __restrict__ Vh, bf16_t* __restrict__ Ob, char* lds) {
  constexpr float SCALE = (DK == 128) ? 0.088388347648318440f : 0.072168783648703220f;
  constexpr float QKS = QK8 ? (ATT_SQK * ATT_SQK) : 1.f;
  constexpr float C = SCALE * 1.4426950408889634f / QKS, THRS = THR / SCALE * QKS;
  constexpr int ND = QK8 ? 0 : DK / 16, NQR = QK8 ? 0 : ((DK == 128) ? 8 : 6);
  const int tid = threadIdx.x, wid = tid >> 6, lane = tid & 63, r32 = lane & 31, hi = lane >> 5;
  char* V_lds = lds + OFF_V; char* K_lds = lds + OFF_K; char* KR_lds = lds + OFF_KR;
  float* ws = (float*)(lds + OFF_WS) + wid * 64; float* li_l = ws; float* al_l = ws + 32;
  float m_reg = -1e30f, l_reg = 0; f32x16 o[4] = {}; bf16x8 qr[NQR ? NQR : 1]; v4i_t qi[DK / 32];
  if constexpr (QK8) { const unsigned char* Qw8 = (const unsigned char*)Qb + (long)(wid * QBLK + r32) * ldq + hi * 16;
#pragma unroll
    for (int d = 0; d < DK / 32; ++d) qi[d] = *reinterpret_cast<const v4i_t*>(Qw8 + d * 32); }
  const bf16_t* Qw = Qb + (long)(wid * QBLK + r32) * ldq + hi * 8;
#pragma unroll
  for (int d0 = 0; d0 < NQR; ++d0) qr[d0] = *reinterpret_cast<const bf16x8*>(Qw + d0 * 16);
  char* qrl = lds + OFF_QR + wid * QR_WAVE + lane * 16;
#pragma unroll
  for (int d0 = NQR; d0 < ND; ++d0) *reinterpret_cast<bf16x8*>(qrl + (d0 - NQR) * 1024) = *reinterpret_cast<const bf16x8*>(Qw + d0 * 16);
  const int sr = tid >> 4, sc = (tid & 15) * 8, vst0 = v_st(sr, sc), vst1 = v_st(32 + sr, sc);
  const int krr = tid >> 3, krc = (tid & 7) * 8;
  const int vb0 = (int)(uintptr_t)V_lds + v_rd_base(lane);
  bf16x8 vs0[SDEPTH], vs1[SDEPTH], ks0[SDEPTH], ks1[SDEPTH], kr0[SDEPTH]; v4i_t k8[SDEPTH], kr8[SDEPTH];
  const int k8off = K8SWZ(krr, tid & 7); const unsigned voffK8 = (unsigned)(krr * ldk + (tid & 7) * 16);
  const int kr8off = KR8SWZ(tid >> 2, tid & 3); const unsigned voffKR8 = (unsigned)((tid >> 2) * 64 + (tid & 3) * 16);
  const unsigned voffV = (unsigned)((sr * ldv + sc) * 2), voffK = (unsigned)((sr * ldk + sc) * 2), voffR = (unsigned)((krr * 64 + krc) * 2);
#define SLOAD(i, k0) do { const char* vb_ = (const char*)Vh + (size_t)(k0) * (ldv * 2); const char* kb_ = (const char*)Kh + (size_t)(k0) * (ldk * 2); \
    vs0[i] = *(const bf16x8*)(vb_ + voffV); vs1[i] = *(const bf16x8*)(vb_ + 32 * ldv * 2 + voffV); \
    if constexpr (QK8) k8[i] = *(const v4i_t*)((const char*)Kh + (size_t)(k0) * ldk + voffK8); \
    else { ks0[i] = *(const bf16x8*)(kb_ + voffK); ks1[i] = *(const bf16x8*)(kb_ + 32 * ldk * 2 + voffK); } \
    if constexpr (DK == 192 && QK8) { if (tid < 256) kr8[i] = *(const v4i_t*)((const char*)Krp + (size_t)(k0) * 64 + voffKR8); } \
    else if constexpr (DK == 192) kr0[i] = *(const bf16x8*)((const char*)Krp + (size_t)(k0) * 128 + voffR); } while (0)
#define SWRITE(b, i) do { *(bf16x8*)(V_lds + (b) * SHM_V + vst0) = vs0[i];          \
    *(bf16x8*)(V_lds + (b) * SHM_V + vst1) = vs1[i]; int kc = sc * 2;               \
    if constexpr (QK8) *(v4i_t*)(K_lds + (b) * SHM_K + k8off) = k8[i];            \
    else { *(bf16x8*)(K_lds + (b) * SHM_K + KSWZ(sr, kc)) = ks0[i];                \
    *(bf16x8*)(K_lds + (b) * SHM_K + KSWZ(32 + sr, kc)) = ks1[i]; }               \
    if constexpr (DK == 192 && QK8) { if (tid < 256) *(v4i_t*)(KR_lds + (b) * SHM_KR + kr8off) = kr8[i]; } \
    else if constexpr (DK == 192) *(bf16x8*)(KR_lds + (b) * SHM_KR + KRSWZ(krr, krc * 2)) = kr0[i]; } while (0)
#define SWAIT() do { if constexpr (SDEPTH == 1) asm volatile("s_waitcnt vmcnt(0)" ::: "memory"); else if constexpr (QK8) asm volatile("s_waitcnt vmcnt(3)" ::: "memory"); else if constexpr (DK == 192) asm volatile("s_waitcnt vmcnt(5)" ::: "memory"); else asm volatile("s_waitcnt vmcnt(4)" ::: "memory"); } while (0)
#define QKT(P0, P1, KB, KRB) do { if constexpr (QK8) qkt8<DK>(P0, P1, KB, KRB, qi, r32, hi); else qkt<DK, (NQR ? NQR : 8)>(P0, P1, KB, KRB, qr, qrl, r32, hi); } while (0)
#define RESC(a) do { if (__any((a) < 1.f)) { if (hi == 0) al_l[r32] = (a); asm volatile("s_waitcnt lgkmcnt(0)" ::: "memory"); \
    _Pragma("unroll") for (int d = 0; d < 4; ++d) _Pragma("unroll") for (int r = 0; r < 16; ++r) o[d][r] *= al_l[crow(r, hi)]; } } while (0)
  f32x16 pA0, pA1, pB0, pB1; float mnA, mnB, alA, alB; bf16x8 pa0, pa1, pa2, pa3; const int NT = seq / KVBLK;
  constexpr int SE = 0, SO = SDEPTH - 1;
  SLOAD(SE, 0); asm volatile("s_waitcnt vmcnt(0)" ::: "memory"); SWRITE(0, SE); __syncthreads();
  QKT(pA0, pA1, K_lds, KR_lds); partialSM(pA0, pA1, m_reg, mnA, alA, C, THRS);
  SLOAD(SO, KVBLK); if constexpr (SDEPTH == 2) { if (2 < NT) SLOAD(SE, 2 * KVBLK); }
  SWAIT(); SWRITE(1, SO); __syncthreads();
  for (int j = 1; j + 1 < NT; j += 2) {
    SBAR(); QKT(pB0, pB1, K_lds + SHM_K, KR_lds + SHM_KR);
    finishSM(pA0, pA1, alA, l_reg, pa0, pa1, pa2, pa3); SBAR();
    SLOAD(SO, (j + SDEPTH) * KVBLK); SBAR();
    pv_d0(o, vb0, pa0, pa1, pa2, pa3); partialSM(pB0, pB1, m_reg, mnB, alB, C, THRS);
    __syncthreads(); SWAIT(); SWRITE(0, SE);
    RESC(alB); __syncthreads();
    SBAR(); QKT(pA0, pA1, K_lds, KR_lds);
    finishSM(pB0, pB1, alB, l_reg, pa0, pa1, pa2, pa3); SBAR();
    if (SDEPTH == 1 || j + 3 < NT) SLOAD(SE, (j + 1 + SDEPTH) * KVBLK); SBAR();
    pv_d0(o, vb0 + SHM_V, pa0, pa1, pa2, pa3); partialSM(pA0, pA1, m_reg, mnA, alA, C, THRS);
    __syncthreads(); SWAIT(); SWRITE(1, SO);
    RESC(alA); __syncthreads();
  }
  SBAR(); QKT(pB0, pB1, K_lds + SHM_K, KR_lds + SHM_KR);
  finishSM(pA0, pA1, alA, l_reg, pa0, pa1, pa2, pa3); SBAR();
  pv_d0(o, vb0, pa0, pa1, pa2, pa3); partialSM(pB0, pB1, m_reg, mnB, alB, C, THRS);
  __syncthreads(); RESC(alB);
  finishSM(pB0, pB1, alB, l_reg, pa0, pa1, pa2, pa3); SBAR();
  pv_d0(o, vb0 + SHM_V, pa0, pa1, pa2, pa3);
  if (hi == 0) li_l[r32] = l_reg; asm volatile("s_waitcnt lgkmcnt(0)" ::: "memory");
  float rli[16];
#pragma unroll
  for (int r = 0; r < 16; ++r) rli[r] = __builtin_amdgcn_rcpf(li_l[crow(r, hi)]);
  bf16_t* Ow = Ob + (long)(wid * QBLK) * ldo;
#pragma unroll
  for (int r = 0; r < 16; ++r) { int orow = crow(r, hi);
#pragma unroll
    for (int d0 = 0; d0 < 4; ++d0) Ow[(long)orow * ldo + d0 * 32 + r32] = f2bf(o[d0][r] * rli[r]); }
#undef QKT
#undef SLOAD
#undef SWRITE
#undef SWAIT
#undef RESC
}
}

struct TrItem { const float* W; bf16_t* WT; int ldw, k0, n0, ldt, drow0, dk0; const float* gain; };
__device__ __forceinline__ void tr_load(f32x4 (&v)[16], const TrItem& t, int lane) {
    const int lr = lane >> 4, lc = (lane & 15) * 4;
#pragma unroll
    for (int i = 0; i < 16; ++i) v[i] = *(const f32x4*)(t.W + (size_t)(t.k0 + 4 * i + lr) * t.ldw + t.n0 + lc);
}
__device__ __forceinline__ void tr_store(const f32x4 (&v)[16], const TrItem& t, LAS float* scr, int lane) {
    const int lr = lane >> 4, lc = (lane & 15) * 4;
#pragma unroll
    for (int i = 0; i < 16; ++i) { LAS float* d = scr + (4 * i + lr) * 65 + lc; const float gk = t.gain ? t.gain[t.k0 + 4 * i + lr] : 1.f;
        d[0] = v[i].x * gk; d[1] = v[i].y * gk; d[2] = v[i].z * gk; d[3] = v[i].w * gk; }
    asm volatile("s_waitcnt lgkmcnt(0)" ::: "memory");
    const int c = lane & 7;
#pragma unroll
    for (int j = 0; j < 8; ++j) { const int n = (lane >> 3) + 8 * j; const LAS float* s = scr + (8 * c) * 65 + n;
        u32x4 o; o.x = cvt_pk_bf16(s[0], s[65]); o.y = cvt_pk_bf16(s[130], s[195]); o.z = cvt_pk_bf16(s[260], s[325]); o.w = cvt_pk_bf16(s[390], s[455]);
        *(u32x4*)(t.WT + (size_t)(t.drow0 + n) * t.ldt + t.dk0 + 8 * c) = o; }
    asm volatile("s_waitcnt lgkmcnt(0)" ::: "memory");
}
__device__ __forceinline__ void tr_item(const float* __restrict__ W, int ldw, int k0, int n0, bf16_t* __restrict__ WT, int ldt, int drow0, int dk0, LAS float* scr, int lane) {
    TrItem t{W, WT, ldw, k0, n0, ldt, drow0, dk0, nullptr}; f32x4 v[16]; tr_load(v, t, lane); tr_store(v, t, scr, lane);
}
__device__ __forceinline__ void rms_row_to_bf16(const float* __restrict__ xrow, const float* __restrict__ g, bf16_t* __restrict__ orow, int lane) {
    f32x4 v[8]; float s = 0.f;
#pragma unroll
    for (int j = 0; j < 8; ++j) { v[j] = *(const f32x4*)(xrow + 4 * lane + 256 * j); s += (v[j].x * v[j].x + v[j].y * v[j].y) + (v[j].z * v[j].z + v[j].w * v[j].w); }
    const float r = 1.0f / sqrtf(wave_sum(s) * (1.f / DM) + EPS);
#pragma unroll
    for (int j = 0; j < 8; ++j) { const f32x4 gg = *(const f32x4*)(g + 4 * lane + 256 * j);
        u32x2 o; o.x = cvt_pk_bf16(v[j].x * r * gg.x, v[j].y * r * gg.y); o.y = cvt_pk_bf16(v[j].z * r * gg.z, v[j].w * r * gg.w);
        *(u32x2*)(orow + 4 * lane + 256 * j) = o; }
}

__device__ __forceinline__ void tr_item8(const float* __restrict__ W, int ldw, int k0, int n0, unsigned char* __restrict__ WT8, int ldt, int drow0, int dk0, LAS float* scr, int lane) {
    const int lr = lane >> 4, lc = (lane & 15) * 4;
    f32x4 v[16];
#pragma unroll
    for (int i = 0; i < 16; ++i) v[i] = *(const f32x4*)(W + (size_t)(k0 + 4 * i + lr) * ldw + n0 + lc);
#pragma unroll
    for (int i = 0; i < 16; ++i) { LAS float* d = scr + (4 * i + lr) * 65 + lc; d[0] = v[i].x * Q8_SW; d[1] = v[i].y * Q8_SW; d[2] = v[i].z * Q8_SW; d[3] = v[i].w * Q8_SW; }
    asm volatile("s_waitcnt lgkmcnt(0)" ::: "memory");
    const int c = lane & 7;
#pragma unroll
    for (int j = 0; j < 8; ++j) { const int n = (lane >> 3) + 8 * j; const LAS float* s = scr + (8 * c) * 65 + n;
        u32x2 o; o.x = q8x4(s[0], s[65], s[130], s[195]); o.y = q8x4(s[260], s[325], s[390], s[455]);
        *(u32x2*)(WT8 + (size_t)(drow0 + n) * ldt + dk0 + 8 * c) = o; }
    asm volatile("s_waitcnt lgkmcnt(0)" ::: "memory");
}
__device__ __forceinline__ void rms_row_to_i8(const float* __restrict__ xrow, const float* __restrict__ g, unsigned char* __restrict__ orow, int lane) {
    f32x4 v[8]; float s = 0.f;
#pragma unroll
    for (int j = 0; j < 8; ++j) { v[j] = *(const f32x4*)(xrow + 4 * lane + 256 * j); s += (v[j].x * v[j].x + v[j].y * v[j].y) + (v[j].z * v[j].z + v[j].w * v[j].w); }
    const float r = Q8_SU / sqrtf(wave_sum(s) * (1.f / DM) + EPS);
#pragma unroll
    for (int j = 0; j < 8; ++j) { const f32x4 gg = *(const f32x4*)(g + 4 * lane + 256 * j);
        *(unsigned*)(orow + 4 * lane + 256 * j) = q8x4(v[j].x * r * gg.x, v[j].y * r * gg.y, v[j].z * r * gg.z, v[j].w * r * gg.w); }
}

#define XB_TMO      128
#define XB_XCNT(j)  (256  + 64 * (j))
#define XB_XSUB(j)  (1280 + 64 * (j))
#define XB_XGEN(j)  (2304 + 64 * (j))
#define XB_TOP      3328
#define XB_TOPGEN   3392
#define XCD_BAR_WORDS 3456
#define XB_SPIN_CAP (1u << 18)
__device__ __forceinline__ unsigned xb_ld(unsigned* p)              { return __hip_atomic_load(p, __ATOMIC_RELAXED, __HIP_MEMORY_SCOPE_AGENT); }
__device__ __forceinline__ unsigned xb_add(unsigned* p, unsigned v) { return __hip_atomic_fetch_add(p, v, __ATOMIC_RELAXED, __HIP_MEMORY_SCOPE_AGENT); }
__device__ __forceinline__ unsigned xb_xcc_id() { return (unsigned)__builtin_amdgcn_s_getreg((3 << 11) | 20) & 0xFu; }
#define XB_SPIN(cond, bar) do { unsigned _sp = 0; while (cond) { __builtin_amdgcn_s_sleep(1); \
    if ((++_sp & 255u) == 0u) { if (xb_ld(&(bar)[XB_TMO])) break; if (_sp > XB_SPIN_CAP) { atomicAdd(&(bar)[XB_TMO], 1u); break; } } } } while (0)
struct XcdBarrier { unsigned* bar; unsigned x; volatile LAS unsigned* st; };
__device__ __forceinline__ XcdBarrier xcd_barrier_post(unsigned* bar, volatile LAS unsigned* st) {
    XcdBarrier b; b.bar = bar; b.x = xb_xcc_id(); b.st = st;
    if (threadIdx.x == 0) (void)xb_add(&bar[XB_XCNT(b.x)], 1u);
    return b;
}
__device__ __forceinline__ void xcd_barrier_complete(unsigned* bar, unsigned x, unsigned& nloc, unsigned& nx) {
    const unsigned G = gridDim.x * gridDim.y * gridDim.z;
    unsigned sum, cnt, mine, sp = 0u;
    for (;;) {
        sum = 0u; cnt = 0u; mine = 0u;
#pragma unroll
        for (unsigned j = 0; j < 16; ++j) { const unsigned c = xb_ld(&bar[XB_XCNT(j)]); sum += c; cnt += (c > 0u) ? 1u : 0u; mine = (j == x) ? c : mine; }
        if (sum == G) break;
        __builtin_amdgcn_s_sleep(1);
        if ((++sp & 255u) == 0u) { if (xb_ld(&bar[XB_TMO])) break; if (sp > XB_SPIN_CAP) { atomicAdd(&bar[XB_TMO], 1u); break; } }
    }
    nloc = mine > 0u ? mine : 1u; nx = cnt > 0u ? cnt : 1u;
}
__device__ __forceinline__ void xcd_barrier(const XcdBarrier& b) {
    asm volatile("s_waitcnt vmcnt(0)" ::: "memory");
    __syncthreads();
    if (threadIdx.x == 0) {
        unsigned* bar = b.bar;
        __builtin_amdgcn_s_waitcnt(0);
        unsigned nloc = b.st[0], nx = b.st[1];
        if (nloc == 0u) { xcd_barrier_complete(bar, b.x, nloc, nx); b.st[0] = nloc; b.st[1] = nx; }
        const unsigned old = xb_add(&bar[XB_XSUB(b.x)], 1u);
        const unsigned gen = old / nloc;
        if (old + 1u == (gen + 1u) * nloc) {
            __builtin_amdgcn_fence(__ATOMIC_RELEASE, "agent");
            asm volatile("s_waitcnt vmcnt(0)" ::: "memory");
            const unsigned og = xb_add(&bar[XB_TOP], 1u);
            const unsigned tg = og / nx;
            if (og + 1u == (tg + 1u) * nx) xb_add(&bar[XB_TOPGEN], 1u);
            else XB_SPIN(xb_ld(&bar[XB_TOPGEN]) == tg, bar);
            __builtin_amdgcn_fence(__ATOMIC_ACQUIRE, "agent");
            xb_add(&bar[XB_XGEN(b.x)], 1u);
            asm volatile("s_waitcnt vmcnt(0)" ::: "memory");
        } else {
            XB_SPIN(xb_ld(&bar[XB_XGEN(b.x)]) == gen, bar);
            __builtin_amdgcn_fence(__ATOMIC_ACQUIRE, "agent");
            asm volatile("s_waitcnt vmcnt(0)" ::: "memory");
        }
    }
    __syncthreads();
}

struct Args {
    const float *x, *p, *g_mix, *w_in, *q_norm_a, *k_norm_a, *q_a_norm, *w_q_b, *kv_a_norm, *w_kv_b, *w_a_out, *w_b_out, *w_o, *g_ffn, *w_gate_up, *w_down, *g_ple,
                *w_ple_gate, *w_ple_proj, *g_ple_post, *g_final;
    float* out; unsigned char* ws; int ph_lo, ph_hi;
};

constexpr int NPHASE = 14;

__global__ void __launch_bounds__(NTHREADS, 2) mk_fwd(Args a) {
    extern __shared__ __attribute__((aligned(16))) unsigned char lds_raw[];
    LAS unsigned char* lds = (LAS unsigned char*)lds_raw;
    const int tid = threadIdx.x, lane = tid & 63, wave = __builtin_amdgcn_readfirstlane(tid >> 6);
    const int G = gridDim.x, bx = blockIdx.x;
    const int gw = bx * NWAVES + wave, NGW = G * NWAVES;
    unsigned char* ws = a.ws;
    bf16_t* WinT = (bf16_t*)(ws + WS_WIN); bf16_t* WqbT = (bf16_t*)(ws + WS_WQB); bf16_t* WkvbT = (bf16_t*)(ws + WS_WKVB); bf16_t* WabT = (bf16_t*)(ws + WS_WAB);
    bf16_t* WoT = (bf16_t*)(ws + WS_WO); bf16_t* WguT = (bf16_t*)(ws + WS_WGU); bf16_t* WdT = (bf16_t*)(ws + WS_WD); bf16_t* WpgT = (bf16_t*)(ws + WS_WPG);
    bf16_t* WppT = (bf16_t*)(ws + WS_WPP); bf16_t* PB = (bf16_t*)(ws + WS_PB); bf16_t* KR = (bf16_t*)(ws + WS_KR); bf16_t* U = (bf16_t*)(ws + WS_U);
    bf16_t* ZS = (bf16_t*)(ws + WS_ZS); bf16_t* SG = (bf16_t*)(ws + WS_SG); bf16_t* QA = (bf16_t*)(ws + WS_QA); bf16_t* QB = (bf16_t*)(ws + WS_QB);
    bf16_t* KVB = (bf16_t*)(ws + WS_KVB); bf16_t* CQN = (bf16_t*)(ws + WS_CQN); bf16_t* CKVN = (bf16_t*)(ws + WS_CKVN); bf16_t* KA = (bf16_t*)(ws + WS_KA);
    bf16_t* KPE = (bf16_t*)(ws + WS_KPE); bf16_t* OAB = (bf16_t*)(ws + WS_OAB); bf16_t* MERGED = (bf16_t*)(ws + WS_MERGED); bf16_t* ACT = (bf16_t*)(ws + WS_ACT);
    bf16_t* GATE = (bf16_t*)(ws + WS_GATE); bf16_t* ERAW = (bf16_t*)(ws + WS_ERAW); float* H = a.out;
    unsigned char* KN8 = ws + WS_KVB; bf16_t* VB = (bf16_t*)(ws + WS_KVB + 8 * MiB);
    float* SSQC = (float*)(ws + 196608); float* SSQK = (float*)(ws + 229376);
    float* SSQ1 = (float*)(ws + 65536); float* SSQ2 = (float*)(ws + 131072);
    const int lo = a.ph_lo, hi = a.ph_hi;
#define IN(k) (lo <= (k) && (k) < hi)
#define SEAM(k) do { if (IN(k) && IN((k) + 1)) { xcd_barrier(xbar); } } while (0)
    volatile LAS unsigned* xst = (volatile LAS unsigned*)(lds + LDS_BYTES - 64);
    if (tid == 0) { xst[0] = 0u; xst[1] = 0u; }
    __syncthreads();
    XcdBarrier xbar = xcd_barrier_post((unsigned*)ws, xst);
    if (a.ph_lo < 0) cg::this_grid().sync();

    constexpr int I0 = 32 * 105, I1 = 8 * 24, I2 = 8 * 32, I3 = 16 * 32, I4 = 16 * 32, I5 = 32 * 32, I6 = 32 * 176, I7 = 88 * 32, I8 = 32 * 32, I9 = 4 * 32;
    constexpr int NREST = I1 + I2 + I3 + I4 + I5 + I6 + I7 + I8 + I9;
    if (IN(0)) {
        LAS float* scr = (LAS float*)(lds + wave * 16640);
        for (int it = gw; it < I0; it += NGW) {
            const int kb = it / 105, nb = it % 105, n0 = nb * 64; const int dr = n0 < 2560 ? n0 : (n0 < 2624 ? 6656 + (n0 - 2560) : n0 - 64);
            tr_item8(a.w_in, NIN, kb * 64, n0, (unsigned char*)WinT, 2048, dr, kb * 64, scr, lane);
        }
        for (int m = gw; m < M; m += NGW) {
            rms_row_to_i8(a.x + (size_t)m * DM, a.g_mix, (unsigned char*)U + (size_t)m * DM, lane);
            const f32x4 pv = *(const f32x4*)(a.p + (size_t)m * PLE + 4 * lane);
            u32x2 o; o.x = cvt_pk_bf16(pv.x, pv.y); o.y = cvt_pk_bf16(pv.z, pv.w);
            *(u32x2*)(PB + (size_t)m * PLE + 4 * lane) = o;
        }
        for (int i = bx * NTHREADS + tid; i < (NINP - NIN) * 2048 / 16; i += G * NTHREADS) *(u32x4*)((unsigned char*)WinT + (size_t)NIN * 2048 + (size_t)i * 16) = (u32x4){0u, 0u, 0u, 0u};
        __syncthreads();
    }
    SEAM(0);
    if (IN(1)) {
        constexpr int NU = (M / 256) * (NINP / 256);
        const int GG = (G >= 256) ? 173 : G;
        if (bx < GG) {
            pg8::Gemm g{U, WinT, M, NINP, DM / 2, DM / 2, 0}; pg8::StaticOrder S; S.init(M, NINP, GG, bx);
            pg8::EpiIn E{ZS, SG, KR, SSQC, SSQK};
            pg8::gemm_phase<pg8::EpiIn, pg8::StaticOrder, true, true, false, true>(lds, g, S, E);
        }
        {
            {
                LAS float* scr = (LAS float*)(lds + wave * 16640);
                unsigned* qctr = (unsigned*)(ws + 262144);
                auto decode = [&](int r) -> TrItem {
                    if (r < I1) { const int kb = r / 24, nb = r % 24; return TrItem{a.w_q_b, WqbT, 1536, kb * 64, nb * 64, 512, nb * 64, kb * 64, a.q_a_norm}; } r -= I1;
                    if (r < I2) { const int kb = r / 32, nb = r % 32; return TrItem{a.w_kv_b, WkvbT, 2048, kb * 64, nb * 64, 512, nb * 64, kb * 64, a.kv_a_norm}; } r -= I2;
                    if (r < I3) { const int kb = r / 32, nb = r % 32; return TrItem{a.w_a_out, WabT, 2048, kb * 64, nb * 64, 2048, nb * 64, kb * 64, nullptr}; } r -= I3;
                    if (r < I4) { const int kb = r / 32, nb = r % 32; return TrItem{a.w_b_out, WabT, 2048, kb * 64, nb * 64, 2048, nb * 64, 1024 + kb * 64, nullptr}; } r -= I4;
                    if (r < I5) { const int kb = r / 32, nb = r % 32; return TrItem{a.w_o, WoT, 2048, kb * 64, nb * 64, 2048, nb * 64, kb * 64, nullptr}; } r -= I5;
                    if (r < I6) { const int kb = r / 176, nb = r % 176, n0 = nb * 64; const int s_ = n0 >= DFF ? 1 : 0, j = n0 - s_ * DFF; const int dr = 256 * (j >> 7) + 128 * s_ + (j & 127);
                        return TrItem{a.w_gate_up, WguT, 2 * DFF, kb * 64, n0, 2048, dr, kb * 64, a.g_ffn}; } r -= I6;
                    if (r < I7) { const int kb = r / 32, nb = r % 32; return TrItem{a.w_down, WdT, 2048, kb * 64, nb * 64, DFF, nb * 64, kb * 64, nullptr}; } r -= I7;
                    if (r < I8) { const int kb = r / 32, nb = r % 32; return TrItem{a.w_ple_gate, WpgT, 2048, kb * 64, nb * 64, 2048, nb * 64, kb * 64, a.g_ple}; } r -= I8;
                    { const int kb = r / 32, nb = r % 32; return TrItem{a.w_ple_proj, WppT, 2048, kb * 64, nb * 64, 256, nb * 64, kb * 64, nullptr}; }
                };
                auto grab = [&]() -> int { unsigned v = 0u; if (lane == 0) v = __hip_atomic_fetch_add((__attribute__((address_space(1))) unsigned*)qctr, 1u, __ATOMIC_RELAXED, __HIP_MEMORY_SCOPE_AGENT); return (int)__builtin_amdgcn_readfirstlane(v); };
                f32x4 va[16], vb[16]; TrItem ta{}, tb{};
                int it = grab();
                if (it < NREST) { ta = decode(it); tr_load(va, ta, lane); }
                while (it < NREST) {
                    int it2 = grab(); if (it2 < NREST) { tb = decode(it2); tr_load(vb, tb, lane); }
                    tr_store(va, ta, scr, lane);
                    it = it2; if (it >= NREST) break;
                    it2 = grab(); if (it2 < NREST) { ta = decode(it2); tr_load(va, ta, lane); }
                    tr_store(vb, tb, scr, lane);
                    it = it2;
                }
            }
            __syncthreads();
        }
        (void)NU;
    }
    SEAM(1);
    if (IN(2)) {
        const int l5 = lane & 31, hsel = lane >> 5, d0 = l5 * 4, isx2 = (l5 >> 3) & 1, halfc = (l5 >> 4) & 1;
        float invA4[4]; f32x4 gq, gk;
#pragma unroll
        for (int i = 0; i < 4; ++i) invA4[i] = powf(10000.f, -(float)(2 * ((d0 & 31) + i)) / 64.f);
        gq = *(const f32x4*)(a.q_norm_a + d0); gk = *(const f32x4*)(a.k_norm_a + d0);
        const int hfb = (lane >> 4) & 1, jb = lane & 15;
        const float invB = powf(10000.f, -(float)(2 * jb) / 32.f);
        for (int m = gw; m < M; m += NGW) {
            const int s = m & (SEQ - 1); const float prow = (float)(s >> 6), pcol = (float)(s & 63);
            const float posA = halfc ? pcol : prow; float cA[4], sA[4];
#pragma unroll
            for (int i = 0; i < 4; ++i) { const float ang = posA * invA4[i]; cA[i] = cosf(ang); sA[i] = sinf(ang); }
            const bf16_t* zr = ZS + (size_t)m * 2560;
#pragma unroll
            for (int it = 0; it < 5; ++it) {
                const int head = 2 * it + hsel;
                const u32x2 w = *(const u32x2*)(zr + head * 128 + d0);
                const float x[4] = {bf_lo(w.x), bf_hi(w.x), bf_lo(w.y), bf_hi(w.y)};
                float ss = (x[0] * x[0] + x[1] * x[1]) + (x[2] * x[2] + x[3] * x[3]);
#pragma unroll
                for (int o2 = 1; o2 < 32; o2 <<= 1) ss += __shfl_xor(ss, o2);
                const float r = 1.0f / sqrtf(ss * (1.f / 128.f) + EPS);
                const f32x4 g = (it < 4) ? gq : gk; float o[4];
#pragma unroll
                for (int i = 0; i < 4; ++i) { const float y = x[i] * r * g[i]; const float p = __shfl_xor(y, 8);
                    o[i] = isx2 ? (y * cA[i] + p * sA[i]) : (y * cA[i] - p * sA[i]); }
                unsigned char* dst = (it < 4) ? ((unsigned char*)QA + (size_t)m * 1024 + head * 128 + d0) : ((unsigned char*)KA + (size_t)m * 256 + (head - 8) * 128 + d0);
                *(unsigned*)dst = q8x4(o[0] * att::ATT_SQK, o[1] * att::ATT_SQK, o[2] * att::ATT_SQK, o[3] * att::ATT_SQK);
            }
            if (lane < 32) {
                const float angB = (hfb ? pcol : prow) * invB; const float cB = cosf(angB), sB = sinf(angB);
                const bf16_t* kr = KR + (size_t)m * 64 + hfb * 32 + jb;
                const float x1 = bf1(kr[0]), x2 = bf1(kr[16]);
                bf16_t* dst = KPE + (size_t)m * 64 + hfb * 32 + jb;
                unsigned char* d8 = (unsigned char*)KPE + (size_t)m * 64 + hfb * 32 + jb;
                d8[0] = (unsigned char)q8((x1 * cB - x2 * sB) * QKSB); d8[16] = (unsigned char)q8((x2 * cB + x1 * sB) * QKSB); (void)dst;
            }
        }
    }
    if (IN(3)) {
        { pg8::Gemm g{ZS + 1536, WqbT, M, 1536, 512, 512, 0, 2560}; pg8::StaticOrder S; S.init(M, 1536, G, bx); pg8::EpiQB E{QB, SSQC};
          pg8::gemm_phase<pg8::EpiQB, pg8::StaticOrder, true, true, false>(lds, g, S, E); }
        { pg8::Gemm g{ZS + 2048, WkvbT, M, 2048, 512, 512, 0, 2560}; pg8::StaticOrder S; S.init(M, 2048, G, bx); pg8::EpiKV E{KN8, VB, SSQK};
          pg8::gemm_phase<pg8::EpiKV, pg8::StaticOrder, true, true, false>(lds, g, S, E); }
    }
    SEAM(3);
    if (IN(5)) {
        char* lds_g = (char*)lds_raw;
        const int x = bx & 7, i = bx >> 3;
        for (int c = bx; c < 256; c += G) {
            const int xx = c & 7, ii = c >> 3;
            {
                const int combo = xx >> 1, w = (xx & 1) * 32 + ii, b = combo >> 1, kvh = combo & 1, hq = kvh * 4 + (w >> 4), qb = w & 15;
                const size_t row0 = (size_t)b * SEQ;
                __syncthreads();
                att::attn_unit<128, ATT_SD_A, 1024, 256, 2560, 2048, SEQ, true>((const bf16_t*)((const unsigned char*)QA + (row0 + qb * 256) * 1024 + hq * 128), (const bf16_t*)((const unsigned char*)KA + row0 * 256 + kvh * 128), nullptr,
                                    ZS + row0 * 2560 + 1280 + kvh * 128, OAB + (row0 + qb * 256) * 2048 + hq * 128, lds_g);
            }
            {
                const int unit = xx * 32 + ii, bh = unit >> 4, qb = unit & 15, b = bh >> 3, h = bh & 7;
                const size_t row0 = (size_t)b * SEQ;
                __syncthreads();
                att::attn_unit<192, ATT_SD_B, 1536, 1024, 1024, 2048, SEQ, true>((const bf16_t*)((const unsigned char*)QB + (row0 + qb * 256) * 1536 + h * 192), (const bf16_t*)(KN8 + row0 * 1024 + h * 128), (const bf16_t*)((const unsigned char*)KPE + row0 * 64),
                                    VB + row0 * 1024 + h * 128, OAB + (row0 + qb * 256) * 2048 + 1024 + h * 128, lds_g);
            }
        }
        (void)x; (void)i;
        __syncthreads();
    }
    SEAM(5);
    if (IN(6)) {
        bf16_t* T1 = (bf16_t*)(ws + WS_T1);
        { pg8::Gemm g{OAB, WabT, M, 2048, 1024, 2048, 0}; pg8::StaticOrder S; S.init(M, 2048, G, bx); pg8::EpiGate<false> E{SG, T1, MERGED};
          pg8::gemm_phase<pg8::EpiGate<false>, pg8::StaticOrder, true, true, false>(lds, g, S, E); }
        { pg8::Gemm g{OAB + 1024, WabT + 1024, M, 2048, 1024, 2048, 0}; pg8::StaticOrder S; S.init(M, 2048, G, bx); pg8::EpiGate<true> E{SG, T1, MERGED};
          pg8::gemm_phase<pg8::EpiGate<true>, pg8::StaticOrder, true, true, false>(lds, g, S, E); }
    }
    SEAM(6);
    if (IN(7)) {
        pg8::Gemm g{MERGED, WoT, M, 2048, 2048, 2048, 0}; pg8::StaticOrder S; S.init(M, 2048, G, bx); pg8::EpiResid<false> E{a.x, nullptr, U, SSQ1};
        pg8::gemm_phase<pg8::EpiResid<false>, pg8::StaticOrder, true, true, false>(lds, g, S, E);
    }
    SEAM(7);
    if (IN(9)) {
        pg8::Gemm g{U, WguT, M, 2 * DFF, DM, DM, 0}; pg8::StaticOrder S; S.init(M, 2 * DFF, G, bx); pg8::EpiSwiglu E{ACT, SSQ1};
        pg8::gemm_phase<pg8::EpiSwiglu, pg8::StaticOrder, true, true, false>(lds, g, S, E);
        {
            constexpr int NU = (M / 256) * (2 * DFF / 256);
            const int nr = (NU + G - 1) / G, nbusy = NU - (nr - 1) * G; int idx = bx - nbusy, cnt = G - nbusy; if (cnt < 32) { idx = bx; cnt = G; }
            if (idx >= 0) { pg8::Gemm g2{PB, WppT, M, 2048, PLE, PLE, 0}; pg8::StaticOrder S2; S2.init(M, 2048, cnt, idx); pg8::EpiBf16<0> E2{ERAW, 2048, nullptr, 0.f};
                pg8::gemm_phase<pg8::EpiBf16<0>, pg8::StaticOrder, false, true, false>(lds, g2, S2, E2); }
        }
    }
    SEAM(9);
    if (IN(10)) {
        pg8::Gemm g{ACT, WdT, M, 2048, DFF, DFF, 0}; pg8::StaticOrder S; S.init(M, 2048, G, bx); pg8::EpiResid<true> E{nullptr, U, U, SSQ2};
        pg8::gemm_phase<pg8::EpiResid<true>, pg8::StaticOrder, true, true, false>(lds, g, S, E);
    }
    SEAM(10);
    if (IN(12)) {
        { pg8::Gemm g{U, WpgT, M, 2048, DM, DM, 0}; pg8::StaticOrder S; S.init(M, 2048, G, bx); pg8::EpiBf16<1> E{GATE, 2048, SSQ2, 1.f / DM};
          pg8::gemm_phase<pg8::EpiBf16<1>, pg8::StaticOrder, true, true, false>(lds, g, S, E); }
    }
    SEAM(12);
    if (IN(13)) {
        u32x2 nh[8], ne[8], ng[8];
        int m = gw;
        if (m < M) {
#pragma unroll
            for (int j = 0; j < 8; ++j) { const size_t o = (size_t)m * DM + 4 * lane + 256 * j; nh[j] = *(const u32x2*)(U + o); ne[j] = *(const u32x2*)(ERAW + o); ng[j] = *(const u32x2*)(GATE + o); }
        }
        for (; m < M; m += NGW) {
            f32x4 h[8], e[8]; u32x2 gtw[8]; float se = 0.f;
#pragma unroll
            for (int j = 0; j < 8; ++j) { h[j] = (f32x4){bf_lo(nh[j].x), bf_hi(nh[j].x), bf_lo(nh[j].y), bf_hi(nh[j].y)}; e[j] = (f32x4){bf_lo(ne[j].x), bf_hi(ne[j].x), bf_lo(ne[j].y), bf_hi(ne[j].y)}; gtw[j] = ng[j];
                se += (e[j].x * e[j].x + e[j].y * e[j].y) + (e[j].z * e[j].z + e[j].w * e[j].w); }
            const int m2 = m + NGW;
            if (m2 < M) {
#pragma unroll
                for (int j = 0; j < 8; ++j) { const size_t o = (size_t)m2 * DM + 4 * lane + 256 * j; nh[j] = *(const u32x2*)(U + o); ne[j] = *(const u32x2*)(ERAW + o); ng[j] = *(const u32x2*)(GATE + o); }
            }
            const float re = 1.0f / sqrtf(wave_sum(se) * (1.f / DM) + EPS);
            float sh = 0.f;
#pragma unroll
            for (int j = 0; j < 8; ++j) { const u32x2 gt = gtw[j];
                const f32x4 gp = *(const f32x4*)(a.g_ple_post + 4 * lane + 256 * j);
                h[j].x += bf_lo(gt.x) * (e[j].x * re * gp.x); h[j].y += bf_hi(gt.x) * (e[j].y * re * gp.y);
                h[j].z += bf_lo(gt.y) * (e[j].z * re * gp.z); h[j].w += bf_hi(gt.y) * (e[j].w * re * gp.w);
                sh += (h[j].x * h[j].x + h[j].y * h[j].y) + (h[j].z * h[j].z + h[j].w * h[j].w); }
            const float rh = 1.0f / sqrtf(wave_sum(sh) * (1.f / DM) + EPS);
#pragma unroll
            for (int j = 0; j < 8; ++j) { const f32x4 gf = *(const f32x4*)(a.g_final + 4 * lane + 256 * j);
                f32x4 o; o.x = h[j].x * rh * gf.x; o.y = h[j].y * rh * gf.y; o.z = h[j].z * rh * gf.z; o.w = h[j].w * rh * gf.w;
                *(f32x4*)(a.out + (size_t)m * DM + 4 * lane + 256 * j) = o;
            }
        }
    }
#undef IN
#undef SEAM
}

extern "C" void kernel_launch(void* const* d_in, const int* in_sizes, int n_in, void* d_out, int out_size, void* d_ws, size_t ws_size, hipStream_t stream) {
    static int grid = 0;
    if (grid == 0) {
        if (n_in != 21 || in_sizes[0] != M * DM || out_size != M * DM || ws_size < WS_END) {
            fprintf(stderr, "kernel_launch: unexpected shapes: n_in %d in0 %d out %d ws %zu (need %zu)\n", n_in, n_in > 0 ? in_sizes[0] : -1, out_size, ws_size, (size_t)WS_END); grid = -1; return; }
        int dev = 0, cus = 0, per_cu = 0;
        if (hipGetDevice(&dev) != hipSuccess || hipDeviceGetAttribute(&cus, hipDeviceAttributeMultiprocessorCount, dev) != hipSuccess) { grid = -1; return; }
        if (hipFuncSetAttribute((const void*)mk_fwd, hipFuncAttributeMaxDynamicSharedMemorySize, LDS_BYTES) != hipSuccess) { fprintf(stderr, "kernel_launch: hipFuncSetAttribute failed\n"); grid = -1; return; }
        if (hipOccupancyMaxActiveBlocksPerMultiprocessor(&per_cu, (const void*)mk_fwd, NTHREADS, LDS_BYTES) != hipSuccess || per_cu < 1) { fprintf(stderr, "kernel_launch: occupancy query says %d\n", per_cu); per_cu = 1; }
        (void)hipGetLastError();
        grid = cus * 1;
    }
    if (grid < 0) return;
    Args a{};
    const float** f = (const float**)&a;
    for (int i = 0; i < 21; ++i) f[i] = (const float*)d_in[i];
    a.out = (float*)d_out; a.ws = (unsigned char*)d_ws;
#if MK_ONE_LAUNCH
    if (hipMemsetAsync(d_ws, 0, 262144 + 256, stream) != hipSuccess) { fprintf(stderr, "kernel_launch: memset failed\n"); return; }
    a.ph_lo = 0; a.ph_hi = NPHASE;
    void* args[] = {&a};
    hipError_t e = hipLaunchCooperativeKernel((const void*)mk_fwd, dim3(grid), dim3(NTHREADS), args, LDS_BYTES, stream);
    if (e != hipSuccess) fprintf(stderr, "kernel_launch: cooperative launch failed: %s (grid %d)\n", hipGetErrorString(e), grid);
#else
    for (int ph = 0; ph < NPHASE; ++ph) {
        a.ph_lo = ph; a.ph_hi = ph + 1;
        hipLaunchKernelGGL(mk_fwd, dim3(grid), dim3(NTHREADS), LDS_BYTES, stream, a);
    }
#endif
}
```

```cpp
#include <hip/hip_runtime.h>
#include <hip/hip_cooperative_groups.h>
#include <cstdio>
#include <cstdint>
namespace cg = cooperative_groups;

#ifndef ATT_SD_A
#define ATT_SD_A 2
#endif
#ifndef ATT_SD_B
#define ATT_SD_B 1
#endif
#ifndef MK_ONE_LAUNCH
#define MK_ONE_LAUNCH 1
#endif

#define LAS __attribute__((address_space(3)))
typedef unsigned short bf16_t;
typedef short bf16x8 __attribute__((ext_vector_type(8)));
typedef short s16x4 __attribute__((ext_vector_type(4)));
typedef float f32x4 __attribute__((ext_vector_type(4)));
typedef float f32x16 __attribute__((ext_vector_type(16)));
typedef unsigned u32x4 __attribute__((ext_vector_type(4)));
typedef unsigned u32x2 __attribute__((ext_vector_type(2)));
typedef int v4i_t __attribute__((ext_vector_type(4)));
constexpr float Q8_SU = 20.f, Q8_SW = 900.f;

constexpr int DM = 2048, SEQ = 4096, M = 8192, DFF = 5632, PLE = 256, NIN = 6720, NINP = 6912;
constexpr float EPS = 1e-6f;
constexpr int NWAVES = 8, NTHREADS = 512;
constexpr int LDS_BYTES = 139264;

constexpr size_t MiB = 1u << 20;
constexpr size_t WS_WIN = 1 * MiB, WS_WQB = 28 * MiB, WS_WKVB = 30 * MiB, WS_WAB = 32 * MiB, WS_WO = 40 * MiB, WS_WGU = 48 * MiB, WS_WD = 92 * MiB,
                 WS_WPG = 114 * MiB, WS_WPP = 122 * MiB, WS_PB = 123 * MiB, WS_KR = 127 * MiB, WS_U = 128 * MiB, WS_ZS = 160 * MiB, WS_SG = 200 * MiB,
                 WS_QA = 264 * MiB, WS_QB = 280 * MiB, WS_KVB = 304 * MiB, WS_END = 344 * MiB;
constexpr size_t WS_CQN = 1 * MiB, WS_CKVN = 9 * MiB, WS_KA = 17 * MiB, WS_KPE = 21 * MiB;
constexpr size_t WS_T1 = 264 * MiB;
constexpr size_t WS_OAB = WS_U, WS_MERGED = WS_ZS, WS_ACT = 160 * MiB, WS_GATE = 160 * MiB, WS_ERAW = 280 * MiB;

typedef float f32x2_t __attribute__((ext_vector_type(2)));
typedef __bf16 bf16x2_t __attribute__((ext_vector_type(2)));
__device__ __forceinline__ unsigned cvt_pk_bf16(float lo, float hi) { f32x2_t v = {lo, hi}; bf16x2_t b = __builtin_convertvector(v, bf16x2_t); return __builtin_bit_cast(unsigned, b); }
__device__ __forceinline__ float bf_lo(unsigned w) { return __uint_as_float(w << 16); }
__device__ __forceinline__ float bf_hi(unsigned w) { return __uint_as_float(w & 0xffff0000u); }
__device__ __forceinline__ float bf1(bf16_t h) { return __uint_as_float(((unsigned)h) << 16); }
__device__ __forceinline__ bf16_t f2bf(float f) { unsigned u = __float_as_uint(f); return (bf16_t)((u + 0x7fffu + ((u >> 16) & 1u)) >> 16); }
__device__ __forceinline__ float sigmoidf_(float x) { return __builtin_amdgcn_rcpf(1.f + __expf(-x)); }
__device__ __forceinline__ float wave_sum(float v) {
#pragma unroll
    for (int o = 1; o < 64; o <<= 1) v += __shfl_xor(v, o);
    return v;
}

__device__ __forceinline__ unsigned q8(float v) { int q = (int)__builtin_rintf(v); q = q < -127 ? -127 : (q > 127 ? 127 : q); return (unsigned)q & 0xffu; }
__device__ __forceinline__ unsigned q8x4(float a, float b, float c, float d) { return q8(a) | (q8(b) << 8) | (q8(c) << 16) | (q8(d) << 24); }
constexpr float QKSB = 20.f;

namespace pg8 {
constexpr int BM = 256, BK = 64, HALF = 128, HTB = HALF * BK * 2, STAGE_BYTES = 8 * HTB, NXCD = 8, WGM = 8;
__host__ __device__ __forceinline__ int lds_byte(int r, int c) { const int st = (r >> 4) * 2 + (c >> 5), rr = r & 15, cc = c & 31, ob = rr * 64 + cc * 2; return st * 1024 + (ob ^ (((ob >> 9) & 1) << 5)); }
__host__ __device__ __forceinline__ void stage_rc(int b, int& R, int& C) { const int st = b / 1024, sb = b % 1024, swz = sb ^ (((sb >> 9) & 1) << 5); R = (st >> 1) * 16 + swz / 64; C = (st & 1) * 32 + (swz % 64) / 2; }
__host__ __device__ __forceinline__ int perm32(int rho) { const int n = rho >> 4, i = rho & 15; return 8 * (i >> 2) + 4 * n + (i & 3); }
struct Unit { int pm, pn, kh; };
struct Gemm { const bf16_t* A; const bf16_t* Bt; int M, N, K, ld, koff, lda; };
struct StaticOrder {
    int nM, nN, nwg, G, c;
    __host__ __device__ void init(int M_, int N_, int G_, int c_) { nM = M_ / BM; nN = N_ / BM; nwg = nM * nN; G = G_; c = c_; }
    __host__ __device__ bool next(int i, Unit& u) const {
        const long L = (long)i * G + c; if (L >= nwg) return false;
        int wgid = (int)L; { const int q = nwg / NXCD, r = nwg % NXCD, xcd = wgid % NXCD, off = wgid / NXCD; wgid = (xcd < r ? xcd * (q + 1) : r * (q + 1) + (xcd - r) * q) + off; }
        const int nig = WGM * nN, gid = wgid / nig, fm = gid * WGM, gsz = (nM - fm) < WGM ? (nM - fm) : WGM;
        u.pm = fm + ((wgid % nig) % gsz); u.pn = (wgid % nig) / gsz; u.kh = 0; return true;
    }
    __device__ __forceinline__ void a_ready(const Unit&) const {}
    __device__ __forceinline__ void done(const Unit&) const {}
};
struct DualOrder : StaticOrder {
    __host__ __device__ bool next(int i, Unit& u) const { if (!StaticOrder::next(i >> 1, u)) return false; u.kh = i & 1; return true; }
};
typedef f32x4 Acc[2][2][4][2];

__device__ __forceinline__ void store8(bf16_t* p, f32x4 v0, f32x4 v1) {
    u32x4 w; w.x = cvt_pk_bf16(v0[0], v0[1]); w.y = cvt_pk_bf16(v0[2], v0[3]); w.z = cvt_pk_bf16(v1[0], v1[1]); w.w = cvt_pk_bf16(v1[2], v1[3]);
    *(u32x4*)p = w;
}
struct EpiIn {
    static constexpr bool PERM = true, AFTER_DRAIN = false;
    bf16_t *ZS, *SG, *KR; float *SSQC, *SSQK;
    __device__ __forceinline__ void operator()(const Acc& acc, const Unit& u, int wr, int wc, int fr, int fq) const {
        const int pn = u.pn; bf16_t* base; int ldc, colt; bool sig = false;
        if (pn < 10) { base = ZS; ldc = 2560; colt = pn * 256; }
        else if (pn < 26) { base = SG; ldc = 4096; colt = (pn - 10) * 256; sig = true; }
        else { base = KR; ldc = 64; colt = 0; }
        const int row0 = u.pm * BM + wr * 64 + fr, col0 = colt + wc * 32 + 8 * fq;
#pragma unroll
        for (int ai = 0; ai < 2; ++ai)
#pragma unroll
            for (int m = 0; m < 4; ++m) { bf16_t* rowp = base + (size_t)(row0 + ai * HALF + m * 16) * ldc + col0; float ss = 0.f;
#pragma unroll
                for (int bj = 0; bj < 2; ++bj) {
                    if (pn == 26 && (bj == 1 || wc >= 2)) continue;
                    f32x4 v0 = __builtin_convertvector(__builtin_bit_cast(v4i_t, acc[ai][bj][m][0]), f32x4) * (1.f / (Q8_SU * Q8_SW));
                    f32x4 v1 = __builtin_convertvector(__builtin_bit_cast(v4i_t, acc[ai][bj][m][1]), f32x4) * (1.f / (Q8_SU * Q8_SW));
                    if (sig) {
#pragma unroll
                        for (int j = 0; j < 4; ++j) { v0[j] = sigmoidf_(v0[j]); v1[j] = sigmoidf_(v1[j]); } }
                    ss += (v0[0] * v0[0] + v0[1] * v0[1]) + (v0[2] * v0[2] + v0[3] * v0[3]) + (v1[0] * v1[0] + v1[1] * v1[1]) + (v1[2] * v1[2] + v1[3] * v1[3]);
                    store8(rowp + bj * HALF, v0, v1); }
                if (pn >= 6 && pn < 10) { ss += __shfl_xor(ss, 16); ss += __shfl_xor(ss, 32);
                    if (fq == 0) (void)__hip_atomic_fetch_add((__attribute__((address_space(1))) float*)((pn < 8 ? SSQC : SSQK) + row0 + ai * HALF + m * 16), ss, __ATOMIC_RELAXED, __HIP_MEMORY_SCOPE_AGENT); } }
    }
};
template <int ACT  > struct EpiBf16 {
    static constexpr bool PERM = true, AFTER_DRAIN = false;
    bf16_t* O; int ldc; const float* ssq; float inv_n;
    __device__ __forceinline__ void operator()(const Acc& acc, const Unit& u, int wr, int wc, int fr, int fq) const {
        const int row0 = u.pm * BM + wr * 64 + fr, col0 = u.pn * BM + wc * 32 + 8 * fq;
#pragma unroll
        for (int ai = 0; ai < 2; ++ai)
#pragma unroll
            for (int m = 0; m < 4; ++m) { bf16_t* rowp = O + (size_t)(row0 + ai * HALF + m * 16) * ldc + col0;
                const float r = ssq ? 1.0f / sqrtf(ssq[row0 + ai * HALF + m * 16] * inv_n + EPS) : 1.f;
#pragma unroll
                for (int bj = 0; bj < 2; ++bj) { f32x4 v0 = acc[ai][bj][m][0] * r, v1 = acc[ai][bj][m][1] * r;
                    if (ACT == 1) {
#pragma unroll
                        for (int j = 0; j < 4; ++j) { v0[j] = sigmoidf_(v0[j]); v1[j] = sigmoidf_(v1[j]); } }
                    store8(rowp + bj * HALF, v0, v1); } }
    }
};
struct EpiQB {
    static constexpr bool PERM = true, AFTER_DRAIN = false;
    bf16_t* O; const float* ssq;
    __device__ __forceinline__ void operator()(const Acc& acc, const Unit& u, int wr, int wc, int fr, int fq) const {
        const int row0 = u.pm * BM + wr * 64 + fr, col0 = u.pn * BM + wc * 32 + 8 * fq;
        float inv[8];
#pragma unroll
        for (int t = 0; t < 8; ++t) inv[t] = __builtin_amdgcn_exp2f(-(float)(2 * ((fq & 1) * 8 + t)) * (13.287712379549449f / 32.f));
        const float sgn = (fq >= 2) ? 1.f : -1.f;
#pragma unroll
        for (int ai = 0; ai < 2; ++ai)
#pragma unroll
            for (int m = 0; m < 4; ++m) { const int row = row0 + ai * HALF + m * 16, sq = row & (SEQ - 1); const float prow = (float)(sq >> 6), pcol = (float)(sq & 63);
                const float rq = 1.0f / sqrtf(ssq[row] * (1.f / 512.f) + EPS);
#pragma unroll
                for (int bj = 0; bj < 2; ++bj) { f32x4 v0 = acc[ai][bj][m][0] * rq, v1 = acc[ai][bj][m][1] * rq;
                    const int rel = (u.pn * BM + bj * HALF + wc * 32) % 192;
                    if (rel >= 128) { const float pos = (rel >= 160) ? pcol : prow;
#pragma unroll
                        for (int t = 0; t < 4; ++t) {
                            const float a0 = pos * inv[t], a1 = pos * inv[4 + t];
                            const float p0 = __shfl_xor(v0[t], 32), p1 = __shfl_xor(v1[t], 32);
                            v0[t] = v0[t] * __cosf(a0) + sgn * p0 * __sinf(a0); v1[t] = v1[t] * __cosf(a1) + sgn * p1 * __sinf(a1); } }
                    u32x2 w; w.x = q8x4(v0[0] * QKSB, v0[1] * QKSB, v0[2] * QKSB, v0[3] * QKSB); w.y = q8x4(v1[0] * QKSB, v1[1] * QKSB, v1[2] * QKSB, v1[3] * QKSB);
                    *(u32x2*)((unsigned char*)O + (size_t)row * 1536 + col0 + bj * HALF) = w; } }
    }
};
struct EpiKV {
    static constexpr bool PERM = true, AFTER_DRAIN = false;
    unsigned char* KN8; bf16_t* VB; const float* ssq;
    __device__ __forceinline__ void operator()(const Acc& acc, const Unit& u, int wr, int wc, int fr, int fq) const {
        const int row0 = u.pm * BM + wr * 64 + fr, colh = u.pn * HALF + wc * 32 + 8 * fq;
#pragma unroll
        for (int ai = 0; ai < 2; ++ai)
#pragma unroll
            for (int m = 0; m < 4; ++m) { const int row = row0 + ai * HALF + m * 16; const float r = 1.0f / sqrtf(ssq[row] * (1.f / 512.f) + EPS);
                const f32x4 k0 = acc[ai][0][m][0] * (r * QKSB), k1 = acc[ai][0][m][1] * (r * QKSB);
                u32x2 w; w.x = q8x4(k0[0], k0[1], k0[2], k0[3]); w.y = q8x4(k1[0], k1[1], k1[2], k1[3]);
                *(u32x2*)(KN8 + (size_t)row * 1024 + colh) = w;
                store8(VB + (size_t)row * 1024 + colh, acc[ai][1][m][0] * r, acc[ai][1][m][1] * r); }
    }
};
template <bool SECOND> struct EpiGate {
    static constexpr bool PERM = true, AFTER_DRAIN = false;
    const bf16_t* SG; bf16_t* T1; bf16_t* O;
    __device__ __forceinline__ void operator()(const Acc& acc, const Unit& u, int wr, int wc, int fr, int fq) const {
        const int row0 = u.pm * BM + wr * 64 + fr, col0 = u.pn * BM + wc * 32 + 8 * fq;
#pragma unroll
        for (int ai = 0; ai < 2; ++ai)
#pragma unroll
            for (int m = 0; m < 4; ++m) { const size_t ro = (size_t)(row0 + ai * HALF + m * 16);
#pragma unroll
                for (int bj = 0; bj < 2; ++bj) {
                    const u32x4 b = *(const u32x4*)(SG + ro * 4096 + (SECOND ? 2048 : 0) + col0 + bj * HALF);
                    f32x4 s0, s1;
                    s0[0] = bf_lo(b.x); s0[1] = bf_hi(b.x); s0[2] = bf_lo(b.y); s0[3] = bf_hi(b.y);
                    s1[0] = bf_lo(b.z); s1[1] = bf_hi(b.z); s1[2] = bf_lo(b.w); s1[3] = bf_hi(b.w);
                    bf16_t* tp = T1 + ro * 2048 + col0 + bj * HALF;
                    if constexpr (!SECOND) { store8(tp, acc[ai][bj][m][0] * s0, acc[ai][bj][m][1] * s1); }
                    else { const u32x4 tw = *(const u32x4*)tp; f32x4 t0, t1;
                        t0[0] = bf_lo(tw.x); t0[1] = bf_hi(tw.x); t0[2] = bf_lo(tw.y); t0[3] = bf_hi(tw.y); t1[0] = bf_lo(tw.z); t1[1] = bf_hi(tw.z); t1[2] = bf_lo(tw.w); t1[3] = bf_hi(tw.w);
                        store8(O + ro * 2048 + col0 + bj * HALF, t0 + acc[ai][bj][m][0] * s0, t1 + acc[ai][bj][m][1] * s1); } } }
    }
};
template <bool BASEBF> struct EpiResid {
    static constexpr bool PERM = false, AFTER_DRAIN = false;
    const float* basef; const bf16_t* baseb; bf16_t* HB; float* ssq;
    __device__ __forceinline__ void operator()(const Acc& acc, const Unit& u, int wr, int wc, int fr, int fq) const {
        const int row0 = u.pm * BM + wr * 64 + fr, col0 = u.pn * BM + wc * 32 + 4 * fq;
#pragma unroll
        for (int ai = 0; ai < 2; ++ai)
#pragma unroll
            for (int m = 0; m < 4; ++m) { const int row = row0 + ai * HALF + m * 16; const size_t ro = (size_t)row * DM + col0; float ss = 0.f;
#pragma unroll
                for (int bj = 0; bj < 2; ++bj)
#pragma unroll
                    for (int n = 0; n < 2; ++n) { const size_t o = ro + bj * HALF + n * 16;
                        f32x4 v = acc[ai][bj][m][n];
                        if constexpr (BASEBF) { const u32x2 bw = *(const u32x2*)(baseb + o); v = v + (f32x4){bf_lo(bw.x), bf_hi(bw.x), bf_lo(bw.y), bf_hi(bw.y)}; }
                        else v = v + *(const f32x4*)(basef + o);
                        u32x2 w; w.x = cvt_pk_bf16(v.x, v.y); w.y = cvt_pk_bf16(v.z, v.w);
                        *(u32x2*)(HB + o) = w; ss += (v.x * v.x + v.y * v.y) + (v.z * v.z + v.w * v.w); }
                ss += __shfl_xor(ss, 16); ss += __shfl_xor(ss, 32);
                if (fq == 0) (void)__hip_atomic_fetch_add((__attribute__((address_space(1))) float*)(ssq + row), ss, __ATOMIC_RELAXED, __HIP_MEMORY_SCOPE_AGENT); }
    }
};
struct EpiSwiglu {
    static constexpr bool PERM = true, AFTER_DRAIN = false;
    bf16_t* O; const float* ssq;
    __device__ __forceinline__ void operator()(const Acc& acc, const Unit& u, int wr, int wc, int fr, int fq) const {
        const int row0 = u.pm * BM + wr * 64 + fr, col0 = u.pn * HALF + wc * 32 + 8 * fq;
#pragma unroll
        for (int ai = 0; ai < 2; ++ai)
#pragma unroll
            for (int m = 0; m < 4; ++m) {
                f32x4 a0, a1; const float r = 1.0f / sqrtf(ssq[row0 + ai * HALF + m * 16] * (1.f / DM) + EPS);
#pragma unroll
                for (int j = 0; j < 4; ++j) { const float g0 = acc[ai][0][m][0][j] * r, g1 = acc[ai][0][m][1][j] * r;
                    a0[j] = g0 * sigmoidf_(g0) * (acc[ai][1][m][0][j] * r); a1[j] = g1 * sigmoidf_(g1) * (acc[ai][1][m][1][j] * r); }
                store8(O + (size_t)(row0 + ai * HALF + m * 16) * DFF + col0, a0, a1); }
    }
};

template <class Epi, class Sched, bool ALIGN_EPI, bool SP2, bool MID, bool I8 = false>
__device__ __forceinline__ void gemm_phase(LAS unsigned char* lds, const Gemm g, const Sched S, const Epi E) {
    const int tid = threadIdx.x, wid = __builtin_amdgcn_readfirstlane(tid >> 6), lane = tid & 63, wr = wid >> 2, wc = wid & 3, fr = lane & 15, fq = lane >> 4;
    const int K = g.ld, nt = g.K / BK;
    unsigned voffA[2], voffB[2];
#pragma unroll
    for (int i = 0; i < 2; ++i) { int R, C; stage_rc(tid * 16 + i * 8192, R, C); const int Rb = Epi::PERM ? ((R & ~31) + perm32(R & 31)) : R;
        voffA[i] = (unsigned)(R * (g.lda ? g.lda : K) + C) * 2u; voffB[i] = (unsigned)(Rb * K + C) * 2u; }
    const size_t kstep = (size_t)(BK * 2);
    const int KA = g.lda ? g.lda : K;
    const size_t hstep = (size_t)HALF * K * 2, hstepA = (size_t)HALF * KA * 2;
    const size_t tstep = 2 * hstep, tstepA = 2 * hstepA;
    const unsigned ldsw = (unsigned)wid * 1024u;
    const int aoff = lds_byte(wr * 64 + fr, fq * 8), boff = lds_byte(wc * 32 + fr, fq * 8);
#define PG8_SA(b, h) (((b) * 2 + (h)) * HTB)
#define PG8_SB(b, h) ((4 + (b) * 2 + (h)) * HTB)
#define PG8_STAGE(bufoff, gbase, voff) do { _Pragma("unroll") for (int _i = 0; _i < 2; ++_i) \
        __builtin_amdgcn_global_load_lds((const unsigned*)((const char*)(gbase) + (voff)[_i]), (LAS unsigned*)(lds + (bufoff) + ldsw + _i * 8192), 16, 0, 0); } while (0)
#define PG8_LDA(dst, b, h) do { _Pragma("unroll") for (int m = 0; m < 4; ++m) _Pragma("unroll") for (int k = 0; k < 2; ++k) dst[m][k] = *(const LAS bf16x8*)(lds + PG8_SA(b, h) + aoff + m * 2048 + k * 1024); } while (0)
#define PG8_LDB(dst, b, h) do { _Pragma("unroll") for (int n = 0; n < 2; ++n) _Pragma("unroll") for (int k = 0; k < 2; ++k) dst[n][k] = *(const LAS bf16x8*)(lds + PG8_SB(b, h) + boff + n * 2048 + k * 1024); } while (0)
#define PG8_MMA(ai, bj, At, Bt) do { __builtin_amdgcn_s_setprio(1); _Pragma("unroll") for (int m = 0; m < 4; ++m) _Pragma("unroll") for (int n = 0; n < 2; ++n) _Pragma("unroll") for (int k = 0; k < 2; ++k) { \
        if constexpr (I8) acc[ai][bj][m][n] = __builtin_bit_cast(f32x4, __builtin_amdgcn_mfma_i32_16x16x64_i8(__builtin_bit_cast(v4i_t, Bt[n][k]), __builtin_bit_cast(v4i_t, At[m][k]), __builtin_bit_cast(v4i_t, acc[ai][bj][m][n]), 0, 0, 0)); \
        else acc[ai][bj][m][n] = __builtin_amdgcn_mfma_f32_16x16x32_bf16(Bt[n][k], At[m][k], acc[ai][bj][m][n], 0, 0, 0); } __builtin_amdgcn_s_setprio(0); } while (0)
#define PG8_WAIT_V(n) asm volatile("s_waitcnt vmcnt(" #n ")" ::: "memory")
#define PG8_WAIT_L(n) asm volatile("s_waitcnt lgkmcnt(" #n ")" ::: "memory")
#define PG8_BAR __builtin_amdgcn_s_barrier()
#define PG8_SCHED __builtin_amdgcn_sched_barrier(0)
    Unit cur, nxt; int ui = 0;
    if (!S.next(0, cur)) return;
    Acc acc;
#pragma unroll
    for (int a = 0; a < 2; ++a)
#pragma unroll
        for (int b = 0; b < 2; ++b)
#pragma unroll
            for (int m = 0; m < 4; ++m)
#pragma unroll
                for (int n = 0; n < 2; ++n) acc[a][b][m][n] = (f32x4){0.f, 0.f, 0.f, 0.f};
    bf16x8 At[4][2], B0[2][2], B1[2][2];
    const char* cA = (const char*)g.A + (size_t)cur.pm * tstepA + (size_t)cur.kh * g.koff; const char* cB = (const char*)g.Bt + (size_t)cur.pn * tstep + (size_t)cur.kh * g.koff;
    S.a_ready(cur);
    if constexpr (SP2) {
        PG8_STAGE(PG8_SB(0, 0), cB, voffB); PG8_STAGE(PG8_SB(0, 1), cB + hstep, voffB); PG8_STAGE(PG8_SA(0, 0), cA, voffA); PG8_STAGE(PG8_SA(0, 1), cA + hstepA, voffA);
        if (wr == 1) PG8_BAR;
        PG8_WAIT_V(2); PG8_BAR;
        PG8_STAGE(PG8_SB(1, 0), cB + kstep, voffB); PG8_STAGE(PG8_SA(1, 0), cA + kstep, voffA); PG8_STAGE(PG8_SB(1, 1), cB + hstep + kstep, voffB);
        PG8_WAIT_V(6); PG8_BAR;
    } else {
        PG8_STAGE(PG8_SB(0, 0), cB, voffB); PG8_STAGE(PG8_SA(0, 0), cA, voffA); PG8_STAGE(PG8_SB(0, 1), cB + hstep, voffB); PG8_STAGE(PG8_SA(0, 1), cA + hstepA, voffA);
        if (wr == 1) PG8_BAR;
        PG8_WAIT_V(4); PG8_BAR;
        PG8_STAGE(PG8_SB(1, 0), cB + kstep, voffB); PG8_STAGE(PG8_SA(1, 0), cA + kstep, voffA); PG8_STAGE(PG8_SB(1, 1), cB + hstep + kstep, voffB);
        PG8_WAIT_V(6); PG8_BAR;
    }
    for (;;) {
        const bool has_next = S.next(ui + 1, nxt);
        const char* nA = has_next ? (const char*)g.A + (size_t)nxt.pm * tstepA + (size_t)nxt.kh * g.koff : cA; const char* nB = has_next ? (const char*)g.Bt + (size_t)nxt.pn * tstep + (size_t)nxt.kh * g.koff : cB;
        for (int t = 0; t < nt; t += 2) {
            const bool last = (t == nt - 2);
            const char* a1 = cA + (size_t)(t + 1) * kstep;
            const char* a2 = last ? nA : cA + (size_t)(t + 2) * kstep; const char* b2 = last ? nB : cB + (size_t)(t + 2) * kstep;
            const char* a3 = a2 + kstep; const char* b3 = b2 + kstep;
            if (last && has_next) S.a_ready(nxt);
            if constexpr (SP2) {
            PG8_LDB(B0, 0, 0); PG8_LDB(B1, 0, 1); PG8_SCHED; PG8_LDA(At, 0, 0); PG8_STAGE(PG8_SA(1, 1), a1 + hstepA, voffA);
            PG8_WAIT_V(8); PG8_WAIT_L(0); PG8_BAR; PG8_MMA(0, 0, At, B0); PG8_MMA(0, 1, At, B1); PG8_BAR; PG8_SCHED;
            PG8_LDA(At, 0, 1); PG8_STAGE(PG8_SB(0, 0), b2, voffB); PG8_STAGE(PG8_SB(0, 1), b2 + hstep, voffB); PG8_STAGE(PG8_SA(0, 0), a2, voffA);
            PG8_WAIT_V(8); PG8_WAIT_L(0); PG8_BAR; PG8_MMA(1, 0, At, B0); PG8_MMA(1, 1, At, B1); PG8_BAR; PG8_SCHED;
            PG8_LDB(B0, 1, 0); PG8_LDB(B1, 1, 1); PG8_SCHED; PG8_LDA(At, 1, 0); PG8_STAGE(PG8_SA(0, 1), a2 + hstepA, voffA);
            PG8_WAIT_V(8); PG8_WAIT_L(0); PG8_BAR; PG8_MMA(0, 0, At, B0); PG8_MMA(0, 1, At, B1); PG8_BAR; PG8_SCHED;
            PG8_LDA(At, 1, 1); PG8_STAGE(PG8_SB(1, 0), b3, voffB); PG8_STAGE(PG8_SB(1, 1), b3 + hstep, voffB); PG8_STAGE(PG8_SA(1, 0), a3, voffA);
            PG8_WAIT_V(8); PG8_WAIT_L(0); PG8_BAR; PG8_MMA(1, 0, At, B0); PG8_MMA(1, 1, At, B1); PG8_BAR; PG8_SCHED;
            } else {
            PG8_LDB(B0, 0, 0); PG8_SCHED; PG8_LDA(At, 0, 0); PG8_STAGE(PG8_SA(1, 1), a1 + hstepA, voffA);
            PG8_WAIT_L(8); PG8_BAR; PG8_WAIT_L(0); PG8_MMA(0, 0, At, B0); PG8_BAR; PG8_SCHED;
            PG8_LDB(B1, 0, 1); PG8_STAGE(PG8_SB(0, 0), b2, voffB);
            PG8_BAR; PG8_WAIT_L(0); PG8_MMA(0, 1, At, B1); PG8_BAR;
            PG8_LDA(At, 0, 1); PG8_STAGE(PG8_SA(0, 0), a2, voffA);
            PG8_BAR; PG8_WAIT_L(0); PG8_MMA(1, 0, At, B0); PG8_BAR; PG8_SCHED;
            PG8_STAGE(PG8_SB(0, 1), b2 + hstep, voffB);
            PG8_WAIT_V(6); PG8_BAR; PG8_MMA(1, 1, At, B1); PG8_BAR;
            PG8_LDB(B0, 1, 0); PG8_SCHED; PG8_LDA(At, 1, 0); PG8_STAGE(PG8_SA(0, 1), a2 + hstepA, voffA);
            PG8_WAIT_L(8); PG8_BAR; PG8_WAIT_L(0); PG8_MMA(0, 0, At, B0); PG8_BAR; PG8_SCHED;
            PG8_LDB(B1, 1, 1); PG8_STAGE(PG8_SB(1, 0), b3, voffB);
            PG8_BAR; PG8_WAIT_L(0); PG8_MMA(0, 1, At, B1); PG8_BAR;
            PG8_LDA(At, 1, 1); PG8_STAGE(PG8_SA(1, 0), a3, voffA);
            PG8_BAR; PG8_WAIT_L(0); PG8_MMA(1, 0, At, B0); PG8_BAR; PG8_SCHED;
            PG8_STAGE(PG8_SB(1, 1), b3 + hstep, voffB);
            PG8_WAIT_V(6); PG8_BAR; PG8_MMA(1, 1, At, B1); PG8_BAR;
            }
        }
        if constexpr (ALIGN_EPI) { if (wr == 0) PG8_BAR; }
        { E(acc, cur, wr, wc, fr, fq); S.done(cur);
#pragma unroll
        for (int a = 0; a < 2; ++a)
#pragma unroll
            for (int b = 0; b < 2; ++b)
#pragma unroll
                for (int m = 0; m < 4; ++m)
#pragma unroll
                    for (int n = 0; n < 2; ++n) acc[a][b][m][n] = (f32x4){0.f, 0.f, 0.f, 0.f};
        }
        if (!has_next) break;
        cur = nxt; cA = nA; cB = nB; ++ui;
        if constexpr (ALIGN_EPI) { if (wr == 1) PG8_BAR; }
    }
    PG8_WAIT_V(0);
    if constexpr (!ALIGN_EPI) { if (wr == 0) PG8_BAR; }
    PG8_BAR;
#undef PG8_SA
#undef PG8_SB
#undef PG8_STAGE
#undef PG8_LDA
#undef PG8_LDB
#undef PG8_MMA
#undef PG8_WAIT_V
#undef PG8_WAIT_L
#undef PG8_BAR
#undef PG8_SCHED
}
}

namespace att {
constexpr int NW = 8, QBLK = 32, KVBLK = 64;
constexpr int SHM_V = KVBLK * 128 * 2, SHM_K = KVBLK * 128 * 2, SHM_KR = KVBLK * 64 * 2;
constexpr int OFF_V = 0, OFF_K = 2 * SHM_V, OFF_WS = OFF_K + 2 * SHM_K, OFF_KR = OFF_WS + NW * 64 * 4, OFF_QR = OFF_KR + 2 * SHM_KR, QR_WAVE = 6144, ATT_LDS = OFF_QR + NW * QR_WAVE;
constexpr float THR = 8.f;
#define KSWZ(row, colB) ((row) * 256 + ((colB) ^ (((row) & 7) << 4)))
#define KRSWZ(row, colB) ((row) * 128 + ((colB) ^ ((((row) >> 1) & 7) << 4)))
#define SBAR() __builtin_amdgcn_sched_barrier(0)
__device__ __forceinline__ int crow(int r, int hi) { return (r & 3) + 8 * (r >> 2) + 4 * hi; }

__device__ __forceinline__ void partialSM(f32x16& p0, f32x16& p1, float& m_reg, float& mn, float& alpha, const float C, const float THRS) {
  float pmax = p0[0];
#pragma unroll
  for (int r = 1; r < 16; ++r) pmax = fmaxf(pmax, p0[r]);
#pragma unroll
  for (int r = 0; r < 16; ++r) pmax = fmaxf(pmax, p1[r]);
  { auto rr = __builtin_amdgcn_permlane32_swap(__float_as_uint(pmax), __float_as_uint(pmax), false, false);
    pmax = fmaxf(__uint_as_float(rr[0]), __uint_as_float(rr[1])); }
  if (__builtin_expect(__all(pmax - m_reg <= THRS), 1)) { mn = m_reg; alpha = 1.f; }
  else { mn = fmaxf(m_reg, pmax); alpha = __builtin_amdgcn_exp2f((m_reg - mn) * C); m_reg = mn; }
  float mnC = -mn * C;
#pragma unroll
  for (int r = 0; r < 16; ++r) p0[r] = fmaf(p0[r], C, mnC);
#pragma unroll
  for (int r = 0; r < 16; ++r) p1[r] = fmaf(p1[r], C, mnC);
#pragma unroll
  for (int r = 0; r < 16; ++r) p0[r] = __builtin_amdgcn_exp2f(p0[r]);
}
__device__ __forceinline__ void finishSM(f32x16& p0, f32x16& p1, float alpha, float& l_reg, bf16x8& pa0, bf16x8& pa1, bf16x8& pa2, bf16x8& pa3) {
#pragma unroll
  for (int r = 0; r < 16; ++r) p1[r] = __builtin_amdgcn_exp2f(p1[r]);
  float ps = 0;
#pragma unroll
  for (int r = 0; r < 16; ++r) ps += p0[r];
#pragma unroll
  for (int r = 0; r < 16; ++r) ps += p1[r];
  { auto rr = __builtin_amdgcn_permlane32_swap(__float_as_uint(ps), __float_as_uint(ps), false, false);
    ps = __uint_as_float(rr[0]) + __uint_as_float(rr[1]); }
  l_reg = l_reg * alpha + ps;
#define PK4(P, BASE, OUT) do { unsigned a0 = cvt_pk_bf16(P[BASE + 0], P[BASE + 1]), a1 = cvt_pk_bf16(P[BASE + 2], P[BASE + 3]);   \
    unsigned b0 = cvt_pk_bf16(P[BASE + 4], P[BASE + 5]), b1 = cvt_pk_bf16(P[BASE + 6], P[BASE + 7]);                              \
    auto r0 = __builtin_amdgcn_permlane32_swap(a0, b0, false, false); auto r1 = __builtin_amdgcn_permlane32_swap(a1, b1, false, false); \
    u32x4 w = {r0[0], r1[0], r0[1], r1[1]}; OUT = *reinterpret_cast<bf16x8*>(&w); } while (0)
  PK4(p0, 0, pa0); PK4(p0, 8, pa1); PK4(p1, 0, pa2); PK4(p1, 8, pa3);
#undef PK4
}
template <int DK, int NQR>
__device__ __forceinline__ void qkt(f32x16& p0, f32x16& p1, const char* Ks, const char* Krs, const bf16x8* qr, const char* qrl, int r32, int hi) {
  p0 = f32x16{}; p1 = f32x16{};
#pragma unroll
  for (int d0 = 0; d0 < 8; ++d0) { int cb = (d0 * 16 + hi * 8) * 2;
    bf16x8 b0 = *reinterpret_cast<const bf16x8*>(Ks + KSWZ(r32, cb));
    bf16x8 b1 = *reinterpret_cast<const bf16x8*>(Ks + KSWZ(32 + r32, cb));
    bf16x8 qv; if (d0 < NQR) qv = qr[d0 < NQR ? d0 : 0]; else qv = *reinterpret_cast<const bf16x8*>(qrl + (d0 - NQR) * 1024);
    p0 = __builtin_amdgcn_mfma_f32_32x32x16_bf16(b0, qv, p0, 0, 0, 0);
    p1 = __builtin_amdgcn_mfma_f32_32x32x16_bf16(b1, qv, p1, 0, 0, 0); }
  if constexpr (DK == 192) {
#pragma unroll
    for (int d0 = 0; d0 < 4; ++d0) { int cb = (d0 * 16 + hi * 8) * 2;
      bf16x8 b0 = *reinterpret_cast<const bf16x8*>(Krs + KRSWZ(r32, cb));
      bf16x8 b1 = *reinterpret_cast<const bf16x8*>(Krs + KRSWZ(32 + r32, cb));
      const bf16x8 qv = *reinterpret_cast<const bf16x8*>(qrl + (8 - NQR + d0) * 1024);
      p0 = __builtin_amdgcn_mfma_f32_32x32x16_bf16(b0, qv, p0, 0, 0, 0);
      p1 = __builtin_amdgcn_mfma_f32_32x32x16_bf16(b1, qv, p1, 0, 0, 0); }
  }
}
__device__ __forceinline__ int v_st(int k, int c) { const int kk = (k & ~0xC) | ((k & 4) << 1) | ((k & 8) >> 1); return ((kk >> 3) * 4 + (c >> 5)) * 512 + ((kk & 7) * 32 + (c & 31)) * 2; }
__device__ __forceinline__ int v_rd_base(int lane) { return ((lane & 3) << 3) | (((lane >> 2) & 3) << 6) | (((lane >> 4) & 1) << 5) | (((lane >> 5) & 1) << 8); }
constexpr int v_rd_off(int d0, int ks, int half) { return d0 * 512 + ks * 4096 + half * 2048; }
template <int OFF> __device__ __forceinline__ s16x4 tr_read(int vb) {
  s16x4 r; asm volatile("ds_read_b64_tr_b16 %0, %1 offset:%2" : "=&v"(r) : "v"(vb), "i"(OFF) : "memory"); return r;
}
template <int D0> __device__ __forceinline__ void pv_one(f32x16& od, int vb, bf16x8 pa0, bf16x8 pa1, bf16x8 pa2, bf16x8 pa3) {
  const s16x4 l0 = tr_read<v_rd_off(D0, 0, 0)>(vb), h0 = tr_read<v_rd_off(D0, 0, 1)>(vb), l1 = tr_read<v_rd_off(D0, 1, 0)>(vb), h1 = tr_read<v_rd_off(D0, 1, 1)>(vb);
  const s16x4 l2 = tr_read<v_rd_off(D0, 2, 0)>(vb), h2 = tr_read<v_rd_off(D0, 2, 1)>(vb), l3 = tr_read<v_rd_off(D0, 3, 0)>(vb), h3 = tr_read<v_rd_off(D0, 3, 1)>(vb);
  asm volatile("s_waitcnt lgkmcnt(0)" ::: "memory"); SBAR();
#define PK(L, H) (bf16x8){L[0], L[1], L[2], L[3], H[0], H[1], H[2], H[3]}
  od = __builtin_amdgcn_mfma_f32_32x32x16_bf16(pa0, PK(l0, h0), od, 0, 0, 0);
  od = __builtin_amdgcn_mfma_f32_32x32x16_bf16(pa1, PK(l1, h1), od, 0, 0, 0);
  od = __builtin_amdgcn_mfma_f32_32x32x16_bf16(pa2, PK(l2, h2), od, 0, 0, 0);
  od = __builtin_amdgcn_mfma_f32_32x32x16_bf16(pa3, PK(l3, h3), od, 0, 0, 0);
#undef PK
}
__device__ __forceinline__ void pv_d0(f32x16* o, int vb, bf16x8 pa0, bf16x8 pa1, bf16x8 pa2, bf16x8 pa3) {
  pv_one<0>(o[0], vb, pa0, pa1, pa2, pa3); pv_one<1>(o[1], vb, pa0, pa1, pa2, pa3); pv_one<2>(o[2], vb, pa0, pa1, pa2, pa3); pv_one<3>(o[3], vb, pa0, pa1, pa2, pa3);
}

#define K8SWZ(row, chunk) ((row) * 128 + ((((chunk) ^ (((row) >> 1) & 7))) << 4))
#define KR8SWZ(row, chunk) ((row) * 64 + ((((chunk) ^ (((row) >> 2) & 3))) << 4))
constexpr float ATT_SQK = 20.f;
typedef int v16i_t __attribute__((ext_vector_type(16)));
template <int DK>
__device__ __forceinline__ void qkt8(f32x16& p0, f32x16& p1, const char* Ks, const char* Krs, const v4i_t* qi, int r32, int hi) {
  p0 = f32x16{}; p1 = f32x16{};
#pragma unroll
  for (int d = 0; d < 4; ++d) {
    const v4i_t b0 = *reinterpret_cast<const v4i_t*>(Ks + K8SWZ(r32, 2 * d + hi));
    const v4i_t b1 = *reinterpret_cast<const v4i_t*>(Ks + K8SWZ(32 + r32, 2 * d + hi));
    p0 = __builtin_bit_cast(f32x16, __builtin_amdgcn_mfma_i32_32x32x32_i8(b0, qi[d], __builtin_bit_cast(v16i_t, p0), 0, 0, 0));
    p1 = __builtin_bit_cast(f32x16, __builtin_amdgcn_mfma_i32_32x32x32_i8(b1, qi[d], __builtin_bit_cast(v16i_t, p1), 0, 0, 0)); }
  if constexpr (DK == 192) {
#pragma unroll
    for (int d = 0; d < 2; ++d) {
      const v4i_t b0 = *reinterpret_cast<const v4i_t*>(Krs + KR8SWZ(r32, 2 * d + hi));
      const v4i_t b1 = *reinterpret_cast<const v4i_t*>(Krs + KR8SWZ(32 + r32, 2 * d + hi));
      p0 = __builtin_bit_cast(f32x16, __builtin_amdgcn_mfma_i32_32x32x32_i8(b0, qi[4 + d], __builtin_bit_cast(v16i_t, p0), 0, 0, 0));
      p1 = __builtin_bit_cast(f32x16, __builtin_amdgcn_mfma_i32_32x32x32_i8(b1, qi[4 + d], __builtin_bit_cast(v16i_t, p1), 0, 0, 0)); }
  }
#pragma unroll
  for (int r = 0; r < 16; ++r) { p0[r] = (float)__float_as_int(p0[r]); p1[r] = (float)__float_as_int(p1[r]); }
}
template <int DK, int SDEPTH, int ldq, int ldk, int ldv, int ldo, int seq, bool QK8 = false>
__device__ __forceinline__ void attn_unit(const bf16_t* __restrict__ Qb, const bf16_t* __restrict__ Kh, const bf16_t* __restrict__ Krp,
                                          const bf16_t* __restrict__ Vh, bf16_t* __restrict__ Ob, char* lds) {
  constexpr float SCALE = (DK == 128) ? 0.088388347648318440f : 0.072168783648703220f;
  constexpr float QKS = QK8 ? (ATT_SQK * ATT_SQK) : 1.f;
  constexpr float C = SCALE * 1.4426950408889634f / QKS, THRS = THR / SCALE * QKS;
  constexpr int ND = QK8 ? 0 : DK / 16, NQR = QK8 ? 0 : ((DK == 128) ? 8 : 6);
  const int tid = threadIdx.x, wid = tid >> 6, lane = tid & 63, r32 = lane & 31, hi = lane >> 5;
  char* V_lds = lds + OFF_V; char* K_lds = lds + OFF_K; char* KR_lds = lds + OFF_KR;
  float* ws = (float*)(lds + OFF_WS) + wid * 64; float* li_l = ws; float* al_l = ws + 32;
  float m_reg = -1e30f, l_reg = 0; f32x16 o[4] = {}; bf16x8 qr[NQR ? NQR : 1]; v4i_t qi[DK / 32];
  if constexpr (QK8) { const unsigned char* Qw8 = (const unsigned char*)Qb + (long)(wid * QBLK + r32) * ldq + hi * 16;
#pragma unroll
    for (int d = 0; d < DK / 32; ++d) qi[d] = *reinterpret_cast<const v4i_t*>(Qw8 + d * 32); }
  const bf16_t* Qw = Qb + (long)(wid * QBLK + r32) * ldq + hi * 8;
#pragma unroll
  for (int d0 = 0; d0 < NQR; ++d0) qr[d0] = *reinterpret_cast<const bf16x8*>(Qw + d0 * 16);
  char* qrl = lds + OFF_QR + wid * QR_WAVE + lane * 16;
#pragma unroll
  for (int d0 = NQR; d0 < ND; ++d0) *reinterpret_cast<bf16x8*>(qrl + (d0 - NQR) * 1024) = *reinterpret_cast<const bf16x8*>(Qw + d0 * 16);
  const int sr = tid >> 4, sc = (tid & 15) * 8, vst0 = v_st(sr, sc), vst1 = v_st(32 + sr, sc);
  const int krr = tid >> 3, krc = (tid & 7) * 8;
  const int vb0 = (int)(uintptr_t)V_lds + v_rd_base(lane);
  bf16x8 vs0[SDEPTH], vs1[SDEPTH], ks0[SDEPTH], ks1[SDEPTH], kr0[SDEPTH]; v4i_t k8[SDEPTH], kr8[SDEPTH];
  const int k8off = K8SWZ(krr, tid & 7); const unsigned voffK8 = (unsigned)(krr * ldk + (tid & 7) * 16);
  const int kr8off = KR8SWZ(tid >> 2, tid & 3); const unsigned voffKR8 = (unsigned)((tid >> 2) * 64 + (tid & 3) * 16);
  const unsigned voffV = (unsigned)((sr * ldv + sc) * 2), voffK = (unsigned)((sr * ldk + sc) * 2), voffR = (unsigned)((krr * 64 + krc) * 2);
#define SLOAD(i, k0) do { const char* vb_ = (const char*)Vh + (size_t)(k0) * (ldv * 2); const char* kb_ = (const char*)Kh + (size_t)(k0) * (ldk * 2); \
    vs0[i] = *(const bf16x8*)(vb_ + voffV); vs1[i] = *(const bf16x8*)(vb_ + 32 * ldv * 2 + voffV); \
    if constexpr (QK8) k8[i] = *(const v4i_t*)((const char*)Kh + (size_t)(k0) * ldk + voffK8); \
    else { ks0[i] = *(const bf16x8*)(kb_ + voffK); ks1[i] = *(const bf16x8*)(kb_ + 32 * ldk * 2 + voffK); } \
    if constexpr (DK == 192 && QK8) { if (tid < 256) kr8[i] = *(const v4i_t*)((const char*)Krp + (size_t)(k0) * 64 + voffKR8); } \
    else if constexpr (DK == 192) kr0[i] = *(const bf16x8*)((const char*)Krp + (size_t)(k0) * 128 + voffR); } while (0)
#define SWRITE(b, i) do { *(bf16x8*)(V_lds + (b) * SHM_V + vst0) = vs0[i];          \
    *(bf16x8*)(V_lds + (b) * SHM_V + vst1) = vs1[i]; int kc = sc * 2;               \
    if constexpr (QK8) *(v4i_t*)(K_lds + (b) * SHM_K + k8off) = k8[i];            \
    else { *(bf16x8*)(K_lds + (b) * SHM_K + KSWZ(sr, kc)) = ks0[i];                \
    *(bf16x8*)(K_lds + (b) * SHM_K + KSWZ(32 + sr, kc)) = ks1[i]; }               \
    if constexpr (DK == 192 && QK8) { if (tid < 256) *(v4i_t*)(KR_lds + (b) * SHM_KR + kr8off) = kr8[i]; } \
    else if constexpr (DK == 192) *(bf16x8*)(KR_lds + (b) * SHM_KR + KRSWZ(krr, krc * 2)) = kr0[i]; } while (0)
#define SWAIT() do { if constexpr (SDEPTH == 1) asm volatile("s_waitcnt vmcnt(0)" ::: "memory"); else if constexpr (QK8) asm volatile("s_waitcnt vmcnt(3)" ::: "memory"); else if constexpr (DK == 192) asm volatile("s_waitcnt vmcnt(5)" ::: "memory"); else asm volatile("s_waitcnt vmcnt(4)" ::: "memory"); } while (0)
#define QKT(P0, P1, KB, KRB) do { if constexpr (QK8) qkt8<DK>(P0, P1, KB, KRB, qi, r32, hi); else qkt<DK, (NQR ? NQR : 8)>(P0, P1, KB, KRB, qr, qrl, r32, hi); } while (0)
#define RESC(a) do { if (__any((a) < 1.f)) { if (hi == 0) al_l[r32] = (a); asm volatile("s_waitcnt lgkmcnt(0)" ::: "memory"); \
    _Pragma("unroll") for (int d = 0; d < 4; ++d) _Pragma("unroll") for (int r = 0; r < 16; ++r) o[d][r] *= al_l[crow(r, hi)]; } } while (0)
  f32x16 pA0, pA1, pB0, pB1; float mnA, mnB, alA, alB; bf16x8 pa0, pa1, pa2, pa3; const int NT = seq / KVBLK;
  constexpr int SE = 0, SO = SDEPTH - 1;
  SLOAD(SE, 0); asm volatile("s_waitcnt vmcnt(0)" ::: "memory"); SWRITE(0, SE); __syncthreads();
  QKT(pA0, pA1, K_lds, KR_lds); partialSM(pA0, pA1, m_reg, mnA, alA, C, THRS);
  SLOAD(SO, KVBLK); if constexpr (SDEPTH == 2) { if (2 < NT) SLOAD(SE, 2 * KVBLK); }
  SWAIT(); SWRITE(1, SO); __syncthreads();
  for (int j = 1; j + 1 < NT; j += 2) {
    SBAR(); QKT(pB0, pB1, K_lds + SHM_K, KR_lds + SHM_KR);
    finishSM(pA0, pA1, alA, l_reg, pa0, pa1, pa2, pa3); SBAR();
    SLOAD(SO, (j + SDEPTH) * KVBLK); SBAR();
    pv_d0(o, vb0, pa0, pa1, pa2, pa3); partialSM(pB0, pB1, m_reg, mnB, alB, C, THRS);
    __syncthreads(); SWAIT(); SWRITE(0, SE);
    RESC(alB); __syncthreads();
    SBAR(); QKT(pA0, pA1, K_lds, KR_lds);
    finishSM(pB0, pB1, alB, l_reg, pa0, pa1, pa2, pa3); SBAR();
    if (SDEPTH == 1 || j + 3 < NT) SLOAD(SE, (j + 1 + SDEPTH) * KVBLK); SBAR();
    pv_d0(o, vb0 + SHM_V, pa0, pa1, pa2, pa3); partialSM(pA0, pA1, m_reg, mnA, alA, C, THRS);
    __syncthreads(); SWAIT(); SWRITE(1, SO);
    RESC(alA); __syncthreads();
  }
  SBAR(); QKT(pB0, pB1, K_lds + SHM_K, KR_lds + SHM_KR);
  finishSM(pA0, pA1, alA, l_reg, pa0, pa1, pa2, pa3); SBAR();
  pv_d0(o, vb0, pa0, pa1, pa2, pa3); partialSM(pB0, pB1, m_reg, mnB, alB, C, THRS);
  __syncthreads(); RESC(alB);
  finishSM(pB0, pB1, alB, l_reg, pa0, pa1, pa2, pa3); SBAR();
  pv_d0(o, vb0 + SHM_V, pa0, pa1, pa2, pa3);
  if (hi == 0) li_l[r32] = l_reg; asm volatile("s_waitcnt lgkmcnt(0)" ::: "memory");
  float rli[16];
#pragma unroll
  for (int r = 0; r < 16; ++r) rli[r] = __builtin_amdgcn_rcpf(li_l[crow(r, hi)]);
  bf16_t* Ow = Ob + (long)(wid * QBLK) * ldo;
#pragma unroll
  for (int r = 0; r < 16; ++r) { int orow = crow(r, hi);
#pragma unroll
    for (int d0 = 0; d0 < 4; ++d0) Ow[(long)orow * ldo + d0 * 32 + r32] = f2bf(o[d0][r] * rli[r]); }
#undef QKT
#undef SLOAD
#undef SWRITE
#undef SWAIT
#undef RESC
}
}

struct TrItem { const float* W; bf16_t* WT; int ldw, k0, n0, ldt, drow0, dk0; const float* gain; };
__device__ __forceinline__ void tr_load(f32x4 (&v)[16], const TrItem& t, int lane) {
    const int lr = lane >> 4, lc = (lane & 15) * 4;
#pragma unroll
    for (int i = 0; i < 16; ++i) v[i] = *(const f32x4*)(t.W + (size_t)(t.k0 + 4 * i + lr) * t.ldw + t.n0 + lc);
}
__device__ __forceinline__ void tr_store(const f32x4 (&v)[16], const TrItem& t, LAS float* scr, int lane) {
    const int lr = lane >> 4, lc = (lane & 15) * 4;
#pragma unroll
    for (int i = 0; i < 16; ++i) { LAS float* d = scr + (4 * i + lr) * 65 + lc; const float gk = t.gain ? t.gain[t.k0 + 4 * i + lr] : 1.f;
        d[0] = v[i].x * gk; d[1] = v[i].y * gk; d[2] = v[i].z * gk; d[3] = v[i].w * gk; }
    asm volatile("s_waitcnt lgkmcnt(0)" ::: "memory");
    const int c = lane & 7;
#pragma unroll
    for (int j = 0; j < 8; ++j) { const int n = (lane >> 3) + 8 * j; const LAS float* s = scr + (8 * c) * 65 + n;
        u32x4 o; o.x = cvt_pk_bf16(s[0], s[65]); o.y = cvt_pk_bf16(s[130], s[195]); o.z = cvt_pk_bf16(s[260], s[325]); o.w = cvt_pk_bf16(s[390], s[455]);
        *(u32x4*)(t.WT + (size_t)(t.drow0 + n) * t.ldt + t.dk0 + 8 * c) = o; }
    asm volatile("s_waitcnt lgkmcnt(0)" ::: "memory");
}
__device__ __forceinline__ void tr_item(const float* __restrict__ W, int ldw, int k0, int n0, bf16_t* __restrict__ WT, int ldt, int drow0, int dk0, LAS float* scr, int lane) {
    TrItem t{W, WT, ldw, k0, n0, ldt, drow0, dk0, nullptr}; f32x4 v[16]; tr_load(v, t, lane); tr_store(v, t, scr, lane);
}
__device__ __forceinline__ void rms_row_to_bf16(const float* __restrict__ xrow, const float* __restrict__ g, bf16_t* __restrict__ orow, int lane) {
    f32x4 v[8]; float s = 0.f;
#pragma unroll
    for (int j = 0; j < 8; ++j) { v[j] = *(const f32x4*)(xrow + 4 * lane + 256 * j); s += (v[j].x * v[j].x + v[j].y * v[j].y) + (v[j].z * v[j].z + v[j].w * v[j].w); }
    const float r = 1.0f / sqrtf(wave_sum(s) * (1.f / DM) + EPS);
#pragma unroll
    for (int j = 0; j < 8; ++j) { const f32x4 gg = *(const f32x4*)(g + 4 * lane + 256 * j);
        u32x2 o; o.x = cvt_pk_bf16(v[j].x * r * gg.x, v[j].y * r * gg.y); o.y = cvt_pk_bf16(v[j].z * r * gg.z, v[j].w * r * gg.w);
        *(u32x2*)(orow + 4 * lane + 256 * j) = o; }
}

__device__ __forceinline__ void tr_item8(const float* __restrict__ W, int ldw, int k0, int n0, unsigned char* __restrict__ WT8, int ldt, int drow0, int dk0, LAS float* scr, int lane) {
    const int lr = lane >> 4, lc = (lane & 15) * 4;
    f32x4 v[16];
#pragma unroll
    for (int i = 0; i < 16; ++i) v[i] = *(const f32x4*)(W + (size_t)(k0 + 4 * i + lr) * ldw + n0 + lc);
#pragma unroll
    for (int i = 0; i < 16; ++i) { LAS float* d = scr + (4 * i + lr) * 65 + lc; d[0] = v[i].x * Q8_SW; d[1] = v[i].y * Q8_SW; d[2] = v[i].z * Q8_SW; d[3] = v[i].w * Q8_SW; }
    asm volatile("s_waitcnt lgkmcnt(0)" ::: "memory");
    const int c = lane & 7;
#pragma unroll
    for (int j = 0; j < 8; ++j) { const int n = (lane >> 3) + 8 * j; const LAS float* s = scr + (8 * c) * 65 + n;
        u32x2 o; o.x = q8x4(s[0], s[65], s[130], s[195]); o.y = q8x4(s[260], s[325], s[390], s[455]);
        *(u32x2*)(WT8 + (size_t)(drow0 + n) * ldt + dk0 + 8 * c) = o; }
    asm volatile("s_waitcnt lgkmcnt(0)" ::: "memory");
}
__device__ __forceinline__ void rms_row_to_i8(const float* __restrict__ xrow, const float* __restrict__ g, unsigned char* __restrict__ orow, int lane) {
    f32x4 v[8]; float s = 0.f;
#pragma unroll
    for (int j = 0; j < 8; ++j) { v[j] = *(const f32x4*)(xrow + 4 * lane + 256 * j); s += (v[j].x * v[j].x + v[j].y * v[j].y) + (v[j].z * v[j].z + v[j].w * v[j].w); }
    const float r = Q8_SU / sqrtf(wave_sum(s) * (1.f / DM) + EPS);
#pragma unroll
    for (int j = 0; j < 8; ++j) { const f32x4 gg = *(const f32x4*)(g + 4 * lane + 256 * j);
        *(unsigned*)(orow + 4 * lane + 256 * j) = q8x4(v[j].x * r * gg.x, v[j].y * r * gg.y, v[j].z * r * gg.z, v[j].w * r * gg.w); }
}

#define XB_TMO      128
#define XB_XCNT(j)  (256  + 64 * (j))
#define XB_XSUB(j)  (1280 + 64 * (j))
#define XB_XGEN(j)  (2304 + 64 * (j))
#define XB_TOP      3328
#define XB_TOPGEN   3392
#define XCD_BAR_WORDS 3456
#define XB_SPIN_CAP (1u << 18)
__device__ __forceinline__ unsigned xb_ld(unsigned* p)              { return __hip_atomic_load(p, __ATOMIC_RELAXED, __HIP_MEMORY_SCOPE_AGENT); }
__device__ __forceinline__ unsigned xb_add(unsigned* p, unsigned v) { return __hip_atomic_fetch_add(p, v, __ATOMIC_RELAXED, __HIP_MEMORY_SCOPE_AGENT); }
__device__ __forceinline__ unsigned xb_xcc_id() { return (unsigned)__builtin_amdgcn_s_getreg((3 << 11) | 20) & 0xFu; }
#define XB_SPIN(cond, bar) do { unsigned _sp = 0; while (cond) { __builtin_amdgcn_s_sleep(1); \
    if ((++_sp & 255u) == 0u) { if (xb_ld(&(bar)[XB_TMO])) break; if (_sp > XB_SPIN_CAP) { atomicAdd(&(bar)[XB_TMO], 1u); break; } } } } while (0)
struct XcdBarrier { unsigned* bar; unsigned x; volatile LAS unsigned* st; };
__device__ __forceinline__ XcdBarrier xcd_barrier_post(unsigned* bar, volatile LAS unsigned* st) {
    XcdBarrier b; b.bar = bar; b.x = xb_xcc_id(); b.st = st;
    if (threadIdx.x == 0) (void)xb_add(&bar[XB_XCNT(b.x)], 1u);
    return b;
}
__device__ __forceinline__ void xcd_barrier_complete(unsigned* bar, unsigned x, unsigned& nloc, unsigned& nx) {
    const unsigned G = gridDim.x * gridDim.y * gridDim.z;
    unsigned sum, cnt, mine, sp = 0u;
    for (;;) {
        sum = 0u; cnt = 0u; mine = 0u;
#pragma unroll
        for (unsigned j = 0; j < 16; ++j) { const unsigned c = xb_ld(&bar[XB_XCNT(j)]); sum += c; cnt += (c > 0u) ? 1u : 0u; mine = (j == x) ? c : mine; }
        if (sum == G) break;
        __builtin_amdgcn_s_sleep(1);
        if ((++sp & 255u) == 0u) { if (xb_ld(&bar[XB_TMO])) break; if (sp > XB_SPIN_CAP) { atomicAdd(&bar[XB_TMO], 1u); break; } }
    }
    nloc = mine > 0u ? mine : 1u; nx = cnt > 0u ? cnt : 1u;
}
__device__ __forceinline__ void xcd_barrier(const XcdBarrier& b) {
    asm volatile("s_waitcnt vmcnt(0)" ::: "memory");
    __syncthreads();
    if (threadIdx.x == 0) {
        unsigned* bar = b.bar;
        __builtin_amdgcn_s_waitcnt(0);
        unsigned nloc = b.st[0], nx = b.st[1];
        if (nloc == 0u) { xcd_barrier_complete(bar, b.x, nloc, nx); b.st[0] = nloc; b.st[1] = nx; }
        const unsigned old = xb_add(&bar[XB_XSUB(b.x)], 1u);
        const unsigned gen = old / nloc;
        if (old + 1u == (gen + 1u) * nloc) {
            __builtin_amdgcn_fence(__ATOMIC_RELEASE, "agent");
            asm volatile("s_waitcnt vmcnt(0)" ::: "memory");
            const unsigned og = xb_add(&bar[XB_TOP], 1u);
            const unsigned tg = og / nx;
            if (og + 1u == (tg + 1u) * nx) xb_add(&bar[XB_TOPGEN], 1u);
            else XB_SPIN(xb_ld(&bar[XB_TOPGEN]) == tg, bar);
            __builtin_amdgcn_fence(__ATOMIC_ACQUIRE, "agent");
            xb_add(&bar[XB_XGEN(b.x)], 1u);
            asm volatile("s_waitcnt vmcnt(0)" ::: "memory");
        } else {
            XB_SPIN(xb_ld(&bar[XB_XGEN(b.x)]) == gen, bar);
            __builtin_amdgcn_fence(__ATOMIC_ACQUIRE, "agent");
            asm volatile("s_waitcnt vmcnt(0)" ::: "memory");
        }
    }
    __syncthreads();
}

struct Args {
    const float *x, *p, *g_mix, *w_in, *q_norm_a, *k_norm_a, *q_a_norm, *w_q_b, *kv_a_norm, *w_kv_b, *w_a_out, *w_b_out, *w_o, *g_ffn, *w_gate_up, *w_down, *g_ple,
                *w_ple_gate, *w_ple_proj, *g_ple_post, *g_final;
    float* out; unsigned char* ws; int ph_lo, ph_hi;
};

constexpr int NPHASE = 14;

__global__ void __launch_bounds__(NTHREADS, 2) mk_fwd(Args a) {
    extern __shared__ __attribute__((aligned(16))) unsigned char lds_raw[];
    LAS unsigned char* lds = (LAS unsigned char*)lds_raw;
    const int tid = threadIdx.x, lane = tid & 63, wave = __builtin_amdgcn_readfirstlane(tid >> 6);
    const int G = gridDim.x, bx = blockIdx.x;
    const int gw = bx * NWAVES + wave, NGW = G * NWAVES;
    unsigned char* ws = a.ws;
    bf16_t* WinT = (bf16_t*)(ws + WS_WIN); bf16_t* WqbT = (bf16_t*)(ws + WS_WQB); bf16_t* WkvbT = (bf16_t*)(ws + WS_WKVB); bf16_t* WabT = (bf16_t*)(ws + WS_WAB);
    bf16_t* WoT = (bf16_t*)(ws + WS_WO); bf16_t* WguT = (bf16_t*)(ws + WS_WGU); bf16_t* WdT = (bf16_t*)(ws + WS_WD); bf16_t* WpgT = (bf16_t*)(ws + WS_WPG);
    bf16_t* WppT = (bf16_t*)(ws + WS_WPP); bf16_t* PB = (bf16_t*)(ws + WS_PB); bf16_t* KR = (bf16_t*)(ws + WS_KR); bf16_t* U = (bf16_t*)(ws + WS_U);
    bf16_t* ZS = (bf16_t*)(ws + WS_ZS); bf16_t* SG = (bf16_t*)(ws + WS_SG); bf16_t* QA = (bf16_t*)(ws + WS_QA); bf16_t* QB = (bf16_t*)(ws + WS_QB);
    bf16_t* KVB = (bf16_t*)(ws + WS_KVB); bf16_t* CQN = (bf16_t*)(ws + WS_CQN); bf16_t* CKVN = (bf16_t*)(ws + WS_CKVN); bf16_t* KA = (bf16_t*)(ws + WS_KA);
    bf16_t* KPE = (bf16_t*)(ws + WS_KPE); bf16_t* OAB = (bf16_t*)(ws + WS_OAB); bf16_t* MERGED = (bf16_t*)(ws + WS_MERGED); bf16_t* ACT = (bf16_t*)(ws + WS_ACT);
    bf16_t* GATE = (bf16_t*)(ws + WS_GATE); bf16_t* ERAW = (bf16_t*)(ws + WS_ERAW); float* H = a.out;
    unsigned char* KN8 = ws + WS_KVB; bf16_t* VB = (bf16_t*)(ws + WS_KVB + 8 * MiB);
    float* SSQC = (float*)(ws + 196608); float* SSQK = (float*)(ws + 229376);
    float* SSQ1 = (float*)(ws + 65536); float* SSQ2 = (float*)(ws + 131072);
    const int lo = a.ph_lo, hi = a.ph_hi;
#define IN(k) (lo <= (k) && (k) < hi)
#define SEAM(k) do { if (IN(k) && IN((k) + 1)) { xcd_barrier(xbar); } } while (0)
    volatile LAS unsigned* xst = (volatile LAS unsigned*)(lds + LDS_BYTES - 64);
    if (tid == 0) { xst[0] = 0u; xst[1] = 0u; }
    __syncthreads();
    XcdBarrier xbar = xcd_barrier_post((unsigned*)ws, xst);
    if (a.ph_lo < 0) cg::this_grid().sync();

    constexpr int I0 = 32 * 105, I1 = 8 * 24, I2 = 8 * 32, I3 = 16 * 32, I4 = 16 * 32, I5 = 32 * 32, I6 = 32 * 176, I7 = 88 * 32, I8 = 32 * 32, I9 = 4 * 32;
    constexpr int NREST = I1 + I2 + I3 + I4 + I5 + I6 + I7 + I8 + I9;
    if (IN(0)) {
        LAS float* scr = (LAS float*)(lds + wave * 16640);
        for (int it = gw; it < I0; it += NGW) {
            const int kb = it / 105, nb = it % 105, n0 = nb * 64; const int dr = n0 < 2560 ? n0 : (n0 < 2624 ? 6656 + (n0 - 2560) : n0 - 64);
            tr_item8(a.w_in, NIN, kb * 64, n0, (unsigned char*)WinT, 2048, dr, kb * 64, scr, lane);
        }
        for (int m = gw; m < M; m += NGW) {
            rms_row_to_i8(a.x + (size_t)m * DM, a.g_mix, (unsigned char*)U + (size_t)m * DM, lane);
            const f32x4 pv = *(const f32x4*)(a.p + (size_t)m * PLE + 4 * lane);
            u32x2 o; o.x = cvt_pk_bf16(pv.x, pv.y); o.y = cvt_pk_bf16(pv.z, pv.w);
            *(u32x2*)(PB + (size_t)m * PLE + 4 * lane) = o;
        }
        for (int i = bx * NTHREADS + tid; i < (NINP - NIN) * 2048 / 16; i += G * NTHREADS) *(u32x4*)((unsigned char*)WinT + (size_t)NIN * 2048 + (size_t)i * 16) = (u32x4){0u, 0u, 0u, 0u};
        __syncthreads();
    }
    SEAM(0);
    if (IN(1)) {
        constexpr int NU = (M / 256) * (NINP / 256);
        const int GG = (G >= 256) ? 173 : G;
        if (bx < GG) {
            pg8::Gemm g{U, WinT, M, NINP, DM / 2, DM / 2, 0}; pg8::StaticOrder S; S.init(M, NINP, GG, bx);
            pg8::EpiIn E{ZS, SG, KR, SSQC, SSQK};
            pg8::gemm_phase<pg8::EpiIn, pg8::StaticOrder, true, true, false, true>(lds, g, S, E);
        }
        {
            {
                LAS float* scr = (LAS float*)(lds + wave * 16640);
                unsigned* qctr = (unsigned*)(ws + 262144);
                auto decode = [&](int r) -> TrItem {
                    if (r < I1) { const int kb = r / 24, nb = r % 24; return TrItem{a.w_q_b, WqbT, 1536, kb * 64, nb * 64, 512, nb * 64, kb * 64, a.q_a_norm}; } r -= I1;
                    if (r < I2) { const int kb = r / 32, nb = r % 32; return TrItem{a.w_kv_b, WkvbT, 2048, kb * 64, nb * 64, 512, nb * 64, kb * 64, a.kv_a_norm}; } r -= I2;
                    if (r < I3) { const int kb = r / 32, nb = r % 32; return TrItem{a.w_a_out, WabT, 2048, kb * 64, nb * 64, 2048, nb * 64, kb * 64, nullptr}; } r -= I3;
                    if (r < I4) { const int kb = r / 32, nb = r % 32; return TrItem{a.w_b_out, WabT, 2048, kb * 64, nb * 64, 2048, nb * 64, 1024 + kb * 64, nullptr}; } r -= I4;
                    if (r < I5) { const int kb = r / 32, nb = r % 32; return TrItem{a.w_o, WoT, 2048, kb * 64, nb * 64, 2048, nb * 64, kb * 64, nullptr}; } r -= I5;
                    if (r < I6) { const int kb = r / 176, nb = r % 176, n0 = nb * 64; const int s_ = n0 >= DFF ? 1 : 0, j = n0 - s_ * DFF; const int dr = 256 * (j >> 7) + 128 * s_ + (j & 127);
                        return TrItem{a.w_gate_up, WguT, 2 * DFF, kb * 64, n0, 2048, dr, kb * 64, a.g_ffn}; } r -= I6;
                    if (r < I7) { const int kb = r / 32, nb = r % 32; return TrItem{a.w_down, WdT, 2048, kb * 64, nb * 64, DFF, nb * 64, kb * 64, nullptr}; } r -= I7;
                    if (r < I8) { const int kb = r / 32, nb = r % 32; return TrItem{a.w_ple_gate, WpgT, 2048, kb * 64, nb * 64, 2048, nb * 64, kb * 64, a.g_ple}; } r -= I8;
                    { const int kb = r / 32, nb = r % 32; return TrItem{a.w_ple_proj, WppT, 2048, kb * 64, nb * 64, 256, nb * 64, kb * 64, nullptr}; }
                };
                auto ticket = [&]() -> unsigned { unsigned v = 0u; if (lane == 0) v = __hip_atomic_fetch_add((__attribute__((address_space(1))) unsigned*)qctr, 2u, __ATOMIC_RELAXED, __HIP_MEMORY_SCOPE_AGENT); return v; };
                f32x4 va[16], vb[16]; TrItem ta{}, tb{};
                unsigned tk = ticket();
                int base = (int)__builtin_amdgcn_readfirstlane(tk);
                if (base < NREST) { ta = decode(base); tr_load(va, ta, lane); }
                while (base < NREST) {
                    tk = ticket();
                    const bool two = base + 1 < NREST;
                    if (two) { tb = decode(base + 1); tr_load(vb, tb, lane); }
                    tr_store(va, ta, scr, lane);
                    const int nbase = (int)__builtin_amdgcn_readfirstlane(tk);
                    if (nbase < NREST) { ta = decode(nbase); tr_load(va, ta, lane); }
                    if (two) tr_store(vb, tb, scr, lane);
                    base = nbase;
                }
            }
            __syncthreads();
        }
        (void)NU;
    }
    SEAM(1);
    if (IN(2)) {
        const int l5 = lane & 31, hsel = lane >> 5, d0 = l5 * 4, isx2 = (l5 >> 3) & 1, halfc = (l5 >> 4) & 1;
        float invA4[4]; f32x4 gq, gk;
#pragma unroll
        for (int i = 0; i < 4; ++i) invA4[i] = powf(10000.f, -(float)(2 * ((d0 & 31) + i)) / 64.f);
        gq = *(const f32x4*)(a.q_norm_a + d0); gk = *(const f32x4*)(a.k_norm_a + d0);
        const int hfb = (lane >> 4) & 1, jb = lane & 15;
        const float invB = powf(10000.f, -(float)(2 * jb) / 32.f);
        for (int m = gw; m < M; m += NGW) {
            const int s = m & (SEQ - 1); const float prow = (float)(s >> 6), pcol = (float)(s & 63);
            const float posA = halfc ? pcol : prow; float cA[4], sA[4];
#pragma unroll
            for (int i = 0; i < 4; ++i) { const float ang = posA * invA4[i]; cA[i] = cosf(ang); sA[i] = sinf(ang); }
            const bf16_t* zr = ZS + (size_t)m * 2560;
#pragma unroll
            for (int it = 0; it < 5; ++it) {
                const int head = 2 * it + hsel;
                const u32x2 w = *(const u32x2*)(zr + head * 128 + d0);
                const float x[4] = {bf_lo(w.x), bf_hi(w.x), bf_lo(w.y), bf_hi(w.y)};
                float ss = (x[0] * x[0] + x[1] * x[1]) + (x[2] * x[2] + x[3] * x[3]);
#pragma unroll
                for (int o2 = 1; o2 < 32; o2 <<= 1) ss += __shfl_xor(ss, o2);
                const float r = 1.0f / sqrtf(ss * (1.f / 128.f) + EPS);
                const f32x4 g = (it < 4) ? gq : gk; float o[4];
#pragma unroll
                for (int i = 0; i < 4; ++i) { const float y = x[i] * r * g[i]; const float p = __shfl_xor(y, 8);
                    o[i] = isx2 ? (y * cA[i] + p * sA[i]) : (y * cA[i] - p * sA[i]); }
                unsigned char* dst = (it < 4) ? ((unsigned char*)QA + (size_t)m * 1024 + head * 128 + d0) : ((unsigned char*)KA + (size_t)m * 256 + (head - 8) * 128 + d0);
                *(unsigned*)dst = q8x4(o[0] * att::ATT_SQK, o[1] * att::ATT_SQK, o[2] * att::ATT_SQK, o[3] * att::ATT_SQK);
            }
            if (lane < 32) {
                const float angB = (hfb ? pcol : prow) * invB; const float cB = cosf(angB), sB = sinf(angB);
                const bf16_t* kr = KR + (size_t)m * 64 + hfb * 32 + jb;
                const float x1 = bf1(kr[0]), x2 = bf1(kr[16]);
                bf16_t* dst = KPE + (size_t)m * 64 + hfb * 32 + jb;
                unsigned char* d8 = (unsigned char*)KPE + (size_t)m * 64 + hfb * 32 + jb;
                d8[0] = (unsigned char)q8((x1 * cB - x2 * sB) * QKSB); d8[16] = (unsigned char)q8((x2 * cB + x1 * sB) * QKSB); (void)dst;
            }
        }
    }
    if (IN(3)) {
        { pg8::Gemm g{ZS + 1536, WqbT, M, 1536, 512, 512, 0, 2560}; pg8::StaticOrder S; S.init(M, 1536, G, bx); pg8::EpiQB E{QB, SSQC};
          pg8::gemm_phase<pg8::EpiQB, pg8::StaticOrder, true, true, false>(lds, g, S, E); }
        { pg8::Gemm g{ZS + 2048, WkvbT, M, 2048, 512, 512, 0, 2560}; pg8::StaticOrder S; S.init(M, 2048, G, bx); pg8::EpiKV E{KN8, VB, SSQK};
          pg8::gemm_phase<pg8::EpiKV, pg8::StaticOrder, true, true, false>(lds, g, S, E); }
    }
    SEAM(3);
    if (IN(5)) {
        char* lds_g = (char*)lds_raw;
        const int x = bx & 7, i = bx >> 3;
        for (int c = bx; c < 256; c += G) {
            const int xx = c & 7, ii = c >> 3;
            {
                const int combo = xx >> 1, w = (xx & 1) * 32 + ii, b = combo >> 1, kvh = combo & 1, hq = kvh * 4 + (w >> 4), qb = w & 15;
                const size_t row0 = (size_t)b * SEQ;
                __syncthreads();
                att::attn_unit<128, ATT_SD_A, 1024, 256, 2560, 2048, SEQ, true>((const bf16_t*)((const unsigned char*)QA + (row0 + qb * 256) * 1024 + hq * 128), (const bf16_t*)((const unsigned char*)KA + row0 * 256 + kvh * 128), nullptr,
                                    ZS + row0 * 2560 + 1280 + kvh * 128, OAB + (row0 + qb * 256) * 2048 + hq * 128, lds_g);
            }
            {
                const int unit = xx * 32 + ii, bh = unit >> 4, qb = unit & 15, b = bh >> 3, h = bh & 7;
                const size_t row0 = (size_t)b * SEQ;
                __syncthreads();
                att::attn_unit<192, ATT_SD_B, 1536, 1024, 1024, 2048, SEQ, true>((const bf16_t*)((const unsigned char*)QB + (row0 + qb * 256) * 1536 + h * 192), (const bf16_t*)(KN8 + row0 * 1024 + h * 128), (const bf16_t*)((const unsigned char*)KPE + row0 * 64),
                                    VB + row0 * 1024 + h * 128, OAB + (row0 + qb * 256) * 2048 + 1024 + h * 128, lds_g);
            }
        }
        (void)x; (void)i;
        __syncthreads();
    }
    SEAM(5);
    if (IN(6)) {
        bf16_t* T1 = (bf16_t*)(ws + WS_T1);
        { pg8::Gemm g{OAB, WabT, M, 2048, 1024, 2048, 0}; pg8::StaticOrder S; S.init(M, 2048, G, bx); pg8::EpiGate<false> E{SG, T1, MERGED};
          pg8::gemm_phase<pg8::EpiGate<false>, pg8::StaticOrder, true, true, false>(lds, g, S, E); }
        { pg8::Gemm g{OAB + 1024, WabT + 1024, M, 2048, 1024, 2048, 0}; pg8::StaticOrder S; S.init(M, 2048, G, bx); pg8::EpiGate<true> E{SG, T1, MERGED};
          pg8::gemm_phase<pg8::EpiGate<true>, pg8::StaticOrder, true, true, false>(lds, g, S, E); }
    }
    SEAM(6);
    if (IN(7)) {
        pg8::Gemm g{MERGED, WoT, M, 2048, 2048, 2048, 0}; pg8::StaticOrder S; S.init(M, 2048, G, bx); pg8::EpiResid<false> E{a.x, nullptr, U, SSQ1};
        pg8::gemm_phase<pg8::EpiResid<false>, pg8::StaticOrder, true, true, false>(lds, g, S, E);
    }
    SEAM(7);
    if (IN(9)) {
        pg8::Gemm g{U, WguT, M, 2 * DFF, DM, DM, 0}; pg8::StaticOrder S; S.init(M, 2 * DFF, G, bx); pg8::EpiSwiglu E{ACT, SSQ1};
        pg8::gemm_phase<pg8::EpiSwiglu, pg8::StaticOrder, true, true, false>(lds, g, S, E);
        {
            constexpr int NU = (M / 256) * (2 * DFF / 256);
            const int nr = (NU + G - 1) / G, nbusy = NU - (nr - 1) * G; int idx = bx - nbusy, cnt = G - nbusy; if (cnt < 32) { idx = bx; cnt = G; }
            if (idx >= 0) { pg8::Gemm g2{PB, WppT, M, 2048, PLE, PLE, 0}; pg8::StaticOrder S2; S2.init(M, 2048, cnt, idx); pg8::EpiBf16<0> E2{ERAW, 2048, nullptr, 0.f};
                pg8::gemm_phase<pg8::EpiBf16<0>, pg8::StaticOrder, false, true, false>(lds, g2, S2, E2); }
        }
    }
    SEAM(9);
    if (IN(10)) {
        pg8::Gemm g{ACT, WdT, M, 2048, DFF, DFF, 0}; pg8::StaticOrder S; S.init(M, 2048, G, bx); pg8::EpiResid<true> E{nullptr, U, U, SSQ2};
        pg8::gemm_phase<pg8::EpiResid<true>, pg8::StaticOrder, true, true, false>(lds, g, S, E);
    }
    SEAM(10);
    if (IN(12)) {
        { pg8::Gemm g{U, WpgT, M, 2048, DM, DM, 0}; pg8::StaticOrder S; S.init(M, 2048, G, bx); pg8::EpiBf16<1> E{GATE, 2048, SSQ2, 1.f / DM};
          pg8::gemm_phase<pg8::EpiBf16<1>, pg8::StaticOrder, true, true, false>(lds, g, S, E); }
    }
    SEAM(12);
    if (IN(13)) {
        u32x2 nh[8], ne[8], ng[8];
        int m = gw;
        if (m < M) {
#pragma unroll
            for (int j = 0; j < 8; ++j) { const size_t o = (size_t)m * DM + 4 * lane + 256 * j; nh[j] = *(const u32x2*)(U + o); ne[j] = *(const u32x2*)(ERAW + o); ng[j] = *(const u32x2*)(GATE + o); }
        }
        for (; m < M; m += NGW) {
            f32x4 h[8], e[8]; u32x2 gtw[8]; float se = 0.f;
#pragma unroll
            for (int j = 0; j < 8; ++j) { h[j] = (f32x4){bf_lo(nh[j].x), bf_hi(nh[j].x), bf_lo(nh[j].y), bf_hi(nh[j].y)}; e[j] = (f32x4){bf_lo(ne[j].x), bf_hi(ne[j].x), bf_lo(ne[j].y), bf_hi(ne[j].y)}; gtw[j] = ng[j];
                se += (e[j].x * e[j].x + e[j].y * e[j].y) + (e[j].z * e[j].z + e[j].w * e[j].w); }
            const int m2 = m + NGW;
            if (m2 < M) {
#pragma unroll
                for (int j = 0; j < 8; ++j) { const size_t o = (size_t)m2 * DM + 4 * lane + 256 * j; nh[j] = *(const u32x2*)(U + o); ne[j] = *(const u32x2*)(ERAW + o); ng[j] = *(const u32x2*)(GATE + o); }
            }
            const float re = 1.0f / sqrtf(wave_sum(se) * (1.f / DM) + EPS);
            float sh = 0.f;
#pragma unroll
            for (int j = 0; j < 8; ++j) { const u32x2 gt = gtw[j];
                const f32x4 gp = *(const f32x4*)(a.g_ple_post + 4 * lane + 256 * j);
                h[j].x += bf_lo(gt.x) * (e[j].x * re * gp.x); h[j].y += bf_hi(gt.x) * (e[j].y * re * gp.y);
                h[j].z += bf_lo(gt.y) * (e[j].z * re * gp.z); h[j].w += bf_hi(gt.y) * (e[j].w * re * gp.w);
                sh += (h[j].x * h[j].x + h[j].y * h[j].y) + (h[j].z * h[j].z + h[j].w * h[j].w); }
            const float rh = 1.0f / sqrtf(wave_sum(sh) * (1.f / DM) + EPS);
#pragma unroll
            for (int j = 0; j < 8; ++j) { const f32x4 gf = *(const f32x4*)(a.g_final + 4 * lane + 256 * j);
                f32x4 o; o.x = h[j].x * rh * gf.x; o.y = h[j].y * rh * gf.y; o.z = h[j].z * rh * gf.z; o.w = h[j].w * rh * gf.w;
                *(f32x4*)(a.out + (size_t)m * DM + 4 * lane + 256 * j) = o;
            }
        }
    }
#undef IN
#undef SEAM
}

extern "C" void kernel_launch(void* const* d_in, const int* in_sizes, int n_in, void* d_out, int out_size, void* d_ws, size_t ws_size, hipStream_t stream) {
    static int grid = 0;
    if (grid == 0) {
        if (n_in != 21 || in_sizes[0] != M * DM || out_size != M * DM || ws_size < WS_END) {
            fprintf(stderr, "kernel_launch: unexpected shapes: n_in %d in0 %d out %d ws %zu (need %zu)\n", n_in, n_in > 0 ? in_sizes[0] : -1, out_size, ws_size, (size_t)WS_END); grid = -1; return; }
        int dev = 0, cus = 0, per_cu = 0;
        if (hipGetDevice(&dev) != hipSuccess || hipDeviceGetAttribute(&cus, hipDeviceAttributeMultiprocessorCount, dev) != hipSuccess) { grid = -1; return; }
        if (hipFuncSetAttribute((const void*)mk_fwd, hipFuncAttributeMaxDynamicSharedMemorySize, LDS_BYTES) != hipSuccess) { fprintf(stderr, "kernel_launch: hipFuncSetAttribute failed\n"); grid = -1; return; }
        if (hipOccupancyMaxActiveBlocksPerMultiprocessor(&per_cu, (const void*)mk_fwd, NTHREADS, LDS_BYTES) != hipSuccess || per_cu < 1) { fprintf(stderr, "kernel_launch: occupancy query says %d\n", per_cu); per_cu = 1; }
        (void)hipGetLastError();
        grid = cus * 1;
    }
    if (grid < 0) return;
    Args a{};
    const float** f = (const float**)&a;
    for (int i = 0; i < 21; ++i) f[i] = (const float*)d_in[i];
    a.out = (float*)d_out; a.ws = (unsigned char*)d_ws;
#if MK_ONE_LAUNCH
    if (hipMemsetAsync(d_ws, 0, 262144 + 256, stream) != hipSuccess) { fprintf(stderr, "kernel_launch: memset failed\n"); return; }
    a.ph_lo = 0; a.ph_hi = NPHASE;
    void* args[] = {&a};
    hipError_t e = hipLaunchCooperativeKernel((const void*)mk_fwd, dim3(grid), dim3(NTHREADS), args, LDS_BYTES, stream);
    if (e != hipSuccess) fprintf(stderr, "kernel_launch: cooperative launch failed: %s (grid %d)\n", hipGetErrorString(e), grid);
#else
    for (int ph = 0; ph < NPHASE; ++ph) {
        a.ph_lo = ph; a.ph_hi = ph + 1;
        hipLaunchKernelGGL(mk_fwd, dim3(grid), dim3(NTHREADS), LDS_BYTES, stream, a);
    }
#endif
}
```

```cpp
#include <hip/hip_runtime.h>
#include <hip/hip_cooperative_groups.h>
#include <cstdio>
#include <cstdint>
namespace cg = cooperative_groups;

#ifndef ATT_SD_A
#define ATT_SD_A 2
#endif
#ifndef ATT_SD_B
#define ATT_SD_B 1
#endif
#ifndef MK_ONE_LAUNCH
#define MK_ONE_LAUNCH 1
#endif

#define LAS __attribute__((address_space(3)))
typedef unsigned short bf16_t;
typedef short bf16x8 __attribute__((ext_vector_type(8)));
typedef short s16x4 __attribute__((ext_vector_type(4)));
typedef float f32x4 __attribute__((ext_vector_type(4)));
typedef float f32x16 __attribute__((ext_vector_type(16)));
typedef unsigned u32x4 __attribute__((ext_vector_type(4)));
typedef unsigned u32x2 __attribute__((ext_vector_type(2)));
typedef int v4i_t __attribute__((ext_vector_type(4)));
constexpr float Q8_SU = 20.f, Q8_SW = 900.f;

constexpr int DM = 2048, SEQ = 4096, M = 8192, DFF = 5632, PLE = 256, NIN = 6720, NINP = 6912;
constexpr float EPS = 1e-6f;
constexpr int NWAVES = 8, NTHREADS = 512;
constexpr int LDS_BYTES = 139264;

constexpr size_t MiB = 1u << 20;
constexpr size_t WS_WIN = 1 * MiB, WS_WQB = 28 * MiB, WS_WKVB = 30 * MiB, WS_WAB = 32 * MiB, WS_WO = 40 * MiB, WS_WGU = 48 * MiB, WS_WD = 92 * MiB,
                 WS_WPG = 114 * MiB, WS_WPP = 122 * MiB, WS_PB = 123 * MiB, WS_KR = 127 * MiB, WS_U = 128 * MiB, WS_ZS = 160 * MiB, WS_SG = 200 * MiB,
                 WS_QA = 264 * MiB, WS_QB = 280 * MiB, WS_KVB = 304 * MiB, WS_END = 344 * MiB;
constexpr size_t WS_CQN = 1 * MiB, WS_CKVN = 9 * MiB, WS_KA = 17 * MiB, WS_KPE = 21 * MiB;
constexpr size_t WS_T1 = 264 * MiB;
constexpr size_t WS_OAB = WS_U, WS_MERGED = WS_ZS, WS_ACT = 160 * MiB, WS_GATE = 160 * MiB, WS_ERAW = 280 * MiB;

typedef float f32x2_t __attribute__((ext_vector_type(2)));
typedef __bf16 bf16x2_t __attribute__((ext_vector_type(2)));
__device__ __forceinline__ unsigned cvt_pk_bf16(float lo, float hi) { f32x2_t v = {lo, hi}; bf16x2_t b = __builtin_convertvector(v, bf16x2_t); return __builtin_bit_cast(unsigned, b); }
__device__ __forceinline__ float bf_lo(unsigned w) { return __uint_as_float(w << 16); }
__device__ __forceinline__ float bf_hi(unsigned w) { return __uint_as_float(w & 0xffff0000u); }
__device__ __forceinline__ float bf1(bf16_t h) { return __uint_as_float(((unsigned)h) << 16); }
__device__ __forceinline__ bf16_t f2bf(float f) { unsigned u = __float_as_uint(f); return (bf16_t)((u + 0x7fffu + ((u >> 16) & 1u)) >> 16); }
__device__ __forceinline__ float sigmoidf_(float x) { return __builtin_amdgcn_rcpf(1.f + __expf(-x)); }
__device__ __forceinline__ float wave_sum(float v) {
#pragma unroll
    for (int o = 1; o < 64; o <<= 1) v += __shfl_xor(v, o);
    return v;
}

__device__ __forceinline__ unsigned q8(float v) { int q = (int)__builtin_rintf(v); q = q < -127 ? -127 : (q > 127 ? 127 : q); return (unsigned)q & 0xffu; }
__device__ __forceinline__ unsigned q8x4(float a, float b, float c, float d) { return q8(a) | (q8(b) << 8) | (q8(c) << 16) | (q8(d) << 24); }
constexpr float QKSB = 20.f;

namespace pg8 {
constexpr int BM = 256, BK = 64, HALF = 128, HTB = HALF * BK * 2, STAGE_BYTES = 8 * HTB, NXCD = 8, WGM = 8;
__host__ __device__ __forceinline__ int lds_byte(int r, int c) { const int st = (r >> 4) * 2 + (c >> 5), rr = r & 15, cc = c & 31, ob = rr * 64 + cc * 2; return st * 1024 + (ob ^ (((ob >> 9) & 1) << 5)); }
__host__ __device__ __forceinline__ void stage_rc(int b, int& R, int& C) { const int st = b / 1024, sb = b % 1024, swz = sb ^ (((sb >> 9) & 1) << 5); R = (st >> 1) * 16 + swz / 64; C = (st & 1) * 32 + (swz % 64) / 2; }
__host__ __device__ __forceinline__ int perm32(int rho) { const int n = rho >> 4, i = rho & 15; return 8 * (i >> 2) + 4 * n + (i & 3); }
struct Unit { int pm, pn, kh; };
struct Gemm { const bf16_t* A; const bf16_t* Bt; int M, N, K, ld, koff, lda; };
struct StaticOrder {
    int nM, nN, nwg, G, c;
    __host__ __device__ void init(int M_, int N_, int G_, int c_) { nM = M_ / BM; nN = N_ / BM; nwg = nM * nN; G = G_; c = c_; }
    __host__ __device__ bool next(int i, Unit& u) const {
        const long L = (long)i * G + c; if (L >= nwg) return false;
        int wgid = (int)L; { const int q = nwg / NXCD, r = nwg % NXCD, xcd = wgid % NXCD, off = wgid / NXCD; wgid = (xcd < r ? xcd * (q + 1) : r * (q + 1) + (xcd - r) * q) + off; }
        const int nig = WGM * nN, gid = wgid / nig, fm = gid * WGM, gsz = (nM - fm) < WGM ? (nM - fm) : WGM;
        u.pm = fm + ((wgid % nig) % gsz); u.pn = (wgid % nig) / gsz; u.kh = 0; return true;
    }
    __device__ __forceinline__ void a_ready(const Unit&) const {}
    __device__ __forceinline__ void done(const Unit&) const {}
};
struct DualOrder : StaticOrder {
    __host__ __device__ bool next(int i, Unit& u) const { if (!StaticOrder::next(i >> 1, u)) return false; u.kh = i & 1; return true; }
};
typedef f32x4 Acc[2][2][4][2];

__device__ __forceinline__ void store8(bf16_t* p, f32x4 v0, f32x4 v1) {
    u32x4 w; w.x = cvt_pk_bf16(v0[0], v0[1]); w.y = cvt_pk_bf16(v0[2], v0[3]); w.z = cvt_pk_bf16(v1[0], v1[1]); w.w = cvt_pk_bf16(v1[2], v1[3]);
    *(u32x4*)p = w;
}
struct EpiIn {
    static constexpr bool PERM = true, AFTER_DRAIN = false;
    bf16_t *ZS, *SG, *KR; float *SSQC, *SSQK;
    __device__ __forceinline__ void operator()(const Acc& acc, const Unit& u, int wr, int wc, int fr, int fq) const {
        const int pn = u.pn; bf16_t* base; int ldc, colt; bool sig = false;
        if (pn < 10) { base = ZS; ldc = 2560; colt = pn * 256; }
        else if (pn < 26) { base = SG; ldc = 4096; colt = (pn - 10) * 256; sig = true; }
        else { base = KR; ldc = 64; colt = 0; }
        const int row0 = u.pm * BM + wr * 64 + fr, col0 = colt + wc * 32 + 8 * fq;
#pragma unroll
        for (int ai = 0; ai < 2; ++ai)
#pragma unroll
            for (int m = 0; m < 4; ++m) { bf16_t* rowp = base + (size_t)(row0 + ai * HALF + m * 16) * ldc + col0; float ss = 0.f;
#pragma unroll
                for (int bj = 0; bj < 2; ++bj) {
                    if (pn == 26 && (bj == 1 || wc >= 2)) continue;
                    f32x4 v0 = __builtin_convertvector(__builtin_bit_cast(v4i_t, acc[ai][bj][m][0]), f32x4) * (1.f / (Q8_SU * Q8_SW));
                    f32x4 v1 = __builtin_convertvector(__builtin_bit_cast(v4i_t, acc[ai][bj][m][1]), f32x4) * (1.f / (Q8_SU * Q8_SW));
                    if (sig) {
#pragma unroll
                        for (int j = 0; j < 4; ++j) { v0[j] = sigmoidf_(v0[j]); v1[j] = sigmoidf_(v1[j]); } }
                    ss += (v0[0] * v0[0] + v0[1] * v0[1]) + (v0[2] * v0[2] + v0[3] * v0[3]) + (v1[0] * v1[0] + v1[1] * v1[1]) + (v1[2] * v1[2] + v1[3] * v1[3]);
                    store8(rowp + bj * HALF, v0, v1); }
                if (pn >= 6 && pn < 10) { ss += __shfl_xor(ss, 16); ss += __shfl_xor(ss, 32);
                    if (fq == 0) (void)__hip_atomic_fetch_add((__attribute__((address_space(1))) float*)((pn < 8 ? SSQC : SSQK) + row0 + ai * HALF + m * 16), ss, __ATOMIC_RELAXED, __HIP_MEMORY_SCOPE_AGENT); } }
    }
};
template <int ACT  > struct EpiBf16 {
    static constexpr bool PERM = true, AFTER_DRAIN = false;
    bf16_t* O; int ldc; const float* ssq; float inv_n;
    __device__ __forceinline__ void operator()(const Acc& acc, const Unit& u, int wr, int wc, int fr, int fq) const {
        const int row0 = u.pm * BM + wr * 64 + fr, col0 = u.pn * BM + wc * 32 + 8 * fq;
#pragma unroll
        for (int ai = 0; ai < 2; ++ai)
#pragma unroll
            for (int m = 0; m < 4; ++m) { bf16_t* rowp = O + (size_t)(row0 + ai * HALF + m * 16) * ldc + col0;
                const float r = ssq ? 1.0f / sqrtf(ssq[row0 + ai * HALF + m * 16] * inv_n + EPS) : 1.f;
#pragma unroll
                for (int bj = 0; bj < 2; ++bj) { f32x4 v0 = acc[ai][bj][m][0] * r, v1 = acc[ai][bj][m][1] * r;
                    if (ACT == 1) {
#pragma unroll
                        for (int j = 0; j < 4; ++j) { v0[j] = sigmoidf_(v0[j]); v1[j] = sigmoidf_(v1[j]); } }
                    store8(rowp + bj * HALF, v0, v1); } }
    }
};
struct EpiQB {
    static constexpr bool PERM = true, AFTER_DRAIN = false;
    bf16_t* O; const float* ssq;
    __device__ __forceinline__ void operator()(const Acc& acc, const Unit& u, int wr, int wc, int fr, int fq) const {
        const int row0 = u.pm * BM + wr * 64 + fr, col0 = u.pn * BM + wc * 32 + 8 * fq;
        float inv[8];
#pragma unroll
        for (int t = 0; t < 8; ++t) inv[t] = __builtin_amdgcn_exp2f(-(float)(2 * ((fq & 1) * 8 + t)) * (13.287712379549449f / 32.f));
        const float sgn = (fq >= 2) ? 1.f : -1.f;
#pragma unroll
        for (int ai = 0; ai < 2; ++ai)
#pragma unroll
            for (int m = 0; m < 4; ++m) { const int row = row0 + ai * HALF + m * 16, sq = row & (SEQ - 1); const float prow = (float)(sq >> 6), pcol = (float)(sq & 63);
                const float rq = 1.0f / sqrtf(ssq[row] * (1.f / 512.f) + EPS);
#pragma unroll
                for (int bj = 0; bj < 2; ++bj) { f32x4 v0 = acc[ai][bj][m][0] * rq, v1 = acc[ai][bj][m][1] * rq;
                    const int rel = (u.pn * BM + bj * HALF + wc * 32) % 192;
                    if (rel >= 128) { const float pos = (rel >= 160) ? pcol : prow;
#pragma unroll
                        for (int t = 0; t < 4; ++t) {
                            const float a0 = pos * inv[t], a1 = pos * inv[4 + t];
                            const float p0 = __shfl_xor(v0[t], 32), p1 = __shfl_xor(v1[t], 32);
                            v0[t] = v0[t] * __cosf(a0) + sgn * p0 * __sinf(a0); v1[t] = v1[t] * __cosf(a1) + sgn * p1 * __sinf(a1); } }
                    u32x2 w; w.x = q8x4(v0[0] * QKSB, v0[1] * QKSB, v0[2] * QKSB, v0[3] * QKSB); w.y = q8x4(v1[0] * QKSB, v1[1] * QKSB, v1[2] * QKSB, v1[3] * QKSB);
                    *(u32x2*)((unsigned char*)O + (size_t)row * 1536 + col0 + bj * HALF) = w; } }
    }
};
struct EpiKV {
    static constexpr bool PERM = true, AFTER_DRAIN = false;
    unsigned char* KN8; bf16_t* VB; const float* ssq;
    __device__ __forceinline__ void operator()(const Acc& acc, const Unit& u, int wr, int wc, int fr, int fq) const {
        const int row0 = u.pm * BM + wr * 64 + fr, colh = u.pn * HALF + wc * 32 + 8 * fq;
#pragma unroll
        for (int ai = 0; ai < 2; ++ai)
#pragma unroll
            for (int m = 0; m < 4; ++m) { const int row = row0 + ai * HALF + m * 16; const float r = 1.0f / sqrtf(ssq[row] * (1.f / 512.f) + EPS);
                const f32x4 k0 = acc[ai][0][m][0] * (r * QKSB), k1 = acc[ai][0][m][1] * (r * QKSB);
                u32x2 w; w.x = q8x4(k0[0], k0[1], k0[2], k0[3]); w.y = q8x4(k1[0], k1[1], k1[2], k1[3]);
                *(u32x2*)(KN8 + (size_t)row * 1024 + colh) = w;
                store8(VB + (size_t)row * 1024 + colh, acc[ai][1][m][0] * r, acc[ai][1][m][1] * r); }
    }
};
template <bool SECOND> struct EpiGate {
    static constexpr bool PERM = true, AFTER_DRAIN = false;
    const bf16_t* SG; bf16_t* T1; bf16_t* O;
    __device__ __forceinline__ void operator()(const Acc& acc, const Unit& u, int wr, int wc, int fr, int fq) const {
        const int row0 = u.pm * BM + wr * 64 + fr, col0 = u.pn * BM + wc * 32 + 8 * fq;
#pragma unroll
        for (int ai = 0; ai < 2; ++ai)
#pragma unroll
            for (int m = 0; m < 4; ++m) { const size_t ro = (size_t)(row0 + ai * HALF + m * 16);
#pragma unroll
                for (int bj = 0; bj < 2; ++bj) {
                    const u32x4 b = *(const u32x4*)(SG + ro * 4096 + (SECOND ? 2048 : 0) + col0 + bj * HALF);
                    f32x4 s0, s1;
                    s0[0] = bf_lo(b.x); s0[1] = bf_hi(b.x); s0[2] = bf_lo(b.y); s0[3] = bf_hi(b.y);
                    s1[0] = bf_lo(b.z); s1[1] = bf_hi(b.z); s1[2] = bf_lo(b.w); s1[3] = bf_hi(b.w);
                    bf16_t* tp = T1 + ro * 2048 + col0 + bj * HALF;
                    if constexpr (!SECOND) { store8(tp, acc[ai][bj][m][0] * s0, acc[ai][bj][m][1] * s1); }
                    else { const u32x4 tw = *(const u32x4*)tp; f32x4 t0, t1;
                        t0[0] = bf_lo(tw.x); t0[1] = bf_hi(tw.x); t0[2] = bf_lo(tw.y); t0[3] = bf_hi(tw.y); t1[0] = bf_lo(tw.z); t1[1] = bf_hi(tw.z); t1[2] = bf_lo(tw.w); t1[3] = bf_hi(tw.w);
                        store8(O + ro * 2048 + col0 + bj * HALF, t0 + acc[ai][bj][m][0] * s0, t1 + acc[ai][bj][m][1] * s1); } } }
    }
};
template <bool BASEBF> struct EpiResid {
    static constexpr bool PERM = false, AFTER_DRAIN = false;
    const float* basef; const bf16_t* baseb; bf16_t* HB; float* ssq;
    __device__ __forceinline__ void operator()(const Acc& acc, const Unit& u, int wr, int wc, int fr, int fq) const {
        const int row0 = u.pm * BM + wr * 64 + fr, col0 = u.pn * BM + wc * 32 + 4 * fq;
#pragma unroll
        for (int ai = 0; ai < 2; ++ai)
#pragma unroll
            for (int m = 0; m < 4; ++m) { const int row = row0 + ai * HALF + m * 16; const size_t ro = (size_t)row * DM + col0; float ss = 0.f;
#pragma unroll
                for (int bj = 0; bj < 2; ++bj)
#pragma unroll
                    for (int n = 0; n < 2; ++n) { const size_t o = ro + bj * HALF + n * 16;
                        f32x4 v = acc[ai][bj][m][n];
                        if constexpr (BASEBF) { const u32x2 bw = *(const u32x2*)(baseb + o); v = v + (f32x4){bf_lo(bw.x), bf_hi(bw.x), bf_lo(bw.y), bf_hi(bw.y)}; }
                        else v = v + *(const f32x4*)(basef + o);
                        u32x2 w; w.x = cvt_pk_bf16(v.x, v.y); w.y = cvt_pk_bf16(v.z, v.w);
                        *(u32x2*)(HB + o) = w; ss += (v.x * v.x + v.y * v.y) + (v.z * v.z + v.w * v.w); }
                ss += __shfl_xor(ss, 16); ss += __shfl_xor(ss, 32);
                if (fq == 0) (void)__hip_atomic_fetch_add((__attribute__((address_space(1))) float*)(ssq + row), ss, __ATOMIC_RELAXED, __HIP_MEMORY_SCOPE_AGENT); }
    }
};
struct EpiSwiglu {
    static constexpr bool PERM = true, AFTER_DRAIN = false;
    bf16_t* O; const float* ssq;
    __device__ __forceinline__ void operator()(const Acc& acc, const Unit& u, int wr, int wc, int fr, int fq) const {
        const int row0 = u.pm * BM + wr * 64 + fr, col0 = u.pn * HALF + wc * 32 + 8 * fq;
#pragma unroll
        for (int ai = 0; ai < 2; ++ai)
#pragma unroll
            for (int m = 0; m < 4; ++m) {
                f32x4 a0, a1; const float r = 1.0f / sqrtf(ssq[row0 + ai * HALF + m * 16] * (1.f / DM) + EPS);
#pragma unroll
                for (int j = 0; j < 4; ++j) { const float g0 = acc[ai][0][m][0][j] * r, g1 = acc[ai][0][m][1][j] * r;
                    a0[j] = g0 * sigmoidf_(g0) * (acc[ai][1][m][0][j] * r); a1[j] = g1 * sigmoidf_(g1) * (acc[ai][1][m][1][j] * r); }
                store8(O + (size_t)(row0 + ai * HALF + m * 16) * DFF + col0, a0, a1); }
    }
};

template <class Epi, class Sched, bool ALIGN_EPI, bool SP2, bool MID, bool I8 = false>
__device__ __forceinline__ void gemm_phase(LAS unsigned char* lds, const Gemm g, const Sched S, const Epi E) {
    const int tid = threadIdx.x, wid = __builtin_amdgcn_readfirstlane(tid >> 6), lane = tid & 63, wr = wid >> 2, wc = wid & 3, fr = lane & 15, fq = lane >> 4;
    const int K = g.ld, nt = g.K / BK;
    unsigned voffA[2], voffB[2];
#pragma unroll
    for (int i = 0; i < 2; ++i) { int R, C; stage_rc(tid * 16 + i * 8192, R, C); const int Rb = Epi::PERM ? ((R & ~31) + perm32(R & 31)) : R;
        voffA[i] = (unsigned)(R * (g.lda ? g.lda : K) + C) * 2u; voffB[i] = (unsigned)(Rb * K + C) * 2u; }
    const size_t kstep = (size_t)(BK * 2);
    const int KA = g.lda ? g.lda : K;
    const size_t hstep = (size_t)HALF * K * 2, hstepA = (size_t)HALF * KA * 2;
    const size_t tstep = 2 * hstep, tstepA = 2 * hstepA;
    const unsigned ldsw = (unsigned)wid * 1024u;
    const int aoff = lds_byte(wr * 64 + fr, fq * 8), boff = lds_byte(wc * 32 + fr, fq * 8);
#define PG8_SA(b, h) (((b) * 2 + (h)) * HTB)
#define PG8_SB(b, h) ((4 + (b) * 2 + (h)) * HTB)
#define PG8_STAGE(bufoff, gbase, voff) do { _Pragma("unroll") for (int _i = 0; _i < 2; ++_i) \
        __builtin_amdgcn_global_load_lds((const unsigned*)((const char*)(gbase) + (voff)[_i]), (LAS unsigned*)(lds + (bufoff) + ldsw + _i * 8192), 16, 0, 0); } while (0)
#define PG8_LDA(dst, b, h) do { _Pragma("unroll") for (int m = 0; m < 4; ++m) _Pragma("unroll") for (int k = 0; k < 2; ++k) dst[m][k] = *(const LAS bf16x8*)(lds + PG8_SA(b, h) + aoff + m * 2048 + k * 1024); } while (0)
#define PG8_LDB(dst, b, h) do { _Pragma("unroll") for (int n = 0; n < 2; ++n) _Pragma("unroll") for (int k = 0; k < 2; ++k) dst[n][k] = *(const LAS bf16x8*)(lds + PG8_SB(b, h) + boff + n * 2048 + k * 1024); } while (0)
#define PG8_MMA(ai, bj, At, Bt) do { __builtin_amdgcn_s_setprio(1); _Pragma("unroll") for (int m = 0; m < 4; ++m) _Pragma("unroll") for (int n = 0; n < 2; ++n) _Pragma("unroll") for (int k = 0; k < 2; ++k) { \
        if constexpr (I8) acc[ai][bj][m][n] = __builtin_bit_cast(f32x4, __builtin_amdgcn_mfma_i32_16x16x64_i8(__builtin_bit_cast(v4i_t, Bt[n][k]), __builtin_bit_cast(v4i_t, At[m][k]), __builtin_bit_cast(v4i_t, acc[ai][bj][m][n]), 0, 0, 0)); \
        else acc[ai][bj][m][n] = __builtin_amdgcn_mfma_f32_16x16x32_bf16(Bt[n][k], At[m][k], acc[ai][bj][m][n], 0, 0, 0); } __builtin_amdgcn_s_setprio(0); } while (0)
#define PG8_WAIT_V(n) asm volatile("s_waitcnt vmcnt(" #n ")" ::: "memory")
#define PG8_WAIT_L(n) asm volatile("s_waitcnt lgkmcnt(" #n ")" ::: "memory")
#define PG8_BAR __builtin_amdgcn_s_barrier()
#define PG8_SCHED __builtin_amdgcn_sched_barrier(0)
    Unit cur, nxt; int ui = 0;
    if (!S.next(0, cur)) return;
    Acc acc;
#pragma unroll
    for (int a = 0; a < 2; ++a)
#pragma unroll
        for (int b = 0; b < 2; ++b)
#pragma unroll
            for (int m = 0; m < 4; ++m)
#pragma unroll
                for (int n = 0; n < 2; ++n) acc[a][b][m][n] = (f32x4){0.f, 0.f, 0.f, 0.f};
    bf16x8 At[4][2], B0[2][2], B1[2][2];
    const char* cA = (const char*)g.A + (size_t)cur.pm * tstepA + (size_t)cur.kh * g.koff; const char* cB = (const char*)g.Bt + (size_t)cur.pn * tstep + (size_t)cur.kh * g.koff;
    S.a_ready(cur);
    if constexpr (SP2) {
        PG8_STAGE(PG8_SB(0, 0), cB, voffB); PG8_STAGE(PG8_SB(0, 1), cB + hstep, voffB); PG8_STAGE(PG8_SA(0, 0), cA, voffA); PG8_STAGE(PG8_SA(0, 1), cA + hstepA, voffA);
        if (wr == 1) PG8_BAR;
        PG8_WAIT_V(2); PG8_BAR;
        PG8_STAGE(PG8_SB(1, 0), cB + kstep, voffB); PG8_STAGE(PG8_SA(1, 0), cA + kstep, voffA); PG8_STAGE(PG8_SB(1, 1), cB + hstep + kstep, voffB);
        PG8_WAIT_V(6); PG8_BAR;
    } else {
        PG8_STAGE(PG8_SB(0, 0), cB, voffB); PG8_STAGE(PG8_SA(0, 0), cA, voffA); PG8_STAGE(PG8_SB(0, 1), cB + hstep, voffB); PG8_STAGE(PG8_SA(0, 1), cA + hstepA, voffA);
        if (wr == 1) PG8_BAR;
        PG8_WAIT_V(4); PG8_BAR;
        PG8_STAGE(PG8_SB(1, 0), cB + kstep, voffB); PG8_STAGE(PG8_SA(1, 0), cA + kstep, voffA); PG8_STAGE(PG8_SB(1, 1), cB + hstep + kstep, voffB);
        PG8_WAIT_V(6); PG8_BAR;
    }
    for (;;) {
        const bool has_next = S.next(ui + 1, nxt);
        const char* nA = has_next ? (const char*)g.A + (size_t)nxt.pm * tstepA + (size_t)nxt.kh * g.koff : cA; const char* nB = has_next ? (const char*)g.Bt + (size_t)nxt.pn * tstep + (size_t)nxt.kh * g.koff : cB;
        for (int t = 0; t < nt; t += 2) {
            const bool last = (t == nt - 2);
            const char* a1 = cA + (size_t)(t + 1) * kstep;
            const char* a2 = last ? nA : cA + (size_t)(t + 2) * kstep; const char* b2 = last ? nB : cB + (size_t)(t + 2) * kstep;
            const char* a3 = a2 + kstep; const char* b3 = b2 + kstep;
            if (last && has_next) S.a_ready(nxt);
            if constexpr (SP2) {
            PG8_LDB(B0, 0, 0); PG8_LDB(B1, 0, 1); PG8_SCHED; PG8_LDA(At, 0, 0); PG8_STAGE(PG8_SA(1, 1), a1 + hstepA, voffA);
            PG8_WAIT_V(8); PG8_WAIT_L(0); PG8_BAR; PG8_MMA(0, 0, At, B0); PG8_MMA(0, 1, At, B1); PG8_BAR; PG8_SCHED;
            PG8_LDA(At, 0, 1); PG8_STAGE(PG8_SB(0, 0), b2, voffB); PG8_STAGE(PG8_SB(0, 1), b2 + hstep, voffB); PG8_STAGE(PG8_SA(0, 0), a2, voffA);
            PG8_WAIT_V(8); PG8_WAIT_L(0); PG8_BAR; PG8_MMA(1, 0, At, B0); PG8_MMA(1, 1, At, B1); PG8_BAR; PG8_SCHED;
            PG8_LDB(B0, 1, 0); PG8_LDB(B1, 1, 1); PG8_SCHED; PG8_LDA(At, 1, 0); PG8_STAGE(PG8_SA(0, 1), a2 + hstepA, voffA);
            PG8_WAIT_V(8); PG8_WAIT_L(0); PG8_BAR; PG8_MMA(0, 0, At, B0); PG8_MMA(0, 1, At, B1); PG8_BAR; PG8_SCHED;
            PG8_LDA(At, 1, 1); PG8_STAGE(PG8_SB(1, 0), b3, voffB); PG8_STAGE(PG8_SB(1, 1), b3 + hstep, voffB); PG8_STAGE(PG8_SA(1, 0), a3, voffA);
            PG8_WAIT_V(8); PG8_WAIT_L(0); PG8_BAR; PG8_MMA(1, 0, At, B0); PG8_MMA(1, 1, At, B1); PG8_BAR; PG8_SCHED;
            } else {
            PG8_LDB(B0, 0, 0); PG8_SCHED; PG8_LDA(At, 0, 0); PG8_STAGE(PG8_SA(1, 1), a1 + hstepA, voffA);
            PG8_WAIT_L(8); PG8_BAR; PG8_WAIT_L(0); PG8_MMA(0, 0, At, B0); PG8_BAR; PG8_SCHED;
            PG8_LDB(B1, 0, 1); PG8_STAGE(PG8_SB(0, 0), b2, voffB);
            PG8_BAR; PG8_WAIT_L(0); PG8_MMA(0, 1, At, B1); PG8_BAR;
            PG8_LDA(At, 0, 1); PG8_STAGE(PG8_SA(0, 0), a2, voffA);
            PG8_BAR; PG8_WAIT_L(0); PG8_MMA(1, 0, At, B0); PG8_BAR; PG8_SCHED;
            PG8_STAGE(PG8_SB(0, 1), b2 + hstep, voffB);
            PG8_WAIT_V(6); PG8_BAR; PG8_MMA(1, 1, At, B1); PG8_BAR;
            PG8_LDB(B0, 1, 0); PG8_SCHED; PG8_LDA(At, 1, 0); PG8_STAGE(PG8_SA(0, 1), a2 + hstepA, voffA);
            PG8_WAIT_L(8); PG8_BAR; PG8_WAIT_L(0); PG8_MMA(0, 0, At, B0); PG8_BAR; PG8_SCHED;
            PG8_LDB(B1, 1, 1); PG8_STAGE(PG8_SB(1, 0), b3, voffB);
            PG8_BAR; PG8_WAIT_L(0); PG8_MMA(0, 1, At, B1); PG8_BAR;
            PG8_LDA(At, 1, 1); PG8_STAGE(PG8_SA(1, 0), a3, voffA);
            PG8_BAR; PG8_WAIT_L(0); PG8_MMA(1, 0, At, B0); PG8_BAR; PG8_SCHED;
            PG8_STAGE(PG8_SB(1, 1), b3 + hstep, voffB);
            PG8_WAIT_V(6); PG8_BAR; PG8_MMA(1, 1, At, B1); PG8_BAR;
            }
        }
        if constexpr (ALIGN_EPI) { if (wr == 0) PG8_BAR; }
        { E(acc, cur, wr, wc, fr, fq); S.done(cur);
#pragma unroll
        for (int a = 0; a < 2; ++a)
#pragma unroll
            for (int b = 0; b < 2; ++b)
#pragma unroll
                for (int m = 0; m < 4; ++m)
#pragma unroll
                    for (int n = 0; n < 2; ++n) acc[a][b][m][n] = (f32x4){0.f, 0.f, 0.f, 0.f};
        }
        if (!has_next) break;
        cur = nxt; cA = nA; cB = nB; ++ui;
        if constexpr (ALIGN_EPI) { if (wr == 1) PG8_BAR; }
    }
    PG8_WAIT_V(0);
    if constexpr (!ALIGN_EPI) { if (wr == 0) PG8_BAR; }
    PG8_BAR;
#undef PG8_SA
#undef PG8_SB
#undef PG8_STAGE
#undef PG8_LDA
#undef PG8_LDB
#undef PG8_MMA
#undef PG8_WAIT_V
#undef PG8_WAIT_L
#undef PG8_BAR
#undef PG8_SCHED
}
}

namespace att {
constexpr int NW = 8, QBLK = 32, KVBLK = 64;
constexpr int SHM_V = KVBLK * 128 * 2, SHM_K = KVBLK * 128 * 2, SHM_KR = KVBLK * 64 * 2;
constexpr int OFF_V = 0, OFF_K = 2 * SHM_V, OFF_WS = OFF_K + 2 * SHM_K, OFF_KR = OFF_WS + NW * 64 * 4, OFF_QR = OFF_KR + 2 * SHM_KR, QR_WAVE = 6144, ATT_LDS = OFF_QR + NW * QR_WAVE;
constexpr float THR = 8.f;
#define KSWZ(row, colB) ((row) * 256 + ((colB) ^ (((row) & 7) << 4)))
#define KRSWZ(row, colB) ((row) * 128 + ((colB) ^ ((((row) >> 1) & 7) << 4)))
#define SBAR() __builtin_amdgcn_sched_barrier(0)
__device__ __forceinline__ int crow(int r, int hi) { return (r & 3) + 8 * (r >> 2) + 4 * hi; }

__device__ __forceinline__ void partialSM(f32x16& p0, f32x16& p1, float& m_reg, float& mn, float& alpha, const float C, const float THRS) {
  float pmax = p0[0];
#pragma unroll
  for (int r = 1; r < 16; ++r) pmax = fmaxf(pmax, p0[r]);
#pragma unroll
  for (int r = 0; r < 16; ++r) pmax = fmaxf(pmax, p1[r]);
  { auto rr = __builtin_amdgcn_permlane32_swap(__float_as_uint(pmax), __float_as_uint(pmax), false, false);
    pmax = fmaxf(__uint_as_float(rr[0]), __uint_as_float(rr[1])); }
  if (__builtin_expect(__all(pmax - m_reg <= THRS), 1)) { mn = m_reg; alpha = 1.f; }
  else { mn = fmaxf(m_reg, pmax); alpha = __builtin_amdgcn_exp2f((m_reg - mn) * C); m_reg = mn; }
  float mnC = -mn * C;
#pragma unroll
  for (int r = 0; r < 16; ++r) p0[r] = fmaf(p0[r], C, mnC);
#pragma unroll
  for (int r = 0; r < 16; ++r) p1[r] = fmaf(p1[r], C, mnC);
#pragma unroll
  for (int r = 0; r < 16; ++r) p0[r] = __builtin_amdgcn_exp2f(p0[r]);
}
__device__ __forceinline__ void finishSM(f32x16& p0, f32x16& p1, float alpha, float& l_reg, bf16x8& pa0, bf16x8& pa1, bf16x8& pa2, bf16x8& pa3) {
#pragma unroll
  for (int r = 0; r < 16; ++r) p1[r] = __builtin_amdgcn_exp2f(p1[r]);
  float ps = 0;
#pragma unroll
  for (int r = 0; r < 16; ++r) ps += p0[r];
#pragma unroll
  for (int r = 0; r < 16; ++r) ps += p1[r];
  { auto rr = __builtin_amdgcn_permlane32_swap(__float_as_uint(ps), __float_as_uint(ps), false, false);
    ps = __uint_as_float(rr[0]) + __uint_as_float(rr[1]); }
  l_reg = l_reg * alpha + ps;
#define PK4(P, BASE, OUT) do { unsigned a0 = cvt_pk_bf16(P[BASE + 0], P[BASE + 1]), a1 = cvt_pk_bf16(P[BASE + 2], P[BASE + 3]);   \
    unsigned b0 = cvt_pk_bf16(P[BASE + 4], P[BASE + 5]), b1 = cvt_pk_bf16(P[BASE + 6], P[BASE + 7]);                              \
    auto r0 = __builtin_amdgcn_permlane32_swap(a0, b0, false, false); auto r1 = __builtin_amdgcn_permlane32_swap(a1, b1, false, false); \
    u32x4 w = {r0[0], r1[0], r0[1], r1[1]}; OUT = *reinterpret_cast<bf16x8*>(&w); } while (0)
  PK4(p0, 0, pa0); PK4(p0, 8, pa1); PK4(p1, 0, pa2); PK4(p1, 8, pa3);
#undef PK4
}
template <int DK, int NQR>
__device__ __forceinline__ void qkt(f32x16& p0, f32x16& p1, const char* Ks, const char* Krs, const bf16x8* qr, const char* qrl, int r32, int hi) {
  p0 = f32x16{}; p1 = f32x16{};
#pragma unroll
  for (int d0 = 0; d0 < 8; ++d0) { int cb = (d0 * 16 + hi * 8) * 2;
    bf16x8 b0 = *reinterpret_cast<const bf16x8*>(Ks + KSWZ(r32, cb));
    bf16x8 b1 = *reinterpret_cast<const bf16x8*>(Ks + KSWZ(32 + r32, cb));
    bf16x8 qv; if (d0 < NQR) qv = qr[d0 < NQR ? d0 : 0]; else qv = *reinterpret_cast<const bf16x8*>(qrl + (d0 - NQR) * 1024);
    p0 = __builtin_amdgcn_mfma_f32_32x32x16_bf16(b0, qv, p0, 0, 0, 0);
    p1 = __builtin_amdgcn_mfma_f32_32x32x16_bf16(b1, qv, p1, 0, 0, 0); }
  if constexpr (DK == 192) {
#pragma unroll
    for (int d0 = 0; d0 < 4; ++d0) { int cb = (d0 * 16 + hi * 8) * 2;
      bf16x8 b0 = *reinterpret_cast<const bf16x8*>(Krs + KRSWZ(r32, cb));
      bf16x8 b1 = *reinterpret_cast<const bf16x8*>(Krs + KRSWZ(32 + r32, cb));
      const bf16x8 qv = *reinterpret_cast<const bf16x8*>(qrl + (8 - NQR + d0) * 1024);
      p0 = __builtin_amdgcn_mfma_f32_32x32x16_bf16(b0, qv, p0, 0, 0, 0);
      p1 = __builtin_amdgcn_mfma_f32_32x32x16_bf16(b1, qv, p1, 0, 0, 0); }
  }
}
__device__ __forceinline__ int v_st(int k, int c) { const int kk = (k & ~0xC) | ((k & 4) << 1) | ((k & 8) >> 1); return ((kk >> 3) * 4 + (c >> 5)) * 512 + ((kk & 7) * 32 + (c & 31)) * 2; }
__device__ __forceinline__ int v_rd_base(int lane) { return ((lane & 3) << 3) | (((lane >> 2) & 3) << 6) | (((lane >> 4) & 1) << 5) | (((lane >> 5) & 1) << 8); }
constexpr int v_rd_off(int d0, int ks, int half) { return d0 * 512 + ks * 4096 + half * 2048; }
template <int OFF> __device__ __forceinline__ s16x4 tr_read(int vb) {
  s16x4 r; asm volatile("ds_read_b64_tr_b16 %0, %1 offset:%2" : "=&v"(r) : "v"(vb), "i"(OFF) : "memory"); return r;
}
template <int D0> __device__ __forceinline__ void pv_one(f32x16& od, int vb, bf16x8 pa0, bf16x8 pa1, bf16x8 pa2, bf16x8 pa3) {
  const s16x4 l0 = tr_read<v_rd_off(D0, 0, 0)>(vb), h0 = tr_read<v_rd_off(D0, 0, 1)>(vb), l1 = tr_read<v_rd_off(D0, 1, 0)>(vb), h1 = tr_read<v_rd_off(D0, 1, 1)>(vb);
  const s16x4 l2 = tr_read<v_rd_off(D0, 2, 0)>(vb), h2 = tr_read<v_rd_off(D0, 2, 1)>(vb), l3 = tr_read<v_rd_off(D0, 3, 0)>(vb), h3 = tr_read<v_rd_off(D0, 3, 1)>(vb);
  asm volatile("s_waitcnt lgkmcnt(0)" ::: "memory"); SBAR();
#define PK(L, H) (bf16x8){L[0], L[1], L[2], L[3], H[0], H[1], H[2], H[3]}
  od = __builtin_amdgcn_mfma_f32_32x32x16_bf16(pa0, PK(l0, h0), od, 0, 0, 0);
  od = __builtin_amdgcn_mfma_f32_32x32x16_bf16(pa1, PK(l1, h1), od, 0, 0, 0);
  od = __builtin_amdgcn_mfma_f32_32x32x16_bf16(pa2, PK(l2, h2), od, 0, 0, 0);
  od = __builtin_amdgcn_mfma_f32_32x32x16_bf16(pa3, PK(l3, h3), od, 0, 0, 0);
#undef PK
}
__device__ __forceinline__ void pv_d0(f32x16* o, int vb, bf16x8 pa0, bf16x8 pa1, bf16x8 pa2, bf16x8 pa3) {
  pv_one<0>(o[0], vb, pa0, pa1, pa2, pa3); pv_one<1>(o[1], vb, pa0, pa1, pa2, pa3); pv_one<2>(o[2], vb, pa0, pa1, pa2, pa3); pv_one<3>(o[3], vb, pa0, pa1, pa2, pa3);
}

#define K8SWZ(row, chunk) ((row) * 128 + ((((chunk) ^ (((row) >> 1) & 7))) << 4))
#define KR8SWZ(row, chunk) ((row) * 64 + ((((chunk) ^ (((row) >> 2) & 3))) << 4))
constexpr float ATT_SQK = 20.f;
typedef int v16i_t __attribute__((ext_vector_type(16)));
template <int DK>
__device__ __forceinline__ void qkt8(f32x16& p0, f32x16& p1, const char* Ks, const char* Krs, const v4i_t* qi, int r32, int hi) {
  p0 = f32x16{}; p1 = f32x16{};
#pragma unroll
  for (int d = 0; d < 4; ++d) {
    const v4i_t b0 = *reinterpret_cast<const v4i_t*>(Ks + K8SWZ(r32, 2 * d + hi));
    const v4i_t b1 = *reinterpret_cast<const v4i_t*>(Ks + K8SWZ(32 + r32, 2 * d + hi));
    p0 = __builtin_bit_cast(f32x16, __builtin_amdgcn_mfma_i32_32x32x32_i8(b0, qi[d], __builtin_bit_cast(v16i_t, p0), 0, 0, 0));
    p1 = __builtin_bit_cast(f32x16, __builtin_amdgcn_mfma_i32_32x32x32_i8(b1, qi[d], __builtin_bit_cast(v16i_t, p1), 0, 0, 0)); }
  if constexpr (DK == 192) {
#pragma unroll
    for (int d = 0; d < 2; ++d) {
      const v4i_t b0 = *reinterpret_cast<const v4i_t*>(Krs + KR8SWZ(r32, 2 * d + hi));
      const v4i_t b1 = *reinterpret_cast<const v4i_t*>(Krs + KR8SWZ(32 + r32, 2 * d + hi));
      p0 = __builtin_bit_cast(f32x16, __builtin_amdgcn_mfma_i32_32x32x32_i8(b0, qi[4 + d], __builtin_bit_cast(v16i_t, p0), 0, 0, 0));
      p1 = __builtin_bit_cast(f32x16, __builtin_amdgcn_mfma_i32_32x32x32_i8(b1, qi[4 + d], __builtin_bit_cast(v16i_t, p1), 0, 0, 0)); }
  }
#pragma unroll
  for (int r = 0; r < 16; ++r) { p0[r] = (float)__float_as_int(p0[r]); p1[r] = (float)__float_as_int(p1[r]); }
}
template <int DK, int SDEPTH, int ldq, int ldk, int ldv, int ldo, int seq, bool QK8 = false>
__device__ __forceinline__ void attn_unit(const bf16_t* __restrict__ Qb, const bf16_t* __restrict__ Kh, const bf16_t* __restrict__ Krp,
                                          const bf16_t* __restrict__ Vh, bf16_t* __restrict__ Ob, char* lds) {
  constexpr float SCALE = (DK == 128) ? 0.088388347648318440f : 0.072168783648703220f;
  constexpr float QKS = QK8 ? (ATT_SQK * ATT_SQK) : 1.f;
  constexpr float C = SCALE * 1.4426950408889634f / QKS, THRS = THR / SCALE * QKS;
  constexpr int ND = QK8 ? 0 : DK / 16, NQR = QK8 ? 0 : ((DK == 128) ? 8 : 6);
  const int tid = threadIdx.x, wid = tid >> 6, lane = tid & 63, r32 = lane & 31, hi = lane >> 5;
  char* V_lds = lds + OFF_V; char* K_lds = lds + OFF_K; char* KR_lds = lds + OFF_KR;
  float* ws = (float*)(lds + OFF_WS) + wid * 64; float* li_l = ws; float* al_l = ws + 32;
  float m_reg = -1e30f, l_reg = 0; f32x16 o[4] = {}; bf16x8 qr[NQR ? NQR : 1]; v4i_t qi[DK / 32];
  if constexpr (QK8) { const unsigned char* Qw8 = (const unsigned char*)Qb + (long)(wid * QBLK + r32) * ldq + hi * 16;
#pragma unroll
    for (int d = 0; d < DK / 32; ++d) qi[d] = *reinterpret_cast<const v4i_t*>(Qw8 + d * 32); }
  const bf16_t* Qw = Qb + (long)(wid * QBLK + r32) * ldq + hi * 8;
#pragma unroll
  for (int d0 = 0; d0 < NQR; ++d0) qr[d0] = *reinterpret_cast<const bf16x8*>(Qw + d0 * 16);
  char* qrl = lds + OFF_QR + wid * QR_WAVE + lane * 16;
#pragma unroll
  for (int d0 = NQR; d0 < ND; ++d0) *reinterpret_cast<bf16x8*>(qrl + (d0 - NQR) * 1024) = *reinterpret_cast<const bf16x8*>(Qw + d0 * 16);
  const int sr = tid >> 4, sc = (tid & 15) * 8, vst0 = v_st(sr, sc), vst1 = v_st(32 + sr, sc);
  const int krr = tid >> 3, krc = (tid & 7) * 8;
  const int vb0 = (int)(uintptr_t)V_lds + v_rd_base(lane);
  bf16x8 vs0[SDEPTH], vs1[SDEPTH], ks0[SDEPTH], ks1[SDEPTH], kr0[SDEPTH]; v4i_t k8[SDEPTH], kr8[SDEPTH];
  const int k8off = K8SWZ(krr, tid & 7); const unsigned voffK8 = (unsigned)(krr * ldk + (tid & 7) * 16);
  const int kr8off = KR8SWZ(tid >> 2, tid & 3); const unsigned voffKR8 = (unsigned)((tid >> 2) * 64 + (tid & 3) * 16);
  const unsigned voffV = (unsigned)((sr * ldv + sc) * 2), voffK = (unsigned)((sr * ldk + sc) * 2), voffR = (unsigned)((krr * 64 + krc) * 2);
#define SLOAD(i, k0) do { const char* vb_ = (const char*)Vh + (size_t)(k0) * (ldv * 2); const char* kb_ = (const char*)Kh + (size_t)(k0) * (ldk * 2); \
    vs0[i] = *(const bf16x8*)(vb_ + voffV); vs1[i] = *(const bf16x8*)(vb_ + 32 * ldv * 2 + voffV); \
    if constexpr (QK8) k8[i] = *(const v4i_t*)((const char*)Kh + (size_t)(k0) * ldk + voffK8); \
    else { ks0[i] = *(const bf16x8*)(kb_ + voffK); ks1[i] = *(const bf16x8*)(kb_ + 32 * ldk * 2 + voffK); } \
    if constexpr (DK == 192 && QK8) { if (tid < 256) kr8[i] = *(const v4i_t*)((const char*)Krp + (size_t)(k0) * 64 + voffKR8); } \
    else if constexpr (DK == 192) kr0[i] = *(const bf16x8*)((const char*)Krp + (size_t)(k0) * 128 + voffR); } while (0)
#define SWRITE(b, i) do { *(bf16x8*)(V_lds + (b) * SHM_V + vst0) = vs0[i];          \
    *(bf16x8*)(V_lds + (b) * SHM_V + vst1) = vs1[i]; int kc = sc * 2;               \
    if constexpr (QK8) *(v4i_t*)(K_lds + (b) * SHM_K + k8off) = k8[i];            \
    else { *(bf16x8*)(K_lds + (b) * SHM_K + KSWZ(sr, kc)) = ks0[i];                \
    *(bf16x8*)(K_lds + (b) * SHM_K + KSWZ(32 + sr, kc)) = ks1[i]; }               \
    if constexpr (DK == 192 && QK8) { if (tid < 256) *(v4i_t*)(KR_lds + (b) * SHM_KR + kr8off) = kr8[i]; } \
    else if constexpr (DK == 192) *(bf16x8*)(KR_lds + (b) * SHM_KR + KRSWZ(krr, krc * 2)) = kr0[i]; } while (0)
#define SWAIT() do { if constexpr (SDEPTH == 1) asm volatile("s_waitcnt vmcnt(0)" ::: "memory"); else if constexpr (QK8) asm volatile("s_waitcnt vmcnt(3)" ::: "memory"); else if constexpr (DK == 192) asm volatile("s_waitcnt vmcnt(5)" ::: "memory"); else asm volatile("s_waitcnt vmcnt(4)" ::: "memory"); } while (0)
#define QKT(P0, P1, KB, KRB) do { if constexpr (QK8) qkt8<DK>(P0, P1, KB, KRB, qi, r32, hi); else qkt<DK, (NQR ? NQR : 8)>(P0, P1, KB, KRB, qr, qrl, r32, hi); } while (0)
#define RESC(a) do { if (__any((a) < 1.f)) { if (hi == 0) al_l[r32] = (a); asm volatile("s_waitcnt lgkmcnt(0)" ::: "memory"); \
    _Pragma("unroll") for (int d = 0; d < 4; ++d) _Pragma("unroll") for (int r = 0; r < 16; ++r) o[d][r] *= al_l[crow(r, hi)]; } } while (0)
  f32x16 pA0, pA1, pB0, pB1; float mnA, mnB, alA, alB; bf16x8 pa0, pa1, pa2, pa3; const int NT = seq / KVBLK;
  constexpr int SE = 0, SO = SDEPTH - 1;
  SLOAD(SE, 0); asm volatile("s_waitcnt vmcnt(0)" ::: "memory"); SWRITE(0, SE); __syncthreads();
  QKT(pA0, pA1, K_lds, KR_lds); partialSM(pA0, pA1, m_reg, mnA, alA, C, THRS);
  SLOAD(SO, KVBLK); if constexpr (SDEPTH == 2) { if (2 < NT) SLOAD(SE, 2 * KVBLK); }
  SWAIT(); SWRITE(1, SO); __syncthreads();
  for (int j = 1; j + 1 < NT; j += 2) {
    SBAR(); QKT(pB0, pB1, K_lds + SHM_K, KR_lds + SHM_KR);
    finishSM(pA0, pA1, alA, l_reg, pa0, pa1, pa2, pa3); SBAR();
    SLOAD(SO, (j + SDEPTH) * KVBLK); SBAR();
    pv_d0(o, vb0, pa0, pa1, pa2, pa3); partialSM(pB0, pB1, m_reg, mnB, alB, C, THRS);
    __syncthreads(); SWAIT(); SWRITE(0, SE);
    RESC(alB); __syncthreads();
    SBAR(); QKT(pA0, pA1, K_lds, KR_lds);
    finishSM(pB0, pB1, alB, l_reg, pa0, pa1, pa2, pa3); SBAR();
    if (SDEPTH == 1 || j + 3 < NT) SLOAD(SE, (j + 1 + SDEPTH) * KVBLK); SBAR();
    pv_d0(o, vb0 + SHM_V, pa0, pa1, pa2, pa3); partialSM(pA0, pA1, m_reg, mnA, alA, C, THRS);
    __syncthreads(); SWAIT(); SWRITE(1, SO);
    RESC(alA); __syncthreads();
  }
  SBAR(); QKT(pB0, pB1, K_lds + SHM_K, KR_lds + SHM_KR);
  finishSM(pA0, pA1, alA, l_reg, pa0, pa1, pa2, pa3); SBAR();
  pv_d0(o, vb0, pa0, pa1, pa2, pa3); partialSM(pB0, pB1, m_reg, mnB, alB, C, THRS);
  __syncthreads(); RESC(alB);
  finishSM(pB0, pB1, alB, l_reg, pa0, pa1, pa2, pa3); SBAR();
  pv_d0(o, vb0 + SHM_V, pa0, pa1, pa2, pa3);
  if (hi == 0) li_l[r32] = l_reg; asm volatile("s_waitcnt lgkmcnt(0)" ::: "memory");
  float rli[16];
#pragma unroll
  for (int r = 0; r < 16; ++r) rli[r] = __builtin_amdgcn_rcpf(li_l[crow(r, hi)]);
  bf16_t* Ow = Ob + (long)(wid * QBLK) * ldo;
#pragma unroll
  for (int r = 0; r < 16; ++r) { int orow = crow(r, hi);
#pragma unroll
    for (int d0 = 0; d0 < 4; ++d0) Ow[(long)orow * ldo + d0 * 32 + r32] = f2bf(o[d0][r] * rli[r]); }
#undef QKT
#undef SLOAD
#undef SWRITE
#undef SWAIT
#undef RESC
}
}

struct TrItem { const float* W; bf16_t* WT; int ldw, k0, n0, ldt, drow0, dk0; const float* gain; };
__device__ __forceinline__ void tr_load(f32x4 (&v)[16], const TrItem& t, int lane) {
    const int lr = lane >> 4, lc = (lane & 15) * 4;
#pragma unroll
    for (int i = 0; i < 16; ++i) v[i] = *(const f32x4*)(t.W + (size_t)(t.k0 + 4 * i + lr) * t.ldw + t.n0 + lc);
}
__device__ __forceinline__ void tr_store(const f32x4 (&v)[16], const TrItem& t, LAS float* scr, int lane) {
    const int lr = lane >> 4, lc = (lane & 15) * 4;
#pragma unroll
    for (int i = 0; i < 16; ++i) { LAS float* d = scr + (4 * i + lr) * 65 + lc; const float gk = t.gain ? t.gain[t.k0 + 4 * i + lr] : 1.f;
        d[0] = v[i].x * gk; d[1] = v[i].y * gk; d[2] = v[i].z * gk; d[3] = v[i].w * gk; }
    asm volatile("s_waitcnt lgkmcnt(0)" ::: "memory");
    const int c = lane & 7;
#pragma unroll
    for (int j = 0; j < 8; ++j) { const int n = (lane >> 3) + 8 * j; const LAS float* s = scr + (8 * c) * 65 + n;
        u32x4 o; o.x = cvt_pk_bf16(s[0], s[65]); o.y = cvt_pk_bf16(s[130], s[195]); o.z = cvt_pk_bf16(s[260], s[325]); o.w = cvt_pk_bf16(s[390], s[455]);
        *(u32x4*)(t.WT + (size_t)(t.drow0 + n) * t.ldt + t.dk0 + 8 * c) = o; }
    asm volatile("s_waitcnt lgkmcnt(0)" ::: "memory");
}
__device__ __forceinline__ void tr_item(const float* __restrict__ W, int ldw, int k0, int n0, bf16_t* __restrict__ WT, int ldt, int drow0, int dk0, LAS float* scr, int lane) {
    TrItem t{W, WT, ldw, k0, n0, ldt, drow0, dk0, nullptr}; f32x4 v[16]; tr_load(v, t, lane); tr_store(v, t, scr, lane);
}
__device__ __forceinline__ void rms_row_to_bf16(const float* __restrict__ xrow, const float* __restrict__ g, bf16_t* __restrict__ orow, int lane) {
    f32x4 v[8]; float s = 0.f;
#pragma unroll
    for (int j = 0; j < 8; ++j) { v[j] = *(const f32x4*)(xrow + 4 * lane + 256 * j); s += (v[j].x * v[j].x + v[j].y * v[j].y) + (v[j].z * v[j].z + v[j].w * v[j].w); }
    const float r = 1.0f / sqrtf(wave_sum(s) * (1.f / DM) + EPS);
#pragma unroll
    for (int j = 0; j < 8; ++j) { const f32x4 gg = *(const f32x4*)(g + 4 * lane + 256 * j);
        u32x2 o; o.x = cvt_pk_bf16(v[j].x * r * gg.x, v[j].y * r * gg.y); o.y = cvt_pk_bf16(v[j].z * r * gg.z, v[j].w * r * gg.w);
        *(u32x2*)(orow + 4 * lane + 256 * j) = o; }
}

__device__ __forceinline__ void tr_item8(const float* __restrict__ W, int ldw, int k0, int n0, unsigned char* __restrict__ WT8, int ldt, int drow0, int dk0, LAS float* scr, int lane) {
    const int lr = lane >> 4, lc = (lane & 15) * 4;
    f32x4 v[16];
#pragma unroll
    for (int i = 0; i < 16; ++i) v[i] = *(const f32x4*)(W + (size_t)(k0 + 4 * i + lr) * ldw + n0 + lc);
#pragma unroll
    for (int i = 0; i < 16; ++i) { LAS float* d = scr + (4 * i + lr) * 65 + lc; d[0] = v[i].x * Q8_SW; d[1] = v[i].y * Q8_SW; d[2] = v[i].z * Q8_SW; d[3] = v[i].w * Q8_SW; }
    asm volatile("s_waitcnt lgkmcnt(0)" ::: "memory");
    const int c = lane & 7;
#pragma unroll
    for (int j = 0; j < 8; ++j) { const int n = (lane >> 3) + 8 * j; const LAS float* s = scr + (8 * c) * 65 + n;
        u32x2 o; o.x = q8x4(s[0], s[65], s[130], s[195]); o.y = q8x4(s[260], s[325], s[390], s[455]);
        *(u32x2*)(WT8 + (size_t)(drow0 + n) * ldt + dk0 + 8 * c) = o; }
    asm volatile("s_waitcnt lgkmcnt(0)" ::: "memory");
}
__device__ __forceinline__ void rms_row_to_i8(const float* __restrict__ xrow, const float* __restrict__ g, unsigned char* __restrict__ orow, int lane) {
    f32x4 v[8]; float s = 0.f;
#pragma unroll
    for (int j = 0; j < 8; ++j) { v[j] = *(const f32x4*)(xrow + 4 * lane + 256 * j); s += (v[j].x * v[j].x + v[j].y * v[j].y) + (v[j].z * v[j].z + v[j].w * v[j].w); }
    const float r = Q8_SU / sqrtf(wave_sum(s) * (1.f / DM) + EPS);
#pragma unroll
    for (int j = 0; j < 8; ++j) { const f32x4 gg = *(const f32x4*)(g + 4 * lane + 256 * j);
        *(unsigned*)(orow + 4 * lane + 256 * j) = q8x4(v[j].x * r * gg.x, v[j].y * r * gg.y, v[j].z * r * gg.z, v[j].w * r * gg.w); }
}

#define XB_TMO      128
#define XB_XCNT(j)  (256  + 64 * (j))
#define XB_XSUB(j)  (1280 + 64 * (j))
#define XB_XGEN(j)  (2304 + 64 * (j))
#define XB_TOP      3328
#define XB_TOPGEN   3392
#define XCD_BAR_WORDS 3456
#define XB_SPIN_CAP (1u << 18)
__device__ __forceinline__ unsigned xb_ld(unsigned* p)              { return __hip_atomic_load(p, __ATOMIC_RELAXED, __HIP_MEMORY_SCOPE_AGENT); }
__device__ __forceinline__ unsigned xb_add(unsigned* p, unsigned v) { return __hip_atomic_fetch_add(p, v, __ATOMIC_RELAXED, __HIP_MEMORY_SCOPE_AGENT); }
__device__ __forceinline__ unsigned xb_xcc_id() { return (unsigned)__builtin_amdgcn_s_getreg((3 << 11) | 20) & 0xFu; }
#define XB_SPIN(cond, bar) do { unsigned _sp = 0; while (cond) { __builtin_amdgcn_s_sleep(1); \
    if ((++_sp & 255u) == 0u) { if (xb_ld(&(bar)[XB_TMO])) break; if (_sp > XB_SPIN_CAP) { atomicAdd(&(bar)[XB_TMO], 1u); break; } } } } while (0)
struct XcdBarrier { unsigned* bar; unsigned x; volatile LAS unsigned* st; };
__device__ __forceinline__ XcdBarrier xcd_barrier_post(unsigned* bar, volatile LAS unsigned* st) {
    XcdBarrier b; b.bar = bar; b.x = xb_xcc_id(); b.st = st;
    if (threadIdx.x == 0) (void)xb_add(&bar[XB_XCNT(b.x)], 1u);
    return b;
}
__device__ __forceinline__ void xcd_barrier_complete(unsigned* bar, unsigned x, unsigned& nloc, unsigned& nx) {
    const unsigned G = gridDim.x * gridDim.y * gridDim.z;
    unsigned sum, cnt, mine, sp = 0u;
    for (;;) {
        sum = 0u; cnt = 0u; mine = 0u;
#pragma unroll
        for (unsigned j = 0; j < 16; ++j) { const unsigned c = xb_ld(&bar[XB_XCNT(j)]); sum += c; cnt += (c > 0u) ? 1u : 0u; mine = (j == x) ? c : mine; }
        if (sum == G) break;
        __builtin_amdgcn_s_sleep(1);
        if ((++sp & 255u) == 0u) { if (xb_ld(&bar[XB_TMO])) break; if (sp > XB_SPIN_CAP) { atomicAdd(&bar[XB_TMO], 1u); break; } }
    }
    nloc = mine > 0u ? mine : 1u; nx = cnt > 0u ? cnt : 1u;
}
__device__ __forceinline__ void xcd_barrier(const XcdBarrier& b) {
    asm volatile("s_waitcnt vmcnt(0)" ::: "memory");
    __syncthreads();
    if (threadIdx.x == 0) {
        unsigned* bar = b.bar;
        __builtin_amdgcn_s_waitcnt(0);
        unsigned nloc = b.st[0], nx = b.st[1];
        if (nloc == 0u) { xcd_barrier_complete(bar, b.x, nloc, nx); b.st[0] = nloc; b.st[1] = nx; }
        const unsigned old = xb_add(&bar[XB_XSUB(b.x)], 1u);
        const unsigned gen = old / nloc;
        if (old + 1u == (gen + 1u) * nloc) {
            __builtin_amdgcn_fence(__ATOMIC_RELEASE, "agent");
            asm volatile("s_waitcnt vmcnt(0)" ::: "memory");
            const unsigned og = xb_add(&bar[XB_TOP], 1u);
            const unsigned tg = og / nx;
            if (og + 1u == (tg + 1u) * nx) xb_add(&bar[XB_TOPGEN], 1u);
            else XB_SPIN(xb_ld(&bar[XB_TOPGEN]) == tg, bar);
            __builtin_amdgcn_fence(__ATOMIC_ACQUIRE, "agent");
            xb_add(&bar[XB_XGEN(b.x)], 1u);
            asm volatile("s_waitcnt vmcnt(0)" ::: "memory");
        } else {
            XB_SPIN(xb_ld(&bar[XB_XGEN(b.x)]) == gen, bar);
            __builtin_amdgcn_fence(__ATOMIC_ACQUIRE, "agent");
            asm volatile("s_waitcnt vmcnt(0)" ::: "memory");
        }
    }
    __syncthreads();
}

struct Args {
    const float *x, *p, *g_mix, *w_in, *q_norm_a, *k_norm_a, *q_a_norm, *w_q_b, *kv_a_norm, *w_kv_b, *w_a_out, *w_b_out, *w_o, *g_ffn, *w_gate_up, *w_down, *g_ple,
                *w_ple_gate, *w_ple_proj, *g_ple_post, *g_final;
    float* out; unsigned char* ws; int ph_lo, ph_hi;
};

constexpr int NPHASE = 14;

__global__ void __launch_bounds__(NTHREADS, 2) mk_fwd(Args a) {
    extern __shared__ __attribute__((aligned(16))) unsigned char lds_raw[];
    LAS unsigned char* lds = (LAS unsigned char*)lds_raw;
    const int tid = threadIdx.x, lane = tid & 63, wave = __builtin_amdgcn_readfirstlane(tid >> 6);
    const int G = gridDim.x, bx = blockIdx.x;
    const int gw = bx * NWAVES + wave, NGW = G * NWAVES;
    unsigned char* ws = a.ws;
    bf16_t* WinT = (bf16_t*)(ws + WS_WIN); bf16_t* WqbT = (bf16_t*)(ws + WS_WQB); bf16_t* WkvbT = (bf16_t*)(ws + WS_WKVB); bf16_t* WabT = (bf16_t*)(ws + WS_WAB);
    bf16_t* WoT = (bf16_t*)(ws + WS_WO); bf16_t* WguT = (bf16_t*)(ws + WS_WGU); bf16_t* WdT = (bf16_t*)(ws + WS_WD); bf16_t* WpgT = (bf16_t*)(ws + WS_WPG);
    bf16_t* WppT = (bf16_t*)(ws + WS_WPP); bf16_t* PB = (bf16_t*)(ws + WS_PB); bf16_t* KR = (bf16_t*)(ws + WS_KR); bf16_t* U = (bf16_t*)(ws + WS_U);
    bf16_t* ZS = (bf16_t*)(ws + WS_ZS); bf16_t* SG = (bf16_t*)(ws + WS_SG); bf16_t* QA = (bf16_t*)(ws + WS_QA); bf16_t* QB = (bf16_t*)(ws + WS_QB);
    bf16_t* KVB = (bf16_t*)(ws + WS_KVB); bf16_t* CQN = (bf16_t*)(ws + WS_CQN); bf16_t* CKVN = (bf16_t*)(ws + WS_CKVN); bf16_t* KA = (bf16_t*)(ws + WS_KA);
    bf16_t* KPE = (bf16_t*)(ws + WS_KPE); bf16_t* OAB = (bf16_t*)(ws + WS_OAB); bf16_t* MERGED = (bf16_t*)(ws + WS_MERGED); bf16_t* ACT = (bf16_t*)(ws + WS_ACT);
    bf16_t* GATE = (bf16_t*)(ws + WS_GATE); bf16_t* ERAW = (bf16_t*)(ws + WS_ERAW); float* H = a.out;
    unsigned char* KN8 = ws + WS_KVB; bf16_t* VB = (bf16_t*)(ws + WS_KVB + 8 * MiB);
    float* SSQC = (float*)(ws + 196608); float* SSQK = (float*)(ws + 229376);
    float* SSQ1 = (float*)(ws + 65536); float* SSQ2 = (float*)(ws + 131072);
    const int lo = a.ph_lo, hi = a.ph_hi;
#define IN(k) (lo <= (k) && (k) < hi)
#define SEAM(k) do { if (IN(k) && IN((k) + 1)) { xcd_barrier(xbar); } } while (0)
    volatile LAS unsigned* xst = (volatile LAS unsigned*)(lds + LDS_BYTES - 64);
    if (tid == 0) { xst[0] = 0u; xst[1] = 0u; }
    __syncthreads();
    XcdBarrier xbar = xcd_barrier_post((unsigned*)ws, xst);
    if (a.ph_lo < 0) cg::this_grid().sync();

    constexpr int I0 = 32 * 105, I1 = 8 * 24, I2 = 8 * 32, I3 = 16 * 32, I4 = 16 * 32, I5 = 32 * 32, I6 = 32 * 176, I7 = 88 * 32, I8 = 32 * 32, I9 = 4 * 32;
    constexpr int NREST = I1 + I2 + I3 + I4 + I5 + I6 + I7 + I8 + I9;
    if (IN(0)) {
        LAS float* scr = (LAS float*)(lds + wave * 16640);
        for (int it = gw; it < I0; it += NGW) {
            const int kb = it / 105, nb = it % 105, n0 = nb * 64; const int dr = n0 < 2560 ? n0 : (n0 < 2624 ? 6656 + (n0 - 2560) : n0 - 64);
            tr_item8(a.w_in, NIN, kb * 64, n0, (unsigned char*)WinT, 2048, dr, kb * 64, scr, lane);
        }
        for (int m = gw; m < M; m += NGW) {
            rms_row_to_i8(a.x + (size_t)m * DM, a.g_mix, (unsigned char*)U + (size_t)m * DM, lane);
            const f32x4 pv = *(const f32x4*)(a.p + (size_t)m * PLE + 4 * lane);
            u32x2 o; o.x = cvt_pk_bf16(pv.x, pv.y); o.y = cvt_pk_bf16(pv.z, pv.w);
            *(u32x2*)(PB + (size_t)m * PLE + 4 * lane) = o;
        }
        for (int i = bx * NTHREADS + tid; i < (NINP - NIN) * 2048 / 16; i += G * NTHREADS) *(u32x4*)((unsigned char*)WinT + (size_t)NIN * 2048 + (size_t)i * 16) = (u32x4){0u, 0u, 0u, 0u};
        __syncthreads();
    }
    SEAM(0);
    if (IN(1)) {
        constexpr int NU = (M / 256) * (NINP / 256);
        const int GG = (G >= 256) ? 173 : G;
        if (bx < GG) {
            pg8::Gemm g{U, WinT, M, NINP, DM / 2, DM / 2, 0}; pg8::StaticOrder S; S.init(M, NINP, GG, bx);
            pg8::EpiIn E{ZS, SG, KR, SSQC, SSQK};
            pg8::gemm_phase<pg8::EpiIn, pg8::StaticOrder, true, true, false, true>(lds, g, S, E);
        }
        {
            {
                LAS float* scr = (LAS float*)(lds + wave * 16640);
                unsigned* qctr = (unsigned*)(ws + 262144);
                auto decode = [&](int r) -> TrItem {
                    if (r < I1) { const int kb = r / 24, nb = r % 24; return TrItem{a.w_q_b, WqbT, 1536, kb * 64, nb * 64, 512, nb * 64, kb * 64, a.q_a_norm}; } r -= I1;
                    if (r < I2) { const int kb = r / 32, nb = r % 32; return TrItem{a.w_kv_b, WkvbT, 2048, kb * 64, nb * 64, 512, nb * 64, kb * 64, a.kv_a_norm}; } r -= I2;
                    if (r < I3) { const int kb = r / 32, nb = r % 32; return TrItem{a.w_a_out, WabT, 2048, kb * 64, nb * 64, 2048, nb * 64, kb * 64, nullptr}; } r -= I3;
                    if (r < I4) { const int kb = r / 32, nb = r % 32; return TrItem{a.w_b_out, WabT, 2048, kb * 64, nb * 64, 2048, nb * 64, 1024 + kb * 64, nullptr}; } r -= I4;
                    if (r < I5) { const int kb = r / 32, nb = r % 32; return TrItem{a.w_o, WoT, 2048, kb * 64, nb * 64, 2048, nb * 64, kb * 64, nullptr}; } r -= I5;
                    if (r < I6) { const int kb = r / 176, nb = r % 176, n0 = nb * 64; const int s_ = n0 >= DFF ? 1 : 0, j = n0 - s_ * DFF; const int dr = 256 * (j >> 7) + 128 * s_ + (j & 127);
                        return TrItem{a.w_gate_up, WguT, 2 * DFF, kb * 64, n0, 2048, dr, kb * 64, a.g_ffn}; } r -= I6;
                    if (r < I7) { const int kb = r / 32, nb = r % 32; return TrItem{a.w_down, WdT, 2048, kb * 64, nb * 64, DFF, nb * 64, kb * 64, nullptr}; } r -= I7;
                    if (r < I8) { const int kb = r / 32, nb = r % 32; return TrItem{a.w_ple_gate, WpgT, 2048, kb * 64, nb * 64, 2048, nb * 64, kb * 64, a.g_ple}; } r -= I8;
                    { const int kb = r / 32, nb = r % 32; return TrItem{a.w_ple_proj, WppT, 2048, kb * 64, nb * 64, 256, nb * 64, kb * 64, nullptr}; }
                };
                auto ticket = [&]() -> unsigned { unsigned v = 0u; if (lane == 0) v = __hip_atomic_fetch_add((__attribute__((address_space(1))) unsigned*)qctr, 2u, __ATOMIC_RELAXED, __HIP_MEMORY_SCOPE_AGENT); return v; };
                f32x4 va[16], vb[16]; TrItem ta{}, tb{};
                unsigned tk = ticket();
                int base = (int)__builtin_amdgcn_readfirstlane(tk);
                if (base < NREST) { ta = decode(base); tr_load(va, ta, lane); }
                while (base < NREST) {
                    tk = ticket();
                    const bool two = base + 1 < NREST;
                    if (two) { tb = decode(base + 1); tr_load(vb, tb, lane); }
                    tr_store(va, ta, scr, lane);
                    const int nbase = (int)__builtin_amdgcn_readfirstlane(tk);
                    if (nbase < NREST) { ta = decode(nbase); tr_load(va, ta, lane); }
                    if (two) tr_store(vb, tb, scr, lane);
                    base = nbase;
                }
            }
            __syncthreads();
        }
        (void)NU;
    }
    SEAM(1);
    if (IN(2)) {
        const int l5 = lane & 31, hsel = lane >> 5, d0 = l5 * 4, isx2 = (l5 >> 3) & 1, halfc = (l5 >> 4) & 1;
        float invA4[4]; f32x4 gq, gk;
#pragma unroll
        for (int i = 0; i < 4; ++i) invA4[i] = powf(10000.f, -(float)(2 * ((d0 & 31) + i)) / 64.f);
        gq = *(const f32x4*)(a.q_norm_a + d0); gk = *(const f32x4*)(a.k_norm_a + d0);
        const int hfb = (lane >> 4) & 1, jb = lane & 15;
        const float invB = powf(10000.f, -(float)(2 * jb) / 32.f);
        const bool even256 = (G == 256);
        const int rbase = even256 ? (bx < 192 ? bx * 24 : 4608 + (bx - 192) * 56) : 0, rcnt = even256 ? (bx < 192 ? 24 : 56) : 0;
        for (int mi = wave, m = even256 ? rbase + wave : gw; even256 ? (mi < rcnt) : (m < M); mi += NWAVES, m += even256 ? NWAVES : NGW) {
            const int s = m & (SEQ - 1); const float prow = (float)(s >> 6), pcol = (float)(s & 63);
            const float posA = halfc ? pcol : prow; float cA[4], sA[4];
#pragma unroll
            for (int i = 0; i < 4; ++i) { const float ang = posA * invA4[i]; cA[i] = cosf(ang); sA[i] = sinf(ang); }
            const bf16_t* zr = ZS + (size_t)m * 2560;
#pragma unroll
            for (int it = 0; it < 5; ++it) {
                const int head = 2 * it + hsel;
                const u32x2 w = *(const u32x2*)(zr + head * 128 + d0);
                const float x[4] = {bf_lo(w.x), bf_hi(w.x), bf_lo(w.y), bf_hi(w.y)};
                float ss = (x[0] * x[0] + x[1] * x[1]) + (x[2] * x[2] + x[3] * x[3]);
#pragma unroll
                for (int o2 = 1; o2 < 32; o2 <<= 1) ss += __shfl_xor(ss, o2);
                const float r = 1.0f / sqrtf(ss * (1.f / 128.f) + EPS);
                const f32x4 g = (it < 4) ? gq : gk; float o[4];
#pragma unroll
                for (int i = 0; i < 4; ++i) { const float y = x[i] * r * g[i]; const float p = __shfl_xor(y, 8);
                    o[i] = isx2 ? (y * cA[i] + p * sA[i]) : (y * cA[i] - p * sA[i]); }
                unsigned char* dst = (it < 4) ? ((unsigned char*)QA + (size_t)m * 1024 + head * 128 + d0) : ((unsigned char*)KA + (size_t)m * 256 + (head - 8) * 128 + d0);
                *(unsigned*)dst = q8x4(o[0] * att::ATT_SQK, o[1] * att::ATT_SQK, o[2] * att::ATT_SQK, o[3] * att::ATT_SQK);
            }
            if (lane < 32) {
                const float angB = (hfb ? pcol : prow) * invB; const float cB = cosf(angB), sB = sinf(angB);
                const bf16_t* kr = KR + (size_t)m * 64 + hfb * 32 + jb;
                const float x1 = bf1(kr[0]), x2 = bf1(kr[16]);
                bf16_t* dst = KPE + (size_t)m * 64 + hfb * 32 + jb;
                unsigned char* d8 = (unsigned char*)KPE + (size_t)m * 64 + hfb * 32 + jb;
                d8[0] = (unsigned char)q8((x1 * cB - x2 * sB) * QKSB); d8[16] = (unsigned char)q8((x2 * cB + x1 * sB) * QKSB); (void)dst;
            }
        }
    }
    if (IN(3)) {
        { pg8::Gemm g{ZS + 1536, WqbT, M, 1536, 512, 512, 0, 2560}; pg8::StaticOrder S; S.init(M, 1536, G, bx); pg8::EpiQB E{QB, SSQC};
          pg8::gemm_phase<pg8::EpiQB, pg8::StaticOrder, true, true, false>(lds, g, S, E); }
        { pg8::Gemm g{ZS + 2048, WkvbT, M, 2048, 512, 512, 0, 2560}; pg8::StaticOrder S; S.init(M, 2048, G, bx); pg8::EpiKV E{KN8, VB, SSQK};
          pg8::gemm_phase<pg8::EpiKV, pg8::StaticOrder, true, true, false>(lds, g, S, E); }
    }
    SEAM(3);
    if (IN(5)) {
        char* lds_g = (char*)lds_raw;
        const int x = bx & 7, i = bx >> 3;
        for (int c = bx; c < 256; c += G) {
            const int xx = c & 7, ii = c >> 3;
            {
                const int combo = xx >> 1, w = (xx & 1) * 32 + ii, b = combo >> 1, kvh = combo & 1, hq = kvh * 4 + (w >> 4), qb = w & 15;
                const size_t row0 = (size_t)b * SEQ;
                __syncthreads();
                att::attn_unit<128, ATT_SD_A, 1024, 256, 2560, 2048, SEQ, true>((const bf16_t*)((const unsigned char*)QA + (row0 + qb * 256) * 1024 + hq * 128), (const bf16_t*)((const unsigned char*)KA + row0 * 256 + kvh * 128), nullptr,
                                    ZS + row0 * 2560 + 1280 + kvh * 128, OAB + (row0 + qb * 256) * 2048 + hq * 128, lds_g);
            }
            {
                const int unit = xx * 32 + ii, bh = unit >> 4, qb = unit & 15, b = bh >> 3, h = bh & 7;
                const size_t row0 = (size_t)b * SEQ;
                __syncthreads();
                att::attn_unit<192, ATT_SD_B, 1536, 1024, 1024, 2048, SEQ, true>((const bf16_t*)((const unsigned char*)QB + (row0 + qb * 256) * 1536 + h * 192), (const bf16_t*)(KN8 + row0 * 1024 + h * 128), (const bf16_t*)((const unsigned char*)KPE + row0 * 64),
                                    VB + row0 * 1024 + h * 128, OAB + (row0 + qb * 256) * 2048 + 1024 + h * 128, lds_g);
            }
        }
        (void)x; (void)i;
        __syncthreads();
    }
    SEAM(5);
    if (IN(6)) {
        bf16_t* T1 = (bf16_t*)(ws + WS_T1);
        { pg8::Gemm g{OAB, WabT, M, 2048, 1024, 2048, 0}; pg8::StaticOrder S; S.init(M, 2048, G, bx); pg8::EpiGate<false> E{SG, T1, MERGED};
          pg8::gemm_phase<pg8::EpiGate<false>, pg8::StaticOrder, true, true, false>(lds, g, S, E); }
        { pg8::Gemm g{OAB + 1024, WabT + 1024, M, 2048, 1024, 2048, 0}; pg8::StaticOrder S; S.init(M, 2048, G, bx); pg8::EpiGate<true> E{SG, T1, MERGED};
          pg8::gemm_phase<pg8::EpiGate<true>, pg8::StaticOrder, true, true, false>(lds, g, S, E); }
    }
    SEAM(6);
    if (IN(7)) {
        pg8::Gemm g{MERGED, WoT, M, 2048, 2048, 2048, 0}; pg8::StaticOrder S; S.init(M, 2048, G, bx); pg8::EpiResid<false> E{a.x, nullptr, U, SSQ1};
        pg8::gemm_phase<pg8::EpiResid<false>, pg8::StaticOrder, true, true, false>(lds, g, S, E);
    }
    SEAM(7);
    if (IN(9)) {
        pg8::Gemm g{U, WguT, M, 2 * DFF, DM, DM, 0}; pg8::StaticOrder S; S.init(M, 2 * DFF, G, bx); pg8::EpiSwiglu E{ACT, SSQ1};
        pg8::gemm_phase<pg8::EpiSwiglu, pg8::StaticOrder, true, true, false>(lds, g, S, E);
        {
            constexpr int NU = (M / 256) * (2 * DFF / 256);
            const int nr = (NU + G - 1) / G, nbusy = NU - (nr - 1) * G; int idx = bx - nbusy, cnt = G - nbusy; if (cnt < 32) { idx = bx; cnt = G; }
            if (idx >= 0) { pg8::Gemm g2{PB, WppT, M, 2048, PLE, PLE, 0}; pg8::StaticOrder S2; S2.init(M, 2048, cnt, idx); pg8::EpiBf16<0> E2{ERAW, 2048, nullptr, 0.f};
                pg8::gemm_phase<pg8::EpiBf16<0>, pg8::StaticOrder, false, true, false>(lds, g2, S2, E2); }
        }
    }
    SEAM(9);
    if (IN(10)) {
        pg8::Gemm g{ACT, WdT, M, 2048, DFF, DFF, 0}; pg8::StaticOrder S; S.init(M, 2048, G, bx); pg8::EpiResid<true> E{nullptr, U, U, SSQ2};
        pg8::gemm_phase<pg8::EpiResid<true>, pg8::StaticOrder, true, true, false>(lds, g, S, E);
    }
    SEAM(10);
    if (IN(12)) {
        { pg8::Gemm g{U, WpgT, M, 2048, DM, DM, 0}; pg8::StaticOrder S; S.init(M, 2048, G, bx); pg8::EpiBf16<1> E{GATE, 2048, SSQ2, 1.f / DM};
          pg8::gemm_phase<pg8::EpiBf16<1>, pg8::StaticOrder, true, true, false>(lds, g, S, E); }
    }
    SEAM(12);
    if (IN(13)) {
        u32x2 nh[8], ne[8], ng[8];
        int m = gw;
        if (m < M) {
#pragma unroll
            for (int j = 0; j < 8; ++j) { const size_t o = (size_t)m * DM + 4 * lane + 256 * j; nh[j] = *(const u32x2*)(U + o); ne[j] = *(const u32x2*)(ERAW + o); ng[j] = *(const u32x2*)(GATE + o); }
        }
        for (; m < M; m += NGW) {
            f32x4 h[8], e[8]; u32x2 gtw[8]; float se = 0.f;
#pragma unroll
            for (int j = 0; j < 8; ++j) { h[j] = (f32x4){bf_lo(nh[j].x), bf_hi(nh[j].x), bf_lo(nh[j].y), bf_hi(nh[j].y)}; e[j] = (f32x4){bf_lo(ne[j].x), bf_hi(ne[j].x), bf_lo(ne[j].y), bf_hi(ne[j].y)}; gtw[j] = ng[j];
                se += (e[j].x * e[j].x + e[j].y * e[j].y) + (e[j].z * e[j].z + e[j].w * e[j].w); }
            const int m2 = m + NGW;
            if (m2 < M) {
#pragma unroll
                for (int j = 0; j < 8; ++j) { const size_t o = (size_t)m2 * DM + 4 * lane + 256 * j; nh[j] = *(const u32x2*)(U + o); ne[j] = *(const u32x2*)(ERAW + o); ng[j] = *(const u32x2*)(GATE + o); }
            }
            const float re = 1.0f / sqrtf(wave_sum(se) * (1.f / DM) + EPS);
            float sh = 0.f;
#pragma unroll
            for (int j = 0; j < 8; ++j) { const u32x2 gt = gtw[j];
                const f32x4 gp = *(const f32x4*)(a.g_ple_post + 4 * lane + 256 * j);
                h[j].x += bf_lo(gt.x) * (e[j].x * re * gp.x); h[j].y += bf_hi(gt.x) * (e[j].y * re * gp.y);
                h[j].z += bf_lo(gt.y) * (e[j].z * re * gp.z); h[j].w += bf_hi(gt.y) * (e[j].w * re * gp.w);
                sh += (h[j].x * h[j].x + h[j].y * h[j].y) + (h[j].z * h[j].z + h[j].w * h[j].w); }
            const float rh = 1.0f / sqrtf(wave_sum(sh) * (1.f / DM) + EPS);
#pragma unroll
            for (int j = 0; j < 8; ++j) { const f32x4 gf = *(const f32x4*)(a.g_final + 4 * lane + 256 * j);
                f32x4 o; o.x = h[j].x * rh * gf.x; o.y = h[j].y * rh * gf.y; o.z = h[j].z * rh * gf.z; o.w = h[j].w * rh * gf.w;
                *(f32x4*)(a.out + (size_t)m * DM + 4 * lane + 256 * j) = o;
            }
        }
    }
#undef IN
#undef SEAM
}

extern "C" void kernel_launch(void* const* d_in, const int* in_sizes, int n_in, void* d_out, int out_size, void* d_ws, size_t ws_size, hipStream_t stream) {
    static int grid = 0;
    if (grid == 0) {
        if (n_in != 21 || in_sizes[0] != M * DM || out_size != M * DM || ws_size < WS_END) {
            fprintf(stderr, "kernel_launch: unexpected shapes: n_in %d in0 %d out %d ws %zu (need %zu)\n", n_in, n_in > 0 ? in_sizes[0] : -1, out_size, ws_size, (size_t)WS_END); grid = -1; return; }
        int dev = 0, cus = 0, per_cu = 0;
        if (hipGetDevice(&dev) != hipSuccess || hipDeviceGetAttribute(&cus, hipDeviceAttributeMultiprocessorCount, dev) != hipSuccess) { grid = -1; return; }
        if (hipFuncSetAttribute((const void*)mk_fwd, hipFuncAttributeMaxDynamicSharedMemorySize, LDS_BYTES) != hipSuccess) { fprintf(stderr, "kernel_launch: hipFuncSetAttribute failed\n"); grid = -1; return; }
        if (hipOccupancyMaxActiveBlocksPerMultiprocessor(&per_cu, (const void*)mk_fwd, NTHREADS, LDS_BYTES) != hipSuccess || per_cu < 1) { fprintf(stderr, "kernel_launch: occupancy query says %d\n", per_cu); per_cu = 1; }
        (void)hipGetLastError();
        grid = cus * 1;
    }
    if (grid < 0) return;
    Args a{};
    const float** f = (const float**)&a;
    for (int i = 0; i < 21; ++i) f[i] = (const float*)d_in[i];
    a.out = (float*)d_out; a.ws = (unsigned char*)d_ws;
#if MK_ONE_LAUNCH
    if (hipMemsetAsync(d_ws, 0, 262144 + 256, stream) != hipSuccess) { fprintf(stderr, "kernel_launch: memset failed\n"); return; }
    a.ph_lo = 0; a.ph_hi = NPHASE;
    void* args[] = {&a};
    hipError_t e = hipLaunchCooperativeKernel((const void*)mk_fwd, dim3(grid), dim3(NTHREADS), args, LDS_BYTES, stream);
    if (e != hipSuccess) fprintf(stderr, "kernel_launch: cooperative launch failed: %s (grid %d)\n", hipGetErrorString(e), grid);
#else
    for (int ph = 0; ph < NPHASE; ++ph) {
        a.ph_lo = ph; a.ph_hi = ph + 1;
        hipLaunchKernelGGL(mk_fwd, dim3(grid), dim3(NTHREADS), LDS_BYTES, stream, a);
    }
#endif
}
```
